# Optimizing an MI355X kernel written in HIP

```python
import math
import jax, jax.numpy as jnp
from jax import lax
import numpy as np

D_MODEL = 1024
BATCH = 2
SEQ = 16384
DEPTH = 2

N_MIXERS = 2
N_MLA_LAYERS = (DEPTH + 1) // N_MIXERS
N_HYENA_LAYERS = DEPTH // N_MIXERS

MLA_HEADS = 8
QK_NOPE_DIM = 128
QK_ROPE_DIM = 64
V_HEAD_DIM = 128
Q_LORA_RANK = 384
KV_LORA_RANK = 256
MLA_IN_DIM = Q_LORA_RANK + KV_LORA_RANK + QK_ROPE_DIM
ROPE_THETA = 10000.0
Q_BLOCK = 128

HYENA_ORDER = 2
HYENA_EMB_DIM = 33
HYENA_FILTER_WIDTH = 64
HYENA_FAST_DECAY = 0.3
HYENA_SLOW_DECAY = 1.5
HYENA_TARGET = 1e-2
SHORT_CONV_WIDTH = 3

D_FF = 2816
FFN_CONV_WIDTH = 3

NORM_EPS = 1e-5
RMS_EPS = 1e-6
DEEPNORM_ALPHA = (2.0 * DEPTH) ** 0.25
DEEPNORM_BETA = (8.0 * DEPTH) ** -0.25

kernel_name = "hybrid_mla_hyena_convffn_deepnorm"


def layer_norm(x, g, b):
    xf = x.astype(jnp.float32)
    mu = jnp.mean(xf, -1, keepdims=True)
    var = jnp.mean(jnp.square(xf - mu), -1, keepdims=True)
    return ((xf - mu) * lax.rsqrt(var + NORM_EPS) * g.astype(jnp.float32) + b.astype(jnp.float32)).astype(x.dtype)


def rms_norm(x, g):
    xf = x.astype(jnp.float32)
    ms = jnp.mean(jnp.square(xf), -1, keepdims=True)
    return (xf * lax.rsqrt(ms + RMS_EPS) * g.astype(jnp.float32)).astype(x.dtype)


def dwconv_centred(x, w):
    k_width = w.shape[0]
    pad = k_width // 2
    s = x.shape[1]
    xp = jnp.pad(x, ((0, 0), (pad, pad), (0, 0)))
    return sum(xp[:, k:k + s] * w[k] for k in range(k_width))


def rope_tables(positions):
    inv = 1.0 / (ROPE_THETA ** (jnp.arange(0, QK_ROPE_DIM, 2, dtype=jnp.float32) / QK_ROPE_DIM))
    ang = positions.astype(jnp.float32)[..., None] * inv
    return jnp.cos(ang), jnp.sin(ang)


def apply_rope(x, cos, sin):
    x1, x2 = jnp.split(x.astype(jnp.float32), 2, axis=-1)
    return jnp.concatenate([x1 * cos - x2 * sin, x1 * sin + x2 * cos], -1).astype(x.dtype)


def mla_mixer(x, cos, sin, w_in, g_q, w_uq, g_kv, w_ukv, w_o):
    b, s, _ = x.shape
    h = x @ w_in
    c_q, c_kv, k_rope = jnp.split(h, [Q_LORA_RANK, Q_LORA_RANK + KV_LORA_RANK], axis=-1)
    q = (rms_norm(c_q, g_q) @ w_uq).reshape(b, s, MLA_HEADS, QK_NOPE_DIM + QK_ROPE_DIM)
    q_nope = q[..., :QK_NOPE_DIM]
    q_rope = apply_rope(q[..., QK_NOPE_DIM:], cos[:, :, None], sin[:, :, None])
    k_rope = apply_rope(k_rope, cos, sin)
    kv = (rms_norm(c_kv, g_kv) @ w_ukv).reshape(b, s, MLA_HEADS, QK_NOPE_DIM + V_HEAD_DIM)
    k_nope, v = kv[..., :QK_NOPE_DIM], kv[..., QK_NOPE_DIM:]
    scale = (QK_NOPE_DIM + QK_ROPE_DIM) ** -0.5
    nb = s // Q_BLOCK
    qn_blocks = q_nope.reshape(b, nb, Q_BLOCK, MLA_HEADS, QK_NOPE_DIM).transpose(1, 0, 2, 3, 4)
    qr_blocks = q_rope.reshape(b, nb, Q_BLOCK, MLA_HEADS, QK_ROPE_DIM).transpose(1, 0, 2, 3, 4)

    def attend(blk):
        qn, qr = blk
        sc = (jnp.einsum('bqhd,bkhd->bhqk', qn, k_nope)
              + jnp.einsum('bqhr,bkr->bhqk', qr, k_rope))
        p = jax.nn.softmax(sc.astype(jnp.float32) * scale, axis=-1).astype(v.dtype)
        return jnp.einsum('bhqk,bkhd->bqhd', p, v)

    o = lax.map(attend, (qn_blocks, qr_blocks))
    o = o.transpose(1, 0, 2, 3, 4).reshape(b, s, MLA_HEADS * V_HEAD_DIM)
    return o @ w_o


def hyena_positional_features(length):
    t = jnp.linspace(0.0, 1.0, length, dtype=jnp.float32)[:, None]
    bands = (HYENA_EMB_DIM - 1) // 2
    w = 2.0 * math.pi * jnp.arange(length, dtype=jnp.float32)[:, None] / length
    f = jnp.linspace(1e-4, bands - 1, bands, dtype=jnp.float32)[None, :]
    z = jnp.concatenate([t, jnp.cos(f * w), -jnp.sin(f * w)], axis=-1)
    return t, z


def hyena_filters(length, fw1, fb1, fw2, fb2, fw3, fb3, freq, fw_out):
    t, z = hyena_positional_features(length)
    freq = freq.astype(jnp.float32)
    h = jnp.sin(freq * (z @ fw1.astype(jnp.float32) + fb1.astype(jnp.float32)))
    h = jnp.sin(freq * (h @ fw2.astype(jnp.float32) + fb2.astype(jnp.float32)))
    h = jnp.sin(freq * (h @ fw3.astype(jnp.float32) + fb3.astype(jnp.float32)))
    h = h @ fw_out.astype(jnp.float32)
    deltas = jnp.abs(jnp.linspace(math.log(HYENA_FAST_DECAY) / HYENA_TARGET,
                                  math.log(HYENA_SLOW_DECAY) / HYENA_TARGET,
                                  D_MODEL, dtype=jnp.float32))
    decay = jnp.exp(-t * deltas)
    return h.reshape(length, HYENA_ORDER, 2, D_MODEL) * decay[:, None, None, :]


def two_sided_kernel(h_fwd, h_bwd):
    zero = jnp.zeros_like(h_fwd[:1])
    return jnp.concatenate([h_fwd.at[0].add(h_bwd[0]), zero, h_bwd[:0:-1]], axis=0)


def hyena_mixer(x, w_in, w_short, fw1, fb1, fw2, fb2, fw3, fb3, freq, fw_out, d_bias, w_o):
    b, length, _ = x.shape
    u = dwconv_centred(x @ w_in, w_short)
    v, g1, g2 = jnp.split(u, 3, axis=-1)
    filt = hyena_filters(length, fw1, fb1, fw2, fb2, fw3, fb3, freq, fw_out)
    n = 2 * length
    z = v.astype(jnp.float32)
    for o, gate in enumerate((g1, g2)):
        k_f = jnp.fft.rfft(two_sided_kernel(filt[:, o, 0], filt[:, o, 1]), n=n, axis=0)
        z_f = jnp.fft.rfft(z, n=n, axis=1)
        y = jnp.fft.irfft(z_f * k_f, n=n, axis=1)[:, :length]
        z = gate.astype(jnp.float32) * (y + d_bias[o].astype(jnp.float32) * z)
    return z.astype(x.dtype) @ w_o


def conv_ffn(x, w_up, w_conv, w_down):
    h = dwconv_centred(x @ w_up, w_conv)
    a, g = jnp.split(h, 2, axis=-1)
    return (jax.nn.silu(g) * a) @ w_down


def setup_inputs(seed: int = 0) -> dict:
    key = jax.random.key(seed)
    ks = iter(jax.random.split(key, 40))

    def nrm(shape, scale):
        return jax.random.normal(next(ks), shape, jnp.float32) * scale

    def gain(shape):
        return 1.0 + nrm(shape, 0.01)

    nm, nh = N_MLA_LAYERS, N_HYENA_LAYERS
    hf = HYENA_FILTER_WIDTH
    return {
        "x": nrm((BATCH, SEQ, D_MODEL), 1.0),
        "positions": jnp.broadcast_to(jnp.arange(SEQ, dtype=jnp.int32), (BATCH, SEQ)),
        "mla_w_in": nrm((nm, D_MODEL, MLA_IN_DIM), D_MODEL ** -0.5),
        "mla_g_q": gain((nm, Q_LORA_RANK)),
        "mla_w_uq": nrm((nm, Q_LORA_RANK, MLA_HEADS * (QK_NOPE_DIM + QK_ROPE_DIM)), Q_LORA_RANK ** -0.5),
        "mla_g_kv": gain((nm, KV_LORA_RANK)),
        "mla_w_ukv": nrm((nm, KV_LORA_RANK, MLA_HEADS * (QK_NOPE_DIM + V_HEAD_DIM)), KV_LORA_RANK ** -0.5),
        "mla_w_o": nrm((nm, MLA_HEADS * V_HEAD_DIM, D_MODEL), (MLA_HEADS * V_HEAD_DIM) ** -0.5 * DEEPNORM_BETA),
        "hy_w_in": nrm((nh, D_MODEL, 3 * D_MODEL), D_MODEL ** -0.5),
        "hy_w_short": nrm((nh, SHORT_CONV_WIDTH, 3 * D_MODEL), SHORT_CONV_WIDTH ** -0.5),
        "hy_fw1": nrm((nh, HYENA_EMB_DIM, hf), HYENA_EMB_DIM ** -0.5),
        "hy_fb1": nrm((nh, hf), 0.02),
        "hy_fw2": nrm((nh, hf, hf), hf ** -0.5),
        "hy_fb2": nrm((nh, hf), 0.02),
        "hy_fw3": nrm((nh, hf, hf), hf ** -0.5),
        "hy_fb3": nrm((nh, hf), 0.02),
        "hy_freq": gain((nh, hf)),
        "hy_fw_out": nrm((nh, hf, HYENA_ORDER * 2 * D_MODEL), hf ** -0.5),
        "hy_d_bias": nrm((nh, HYENA_ORDER, D_MODEL), 0.1),
        "hy_w_o": nrm((nh, D_MODEL, D_MODEL), D_MODEL ** -0.5 * DEEPNORM_BETA),
        "ffn_w_up": nrm((DEPTH, D_MODEL, 2 * D_FF), D_MODEL ** -0.5),
        "ffn_w_conv": nrm((DEPTH, FFN_CONV_WIDTH, 2 * D_FF), FFN_CONV_WIDTH ** -0.5),
        "ffn_w_down": nrm((DEPTH, D_FF, D_MODEL), D_FF ** -0.5 * DEEPNORM_BETA),
        "ln1_g": gain((DEPTH, D_MODEL)),
        "ln1_b": nrm((DEPTH, D_MODEL), 0.01),
        "ln2_g": gain((DEPTH, D_MODEL)),
        "ln2_b": nrm((DEPTH, D_MODEL), 0.01),
    }


def reference(x, positions, mla_w_in, mla_g_q, mla_w_uq, mla_g_kv, mla_w_ukv, mla_w_o,
              hy_w_in, hy_w_short, hy_fw1, hy_fb1, hy_fw2, hy_fb2, hy_fw3, hy_fb3, hy_freq,
              hy_fw_out, hy_d_bias, hy_w_o, ffn_w_up, ffn_w_conv, ffn_w_down,
              ln1_g, ln1_b, ln2_g, ln2_b):
    cos, sin = rope_tables(positions)
    for i in range(DEPTH):
        j = i // N_MIXERS
        if i % N_MIXERS == 0:
            m = mla_mixer(x, cos, sin, mla_w_in[j], mla_g_q[j], mla_w_uq[j],
                          mla_g_kv[j], mla_w_ukv[j], mla_w_o[j])
        else:
            m = hyena_mixer(x, hy_w_in[j], hy_w_short[j], hy_fw1[j], hy_fb1[j], hy_fw2[j],
                            hy_fb2[j], hy_fw3[j], hy_fb3[j], hy_freq[j], hy_fw_out[j],
                            hy_d_bias[j], hy_w_o[j])
        x = layer_norm(DEEPNORM_ALPHA * x + m, ln1_g[i], ln1_b[i])
        x = layer_norm(DEEPNORM_ALPHA * x + conv_ffn(x, ffn_w_up[i], ffn_w_conv[i], ffn_w_down[i]),
                       ln2_g[i], ln2_b[i])
    return x
```

```cpp
#include <hip/hip_runtime.h>
#include <cstdio>
#include <cstdint>
__device__ __forceinline__ int hw_lane() { int l; asm volatile("v_mbcnt_lo_u32_b32 %0, -1, 0\n\tv_mbcnt_hi_u32_b32 %0, -1, %0" : "=v"(l)); return l; }
namespace pg8 {
#define PG8_LAS __attribute__((address_space(3)))
typedef unsigned short bf16_t;
typedef short bf16x8 __attribute__((ext_vector_type(8)));
typedef float f32x4 __attribute__((ext_vector_type(4)));
typedef unsigned u32x4 __attribute__((ext_vector_type(4)));
constexpr int BM = 256, BK = 64, HALF = 128, HTB = HALF * BK * 2  , STAGE_BYTES = 8 * HTB, NXCD = 8, WGM = 8;

__host__ __device__ __forceinline__ int lds_byte(int r, int c) { const int st = (r >> 4) * 2 + (c >> 5), rr = r & 15, cc = c & 31, ob = rr * 64 + cc * 2; return st * 1024 + (ob ^ (((ob >> 9) & 1) << 5)); }
__host__ __device__ __forceinline__ void stage_rc(int b, int& R, int& C) { const int st = b / 1024, sb = b % 1024, swz = sb ^ (((sb >> 9) & 1) << 5); R = (st >> 1) * 16 + swz / 64; C = (st & 1) * 32 + (swz % 64) / 2; }
__host__ __device__ __forceinline__ int perm32(int rho) { const int n = rho >> 4, i = rho & 15; return 8 * (i >> 2) + 4 * n + (i & 3); }

struct Unit { int pm, pn; };
struct Gemm { const bf16_t* A; const bf16_t* Bt; int M, N, K; };

struct StaticOrder {
    int nM, nN, nwg, G, c;
    __host__ __device__ void init(int M, int N, int G_, int c_) { nM = M / BM; nN = N / BM; nwg = nM * nN; G = G_; c = c_; }
    __host__ __device__ bool next(int i, Unit& u) const {
        const long L = (long)i * G + c; if (L >= nwg) return false;
        int wgid = (int)L; { const int q = nwg / NXCD, r = nwg % NXCD, xcd = wgid % NXCD, off = wgid / NXCD; wgid = (xcd < r ? xcd * (q + 1) : r * (q + 1) + (xcd - r) * q) + off; }
        const int nig = WGM * nN, gid = wgid / nig, fm = gid * WGM, gsz = (nM - fm) < WGM ? (nM - fm) : WGM;
        u.pm = fm + ((wgid % nig) % gsz); u.pn = (wgid % nig) / gsz; return true;
    }
    __device__ __forceinline__ void a_ready(const Unit&) const {}
    __device__ __forceinline__ void done(const Unit&) const {}
};

__device__ __forceinline__ unsigned cvt_pk_bf16(float lo, float hi) { unsigned r; asm volatile("v_cvt_pk_bf16_f32 %0, %1, %2" : "=v"(r) : "v"(lo), "v"(hi)); return r; }
typedef float f32x2 __attribute__((ext_vector_type(2)));

struct EpiF32 {
    static constexpr bool PERM = false, AFTER_DRAIN = false;
    float* C; int ldc;
    __device__ __forceinline__ void operator()(const f32x4 (&acc)[2][2][4][2], const Unit& u_, int wr, int wc, int fr, int fq) const {
        Unit u = u_; asm volatile("" : "+s"(u.pm), "+s"(u.pn)); { const int l_ = hw_lane(); fr = l_ & 15; fq = l_ >> 4; }
        const int row0 = u.pm * BM + wr * 64 + fr, col0 = u.pn * BM + wc * 32 + 4 * fq;
#pragma unroll
        for (int ai = 0; ai < 2; ++ai)
#pragma unroll
            for (int m = 0; m < 4; ++m) { float* rowp = C + (size_t)(row0 + ai * HALF + m * 16) * ldc + col0;
#pragma unroll
                for (int bj = 0; bj < 2; ++bj)
#pragma unroll
                    for (int n = 0; n < 2; ++n) *(f32x4*)(rowp + bj * HALF + n * 16) = acc[ai][bj][m][n]; }
    }
};
struct EpiBf16 {
    static constexpr bool PERM = true, AFTER_DRAIN = false;
    bf16_t* O; int ldc; float scale;
    __device__ __forceinline__ void operator()(const f32x4 (&acc)[2][2][4][2], const Unit& u_, int wr, int wc, int fr, int fq) const {
        Unit u = u_; asm volatile("" : "+s"(u.pm), "+s"(u.pn)); { const int l_ = hw_lane(); fr = l_ & 15; fq = l_ >> 4; }
        const int row0 = u.pm * BM + wr * 64 + fr, col0 = u.pn * BM + wc * 32 + 8 * fq;
#pragma unroll
        for (int ai = 0; ai < 2; ++ai)
#pragma unroll
            for (int m = 0; m < 4; ++m) { bf16_t* rowp = O + (size_t)(row0 + ai * HALF + m * 16) * ldc + col0;
#pragma unroll
                for (int bj = 0; bj < 2; ++bj) { const f32x4 v0 = acc[ai][bj][m][0] * scale, v1 = acc[ai][bj][m][1] * scale;
                    u32x4 w; w.x = cvt_pk_bf16(v0[0], v0[1]); w.y = cvt_pk_bf16(v0[2], v0[3]); w.z = cvt_pk_bf16(v1[0], v1[1]); w.w = cvt_pk_bf16(v1[2], v1[3]);
                    *(u32x4*)(rowp + bj * HALF) = w; } }
    }
};
struct EpiResid {
    static constexpr bool PERM = false, AFTER_DRAIN = false;
    const float* base; float* out; float alpha;
    __device__ __forceinline__ void operator()(const f32x4 (&acc)[2][2][4][2], const Unit& u_, int wr, int wc, int fr, int fq) const {
        Unit u = u_; asm volatile("" : "+s"(u.pm), "+s"(u.pn)); { const int l_ = hw_lane(); fr = l_ & 15; fq = l_ >> 4; }
        const int row0 = u.pm * BM + wr * 64 + fr, col0 = u.pn * BM + wc * 32 + 4 * fq;
#pragma unroll
        for (int ai = 0; ai < 2; ++ai)
#pragma unroll
            for (int m = 0; m < 4; ++m) { const size_t off = (size_t)(row0 + ai * HALF + m * 16) * 1024 + col0;
#pragma unroll
                for (int bj = 0; bj < 2; ++bj)
#pragma unroll
                    for (int n = 0; n < 2; ++n) { const f32x4 bs = *(const f32x4*)(base + off + bj * HALF + n * 16);
                        *(f32x4*)(out + off + bj * HALF + n * 16) = bs * alpha + acc[ai][bj][m][n]; }
                if (m & 1) asm volatile("" ::: "memory"); }
    }
};
struct EpiKV {
    static constexpr bool PERM = true, AFTER_DRAIN = false;
    bf16_t* Kb; bf16_t* Vb;
    __device__ __forceinline__ void operator()(const f32x4 (&acc)[2][2][4][2], const Unit& u_, int wr, int wc, int fr, int fq) const {
        Unit u = u_; asm volatile("" : "+s"(u.pm), "+s"(u.pn)); { const int l_ = hw_lane(); fr = l_ & 15; fq = l_ >> 4; }
        const int row0 = u.pm * BM + wr * 64 + fr, col0 = u.pn * BM + wc * 32 + 8 * fq;
#pragma unroll
        for (int bj = 0; bj < 2; ++bj) { const int c = col0 + bj * HALF; const bool isk = c < 1024;
            bf16_t* dst = isk ? Kb + (c >> 7) * 192 + (c & 127) : Vb + (c - 1024); const size_t ld = isk ? 1536 : 1024;
#pragma unroll
            for (int ai = 0; ai < 2; ++ai)
#pragma unroll
                for (int m = 0; m < 4; ++m) { const int row = row0 + ai * HALF + m * 16; const f32x4 v0 = acc[ai][bj][m][0], v1 = acc[ai][bj][m][1];
                    u32x4 w; w.x = cvt_pk_bf16(v0[0], v0[1]); w.y = cvt_pk_bf16(v0[2], v0[3]); w.z = cvt_pk_bf16(v1[0], v1[1]); w.w = cvt_pk_bf16(v1[2], v1[3]);
                    *(u32x4*)(dst + (size_t)row * ld) = w; } }
    }
};
struct EpiFilt {
    static constexpr bool PERM = false, AFTER_DRAIN = false;
    float* KT; int L; float d0, dstep, tinv;
    __device__ __forceinline__ void operator()(const f32x4 (&acc)[2][2][4][2], const Unit& u_, int wr, int wc, int fr, int fq) const {
        Unit u = u_; asm volatile("" : "+s"(u.pm), "+s"(u.pn)); { const int l_ = hw_lane(); fr = l_ & 15; fq = l_ >> 4; }
        const int row0 = u.pm * BM + wr * 64 + fr, col0 = u.pn * BM + wc * 32 + 4 * fq;
#pragma unroll
        for (int bj = 0; bj < 2; ++bj)
#pragma unroll
            for (int n = 0; n < 2; ++n) { const int c = col0 + bj * HALF + n * 16;
#pragma unroll
                for (int j = 0; j < 4; ++j) { const int cc = c + j, ch = cc & 1023; const float nd = -__builtin_fabsf(d0 + (float)ch * dstep) * tinv; float* dst = KT + (size_t)cc * L;
#pragma unroll
                    for (int ai = 0; ai < 2; ++ai)
#pragma unroll
                        for (int m = 0; m < 4; ++m) { const int l = row0 + ai * HALF + m * 16; dst[l] = acc[ai][bj][m][n][j] * __expf(nd * (float)l); } } }
    }
};

template <class Epi, class Sched, bool ALIGN_EPI = false, bool SP2 = false>
__device__ __forceinline__ void gemm_phase(PG8_LAS unsigned char* lds, const Gemm g, const Sched& S, const Epi& E, int wid_in) {
    const int wid = wid_in, lane = hw_lane(), tid = wid * 64 + lane, wr = wid >> 2, wc = wid & 3, fr = lane & 15, fq = lane >> 4;
    const int K = g.K, nt = K / BK;
    unsigned voffA[2], voffB[2];
#pragma unroll
    for (int i = 0; i < 2; ++i) { int R, C; stage_rc(tid * 16 + i * 8192, R, C); const int Rb = Epi::PERM ? ((R & ~31) + perm32(R & 31)) : R;
        voffA[i] = (unsigned)(R * K + C) * 2u; voffB[i] = (unsigned)(Rb * K + C) * 2u; }
    const size_t kstep = (size_t)(BK * 2);
    const size_t hstep = (size_t)HALF * K * 2;
    const size_t tstep = 2 * hstep;
    const unsigned ldsw = (unsigned)wid * 1024u;
    const int aoff = lds_byte(wr * 64 + fr, fq * 8), boff = lds_byte(wc * 32 + fr, fq * 8);
#define PG8_SA(b, h) (((b) * 2 + (h)) * HTB)
#define PG8_SB(b, h) ((4 + (b) * 2 + (h)) * HTB)
#define PG8_STAGE(bufoff, gbase, voff) do { _Pragma("unroll") for (int _i = 0; _i < 2; ++_i) \
        __builtin_amdgcn_global_load_lds((const unsigned*)((const char*)(gbase) + (voff)[_i]), (PG8_LAS unsigned*)(lds + (bufoff) + ldsw + _i * 8192), 16, 0, 0); } while (0)
#define PG8_LDA(dst, b, h) do { _Pragma("unroll") for (int m = 0; m < 4; ++m) _Pragma("unroll") for (int k = 0; k < 2; ++k) dst[m][k] = *(const PG8_LAS bf16x8*)(lds + PG8_SA(b, h) + aoff + m * 2048 + k * 1024); } while (0)
#define PG8_LDB(dst, b, h) do { _Pragma("unroll") for (int n = 0; n < 2; ++n) _Pragma("unroll") for (int k = 0; k < 2; ++k) dst[n][k] = *(const PG8_LAS bf16x8*)(lds + PG8_SB(b, h) + boff + n * 2048 + k * 1024); } while (0)
#define PG8_MMA(ai, bj, At, Bt) do { __builtin_amdgcn_s_setprio(1); _Pragma("unroll") for (int m = 0; m < 4; ++m) _Pragma("unroll") for (int n = 0; n < 2; ++n) _Pragma("unroll") for (int k = 0; k < 2; ++k) \
        acc[ai][bj][m][n] = __builtin_amdgcn_mfma_f32_16x16x32_bf16(Bt[n][k], At[m][k], acc[ai][bj][m][n], 0, 0, 0); __builtin_amdgcn_s_setprio(0); } while (0)
#define PG8_WAIT_V(n) asm volatile("s_waitcnt vmcnt(" #n ")" ::: "memory")
#define PG8_WAIT_L(n) asm volatile("s_waitcnt lgkmcnt(" #n ")" ::: "memory")
#define PG8_BAR __builtin_amdgcn_s_barrier()
#define PG8_SCHED __builtin_amdgcn_sched_barrier(0)
    Unit cur, nxt; int ui = 0;
    if (!S.next(0, cur)) return;
    f32x4 acc[2][2][4][2];
#pragma unroll
    for (int a = 0; a < 2; ++a)
#pragma unroll
        for (int b = 0; b < 2; ++b)
#pragma unroll
            for (int m = 0; m < 4; ++m)
#pragma unroll
                for (int n = 0; n < 2; ++n) acc[a][b][m][n] = (f32x4){0.f, 0.f, 0.f, 0.f};
    bf16x8 At[4][2], B0[2][2], B1[2][2];
    const char* cA = (const char*)g.A + (size_t)cur.pm * tstep; const char* cB = (const char*)g.Bt + (size_t)cur.pn * tstep;
    S.a_ready(cur);
    if constexpr (SP2) {
        PG8_STAGE(PG8_SB(0, 0), cB, voffB); PG8_STAGE(PG8_SB(0, 1), cB + hstep, voffB); PG8_STAGE(PG8_SA(0, 0), cA, voffA); PG8_STAGE(PG8_SA(0, 1), cA + hstep, voffA);
        if (wr == 1) PG8_BAR;
        PG8_WAIT_V(2); PG8_BAR;
        PG8_STAGE(PG8_SB(1, 0), cB + kstep, voffB); PG8_STAGE(PG8_SA(1, 0), cA + kstep, voffA); PG8_STAGE(PG8_SB(1, 1), cB + hstep + kstep, voffB);
        PG8_WAIT_V(6); PG8_BAR;
    } else {
        PG8_STAGE(PG8_SB(0, 0), cB, voffB); PG8_STAGE(PG8_SA(0, 0), cA, voffA); PG8_STAGE(PG8_SB(0, 1), cB + hstep, voffB); PG8_STAGE(PG8_SA(0, 1), cA + hstep, voffA);
        if (wr == 1) PG8_BAR;
        PG8_WAIT_V(4); PG8_BAR;
        PG8_STAGE(PG8_SB(1, 0), cB + kstep, voffB); PG8_STAGE(PG8_SA(1, 0), cA + kstep, voffA); PG8_STAGE(PG8_SB(1, 1), cB + hstep + kstep, voffB);
        PG8_WAIT_V(6); PG8_BAR;
    }
    for (;;) {
        const bool has_next = S.next(ui + 1, nxt);
        const char* nA = has_next ? (const char*)g.A + (size_t)nxt.pm * tstep : cA; const char* nB = has_next ? (const char*)g.Bt + (size_t)nxt.pn * tstep : cB;
        for (int t = 0; t < nt; t += 2) {
            const bool last = (t == nt - 2);
            const char* a1 = cA + (size_t)(t + 1) * kstep;
            const char* a2 = last ? nA : cA + (size_t)(t + 2) * kstep; const char* b2 = last ? nB : cB + (size_t)(t + 2) * kstep;
            const char* a3 = a2 + kstep; const char* b3 = b2 + kstep;
            if (last && has_next) S.a_ready(nxt);
            if constexpr (SP2) {
            PG8_LDB(B0, 0, 0); PG8_LDB(B1, 0, 1); PG8_SCHED; PG8_LDA(At, 0, 0); PG8_STAGE(PG8_SA(1, 1), a1 + hstep, voffA);
            PG8_WAIT_V(8); PG8_WAIT_L(0); PG8_BAR; PG8_MMA(0, 0, At, B0); PG8_MMA(0, 1, At, B1); PG8_BAR; PG8_SCHED;
            PG8_LDA(At, 0, 1); PG8_STAGE(PG8_SB(0, 0), b2, voffB); PG8_STAGE(PG8_SB(0, 1), b2 + hstep, voffB); PG8_STAGE(PG8_SA(0, 0), a2, voffA);
            PG8_WAIT_V(8); PG8_WAIT_L(0); PG8_BAR; PG8_MMA(1, 0, At, B0); PG8_MMA(1, 1, At, B1); PG8_BAR; PG8_SCHED;
            PG8_LDB(B0, 1, 0); PG8_LDB(B1, 1, 1); PG8_SCHED; PG8_LDA(At, 1, 0); PG8_STAGE(PG8_SA(0, 1), a2 + hstep, voffA);
            PG8_WAIT_V(8); PG8_WAIT_L(0); PG8_BAR; PG8_MMA(0, 0, At, B0); PG8_MMA(0, 1, At, B1); PG8_BAR; PG8_SCHED;
            PG8_LDA(At, 1, 1); PG8_STAGE(PG8_SB(1, 0), b3, voffB); PG8_STAGE(PG8_SB(1, 1), b3 + hstep, voffB); PG8_STAGE(PG8_SA(1, 0), a3, voffA);
            PG8_WAIT_V(8); PG8_WAIT_L(0); PG8_BAR; PG8_MMA(1, 0, At, B0); PG8_MMA(1, 1, At, B1); PG8_BAR; PG8_SCHED;
            } else {
            PG8_LDB(B0, 0, 0); PG8_SCHED; PG8_LDA(At, 0, 0); PG8_STAGE(PG8_SA(1, 1), a1 + hstep, voffA);
            PG8_WAIT_L(8); PG8_BAR; PG8_WAIT_L(0); PG8_MMA(0, 0, At, B0); PG8_BAR; PG8_SCHED;
            PG8_LDB(B1, 0, 1); PG8_STAGE(PG8_SB(0, 0), b2, voffB);
            PG8_BAR; PG8_WAIT_L(0); PG8_MMA(0, 1, At, B1); PG8_BAR;
            PG8_LDA(At, 0, 1); PG8_STAGE(PG8_SA(0, 0), a2, voffA);
            PG8_BAR; PG8_WAIT_L(0); PG8_MMA(1, 0, At, B0); PG8_BAR; PG8_SCHED;
            PG8_STAGE(PG8_SB(0, 1), b2 + hstep, voffB);
            PG8_WAIT_V(6); PG8_BAR; PG8_MMA(1, 1, At, B1); PG8_BAR;
            PG8_LDB(B0, 1, 0); PG8_SCHED; PG8_LDA(At, 1, 0); PG8_STAGE(PG8_SA(0, 1), a2 + hstep, voffA);
            PG8_WAIT_L(8); PG8_BAR; PG8_WAIT_L(0); PG8_MMA(0, 0, At, B0); PG8_BAR; PG8_SCHED;
            PG8_LDB(B1, 1, 1); PG8_STAGE(PG8_SB(1, 0), b3, voffB);
            PG8_BAR; PG8_WAIT_L(0); PG8_MMA(0, 1, At, B1); PG8_BAR;
            PG8_LDA(At, 1, 1); PG8_STAGE(PG8_SA(1, 0), a3, voffA);
            PG8_BAR; PG8_WAIT_L(0); PG8_MMA(1, 0, At, B0); PG8_BAR; PG8_SCHED;
            PG8_STAGE(PG8_SB(1, 1), b3 + hstep, voffB);
            PG8_WAIT_V(6); PG8_BAR; PG8_MMA(1, 1, At, B1); PG8_BAR;
            }
        }
        if constexpr (ALIGN_EPI) { if (wr == 0) PG8_BAR; }
        if constexpr (!Epi::AFTER_DRAIN) { E(acc, cur, wr, wc, fr, fq); S.done(cur); }
        if (!has_next) break;
#pragma unroll
        for (int a = 0; a < 2; ++a)
#pragma unroll
            for (int b = 0; b < 2; ++b)
#pragma unroll
                for (int m = 0; m < 4; ++m)
#pragma unroll
                    for (int n = 0; n < 2; ++n) acc[a][b][m][n] = (f32x4){0.f, 0.f, 0.f, 0.f};
        cur = nxt; cA = nA; cB = nB; ++ui;
        if constexpr (ALIGN_EPI) { if (wr == 1) PG8_BAR; }
    }
    PG8_WAIT_V(0);
    if constexpr (!ALIGN_EPI) { if (wr == 0) PG8_BAR; }
    PG8_BAR;
    if constexpr (Epi::AFTER_DRAIN) { E.fused(acc, cur, wr, wc, fr, fq, lds, wid, lane); S.done(cur); }
#undef PG8_SA
#undef PG8_SB
#undef PG8_STAGE
#undef PG8_LDA
#undef PG8_LDB
#undef PG8_MMA
#undef PG8_WAIT_V
#undef PG8_WAIT_L
#undef PG8_BAR
#undef PG8_SCHED
}
}
#define GAS __attribute__((address_space(1)))
#define LAS __attribute__((address_space(3)))
typedef unsigned short bf16;
typedef unsigned v4u __attribute__((ext_vector_type(4)));
typedef float f32x4 __attribute__((ext_vector_type(4)));
typedef short bf16x8 __attribute__((ext_vector_type(8)));
typedef GAS unsigned gu32;
typedef GAS unsigned long long gu64;
#define RLX_AGENT __ATOMIC_RELAXED, __HIP_MEMORY_SCOPE_AGENT
#define LDS_WAIT() asm volatile("s_waitcnt lgkmcnt(0)" ::: "memory")
#define VM_WAIT() asm volatile("s_waitcnt vmcnt(0)" ::: "memory")
__device__ __forceinline__ unsigned long long rt() { return __builtin_amdgcn_s_memrealtime(); }
__device__ __forceinline__ unsigned f2bf(float f) { unsigned u = __builtin_bit_cast(unsigned, f); return (u + 0x7fffu + ((u >> 16) & 1u)) >> 16; }
__device__ __forceinline__ unsigned pk2(float lo, float hi) { return f2bf(lo) | (f2bf(hi) << 16); }

#define XB_TMO      128
#define XB_XCNT(j)  (256  + 64 * (j))
#define XB_XSUB(j)  (1280 + 64 * (j))
#define XB_XGEN(j)  (2304 + 64 * (j))
#define XB_TOP      3328
#define XB_TOPGEN   3392
#define XCD_BAR_WORDS 3456
#define XB_SPIN_CAP (1u << 18)

__device__ __forceinline__ unsigned xb_ld(unsigned* p)              { return __hip_atomic_load(p, __ATOMIC_RELAXED, __HIP_MEMORY_SCOPE_AGENT); }
__device__ __forceinline__ unsigned xb_add(unsigned* p, unsigned v) { return __hip_atomic_fetch_add(p, v, __ATOMIC_RELAXED, __HIP_MEMORY_SCOPE_AGENT); }
__device__ __forceinline__ unsigned xb_xcc_id() { return (unsigned)__builtin_amdgcn_s_getreg((3 << 11) | 20) & 0xFu; }
#define XB_SPIN(cond, bar) do { unsigned _sp = 0; while (cond) { __builtin_amdgcn_s_sleep(1); \
    if ((++_sp & 255u) == 0u) { if (xb_ld(&(bar)[XB_TMO])) break; if (_sp > XB_SPIN_CAP) { atomicAdd(&(bar)[XB_TMO], 1u); break; } } } } while (0)

struct XcdBarrier {
    unsigned* bar; unsigned x; unsigned wv;
    volatile LAS unsigned* st;
};

__device__ __forceinline__ XcdBarrier xcd_barrier_post(unsigned* bar, volatile LAS unsigned* st, unsigned wv) {
    XcdBarrier b; b.bar = bar; b.x = xb_xcc_id(); b.st = st; b.wv = wv;
    if (wv == 0u && hw_lane() == 0) (void)xb_add(&bar[XB_XCNT(b.x)], 1u);
    return b;
}
__device__ __forceinline__ void xcd_barrier_complete(unsigned* bar, unsigned x, unsigned& nloc, unsigned& nx) {
    const unsigned G = gridDim.x * gridDim.y * gridDim.z;
    unsigned sum, cnt, mine, sp = 0u;
    for (;;) {
        sum = 0u; cnt = 0u; mine = 0u;
#pragma unroll
        for (unsigned j = 0; j < 16; ++j) { const unsigned c = xb_ld(&bar[XB_XCNT(j)]); sum += c; cnt += (c > 0u) ? 1u : 0u; mine = (j == x) ? c : mine; }
        if (sum == G) break;
        __builtin_amdgcn_s_sleep(1);
        if ((++sp & 255u) == 0u) { if (xb_ld(&bar[XB_TMO])) break; if (sp > XB_SPIN_CAP) { atomicAdd(&bar[XB_TMO], 1u); break; } }
    }
    nloc = mine > 0u ? mine : 1u; nx = cnt > 0u ? cnt : 1u;
}

__device__ __forceinline__ void xcd_barrier(const XcdBarrier& b) {
    asm volatile("s_waitcnt vmcnt(0)" ::: "memory");
    __syncthreads();
    if (b.wv == 0u && hw_lane() == 0) {
        unsigned* bar = b.bar;
        __builtin_amdgcn_s_waitcnt(0);
        unsigned nloc = b.st[0], nx = b.st[1];
        if (nloc == 0u) { xcd_barrier_complete(bar, b.x, nloc, nx); b.st[0] = nloc; b.st[1] = nx; }
        const unsigned old = xb_add(&bar[XB_XSUB(b.x)], 1u);
        const unsigned gen = old / nloc;
        if (old + 1u == (gen + 1u) * nloc) {
            __builtin_amdgcn_fence(__ATOMIC_RELEASE, "agent");
            asm volatile("s_waitcnt vmcnt(0)" ::: "memory");
            const unsigned og = xb_add(&bar[XB_TOP], 1u);
            const unsigned tg = og / nx;
            if (og + 1u == (tg + 1u) * nx) xb_add(&bar[XB_TOPGEN], 1u);
            else XB_SPIN(xb_ld(&bar[XB_TOPGEN]) == tg, bar);
            __builtin_amdgcn_fence(__ATOMIC_ACQUIRE, "agent");
            xb_add(&bar[XB_XGEN(b.x)], 1u);
            asm volatile("s_waitcnt vmcnt(0)" ::: "memory");
        } else {
            XB_SPIN(xb_ld(&bar[XB_XGEN(b.x)]) == gen, bar);
            __builtin_amdgcn_fence(__ATOMIC_ACQUIRE, "agent");
            asm volatile("s_waitcnt vmcnt(0)" ::: "memory");
        }
    }
    __syncthreads();
}
namespace attn {
using bf16x8 = __attribute__((ext_vector_type(8))) short;
using s16x4  = __attribute__((ext_vector_type(4))) short;
using f32x16 = __attribute__((ext_vector_type(16))) float;
using u32x4  = __attribute__((ext_vector_type(4))) unsigned;
constexpr int NW = 8, QBLK = 32, KVBLK = 64, DQ = 192, DVV = 128;
constexpr int LDQ = 1536, LDK = 1536, LDV = 1024, LDO = 1024;
constexpr int KROW = 400;
constexpr int SHM_V = KVBLK * DVV * 2, SHM_K = KVBLK * KROW, SHM_WS = NW * 64 * 4, SHM_QR = NW * 4096, SHM_ATTN = 2 * SHM_V + 2 * SHM_K + SHM_WS + SHM_QR;
constexpr float THRL = 11.5f;
#define SBAR() __builtin_amdgcn_sched_barrier(0)
__device__ __forceinline__ int crow(int r, int hi) { return (r & 3) + 8 * (r >> 2) + 4 * hi; }
__device__ __forceinline__ unsigned cvtpk(float lo, float hi) { unsigned r; asm volatile("v_cvt_pk_bf16_f32 %0, %1, %2" : "=v"(r) : "v"(lo), "v"(hi)); return r; }

__device__ __forceinline__ void partialSM(f32x16& p0, f32x16& p1, float& m_reg, float& mn, float& alpha) {
  float pmax = p0[0]; for (int r = 1; r < 16; ++r) pmax = fmaxf(pmax, p0[r]); for (int r = 0; r < 16; ++r) pmax = fmaxf(pmax, p1[r]);
  { auto rr = __builtin_amdgcn_permlane32_swap(__float_as_uint(pmax), __float_as_uint(pmax), false, false);
    pmax = fmaxf(__uint_as_float(rr[0]), __uint_as_float(rr[1])); }
  if (__builtin_expect(__all(pmax - m_reg <= THRL), 1)) { mn = m_reg; alpha = 1.f; }
  else { mn = fmaxf(m_reg, pmax); alpha = __builtin_amdgcn_exp2f(m_reg - mn); m_reg = mn; }
  for (int r = 0; r < 16; ++r) p0[r] = p0[r] - mn; for (int r = 0; r < 16; ++r) p1[r] = p1[r] - mn;
  for (int r = 0; r < 16; ++r) p0[r] = __builtin_amdgcn_exp2f(p0[r]);
}
__device__ __forceinline__ void finishSM(f32x16& p0, f32x16& p1, float alpha, float& l_reg, bf16x8& pa0, bf16x8& pa1, bf16x8& pa2, bf16x8& pa3) {
  for (int r = 0; r < 16; ++r) p1[r] = __builtin_amdgcn_exp2f(p1[r]);
  float ps = 0; for (int r = 0; r < 16; ++r) ps += p0[r]; for (int r = 0; r < 16; ++r) ps += p1[r];
  { auto rr = __builtin_amdgcn_permlane32_swap(__float_as_uint(ps), __float_as_uint(ps), false, false);
    ps = __uint_as_float(rr[0]) + __uint_as_float(rr[1]); }
  l_reg = l_reg * alpha + ps;
#define PK4(P, BASE, OUT) do { unsigned a0 = cvtpk(P[BASE + 0], P[BASE + 1]), a1 = cvtpk(P[BASE + 2], P[BASE + 3]);   \
    unsigned b0 = cvtpk(P[BASE + 4], P[BASE + 5]), b1 = cvtpk(P[BASE + 6], P[BASE + 7]);                              \
    auto r0 = __builtin_amdgcn_permlane32_swap(a0, b0, false, false); auto r1 = __builtin_amdgcn_permlane32_swap(a1, b1, false, false); \
    u32x4 w = {r0[0], r1[0], r0[1], r1[1]}; OUT = *reinterpret_cast<bf16x8*>(&w); } while (0)
  PK4(p0, 0, pa0); PK4(p0, 8, pa1); PK4(p1, 0, pa2); PK4(p1, 8, pa3);
#undef PK4
}
__device__ __forceinline__ void qkt(f32x16& p0, f32x16& p1, const char* Ks, const bf16x8* qr, const char* Qrl, int r32, int hi) {
  p0 = f32x16{}; p1 = f32x16{};
#pragma unroll
  for (int d0 = 0; d0 < 12; ++d0) { const int cb = (d0 * 16 + hi * 8) * 2;
    const bf16x8 qf = (d0 < 8) ? qr[d0 < 8 ? d0 : 0] : *reinterpret_cast<const bf16x8*>(Qrl + (d0 - 8) * 1024);
    bf16x8 b0 = *reinterpret_cast<const bf16x8*>(Ks + r32 * KROW + cb);
    bf16x8 b1 = *reinterpret_cast<const bf16x8*>(Ks + (32 + r32) * KROW + cb);
    p0 = __builtin_amdgcn_mfma_f32_32x32x16_bf16(b0, qf, p0, 0, 0, 0);
    p1 = __builtin_amdgcn_mfma_f32_32x32x16_bf16(b1, qf, p1, 0, 0, 0); }
}
__device__ __forceinline__ int v_st(int k, int c) { const int kk = (k & ~0xC) | ((k & 4) << 1) | ((k & 8) >> 1); return ((kk >> 3) * 4 + (c >> 5)) * 512 + ((kk & 7) * 32 + (c & 31)) * 2; }
__device__ __forceinline__ int v_rd_base(int lane) { return ((lane & 3) << 3) | (((lane >> 2) & 3) << 6) | (((lane >> 4) & 1) << 5) | (((lane >> 5) & 1) << 8); }
constexpr int v_rd_off(int d0, int ks, int half) { return d0 * 512 + ks * 4096 + half * 2048; }
template <int OFF> __device__ __forceinline__ s16x4 tr_read(int vb) {
  s16x4 r; asm volatile("ds_read_b64_tr_b16 %0, %1 offset:%2" : "=&v"(r) : "v"(vb), "i"(OFF) : "memory"); return r;
}
template <int D0> __device__ __forceinline__ void pv_one(f32x16& od, int vb, bf16x8 pa0, bf16x8 pa1, bf16x8 pa2, bf16x8 pa3) {
  const s16x4 l0 = tr_read<v_rd_off(D0, 0, 0)>(vb), h0 = tr_read<v_rd_off(D0, 0, 1)>(vb), l1 = tr_read<v_rd_off(D0, 1, 0)>(vb), h1 = tr_read<v_rd_off(D0, 1, 1)>(vb);
  const s16x4 l2 = tr_read<v_rd_off(D0, 2, 0)>(vb), h2 = tr_read<v_rd_off(D0, 2, 1)>(vb), l3 = tr_read<v_rd_off(D0, 3, 0)>(vb), h3 = tr_read<v_rd_off(D0, 3, 1)>(vb);
  asm volatile("s_waitcnt lgkmcnt(0)" ::: "memory"); SBAR();
#define PK(L, H) (bf16x8){L[0], L[1], L[2], L[3], H[0], H[1], H[2], H[3]}
  od = __builtin_amdgcn_mfma_f32_32x32x16_bf16(pa0, PK(l0, h0), od, 0, 0, 0);
  od = __builtin_amdgcn_mfma_f32_32x32x16_bf16(pa1, PK(l1, h1), od, 0, 0, 0);
  od = __builtin_amdgcn_mfma_f32_32x32x16_bf16(pa2, PK(l2, h2), od, 0, 0, 0);
  od = __builtin_amdgcn_mfma_f32_32x32x16_bf16(pa3, PK(l3, h3), od, 0, 0, 0);
#undef PK
}
__device__ __forceinline__ void pv_d0(f32x16* o, int vb, bf16x8 pa0, bf16x8 pa1, bf16x8 pa2, bf16x8 pa3) {
  pv_one<0>(o[0], vb, pa0, pa1, pa2, pa3); pv_one<1>(o[1], vb, pa0, pa1, pa2, pa3); pv_one<2>(o[2], vb, pa0, pa1, pa2, pa3); pv_one<3>(o[3], vb, pa0, pa1, pa2, pa3);
}
typedef unsigned short bf16r;
__device__ __forceinline__ void attn_unit(const bf16r* __restrict__ Qb, const bf16r* __restrict__ Kh, const bf16r* __restrict__ Vh, bf16r* __restrict__ Ob, const float* __restrict__ tab, int seq, char* lds, int wid) {
  const int lane = hw_lane(), tid = wid * 64 + lane, r32 = lane & 31, hi = lane >> 5;
  char* V_lds = lds; char* K_lds = lds + 2 * SHM_V;
  float* wsf = (float*)(lds + 2 * SHM_V + 2 * SHM_K) + wid * 64; float* li_l = wsf; float* al_l = wsf + 32;
  float m_reg = -1e30f, l_reg = 0; f32x16 o[4] = {}; bf16x8 qr[8];
  char* Qrl = lds + 2 * SHM_V + 2 * SHM_K + SHM_WS + wid * 4096 + lane * 16;
  const bf16r* Qw = Qb + (long)(wid * QBLK + r32) * LDQ + hi * 8;
#pragma unroll
  for (int d0 = 0; d0 < 8; ++d0) qr[d0] = *reinterpret_cast<const bf16x8*>(Qw + d0 * 16);
  { const float* tr = tab + (long)(wid * QBLK + r32) * 64 + hi * 8;
#pragma unroll
    for (int d0 = 8; d0 < 12; ++d0) { const u32x4 qv = *reinterpret_cast<const u32x4*>(Qw + d0 * 16);
      const float4 t0 = *reinterpret_cast<const float4*>(tr + (d0 - 8) * 16), t1 = *reinterpret_cast<const float4*>(tr + (d0 - 8) * 16 + 4);
      u32x4 w;
#define ROT(Q_, C_, S_) cvtpk(__uint_as_float((Q_) << 16) * (C_) - __uint_as_float((Q_) & 0xffff0000u) * (S_), __uint_as_float((Q_) << 16) * (S_) + __uint_as_float((Q_) & 0xffff0000u) * (C_))
      w[0] = ROT(qv[0], t0.x, t0.y); w[1] = ROT(qv[1], t0.z, t0.w); w[2] = ROT(qv[2], t1.x, t1.y); w[3] = ROT(qv[3], t1.z, t1.w);
#undef ROT
      *reinterpret_cast<u32x4*>(Qrl + (d0 - 8) * 1024) = w; } }
  const int sr = tid >> 4, sc = (tid & 15) * 8, vst0 = v_st(sr, sc), vst1 = v_st(32 + sr, sc);
  int kg[3], kl[3];
#pragma unroll
  for (int i = 0; i < 3; ++i) { const int q = tid + 512 * i, row = q / 24, ch = q - row * 24; kg[i] = row * LDK + ch * 8; kl[i] = row * KROW + ch * 16; }
  const int vb0 = (int)(uintptr_t)V_lds + v_rd_base(lane);
  struct { bf16x8 vs0, vs1, k0, k1, k2; } sr_[1];
#define SLOAD(i, kk0) do { sr_[i].vs0 = *reinterpret_cast<const bf16x8*>(&Vh[(long)((kk0) + sr) * LDV + sc]); sr_[i].vs1 = *reinterpret_cast<const bf16x8*>(&Vh[(long)((kk0) + 32 + sr) * LDV + sc]); \
    sr_[i].k0 = *reinterpret_cast<const bf16x8*>(&Kh[(long)(kk0) * LDK + kg[0]]); sr_[i].k1 = *reinterpret_cast<const bf16x8*>(&Kh[(long)(kk0) * LDK + kg[1]]); \
    sr_[i].k2 = *reinterpret_cast<const bf16x8*>(&Kh[(long)(kk0) * LDK + kg[2]]); } while (0)
#define SWRITE(b, i) do { *(bf16x8*)(V_lds + (b) * SHM_V + vst0) = sr_[i].vs0; *(bf16x8*)(V_lds + (b) * SHM_V + vst1) = sr_[i].vs1; \
    *(bf16x8*)(K_lds + (b) * SHM_K + kl[0]) = sr_[i].k0; *(bf16x8*)(K_lds + (b) * SHM_K + kl[1]) = sr_[i].k1; *(bf16x8*)(K_lds + (b) * SHM_K + kl[2]) = sr_[i].k2; } while (0)
#define SWAIT() asm volatile("s_waitcnt vmcnt(0)" ::: "memory")
#define RESC(a) do { if (__any((a) < 1.f)) { if (hi == 0) al_l[r32] = (a); asm volatile("s_waitcnt lgkmcnt(0)" ::: "memory"); \
    for (int d = 0; d < 4; ++d) for (int r = 0; r < 16; ++r) o[d][r] *= al_l[crow(r, hi)]; } } while (0)
  f32x16 pA0, pA1, pB0, pB1; float mnA, mnB, alA, alB; bf16x8 pa0, pa1, pa2, pa3; const int NT = seq / KVBLK;
  constexpr int SE = 0, SO = 0;
  SLOAD(SE, 0); asm volatile("s_waitcnt vmcnt(0)" ::: "memory"); SWRITE(0, SE); __syncthreads();
  qkt(pA0, pA1, K_lds, qr, Qrl, r32, hi); partialSM(pA0, pA1, m_reg, mnA, alA);
  SLOAD(SO, KVBLK);
  SWAIT(); SWRITE(1, SO); __syncthreads();
  for (int j = 1; j + 1 < NT; j += 2) {
    SBAR(); qkt(pB0, pB1, K_lds + SHM_K, qr, Qrl, r32, hi);
    finishSM(pA0, pA1, alA, l_reg, pa0, pa1, pa2, pa3); SBAR();
    SLOAD(SO, (j + 1) * KVBLK); SBAR();
    pv_d0(o, vb0, pa0, pa1, pa2, pa3); partialSM(pB0, pB1, m_reg, mnB, alB);
    __syncthreads(); SWAIT(); SWRITE(0, SE);
    RESC(alB); __syncthreads();
    SBAR(); qkt(pA0, pA1, K_lds, qr, Qrl, r32, hi);
    finishSM(pB0, pB1, alB, l_reg, pa0, pa1, pa2, pa3); SBAR();
    SLOAD(SE, (j + 2) * KVBLK); SBAR();
    pv_d0(o, vb0 + (int)SHM_V, pa0, pa1, pa2, pa3); partialSM(pA0, pA1, m_reg, mnA, alA);
    __syncthreads(); SWAIT(); SWRITE(1, SO);
    RESC(alA); __syncthreads();
  }
  SBAR(); qkt(pB0, pB1, K_lds + SHM_K, qr, Qrl, r32, hi);
  finishSM(pA0, pA1, alA, l_reg, pa0, pa1, pa2, pa3); SBAR();
  pv_d0(o, vb0, pa0, pa1, pa2, pa3); partialSM(pB0, pB1, m_reg, mnB, alB);
  __syncthreads(); RESC(alB);
  finishSM(pB0, pB1, alB, l_reg, pa0, pa1, pa2, pa3); SBAR();
  pv_d0(o, vb0 + (int)SHM_V, pa0, pa1, pa2, pa3);
  if (hi == 0) li_l[r32] = l_reg; asm volatile("s_waitcnt lgkmcnt(0)" ::: "memory");
  float rli[16];
#pragma unroll
  for (int r = 0; r < 16; ++r) rli[r] = __builtin_amdgcn_rcpf(li_l[crow(r, hi)]);
  bf16r* Ow = Ob + (long)(wid * QBLK) * LDO;
#pragma unroll
  for (int r = 0; r < 16; ++r) { const int orow = crow(r, hi);
#pragma unroll
    for (int d0 = 0; d0 < 4; ++d0) { const unsigned w = cvtpk(o[d0][r] * rli[r], 0.f); Ow[(long)orow * LDO + d0 * 32 + r32] = (bf16r)(w & 0xffffu); } }
  __syncthreads();
#undef SLOAD
#undef SWRITE
#undef SWAIT
#undef RESC
}
#undef SBAR
}

namespace fftc {
#define FGAS __attribute__((address_space(1)))
typedef float f2 __attribute__((ext_vector_type(2)));
typedef __attribute__((address_space(3))) f2 lf2;
constexpr int L = 16384;
constexpr int FFT_LDS_BYTES = 17920 * 8;
__device__ static const float TW64C[32] = { 1.000000000e+00f, 9.951847267e-01f, 9.807852804e-01f, 9.569403357e-01f, 9.238795325e-01f, 8.819212643e-01f, 8.314696123e-01f, 7.730104534e-01f, 7.071067812e-01f, 6.343932842e-01f, 5.555702330e-01f, 4.713967368e-01f, 3.826834324e-01f, 2.902846773e-01f, 1.950903220e-01f, 9.801714033e-02f, 0.0f, -9.801714033e-02f, -1.950903220e-01f, -2.902846773e-01f, -3.826834324e-01f, -4.713967368e-01f, -5.555702330e-01f, -6.343932842e-01f, -7.071067812e-01f, -7.730104534e-01f, -8.314696123e-01f, -8.819212643e-01f, -9.238795325e-01f, -9.569403357e-01f, -9.807852804e-01f, -9.951847267e-01f };
__device__ static const float TW64S[32] = { 0.000000000e+00f, 9.801714033e-02f, 1.950903220e-01f, 2.902846773e-01f, 3.826834324e-01f, 4.713967368e-01f, 5.555702330e-01f, 6.343932842e-01f, 7.071067812e-01f, 7.730104534e-01f, 8.314696123e-01f, 8.819212643e-01f, 9.238795325e-01f, 9.569403357e-01f, 9.807852804e-01f, 9.951847267e-01f, 1.000000000e+00f, 9.951847267e-01f, 9.807852804e-01f, 9.569403357e-01f, 9.238795325e-01f, 8.819212643e-01f, 8.314696123e-01f, 7.730104534e-01f, 7.071067812e-01f, 6.343932842e-01f, 5.555702330e-01f, 4.713967368e-01f, 3.826834324e-01f, 2.902846773e-01f, 1.950903220e-01f, 9.801714033e-02f };
__device__ __forceinline__ f2 cmul(f2 a, f2 w) { return (f2){a.x * w.x - a.y * w.y, a.x * w.y + a.y * w.x}; }
template <bool INV> __device__ __forceinline__ f2 twmul(f2 d, int tw) {
    if (tw == 0) return d;
    if (tw == 16) return INV ? (f2){-d.y, d.x} : (f2){d.y, -d.x};
    const float c = TW64C[tw], s = TW64S[tw];
    return INV ? (f2){d.x * c - d.y * s, d.y * c + d.x * s} : (f2){d.x * c + d.y * s, d.y * c - d.x * s};
}
template <int N, int S, bool INV> __device__ __forceinline__ void dif_stage(f2 (&v)[N]) {
#pragma unroll
    for (int blk = 0; blk < N; blk += 2 * S)
#pragma unroll
        for (int i = 0; i < S; ++i) { const f2 a = v[blk + i], b = v[blk + i + S]; v[blk + i] = a + b; v[blk + i + S] = twmul<INV>(a - b, i * (32 / S)); }
    if constexpr (S > 1) dif_stage<N, S / 2, INV>(v);
}
constexpr int bitrev(int k, int bits) { int r = 0; for (int b = 0; b < bits; ++b) r |= ((k >> b) & 1) << (bits - 1 - b); return r; }
template <int N, bool INV> __device__ __forceinline__ void dft(f2 (&v)[N]) {
    dif_stage<N, N / 2, INV>(v);
    constexpr int bits = (N == 32) ? 5 : 4;
    f2 t[N];
#pragma unroll
    for (int k = 0; k < N; ++k) t[k] = v[bitrev(k, bits)];
#pragma unroll
    for (int k = 0; k < N; ++k) v[k] = t[k];
}
template <bool CONJ> __device__ __forceinline__ void apply_pow32(f2 (&v)[32], f2 w) {
    if (CONJ) w.y = -w.y;
    f2 lo[8]; lo[0] = (f2){1.f, 0.f}; lo[1] = w; lo[2] = cmul(w, w); lo[3] = cmul(lo[2], w); lo[4] = cmul(lo[2], lo[2]); lo[5] = cmul(lo[4], w); lo[6] = cmul(lo[4], lo[2]); lo[7] = cmul(lo[4], lo[3]);
#pragma unroll
    for (int k = 1; k < 32; ++k) if (k & 7) v[k] = cmul(v[k], lo[k & 7]);
    const f2 p8 = cmul(lo[4], lo[4]), p16 = cmul(p8, p8), p24 = cmul(p16, p8);
#pragma unroll
    for (int k = 8; k < 16; ++k) v[k] = cmul(v[k], p8);
#pragma unroll
    for (int k = 16; k < 24; ++k) v[k] = cmul(v[k], p16);
#pragma unroll
    for (int k = 24; k < 32; ++k) v[k] = cmul(v[k], p24);
}
__device__ __forceinline__ int opaque(int x) { asm volatile("" : "+v"(x)); return x; }
__device__ __forceinline__ f2 cis_pi(float x) { float s, c; sincospif(x, &s, &c); return (f2){c, s}; }
#define FPHYS(d1, d2, d3) ((d1) * 560 + (d2) * 17 + (d3))
#define FSYNC() __syncthreads()
__device__ __forceinline__ void pass1_fwd(lf2* X, f2 (&v)[32], int tid) {
    tid = opaque(tid);
    dft<32, false>(v);
    apply_pow32<false>(v, cis_pi(-(float)tid * (2.0f / L)));
    const int base = (tid >> 4) * 17 + (tid & 15);
#pragma unroll
    for (int k = 0; k < 32; ++k) X[base + k * 560] = v[k];
}
__device__ __forceinline__ void pass1_inv(const lf2* X, f2 (&v)[32], int tid) {
    tid = opaque(tid);
    const int base = (tid >> 4) * 17 + (tid & 15);
#pragma unroll
    for (int k = 0; k < 32; ++k) v[k] = X[base + k * 560];
    apply_pow32<true>(v, cis_pi(-(float)tid * (2.0f / L)));
    dft<32, true>(v);
}
template <bool INV> __device__ __forceinline__ void pass2(lf2* X, int tid) {
    tid = opaque(tid);
    const int base = (tid >> 4) * 560 + (tid & 15); f2 v[32];
#pragma unroll
    for (int k = 0; k < 32; ++k) v[k] = X[base + k * 17];
    const f2 w = cis_pi(-(float)(tid & 15) * (2.0f / 512.0f));
    if (INV) { apply_pow32<true>(v, w); dft<32, true>(v); } else { dft<32, false>(v); apply_pow32<false>(v, w); }
#pragma unroll
    for (int k = 0; k < 32; ++k) X[base + k * 17] = v[k];
}
template <bool KMODE> __device__ __forceinline__ void pass3(lf2* X, f2* KS, int tid) {
    typedef float f4 __attribute__((ext_vector_type(4)));
    tid = opaque(tid);
#pragma unroll 1
    for (int i = 0; i < 2; ++i) { const int base = ((tid >> 5) + 16 * i) * 560 + (tid & 31) * 17; f2 u[16]; FGAS f4* ks = (FGAS f4*)(KS + (size_t)(i * 512 + tid) * 16);
#pragma unroll
        for (int k = 0; k < 16; ++k) u[k] = X[base + k];
        dft<16, false>(u);
        if (KMODE) {
#pragma unroll
            for (int k = 0; k < 8; ++k) ks[k] = (f4){u[2 * k].x, u[2 * k].y, u[2 * k + 1].x, u[2 * k + 1].y};
        } else {
#pragma unroll
            for (int k = 0; k < 8; ++k) { const f4 w = ks[k]; u[2 * k] = cmul(u[2 * k], (f2){w.x, w.y}); u[2 * k + 1] = cmul(u[2 * k + 1], (f2){w.z, w.w}); }
            dft<16, true>(u);
#pragma unroll
            for (int k = 0; k < 16; ++k) X[base + k] = u[k];
        } }
}
__device__ __forceinline__ void kernel_spectrum(lf2* X, f2 (&v)[32], f2* KS, int tid) {
    pass1_fwd(X, v, tid); FSYNC(); pass2<false>(X, tid); FSYNC(); pass3<true>(X, KS, tid); FSYNC();
}
__device__ __forceinline__ void conv_roundtrip(lf2* X, f2 (&v)[32], f2* KS, int tid) {
    pass1_fwd(X, v, tid); FSYNC(); pass2<false>(X, tid); FSYNC(); pass3<false>(X, KS, tid); FSYNC(); pass2<true>(X, tid); FSYNC(); pass1_inv(X, v, tid); FSYNC();
}
__device__ __forceinline__ void modulate(f2 (&v)[32], int tid) {
    const f2 wj = cis_pi(-(float)opaque(tid) * (1.0f / L));
#pragma unroll
    for (int k = 0; k < 32; ++k) v[k] = twmul<false>(cmul(v[k], wj), k);
}
__device__ __forceinline__ void demodulate(f2 (&v)[32], int tid) {
    f2 wj = cis_pi(-(float)opaque(tid) * (1.0f / L)); wj.y = -wj.y;
#pragma unroll
    for (int k = 0; k < 32; ++k) v[k] = twmul<true>(cmul(v[k], wj), k);
}
__device__ __forceinline__ float bf2f(unsigned short u) { return __uint_as_float((unsigned)u << 16); }
__device__ __forceinline__ unsigned short f2bf_rne(float f) { unsigned u = __float_as_uint(f); return (unsigned short)((u + 0x7fffu + ((u >> 16) & 1u)) >> 16); }
template <typename T> __device__ __forceinline__ FGAS T* pstep(FGAS T* p, int n) { p += n; asm volatile("" : "+v"(p)); return p; }
template <bool OUT_BF16> __device__ __forceinline__ void hyena_channel(lf2* X, const float* z0, const float* z1, const float* hf, const float* hb,
                                                                        const unsigned short* g0, const unsigned short* g1, float dbias, float* zo0, float* zo1,
                                                                        unsigned short* o0, unsigned short* o1, f2* stash, f2* KS, int tid) {
    f2 v[32];
    { FGAS const float* pf = (FGAS const float*)hf + opaque(tid); FGAS const float* pb = (FGAS const float*)hb + ((L - opaque(tid)) & (L - 1));
#pragma unroll
      for (int k = 0; k < 32; ++k) { v[k] = (f2){*pf + *pb, 0.f}; pf = pstep(pf, 512); pb = (k == 0) ? pstep((FGAS const float*)hb + (L - 512 - tid), 0) : pstep(pb, -512); } }
    kernel_spectrum(X, v, KS, tid);
    { FGAS const float* p0 = (FGAS const float*)z0 + opaque(tid); FGAS const float* p1 = (FGAS const float*)z1 + opaque(tid);
#pragma unroll
      for (int k = 0; k < 32; ++k) { v[k] = (f2){*p0, *p1}; p0 = pstep(p0, 512); p1 = pstep(p1, 512); } }
    conv_roundtrip(X, v, KS, tid);
    { FGAS f2* ps = (FGAS f2*)stash + opaque(tid);
#pragma unroll
      for (int k = 0; k < 32; ++k) { *ps = v[k]; ps = pstep(ps, 512); } }
    { FGAS const float* pf = (FGAS const float*)hf + opaque(tid); FGAS const float* pb = (FGAS const float*)hb + ((L - opaque(tid)) & (L - 1));
#pragma unroll
      for (int k = 0; k < 32; ++k) { const float hbv = *pb; v[k] = (f2){*pf + ((k == 0 && tid == 0) ? hbv : -hbv), 0.f}; pf = pstep(pf, 512); pb = (k == 0) ? pstep((FGAS const float*)hb + (L - 512 - tid), 0) : pstep(pb, -512); } }
    modulate(v, tid);
    kernel_spectrum(X, v, KS, tid);
    { FGAS const float* p0 = (FGAS const float*)z0 + opaque(tid); FGAS const float* p1 = (FGAS const float*)z1 + opaque(tid);
#pragma unroll
      for (int k = 0; k < 32; ++k) { v[k] = (f2){*p0, *p1}; p0 = pstep(p0, 512); p1 = pstep(p1, 512); } }
    modulate(v, tid);
    conv_roundtrip(X, v, KS, tid);
    demodulate(v, tid);
    const float sc = 1.0f / (2.0f * L);
    { FGAS const f2* ps = (FGAS const f2*)stash + opaque(tid); FGAS const float* p0 = (FGAS const float*)z0 + opaque(tid); FGAS const float* p1 = (FGAS const float*)z1 + opaque(tid); FGAS const unsigned short* q0 = (FGAS const unsigned short*)g0 + opaque(tid); FGAS const unsigned short* q1 = (FGAS const unsigned short*)g1 + opaque(tid);
      FGAS float* w0 = (FGAS float*)zo0 + opaque(tid); FGAS float* w1 = (FGAS float*)zo1 + opaque(tid); FGAS unsigned short* b0 = (FGAS unsigned short*)o0 + opaque(tid); FGAS unsigned short* b1 = (FGAS unsigned short*)o1 + opaque(tid);
#pragma unroll
      for (int k = 0; k < 32; ++k) { const f2 y = (*ps + v[k]) * sc;
          const float r0 = bf2f(*q0) * (y.x + dbias * *p0), r1 = bf2f(*q1) * (y.y + dbias * *p1);
          if (OUT_BF16) { *b0 = f2bf_rne(r0); *b1 = f2bf_rne(r1); b0 = pstep(b0, 512); b1 = pstep(b1, 512); } else { *w0 = r0; *w1 = r1; w0 = pstep(w0, 512); w1 = pstep(w1, 512); }
          ps = pstep(ps, 512); p0 = pstep(p0, 512); p1 = pstep(p1, 512); q0 = pstep(q0, 512); q1 = pstep(q1, 512); } }
}
#undef FPHYS
#undef FGAS
}

constexpr int BATCH = 2, SEQ = 16384, DM = 1024, T = BATCH * SEQ;
constexpr int NH = 8, DNOPE = 128, DROPE = 64, DQK = 192, DVH = 128, QLORA = 384, KVLORA = 256, MLA_IN = 704, MLA_INP = 768;
constexpr int DFF = 2816, NUP = 2 * DFF;
constexpr int HF = 64, HEMB = 33, HKP = 256;
constexpr float LN_EPS = 1e-5f, RMS_EPS = 1e-6f;
constexpr float DN_ALPHA = 1.4142135623730951f;
constexpr float QSCALE = 0.07216878364870322f * 1.4426950408889634f;
constexpr int NWAVES = 8;

constexpr size_t MiB = 1u << 20;
constexpr size_t WS_CTL = 0, CTL_ZERO_BYTES = 1 * MiB;
constexpr size_t WS_WIN = 2 * MiB, WS_WUQ = 4 * MiB, WS_WUKV = 6 * MiB, WS_WO = 7 * MiB, WS_WHIN = 9 * MiB, WS_WHO = 15 * MiB, WS_WUP = 17 * MiB, WS_WDN = 39 * MiB, WS_WFO = 50 * MiB, WS_H3 = 52 * MiB;
constexpr size_t WS_XB = 60 * MiB;
constexpr size_t WS_XF = 124 * MiB;
constexpr size_t WS_S = 252 * MiB;
constexpr size_t WS_END = 512 * MiB;
constexpr size_t WS_CQN = WS_XF, WS_CKVN = WS_XF + 24 * MiB, WS_ROPE = WS_XF + 40 * MiB;
constexpr size_t WS_Q = WS_S, WS_K = WS_S + 96 * MiB, WS_V = WS_S + 192 * MiB;
constexpr size_t WS_UH = WS_S;
constexpr size_t WS_U = WS_S;
constexpr size_t WS_VC0 = WS_XB, WS_VC1 = WS_S + 192 * MiB;
constexpr size_t WS_KT = WS_S, WS_STASH = WS_S + 128 * MiB, WS_KSPEC = WS_S + 160 * MiB;
constexpr int CW_TMO = 0, CW_CODE = 1, CW_BAR = 4096;

constexpr int RING_BYTES = 131072;
constexpr int LDS_BYTES = 147456;
constexpr int MISC_OFF = LDS_BYTES - 512;
static_assert(fftc::FFT_LDS_BYTES <= MISC_OFF && attn::SHM_ATTN <= RING_BYTES, "LDS map");

typedef pg8::bf16_t bf16;
typedef unsigned u32x4t __attribute__((ext_vector_type(4)));
typedef unsigned u32x2t __attribute__((ext_vector_type(2)));
typedef float f32x2 __attribute__((ext_vector_type(2)));
__device__ __forceinline__ float wave_sum(float v) {
#pragma unroll
    for (int o = 1; o < 64; o <<= 1) v += __shfl_xor(v, o);
    return v;
}
__device__ __forceinline__ float bf_lo(unsigned w) { return __uint_as_float(w << 16); }
__device__ __forceinline__ float bf_hi(unsigned w) { return __uint_as_float(w & 0xffff0000u); }
__device__ __forceinline__ unsigned pkbf(float lo, float hi) { return pg8::cvt_pk_bf16(lo, hi); }

template <class ColMap> __device__ __forceinline__ void transpose_item(const float* W, int K, int N, bf16* WT, int ldk, LAS float* scr, int item, int nblk, int lane, const ColMap& cm) {
    const int kb = item / nblk, nb = item % nblk, k0 = 64 * kb, n0 = 32 * nb;
    const int sc = cm(n0 + (lane & 31));
#pragma unroll 8
    for (int i = 0; i < 32; ++i) { const int kk = 2 * i + (lane >> 5); scr[kk * 33 + (lane & 31)] = (sc >= 0) ? W[(size_t)(k0 + kk) * N + sc] : 0.f; }
    asm volatile("s_waitcnt lgkmcnt(0)" ::: "memory");
    const int c = lane & 7;
#pragma unroll
    for (int j = 0; j < 4; ++j) { const int n = (lane >> 3) + 8 * j; const LAS float* s = scr + (8 * c) * 33 + n;
        u32x4t o; o.x = pkbf(s[0 * 33], s[1 * 33]); o.y = pkbf(s[2 * 33], s[3 * 33]); o.z = pkbf(s[4 * 33], s[5 * 33]); o.w = pkbf(s[6 * 33], s[7 * 33]);
        *(u32x4t*)(WT + (size_t)(n0 + n) * ldk + k0 + 8 * c) = o; }
    asm volatile("s_waitcnt lgkmcnt(0)" ::: "memory");
}
struct CmIdent { __device__ __forceinline__ int operator()(int n) const { return n; } };
struct CmWin { __device__ __forceinline__ int operator()(int n) const { if (n < 640) return n; if (n >= 704) return -1; const int i = n - 640; return 640 + (i & 1) * 32 + (i >> 1); } };
struct CmWuq { __device__ __forceinline__ int operator()(int n) const { const int h = n / 192, d = n - h * 192; if (d < 128) return n; const int i = d - 128; return h * 192 + 128 + (i & 1) * 32 + (i >> 1); } };
struct CmWukv { __device__ __forceinline__ int operator()(int n) const { const int v = n >> 10, r = n & 1023, h = r >> 7, d = r & 127; return h * 256 + v * 128 + d; } };
struct CmWup { __device__ __forceinline__ int operator()(int n) const { const int pn = n >> 8, r = n & 255; return (r < 128) ? (pn * 128 + r) : (DFF + pn * 128 + (r - 128)); } };

struct Args {
    const float* in[27]; float* out; unsigned char* ws; int ph_lo, ph_hi;
};
enum { I_X = 0, I_POS, I_MLA_WIN, I_MLA_GQ, I_MLA_WUQ, I_MLA_GKV, I_MLA_WUKV, I_MLA_WO, I_HY_WIN, I_HY_WSHORT, I_HY_FW1, I_HY_FB1, I_HY_FW2, I_HY_FB2, I_HY_FW3, I_HY_FB3, I_HY_FREQ,
       I_HY_FWOUT, I_HY_DBIAS, I_HY_WO, I_FFN_WUP, I_FFN_WCONV, I_FFN_WDOWN, I_LN1G, I_LN1B, I_LN2G, I_LN2B };

__device__ __forceinline__ void ln_rows(const float* Y, float* OF, bf16* OB, const float* g, const float* b, int gw, int ngw, int lane) {
    f32x4 gv[4], bv[4];
#pragma unroll
    for (int j = 0; j < 4; ++j) { gv[j] = *(const f32x4*)(g + 4 * lane + 256 * j); bv[j] = *(const f32x4*)(b + 4 * lane + 256 * j); }
    for (int m = gw; m < T; m += ngw) {
        const f32x4* xr = (const f32x4*)(Y + (size_t)m * DM) + lane;
        f32x4 v[4]; float s = 0.f;
#pragma unroll
        for (int j = 0; j < 4; ++j) { v[j] = xr[64 * j]; s += (v[j].x + v[j].y) + (v[j].z + v[j].w); }
        const float mean = wave_sum(s) * (1.f / DM); float s2 = 0.f;
#pragma unroll
        for (int j = 0; j < 4; ++j) { v[j] = v[j] - mean; s2 += (v[j].x * v[j].x + v[j].y * v[j].y) + (v[j].z * v[j].z + v[j].w * v[j].w); }
        const float rstd = 1.f / sqrtf(wave_sum(s2) * (1.f / DM) + LN_EPS);
        f32x4* of = (f32x4*)(OF + (size_t)m * DM) + lane;
#pragma unroll
        for (int j = 0; j < 4; ++j) { v[j] = v[j] * rstd * gv[j] + bv[j]; of[64 * j] = v[j]; }
        if (OB) { u32x2t* ob = (u32x2t*)(OB + (size_t)m * DM) + lane;
#pragma unroll
            for (int j = 0; j < 4; ++j) { u32x2t w; w.x = pkbf(v[j].x, v[j].y); w.y = pkbf(v[j].z, v[j].w); ob[64 * j] = w; } }
    }
}

__device__ __forceinline__ void mla_norm_rope(const float* H1, const float* gq, const float* gkv, const f32x2* tab, bf16* CQN, bf16* CKVN, bf16* Kb, int gw, int ngw, int lane) {
    float gqv[6], gkvv[4];
#pragma unroll
    for (int k = 0; k < 6; ++k) gqv[k] = gq[lane + 64 * k];
#pragma unroll
    for (int k = 0; k < 4; ++k) gkvv[k] = gkv[lane + 64 * k];
    for (int t = gw; t < T; t += ngw) {
        const float* h = H1 + (size_t)t * MLA_INP;
        float q[6], kv[4]; float sq = 0.f, sk = 0.f;
#pragma unroll
        for (int k = 0; k < 6; ++k) { q[k] = h[lane + 64 * k]; sq += q[k] * q[k]; }
#pragma unroll
        for (int k = 0; k < 4; ++k) { kv[k] = h[QLORA + lane + 64 * k]; sk += kv[k] * kv[k]; }
        const f32x2 xr = *(const f32x2*)(h + 640 + 2 * (lane & 31));
        const float rq = 1.f / sqrtf(wave_sum(sq) * (1.f / QLORA) + RMS_EPS), rk = 1.f / sqrtf(wave_sum(sk) * (1.f / KVLORA) + RMS_EPS);
#pragma unroll
        for (int k = 0; k < 6; ++k) CQN[(size_t)t * QLORA + lane + 64 * k] = (bf16)(pkbf(q[k] * rq * gqv[k], 0.f) & 0xffffu);
#pragma unroll
        for (int k = 0; k < 4; ++k) CKVN[(size_t)t * KVLORA + lane + 64 * k] = (bf16)(pkbf(kv[k] * rk * gkvv[k], 0.f) & 0xffffu);
        const f32x2 cs = tab[(size_t)t * 32 + (lane & 31)];
        const unsigned w = pkbf(xr.x * cs.x - xr.y * cs.y, xr.x * cs.y + xr.y * cs.x);
        unsigned* kr = (unsigned*)(Kb + (size_t)t * 1536 + 128) + (lane & 31);
        if (lane < 32) {
#pragma unroll
            for (int hh = 0; hh < NH; ++hh) kr[hh * 96] = w; }
    }
}

__device__ __forceinline__ void ffn_conv_silu(const bf16* UH, const float* wconv  , bf16* HACT  , int gw, int ngw, int lane) {
    constexpr int RB = 64, NRB = SEQ / RB, NCC = 6;
    for (int it = gw; it < NRB * NCC; it += ngw) {
        const int rb = it / NCC, cc = it - rb * NCC, c = cc * 512 + lane * 8;
        if (c >= DFF) continue;
        const int pn = c >> 7, ucol = pn * 256 + (c & 127);
        float wa[3][8], wg[3][8];
#pragma unroll
        for (int k = 0; k < 3; ++k)
#pragma unroll
            for (int e = 0; e < 8; ++e) { wa[k][e] = wconv[k * NUP + c + e]; wg[k][e] = wconv[k * NUP + DFF + c + e]; }
        const int r0 = rb * RB;
        u32x4t pa = {0u, 0u, 0u, 0u}, pg = pa, ca, cg, na, ng;
        if (r0 > 0) { pa = *(const u32x4t*)(UH + (size_t)(r0 - 1) * NUP + ucol); pg = *(const u32x4t*)(UH + (size_t)(r0 - 1) * NUP + ucol + 128); }
        ca = *(const u32x4t*)(UH + (size_t)r0 * NUP + ucol); cg = *(const u32x4t*)(UH + (size_t)r0 * NUP + ucol + 128);
        for (int r = r0; r < r0 + RB; ++r) {
            if (r + 1 < SEQ) { na = *(const u32x4t*)(UH + (size_t)(r + 1) * NUP + ucol); ng = *(const u32x4t*)(UH + (size_t)(r + 1) * NUP + ucol + 128); }
            else { na = (u32x4t){0u, 0u, 0u, 0u}; ng = na; }
            float ha[8], hg[8];
#pragma unroll
            for (int e2 = 0; e2 < 4; ++e2) {
                ha[2 * e2]     = wa[0][2 * e2] * bf_lo(pa[e2]) + wa[1][2 * e2] * bf_lo(ca[e2]) + wa[2][2 * e2] * bf_lo(na[e2]);
                ha[2 * e2 + 1] = wa[0][2 * e2 + 1] * bf_hi(pa[e2]) + wa[1][2 * e2 + 1] * bf_hi(ca[e2]) + wa[2][2 * e2 + 1] * bf_hi(na[e2]);
                hg[2 * e2]     = wg[0][2 * e2] * bf_lo(pg[e2]) + wg[1][2 * e2] * bf_lo(cg[e2]) + wg[2][2 * e2] * bf_lo(ng[e2]);
                hg[2 * e2 + 1] = wg[0][2 * e2 + 1] * bf_hi(pg[e2]) + wg[1][2 * e2 + 1] * bf_hi(cg[e2]) + wg[2][2 * e2 + 1] * bf_hi(ng[e2]); }
            float o[8];
#pragma unroll
            for (int e = 0; e < 8; ++e) o[e] = ha[e] * hg[e] / (1.f + __expf(-hg[e]));
            u32x4t w; w.x = pkbf(o[0], o[1]); w.y = pkbf(o[2], o[3]); w.z = pkbf(o[4], o[5]); w.w = pkbf(o[6], o[7]);
            *(u32x4t*)(HACT + (size_t)r * DFF + c) = w;
            pa = ca; pg = cg; ca = na; cg = ng;
        }
    }
}

__device__ __forceinline__ void hy_conv_transpose(const bf16* U  , const float* wshort  , float* VC0, float* VC1, bf16* G1C, bf16* G2C, LAS unsigned* scr, int gw, int ngw, int lane) {
    constexpr int NTT = T / 64, NCT = 3072 / 64;
    for (int it = gw; it < NTT * NCT; it += ngw) {
        const int ct = it % NCT, tt = it / NCT, b = tt / (SEQ / 64), t0 = (tt % (SEQ / 64)) * 64, c0 = ct * 64;
        const int r8 = lane >> 3, c8 = lane & 7;
#pragma unroll
        for (int i = 0; i < 9; ++i) { const int row = r8 + 8 * i; if (row < 66) { const int tok = t0 - 1 + row; u32x4t v = {0u, 0u, 0u, 0u};
                if (tok >= 0 && tok < SEQ) v = *(const u32x4t*)(U + ((size_t)b * SEQ + tok) * 3072 + c0 + c8 * 8);
                LAS unsigned* d = scr + row * 33 + c8 * 4; d[0] = v.x; d[1] = v.y; d[2] = v.z; d[3] = v.w; } }
        asm volatile("s_waitcnt lgkmcnt(0)" ::: "memory");
        const int part = c0 >> 10, chb = c0 & 1023;
#pragma unroll 4
        for (int cp = 0; cp < 32; ++cp) {
            const unsigned a0 = scr[lane * 33 + cp], a1 = scr[(lane + 1) * 33 + cp], a2 = scr[(lane + 2) * 33 + cp];
            const int cg = c0 + 2 * cp;
            const float w00 = wshort[cg], w10 = wshort[3072 + cg], w20 = wshort[6144 + cg], w01 = wshort[cg + 1], w11 = wshort[3072 + cg + 1], w21 = wshort[6144 + cg + 1];
            const float v0 = w00 * bf_lo(a0) + w10 * bf_lo(a1) + w20 * bf_lo(a2), v1 = w01 * bf_hi(a0) + w11 * bf_hi(a1) + w21 * bf_hi(a2);
            const size_t o = (size_t)(chb + 2 * cp) * SEQ + t0 + lane;
            if (part == 0) { float* d = b ? VC1 : VC0; d[o] = v0; d[o + SEQ] = v1; }
            else { bf16* d = (part == 1 ? G1C : G2C) + (size_t)b * 1024 * SEQ; d[o] = (bf16)(pkbf(v0, 0.f) & 0xffffu); d[o + SEQ] = (bf16)(pkbf(v1, 0.f) & 0xffffu); }
        }
        asm volatile("s_waitcnt lgkmcnt(0)" ::: "memory");
    }
}
__device__ __forceinline__ void hy_transpose_back(const bf16* Z3C, bf16* XB, LAS unsigned* scr, int gw, int ngw, int lane) {
    constexpr int NTT = T / 64, NCT = 1024 / 64;
    for (int it = gw; it < NTT * NCT; it += ngw) {
        const int ct = it % NCT, tt = it / NCT, b = tt / (SEQ / 64), t0 = (tt % (SEQ / 64)) * 64, c0 = ct * 64;
        const bf16* src = Z3C + ((size_t)b * 1024 + c0) * SEQ + t0 + lane;
#pragma unroll 8
        for (int cp = 0; cp < 32; ++cp) { const unsigned lo = src[(size_t)(2 * cp) * SEQ], hi = src[(size_t)(2 * cp + 1) * SEQ]; scr[lane * 33 + cp] = lo | (hi << 16); }
        asm volatile("s_waitcnt lgkmcnt(0)" ::: "memory");
        const int r8 = lane >> 3, c8 = lane & 7;
#pragma unroll
        for (int i = 0; i < 8; ++i) { const int row = r8 + 8 * i; const LAS unsigned* s = scr + row * 33 + c8 * 4; u32x4t v; v.x = s[0]; v.y = s[1]; v.z = s[2]; v.w = s[3];
            *(u32x4t*)(XB + ((size_t)b * SEQ + t0 + row) * DM + c0 + c8 * 8) = v; }
        asm volatile("s_waitcnt lgkmcnt(0)" ::: "memory");
    }
}

#ifndef MK_PER_PHASE
#define MK_PER_PHASE 0
#endif
constexpr int N_PHASES = 30;
constexpr int GEMM_SP2 = true, GEMM_ALIGN = true;

__global__ void __launch_bounds__(NWAVES * 64, 2) mega_fwd(Args args) {
    extern __shared__ __attribute__((aligned(16))) unsigned char lds[];
    LAS unsigned char* ldsl = (LAS unsigned char*)lds;
    volatile LAS unsigned* MISC = (volatile LAS unsigned*)(ldsl + MISC_OFF);
    const int wave = __builtin_amdgcn_readfirstlane((int)threadIdx.x >> 6);
#define lane hw_lane()
#define tid (wave * 64 + hw_lane())
#define G ((int)gridDim.x)
#define bx ((int)blockIdx.x)
#define gw (bx * NWAVES + wave)
#define ngw (G * NWAVES)
    { const int t_ = tid; if (t_ < 128) MISC[t_] = 0u; }
    __syncthreads();
    if (!MK_PER_PHASE) (void)xcd_barrier_post((unsigned*)(args.ws + WS_CTL) + CW_BAR, MISC + 8, (unsigned)wave);
    const int lo = args.ph_lo, hi = args.ph_hi;
#ifdef ONLY_PHASE
#define IN(k) ((k) == ONLY_PHASE && lo <= (k) && (k) < hi)
#else
#define IN(k) (lo <= (k) && (k) < hi)
#endif
#define SEAM(k) do { if (IN(k) && IN((k) + 1)) { XcdBarrier bar_; bar_.bar = (unsigned*)(args.ws + WS_CTL) + CW_BAR; bar_.x = xb_xcc_id(); bar_.st = MISC + 8; bar_.wv = (unsigned)wave; xcd_barrier(bar_); } } while (0)

#define P_(T_, off) ((T_*)(args.ws + (off)))
#define Win_t P_(bf16, WS_WIN)
#define Wuq_t P_(bf16, WS_WUQ)
#define Wukv_t P_(bf16, WS_WUKV)
#define Wo_t P_(bf16, WS_WO)
#define Whin_t P_(bf16, WS_WHIN)
#define Who_t P_(bf16, WS_WHO)
#define Wup_t P_(bf16, WS_WUP)
#define Wdn_t P_(bf16, WS_WDN)
#define Wfo_t P_(bf16, WS_WFO)
#define H3 P_(bf16, WS_H3)
#define XB P_(bf16, WS_XB)
#define XF P_(float, WS_XF)
#define CQN P_(bf16, WS_CQN)
#define CKVN P_(bf16, WS_CKVN)
#define ROPE P_(f32x2, WS_ROPE)
#define Qb P_(bf16, WS_Q)
#define Kb P_(bf16, WS_K)
#define Vb P_(bf16, WS_V)
#define UH P_(bf16, WS_UH)
#define U P_(bf16, WS_U)
#define VC0 P_(float, WS_VC0)
#define VC1 P_(float, WS_VC1)
#define KT P_(float, WS_KT)
#define STASH P_(fftc::f2, WS_STASH)
#define KSPEC P_(fftc::f2, WS_KSPEC)
#define OUT (args.out)
#define H1 (args.out)
#define HACT ((bf16*)args.out)
#define G1C ((bf16*)args.out)
#define G2C ((bf16*)args.out + (size_t)2 * 1024 * SEQ)
#define Z3C ((bf16*)args.out)
#define GEMM(EPI, A_, B_, M_, N_, K_, ...) do { pg8::Gemm g{(A_), (B_), (M_), (N_), (K_)}; pg8::StaticOrder S; S.init((M_), (N_), G, bx); pg8::EPI E{__VA_ARGS__}; \
        pg8::gemm_phase<pg8::EPI, pg8::StaticOrder, GEMM_ALIGN, GEMM_SP2>(ldsl, g, S, E, wave); } while (0)

    if (IN(0)) {
        LAS float* scr = (LAS float*)(ldsl + wave * 16384);
        {
            int base = 0;
#define TR(W_, K_, N_, WT_, NP_, LDK_, CM_) do { const int nblk_ = (NP_) / 32, nit_ = ((K_) / 64) * nblk_; \
                for (int it_ = (gw + ngw - base % ngw) % ngw; it_ < nit_; it_ += ngw) transpose_item((W_), (K_), (N_), (WT_), (LDK_), scr, it_, nblk_, lane, CM_); base += nit_; } while (0)
            TR(args.in[I_MLA_WIN], DM, MLA_IN, Win_t, MLA_INP, DM, CmWin());
            TR(args.in[I_MLA_WUQ], QLORA, NH * DQK, Wuq_t, NH * DQK, QLORA, CmWuq());
            TR(args.in[I_MLA_WUKV], KVLORA, NH * 256, Wukv_t, NH * 256, KVLORA, CmWukv());
            TR(args.in[I_MLA_WO], DM, DM, Wo_t, DM, DM, CmIdent());
            TR(args.in[I_HY_WIN], DM, 3 * DM, Whin_t, 3 * DM, DM, CmIdent());
            TR(args.in[I_HY_WO], DM, DM, Who_t, DM, DM, CmIdent());
            TR(args.in[I_FFN_WUP], DM, NUP, Wup_t, NUP, DM, CmWup());
            TR(args.in[I_FFN_WUP] + (size_t)DM * NUP, DM, NUP, Wup_t + (size_t)NUP * DM, NUP, DM, CmWup());
            TR(args.in[I_FFN_WDOWN], DFF, DM, Wdn_t, DM, DFF, CmIdent());
            TR(args.in[I_FFN_WDOWN] + (size_t)DFF * DM, DFF, DM, Wdn_t + (size_t)DM * DFF, DM, DFF, CmIdent());
            TR(args.in[I_HY_FWOUT], HF, 4 * DM, Wfo_t, 4 * DM, HKP, CmIdent());
#undef TR
        }
        for (size_t i = (size_t)gw * 64 + lane; i < (size_t)4096 * 24; i += (size_t)ngw * 64) { const size_t r = i / 24, c = i % 24; *(u32x4t*)(Wfo_t + r * HKP + 64 + c * 8) = (u32x4t){0u, 0u, 0u, 0u}; }
        for (size_t i = (size_t)gw * 64 + lane; i < (size_t)SEQ * 24; i += (size_t)ngw * 64) { const size_t r = i / 24, c = i % 24; *(u32x4t*)(H3 + r * HKP + 64 + c * 8) = (u32x4t){0u, 0u, 0u, 0u}; }
        { const float* x_in = args.in[I_X];
          for (size_t i = (size_t)gw * 64 + lane; i < (size_t)T * DM / 8; i += (size_t)ngw * 64) { const f32x4 a = *(const f32x4*)(x_in + i * 8), b = *(const f32x4*)(x_in + i * 8 + 4);
            u32x4t w; w.x = pkbf(a.x, a.y); w.y = pkbf(a.z, a.w); w.z = pkbf(b.x, b.y); w.w = pkbf(b.z, b.w); *(u32x4t*)(XB + i * 8) = w; } }
        { const int* pos = (const int*)args.in[I_POS];
          for (size_t i = (size_t)gw * 64 + lane; i < (size_t)T * 32; i += (size_t)ngw * 64) { const int t = (int)(i >> 5), k = (int)(i & 31);
              const double inv = exp(-(double)k * (9.210340371976184 / 32.0)); const double ang = (double)pos[t] * inv; double s, c; sincos(ang, &s, &c); ROPE[i] = (f32x2){(float)c, (float)s}; } }
        { const float* fw1 = args.in[I_HY_FW1]; const float* fb1 = args.in[I_HY_FB1]; const float* fw2 = args.in[I_HY_FW2]; const float* fb2 = args.in[I_HY_FB2];
          const float* fw3 = args.in[I_HY_FW3]; const float* fb3 = args.in[I_HY_FB3]; const float fr = args.in[I_HY_FREQ][lane];
          for (int l = gw; l < SEQ; l += ngw) {
              const float tt = (float)l / (float)(SEQ - 1); const float w = 6.283185307179586f * (float)l / (float)SEQ;
              float z = 0.f;
              if (lane == 0) z = tt;
              else if (lane <= 16) { const float f = 1e-4f + (float)(lane - 1) * ((15.0f - 1e-4f) / 15.0f); z = cosf(f * w); }
              else if (lane <= 32) { const float f = 1e-4f + (float)(lane - 17) * ((15.0f - 1e-4f) / 15.0f); z = -sinf(f * w); }
              float a = fb1[lane];
#pragma unroll
              for (int i = 0; i < HEMB; ++i) a += __shfl(z, i) * fw1[i * HF + lane];
              float h = sinf(fr * a);
              a = fb2[lane];
#pragma unroll 8
              for (int i = 0; i < HF; ++i) a += __shfl(h, i) * fw2[i * HF + lane];
              h = sinf(fr * a);
              a = fb3[lane];
#pragma unroll 8
              for (int i = 0; i < HF; ++i) a += __shfl(h, i) * fw3[i * HF + lane];
              h = sinf(fr * a);
              H3[(size_t)l * HKP + lane] = (bf16)(pkbf(h, 0.f) & 0xffffu);
          } }
    }
    SEAM(0);
    if (IN(1)) GEMM(EpiF32, XB, Win_t, T, MLA_INP, DM, H1, MLA_INP);
    SEAM(1);
    if (IN(2)) mla_norm_rope(H1, args.in[I_MLA_GQ], args.in[I_MLA_GKV], ROPE, CQN, CKVN, Kb, gw, ngw, lane);
    SEAM(2);
#if !defined(P3_ONLY) || P3_ONLY == 1
    if (IN(3)) GEMM(EpiBf16, CQN, Wuq_t, T, NH * DQK, QLORA, Qb, NH * DQK, QSCALE);
#endif
#if !defined(P3_ONLY) || P3_ONLY == 2
    if (IN(3)) GEMM(EpiKV, CKVN, Wukv_t, T, NH * 256, KVLORA, Kb, Vb);
#endif
    SEAM(3);
    if (IN(4)) {
        for (int u = bx; u < BATCH * NH * (SEQ / 256); u += G) { const int qb = u & 63, h = (u >> 6) & 7, b = u >> 9;
            const size_t r0 = (size_t)b * SEQ + (size_t)qb * 256;
            attn::attn_unit(Qb + r0 * 1536 + h * DQK, Kb + (size_t)b * SEQ * 1536 + h * DQK, Vb + (size_t)b * SEQ * 1024 + h * DVH, XB + r0 * 1024 + h * DVH, (const float*)(ROPE + r0 * 32), SEQ, (char*)lds, wave); }
    }
    SEAM(4);
    if (IN(5)) GEMM(EpiResid, XB, Wo_t, T, DM, DM, args.in[I_X], XF, DN_ALPHA);
    SEAM(5);
    if (IN(6)) ln_rows(XF, XF, XB, args.in[I_LN1G], args.in[I_LN1B], gw, ngw, lane);
    SEAM(6);
#define FFN_HALF(p, layer, hb) \
    if (IN(p)) GEMM(EpiBf16, XB + (size_t)(hb) * SEQ * DM, Wup_t + (size_t)(layer) * NUP * DM, SEQ, NUP, DM, UH, NUP, 1.0f); \
    SEAM(p); \
    if (IN((p) + 1)) ffn_conv_silu(UH, args.in[I_FFN_WCONV] + (size_t)(layer) * 3 * NUP, HACT, gw, ngw, lane); \
    SEAM((p) + 1); \
    if (IN((p) + 2)) GEMM(EpiResid, HACT, Wdn_t + (size_t)(layer) * DM * DFF, SEQ, DM, DFF, XF + (size_t)(hb) * SEQ * DM, XF + (size_t)(hb) * SEQ * DM, DN_ALPHA); \
    SEAM((p) + 2);
    FFN_HALF(7, 0, 0)
    FFN_HALF(10, 0, 1)
    if (IN(13)) ln_rows(XF, XF, XB, args.in[I_LN2G], args.in[I_LN2B], gw, ngw, lane);
    SEAM(13);
    if (IN(14)) GEMM(EpiBf16, XB, Whin_t, T, 3 * DM, DM, U, 3 * DM, 1.0f);
    SEAM(14);
    if (IN(15)) hy_conv_transpose(U, args.in[I_HY_WSHORT], VC0, VC1, G1C, G2C, (LAS unsigned*)(ldsl + wave * 16384), gw, ngw, lane);
    SEAM(15);
#define HY_FILT(p, od) \
    if (IN(p)) GEMM(EpiFilt, H3, Wfo_t + (size_t)(od) * 2048 * HKP, SEQ, 2 * DM, HKP, KT, SEQ, -120.39728043259360f, (40.54651081081644f + 120.39728043259360f) / 1023.0f, 1.0f / (float)(SEQ - 1)); \
    SEAM(p);
    HY_FILT(16, 0)
    if (IN(17)) { for (int c = bx; c < DM; c += G) { const size_t co = (size_t)c * SEQ;
            fftc::hyena_channel<false>((fftc::lf2*)ldsl, VC0 + co, VC1 + co, KT + co, KT + (size_t)DM * SEQ + co, G1C + co, G1C + (size_t)DM * SEQ + co, args.in[I_HY_DBIAS][c],
                                       VC0 + co, VC1 + co, nullptr, nullptr, STASH + (size_t)bx * SEQ, KSPEC + (size_t)bx * SEQ, tid); } }
    SEAM(17);
    HY_FILT(18, 1)
    if (IN(19)) { for (int c = bx; c < DM; c += G) { const size_t co = (size_t)c * SEQ;
            fftc::hyena_channel<true>((fftc::lf2*)ldsl, VC0 + co, VC1 + co, KT + co, KT + (size_t)DM * SEQ + co, G2C + co, G2C + (size_t)DM * SEQ + co, args.in[I_HY_DBIAS][DM + c],
                                      nullptr, nullptr, Z3C + co, Z3C + (size_t)DM * SEQ + co, STASH + (size_t)bx * SEQ, KSPEC + (size_t)bx * SEQ, tid); } }
    SEAM(19);
    if (IN(20)) hy_transpose_back(Z3C, XB, (LAS unsigned*)(ldsl + wave * 16384), gw, ngw, lane);
    SEAM(20);
    if (IN(21)) GEMM(EpiResid, XB, Who_t, T, DM, DM, XF, XF, DN_ALPHA);
    SEAM(21);
    if (IN(22)) ln_rows(XF, XF, XB, args.in[I_LN1G] + DM, args.in[I_LN1B] + DM, gw, ngw, lane);
    SEAM(22);
    FFN_HALF(23, 1, 0)
    FFN_HALF(26, 1, 1)
    if (IN(29)) ln_rows(XF, OUT, nullptr, args.in[I_LN2G] + DM, args.in[I_LN2B] + DM, gw, ngw, lane);
#undef IN
#undef SEAM
#undef lane
#undef tid
#undef G
#undef bx
#undef gw
#undef ngw
}

extern "C" void kernel_launch(void* const* d_in, const int* in_sizes, int n_in, void* d_out, int out_size, void* d_ws, size_t ws_size, hipStream_t stream) {
    static int grid = 0;
    if (grid == 0) {
        if (n_in != 27 || in_sizes[0] != T * DM || out_size != T * DM || ws_size < WS_END) { fprintf(stderr, "kernel_launch: shape/workspace mismatch (n_in %d, in0 %d, out %d, ws %zu)\n", n_in, n_in > 0 ? in_sizes[0] : -1, out_size, ws_size); grid = -1; return; }
        int dev = 0, cus = 0, per_cu = 0;
        if (hipGetDevice(&dev) != hipSuccess || hipDeviceGetAttribute(&cus, hipDeviceAttributeMultiprocessorCount, dev) != hipSuccess) { grid = -1; return; }
        if (hipFuncSetAttribute((const void*)mega_fwd, hipFuncAttributeMaxDynamicSharedMemorySize, LDS_BYTES) != hipSuccess) { fprintf(stderr, "kernel_launch: hipFuncSetAttribute failed\n"); grid = -1; return; }
        if (hipOccupancyMaxActiveBlocksPerMultiprocessor(&per_cu, (const void*)mega_fwd, NWAVES * 64, LDS_BYTES) != hipSuccess || per_cu < 1) { fprintf(stderr, "kernel_launch: occupancy query says %d\n", per_cu); }
        (void)hipGetLastError();
        grid = cus;
    }
    if (grid < 0) return;
    if (hipMemsetAsync((char*)d_ws + WS_CTL, 0, CTL_ZERO_BYTES, stream) != hipSuccess) return;
    Args a{};
    for (int i = 0; i < 27; ++i) a.in[i] = (const float*)d_in[i];
    a.out = (float*)d_out; a.ws = (unsigned char*)d_ws;
#if MK_PER_PHASE
    for (int p = 0; p < N_PHASES; ++p) { a.ph_lo = p; a.ph_hi = p + 1; hipLaunchKernelGGL(mega_fwd, dim3(grid), dim3(NWAVES * 64), LDS_BYTES, stream, a); }
#else
    a.ph_lo = 0; a.ph_hi = N_PHASES; hipLaunchKernelGGL(mega_fwd, dim3(grid), dim3(NWAVES * 64), LDS_BYTES, stream, a);
#endif
}
```

```cpp
#include <hip/hip_runtime.h>
#include <cstdio>
#include <cstdint>
__device__ __forceinline__ int hw_lane() { int l; asm volatile("v_mbcnt_lo_u32_b32 %0, -1, 0\n\tv_mbcnt_hi_u32_b32 %0, -1, %0" : "=v"(l)); return l; }
namespace pg8 {
#define PG8_LAS __attribute__((address_space(3)))
typedef unsigned short bf16_t;
typedef short bf16x8 __attribute__((ext_vector_type(8)));
typedef float f32x4 __attribute__((ext_vector_type(4)));
typedef unsigned u32x4 __attribute__((ext_vector_type(4)));
constexpr int BM = 256, BK = 64, HALF = 128, HTB = HALF * BK * 2  , STAGE_BYTES = 8 * HTB, NXCD = 8, WGM = 8;

__host__ __device__ __forceinline__ int lds_byte(int r, int c) { const int st = (r >> 4) * 2 + (c >> 5), rr = r & 15, cc = c & 31, ob = rr * 64 + cc * 2; return st * 1024 + (ob ^ (((ob >> 9) & 1) << 5)); }
__host__ __device__ __forceinline__ void stage_rc(int b, int& R, int& C) { const int st = b / 1024, sb = b % 1024, swz = sb ^ (((sb >> 9) & 1) << 5); R = (st >> 1) * 16 + swz / 64; C = (st & 1) * 32 + (swz % 64) / 2; }
__host__ __device__ __forceinline__ int perm32(int rho) { const int n = rho >> 4, i = rho & 15; return 8 * (i >> 2) + 4 * n + (i & 3); }

struct Unit { int pm, pn; };
struct Gemm { const bf16_t* A; const bf16_t* Bt; int M, N, K; };

struct StaticOrder {
    int nM, nN, nwg, G, c;
    __host__ __device__ void init(int M, int N, int G_, int c_) { nM = M / BM; nN = N / BM; nwg = nM * nN; G = G_; c = c_; }
    __host__ __device__ bool next(int i, Unit& u) const {
        const long L = (long)i * G + c; if (L >= nwg) return false;
        int wgid = (int)L; { const int q = nwg / NXCD, r = nwg % NXCD, xcd = wgid % NXCD, off = wgid / NXCD; wgid = (xcd < r ? xcd * (q + 1) : r * (q + 1) + (xcd - r) * q) + off; }
        const int nig = WGM * nN, gid = wgid / nig, fm = gid * WGM, gsz = (nM - fm) < WGM ? (nM - fm) : WGM;
        u.pm = fm + ((wgid % nig) % gsz); u.pn = (wgid % nig) / gsz; return true;
    }
    __device__ __forceinline__ void a_ready(const Unit&) const {}
    __device__ __forceinline__ void done(const Unit&) const {}
};

__device__ __forceinline__ unsigned cvt_pk_bf16(float lo, float hi) { unsigned r; asm volatile("v_cvt_pk_bf16_f32 %0, %1, %2" : "=v"(r) : "v"(lo), "v"(hi)); return r; }
typedef float f32x2 __attribute__((ext_vector_type(2)));

struct EpiF32 {
    static constexpr bool PERM = false, AFTER_DRAIN = false;
    float* C; int ldc;
    __device__ __forceinline__ void operator()(const f32x4 (&acc)[2][2][4][2], const Unit& u_, int wr, int wc, int fr, int fq) const {
        Unit u = u_; asm volatile("" : "+s"(u.pm), "+s"(u.pn)); { const int l_ = hw_lane(); fr = l_ & 15; fq = l_ >> 4; }
        const int row0 = u.pm * BM + wr * 64 + fr, col0 = u.pn * BM + wc * 32 + 4 * fq;
#pragma unroll
        for (int ai = 0; ai < 2; ++ai)
#pragma unroll
            for (int m = 0; m < 4; ++m) { float* rowp = C + (size_t)(row0 + ai * HALF + m * 16) * ldc + col0;
#pragma unroll
                for (int bj = 0; bj < 2; ++bj)
#pragma unroll
                    for (int n = 0; n < 2; ++n) *(f32x4*)(rowp + bj * HALF + n * 16) = acc[ai][bj][m][n]; }
    }
};
struct EpiBf16 {
    static constexpr bool PERM = true, AFTER_DRAIN = false;
    bf16_t* O; int ldc; float scale;
    __device__ __forceinline__ void operator()(const f32x4 (&acc)[2][2][4][2], const Unit& u_, int wr, int wc, int fr, int fq) const {
        Unit u = u_; asm volatile("" : "+s"(u.pm), "+s"(u.pn)); { const int l_ = hw_lane(); fr = l_ & 15; fq = l_ >> 4; }
        const int row0 = u.pm * BM + wr * 64 + fr, col0 = u.pn * BM + wc * 32 + 8 * fq;
#pragma unroll
        for (int ai = 0; ai < 2; ++ai)
#pragma unroll
            for (int m = 0; m < 4; ++m) { bf16_t* rowp = O + (size_t)(row0 + ai * HALF + m * 16) * ldc + col0;
#pragma unroll
                for (int bj = 0; bj < 2; ++bj) { const f32x4 v0 = acc[ai][bj][m][0] * scale, v1 = acc[ai][bj][m][1] * scale;
                    u32x4 w; w.x = cvt_pk_bf16(v0[0], v0[1]); w.y = cvt_pk_bf16(v0[2], v0[3]); w.z = cvt_pk_bf16(v1[0], v1[1]); w.w = cvt_pk_bf16(v1[2], v1[3]);
                    *(u32x4*)(rowp + bj * HALF) = w; } }
    }
};
struct EpiResid {
    static constexpr bool PERM = false, AFTER_DRAIN = false;
    const float* base; float* out; float alpha;
    __device__ __forceinline__ void operator()(const f32x4 (&acc)[2][2][4][2], const Unit& u_, int wr, int wc, int fr, int fq) const {
        Unit u = u_; asm volatile("" : "+s"(u.pm), "+s"(u.pn)); { const int l_ = hw_lane(); fr = l_ & 15; fq = l_ >> 4; }
        const int row0 = u.pm * BM + wr * 64 + fr, col0 = u.pn * BM + wc * 32 + 4 * fq;
#pragma unroll
        for (int ai = 0; ai < 2; ++ai)
#pragma unroll
            for (int m = 0; m < 4; ++m) { const size_t off = (size_t)(row0 + ai * HALF + m * 16) * 1024 + col0;
#pragma unroll
                for (int bj = 0; bj < 2; ++bj)
#pragma unroll
                    for (int n = 0; n < 2; ++n) { const f32x4 bs = *(const f32x4*)(base + off + bj * HALF + n * 16);
                        *(f32x4*)(out + off + bj * HALF + n * 16) = bs * alpha + acc[ai][bj][m][n]; }
                if (m & 1) asm volatile("" ::: "memory"); }
    }
};
struct EpiKV {
    static constexpr bool PERM = true, AFTER_DRAIN = false;
    bf16_t* Kb; bf16_t* Vb;
    __device__ __forceinline__ void operator()(const f32x4 (&acc)[2][2][4][2], const Unit& u_, int wr, int wc, int fr, int fq) const {
        Unit u = u_; asm volatile("" : "+s"(u.pm), "+s"(u.pn)); { const int l_ = hw_lane(); fr = l_ & 15; fq = l_ >> 4; }
        const int row0 = u.pm * BM + wr * 64 + fr, col0 = u.pn * BM + wc * 32 + 8 * fq;
#pragma unroll
        for (int bj = 0; bj < 2; ++bj) { const int c = col0 + bj * HALF; const bool isk = c < 1024;
            bf16_t* dst = isk ? Kb + (c >> 7) * 192 + (c & 127) : Vb + (c - 1024); const size_t ld = isk ? 1536 : 1024;
#pragma unroll
            for (int ai = 0; ai < 2; ++ai)
#pragma unroll
                for (int m = 0; m < 4; ++m) { const int row = row0 + ai * HALF + m * 16; const f32x4 v0 = acc[ai][bj][m][0], v1 = acc[ai][bj][m][1];
                    u32x4 w; w.x = cvt_pk_bf16(v0[0], v0[1]); w.y = cvt_pk_bf16(v0[2], v0[3]); w.z = cvt_pk_bf16(v1[0], v1[1]); w.w = cvt_pk_bf16(v1[2], v1[3]);
                    *(u32x4*)(dst + (size_t)row * ld) = w; } }
    }
};
struct EpiFilt {
    static constexpr bool PERM = false, AFTER_DRAIN = false;
    float* KT; int L; float d0, dstep, tinv;
    __device__ __forceinline__ void operator()(const f32x4 (&acc)[2][2][4][2], const Unit& u_, int wr, int wc, int fr, int fq) const {
        Unit u = u_; asm volatile("" : "+s"(u.pm), "+s"(u.pn)); { const int l_ = hw_lane(); fr = l_ & 15; fq = l_ >> 4; }
        const int row0 = u.pm * BM + wr * 64 + fr, col0 = u.pn * BM + wc * 32 + 4 * fq;
#pragma unroll
        for (int bj = 0; bj < 2; ++bj)
#pragma unroll
            for (int n = 0; n < 2; ++n) { const int c = col0 + bj * HALF + n * 16;
#pragma unroll
                for (int j = 0; j < 4; ++j) { const int cc = c + j, ch = cc & 1023; const float nd = -__builtin_fabsf(d0 + (float)ch * dstep) * tinv; float* dst = KT + (size_t)cc * L;
#pragma unroll
                    for (int ai = 0; ai < 2; ++ai)
#pragma unroll
                        for (int m = 0; m < 4; ++m) { const int l = row0 + ai * HALF + m * 16; dst[l] = acc[ai][bj][m][n][j] * __expf(nd * (float)l); } } }
    }
};

template <class Epi, class Sched, bool ALIGN_EPI = false, bool SP2 = false>
__device__ __forceinline__ void gemm_phase(PG8_LAS unsigned char* lds, const Gemm g, const Sched& S, const Epi& E, int wid_in) {
    const int wid = wid_in, lane = hw_lane(), tid = wid * 64 + lane, wr = wid >> 2, wc = wid & 3, fr = lane & 15, fq = lane >> 4;
    const int K = g.K, nt = K / BK;
    unsigned voffA[2], voffB[2];
#pragma unroll
    for (int i = 0; i < 2; ++i) { int R, C; stage_rc(tid * 16 + i * 8192, R, C); const int Rb = Epi::PERM ? ((R & ~31) + perm32(R & 31)) : R;
        voffA[i] = (unsigned)(R * K + C) * 2u; voffB[i] = (unsigned)(Rb * K + C) * 2u; }
    const size_t kstep = (size_t)(BK * 2);
    const size_t hstep = (size_t)HALF * K * 2;
    const size_t tstep = 2 * hstep;
    const unsigned ldsw = (unsigned)wid * 1024u;
    const int aoff = lds_byte(wr * 64 + fr, fq * 8), boff = lds_byte(wc * 32 + fr, fq * 8);
#define PG8_SA(b, h) (((b) * 2 + (h)) * HTB)
#define PG8_SB(b, h) ((4 + (b) * 2 + (h)) * HTB)
#define PG8_STAGE(bufoff, gbase, voff) do { _Pragma("unroll") for (int _i = 0; _i < 2; ++_i) \
        __builtin_amdgcn_global_load_lds((const unsigned*)((const char*)(gbase) + (voff)[_i]), (PG8_LAS unsigned*)(lds + (bufoff) + ldsw + _i * 8192), 16, 0, 0); } while (0)
#define PG8_LDA(dst, b, h) do { _Pragma("unroll") for (int m = 0; m < 4; ++m) _Pragma("unroll") for (int k = 0; k < 2; ++k) dst[m][k] = *(const PG8_LAS bf16x8*)(lds + PG8_SA(b, h) + aoff + m * 2048 + k * 1024); } while (0)
#define PG8_LDB(dst, b, h) do { _Pragma("unroll") for (int n = 0; n < 2; ++n) _Pragma("unroll") for (int k = 0; k < 2; ++k) dst[n][k] = *(const PG8_LAS bf16x8*)(lds + PG8_SB(b, h) + boff + n * 2048 + k * 1024); } while (0)
#define PG8_MMA(ai, bj, At, Bt) do { __builtin_amdgcn_s_setprio(1); _Pragma("unroll") for (int m = 0; m < 4; ++m) _Pragma("unroll") for (int n = 0; n < 2; ++n) _Pragma("unroll") for (int k = 0; k < 2; ++k) \
        acc[ai][bj][m][n] = __builtin_amdgcn_mfma_f32_16x16x32_bf16(Bt[n][k], At[m][k], acc[ai][bj][m][n], 0, 0, 0); __builtin_amdgcn_s_setprio(0); } while (0)
#define PG8_WAIT_V(n) asm volatile("s_waitcnt vmcnt(" #n ")" ::: "memory")
#define PG8_WAIT_L(n) asm volatile("s_waitcnt lgkmcnt(" #n ")" ::: "memory")
#define PG8_BAR __builtin_amdgcn_s_barrier()
#define PG8_SCHED __builtin_amdgcn_sched_barrier(0)
    Unit cur, nxt; int ui = 0;
    if (!S.next(0, cur)) return;
    f32x4 acc[2][2][4][2];
#pragma unroll
    for (int a = 0; a < 2; ++a)
#pragma unroll
        for (int b = 0; b < 2; ++b)
#pragma unroll
            for (int m = 0; m < 4; ++m)
#pragma unroll
                for (int n = 0; n < 2; ++n) acc[a][b][m][n] = (f32x4){0.f, 0.f, 0.f, 0.f};
    bf16x8 At[4][2], B0[2][2], B1[2][2];
    const char* cA = (const char*)g.A + (size_t)cur.pm * tstep; const char* cB = (const char*)g.Bt + (size_t)cur.pn * tstep;
    S.a_ready(cur);
    if constexpr (SP2) {
        PG8_STAGE(PG8_SB(0, 0), cB, voffB); PG8_STAGE(PG8_SB(0, 1), cB + hstep, voffB); PG8_STAGE(PG8_SA(0, 0), cA, voffA); PG8_STAGE(PG8_SA(0, 1), cA + hstep, voffA);
        if (wr == 1) PG8_BAR;
        PG8_WAIT_V(2); PG8_BAR;
        PG8_STAGE(PG8_SB(1, 0), cB + kstep, voffB); PG8_STAGE(PG8_SA(1, 0), cA + kstep, voffA); PG8_STAGE(PG8_SB(1, 1), cB + hstep + kstep, voffB);
        PG8_WAIT_V(6); PG8_BAR;
    } else {
        PG8_STAGE(PG8_SB(0, 0), cB, voffB); PG8_STAGE(PG8_SA(0, 0), cA, voffA); PG8_STAGE(PG8_SB(0, 1), cB + hstep, voffB); PG8_STAGE(PG8_SA(0, 1), cA + hstep, voffA);
        if (wr == 1) PG8_BAR;
        PG8_WAIT_V(4); PG8_BAR;
        PG8_STAGE(PG8_SB(1, 0), cB + kstep, voffB); PG8_STAGE(PG8_SA(1, 0), cA + kstep, voffA); PG8_STAGE(PG8_SB(1, 1), cB + hstep + kstep, voffB);
        PG8_WAIT_V(6); PG8_BAR;
    }
    for (;;) {
        const bool has_next = S.next(ui + 1, nxt);
        const char* nA = has_next ? (const char*)g.A + (size_t)nxt.pm * tstep : cA; const char* nB = has_next ? (const char*)g.Bt + (size_t)nxt.pn * tstep : cB;
        for (int t = 0; t < nt; t += 2) {
            const bool last = (t == nt - 2);
            const char* a1 = cA + (size_t)(t + 1) * kstep;
            const char* a2 = last ? nA : cA + (size_t)(t + 2) * kstep; const char* b2 = last ? nB : cB + (size_t)(t + 2) * kstep;
            const char* a3 = a2 + kstep; const char* b3 = b2 + kstep;
            if (last && has_next) S.a_ready(nxt);
            if constexpr (SP2) {
            PG8_LDB(B0, 0, 0); PG8_LDB(B1, 0, 1); PG8_SCHED; PG8_LDA(At, 0, 0); PG8_STAGE(PG8_SA(1, 1), a1 + hstep, voffA);
            PG8_WAIT_V(8); PG8_WAIT_L(0); PG8_BAR; PG8_MMA(0, 0, At, B0); PG8_MMA(0, 1, At, B1); PG8_BAR; PG8_SCHED;
            PG8_LDA(At, 0, 1); PG8_STAGE(PG8_SB(0, 0), b2, voffB); PG8_STAGE(PG8_SB(0, 1), b2 + hstep, voffB); PG8_STAGE(PG8_SA(0, 0), a2, voffA);
            PG8_WAIT_V(8); PG8_WAIT_L(0); PG8_BAR; PG8_MMA(1, 0, At, B0); PG8_MMA(1, 1, At, B1); PG8_BAR; PG8_SCHED;
            PG8_LDB(B0, 1, 0); PG8_LDB(B1, 1, 1); PG8_SCHED; PG8_LDA(At, 1, 0); PG8_STAGE(PG8_SA(0, 1), a2 + hstep, voffA);
            PG8_WAIT_V(8); PG8_WAIT_L(0); PG8_BAR; PG8_MMA(0, 0, At, B0); PG8_MMA(0, 1, At, B1); PG8_BAR; PG8_SCHED;
            PG8_LDA(At, 1, 1); PG8_STAGE(PG8_SB(1, 0), b3, voffB); PG8_STAGE(PG8_SB(1, 1), b3 + hstep, voffB); PG8_STAGE(PG8_SA(1, 0), a3, voffA);
            PG8_WAIT_V(8); PG8_WAIT_L(0); PG8_BAR; PG8_MMA(1, 0, At, B0); PG8_MMA(1, 1, At, B1); PG8_BAR; PG8_SCHED;
            } else {
            PG8_LDB(B0, 0, 0); PG8_SCHED; PG8_LDA(At, 0, 0); PG8_STAGE(PG8_SA(1, 1), a1 + hstep, voffA);
            PG8_WAIT_L(8); PG8_BAR; PG8_WAIT_L(0); PG8_MMA(0, 0, At, B0); PG8_BAR; PG8_SCHED;
            PG8_LDB(B1, 0, 1); PG8_STAGE(PG8_SB(0, 0), b2, voffB);
            PG8_BAR; PG8_WAIT_L(0); PG8_MMA(0, 1, At, B1); PG8_BAR;
            PG8_LDA(At, 0, 1); PG8_STAGE(PG8_SA(0, 0), a2, voffA);
            PG8_BAR; PG8_WAIT_L(0); PG8_MMA(1, 0, At, B0); PG8_BAR; PG8_SCHED;
            PG8_STAGE(PG8_SB(0, 1), b2 + hstep, voffB);
            PG8_WAIT_V(6); PG8_BAR; PG8_MMA(1, 1, At, B1); PG8_BAR;
            PG8_LDB(B0, 1, 0); PG8_SCHED; PG8_LDA(At, 1, 0); PG8_STAGE(PG8_SA(0, 1), a2 + hstep, voffA);
            PG8_WAIT_L(8); PG8_BAR; PG8_WAIT_L(0); PG8_MMA(0, 0, At, B0); PG8_BAR; PG8_SCHED;
            PG8_LDB(B1, 1, 1); PG8_STAGE(PG8_SB(1, 0), b3, voffB);
            PG8_BAR; PG8_WAIT_L(0); PG8_MMA(0, 1, At, B1); PG8_BAR;
            PG8_LDA(At, 1, 1); PG8_STAGE(PG8_SA(1, 0), a3, voffA);
            PG8_BAR; PG8_WAIT_L(0); PG8_MMA(1, 0, At, B0); PG8_BAR; PG8_SCHED;
            PG8_STAGE(PG8_SB(1, 1), b3 + hstep, voffB);
            PG8_WAIT_V(6); PG8_BAR; PG8_MMA(1, 1, At, B1); PG8_BAR;
            }
        }
        if constexpr (ALIGN_EPI) { if (wr == 0) PG8_BAR; }
        if constexpr (!Epi::AFTER_DRAIN) { E(acc, cur, wr, wc, fr, fq); S.done(cur); }
        if (!has_next) break;
#pragma unroll
        for (int a = 0; a < 2; ++a)
#pragma unroll
            for (int b = 0; b < 2; ++b)
#pragma unroll
                for (int m = 0; m < 4; ++m)
#pragma unroll
                    for (int n = 0; n < 2; ++n) acc[a][b][m][n] = (f32x4){0.f, 0.f, 0.f, 0.f};
        cur = nxt; cA = nA; cB = nB; ++ui;
        if constexpr (ALIGN_EPI) { if (wr == 1) PG8_BAR; }
    }
    PG8_WAIT_V(0);
    if constexpr (!ALIGN_EPI) { if (wr == 0) PG8_BAR; }
    PG8_BAR;
    if constexpr (Epi::AFTER_DRAIN) { E.fused(acc, cur, wr, wc, fr, fq, lds, wid, lane); S.done(cur); }
#undef PG8_SA
#undef PG8_SB
#undef PG8_STAGE
#undef PG8_LDA
#undef PG8_LDB
#undef PG8_MMA
#undef PG8_WAIT_V
#undef PG8_WAIT_L
#undef PG8_BAR
#undef PG8_SCHED
}
}
#define GAS __attribute__((address_space(1)))
#define LAS __attribute__((address_space(3)))
typedef unsigned short bf16;
typedef unsigned v4u __attribute__((ext_vector_type(4)));
typedef float f32x4 __attribute__((ext_vector_type(4)));
typedef short bf16x8 __attribute__((ext_vector_type(8)));
typedef GAS unsigned gu32;
typedef GAS unsigned long long gu64;
#define RLX_AGENT __ATOMIC_RELAXED, __HIP_MEMORY_SCOPE_AGENT
#define LDS_WAIT() asm volatile("s_waitcnt lgkmcnt(0)" ::: "memory")
#define VM_WAIT() asm volatile("s_waitcnt vmcnt(0)" ::: "memory")
__device__ __forceinline__ unsigned long long rt() { return __builtin_amdgcn_s_memrealtime(); }
__device__ __forceinline__ unsigned f2bf(float f) { unsigned u = __builtin_bit_cast(unsigned, f); return (u + 0x7fffu + ((u >> 16) & 1u)) >> 16; }
__device__ __forceinline__ unsigned pk2(float lo, float hi) { return f2bf(lo) | (f2bf(hi) << 16); }

#define XB_TMO      128
#define XB_XCNT(j)  (256  + 64 * (j))
#define XB_XSUB(j)  (1280 + 64 * (j))
#define XB_XGEN(j)  (2304 + 64 * (j))
#define XB_TOP      3328
#define XB_TOPGEN   3392
#define XCD_BAR_WORDS 3456
#define XB_SPIN_CAP (1u << 18)

__device__ __forceinline__ unsigned xb_ld(unsigned* p)              { return __hip_atomic_load(p, __ATOMIC_RELAXED, __HIP_MEMORY_SCOPE_AGENT); }
__device__ __forceinline__ unsigned xb_add(unsigned* p, unsigned v) { return __hip_atomic_fetch_add(p, v, __ATOMIC_RELAXED, __HIP_MEMORY_SCOPE_AGENT); }
__device__ __forceinline__ unsigned xb_xcc_id() { return (unsigned)__builtin_amdgcn_s_getreg((3 << 11) | 20) & 0xFu; }
#define XB_SPIN(cond, bar) do { unsigned _sp = 0; while (cond) { __builtin_amdgcn_s_sleep(1); \
    if ((++_sp & 255u) == 0u) { if (xb_ld(&(bar)[XB_TMO])) break; if (_sp > XB_SPIN_CAP) { atomicAdd(&(bar)[XB_TMO], 1u); break; } } } } while (0)

struct XcdBarrier {
    unsigned* bar; unsigned x; unsigned wv;
    volatile LAS unsigned* st;
};

__device__ __forceinline__ XcdBarrier xcd_barrier_post(unsigned* bar, volatile LAS unsigned* st, unsigned wv) {
    XcdBarrier b; b.bar = bar; b.x = xb_xcc_id(); b.st = st; b.wv = wv;
    if (wv == 0u && hw_lane() == 0) (void)xb_add(&bar[XB_XCNT(b.x)], 1u);
    return b;
}
__device__ __forceinline__ void xcd_barrier_complete(unsigned* bar, unsigned x, unsigned& nloc, unsigned& nx) {
    const unsigned G = gridDim.x * gridDim.y * gridDim.z;
    unsigned sum, cnt, mine, sp = 0u;
    for (;;) {
        sum = 0u; cnt = 0u; mine = 0u;
#pragma unroll
        for (unsigned j = 0; j < 16; ++j) { const unsigned c = xb_ld(&bar[XB_XCNT(j)]); sum += c; cnt += (c > 0u) ? 1u : 0u; mine = (j == x) ? c : mine; }
        if (sum == G) break;
        __builtin_amdgcn_s_sleep(1);
        if ((++sp & 255u) == 0u) { if (xb_ld(&bar[XB_TMO])) break; if (sp > XB_SPIN_CAP) { atomicAdd(&bar[XB_TMO], 1u); break; } }
    }
    nloc = mine > 0u ? mine : 1u; nx = cnt > 0u ? cnt : 1u;
}

__device__ __forceinline__ void xcd_barrier(const XcdBarrier& b) {
    asm volatile("s_waitcnt vmcnt(0)" ::: "memory");
    __syncthreads();
    if (b.wv == 0u && hw_lane() == 0) {
        unsigned* bar = b.bar;
        __builtin_amdgcn_s_waitcnt(0);
        unsigned nloc = b.st[0], nx = b.st[1];
        if (nloc == 0u) { xcd_barrier_complete(bar, b.x, nloc, nx); b.st[0] = nloc; b.st[1] = nx; }
        const unsigned old = xb_add(&bar[XB_XSUB(b.x)], 1u);
        const unsigned gen = old / nloc;
        if (old + 1u == (gen + 1u) * nloc) {
            __builtin_amdgcn_fence(__ATOMIC_RELEASE, "agent");
            asm volatile("s_waitcnt vmcnt(0)" ::: "memory");
            const unsigned og = xb_add(&bar[XB_TOP], 1u);
            const unsigned tg = og / nx;
            if (og + 1u == (tg + 1u) * nx) xb_add(&bar[XB_TOPGEN], 1u);
            else XB_SPIN(xb_ld(&bar[XB_TOPGEN]) == tg, bar);
            __builtin_amdgcn_fence(__ATOMIC_ACQUIRE, "agent");
            xb_add(&bar[XB_XGEN(b.x)], 1u);
            asm volatile("s_waitcnt vmcnt(0)" ::: "memory");
        } else {
            XB_SPIN(xb_ld(&bar[XB_XGEN(b.x)]) == gen, bar);
            __builtin_amdgcn_fence(__ATOMIC_ACQUIRE, "agent");
            asm volatile("s_waitcnt vmcnt(0)" ::: "memory");
        }
    }
    __syncthreads();
}
namespace attn {
using bf16x8 = __attribute__((ext_vector_type(8))) short;
using s16x4  = __attribute__((ext_vector_type(4))) short;
using f32x16 = __attribute__((ext_vector_type(16))) float;
using u32x4  = __attribute__((ext_vector_type(4))) unsigned;
constexpr int NW = 8, QBLK = 32, KVBLK = 64, DQ = 192, DVV = 128;
constexpr int LDQ = 1536, LDK = 1536, LDV = 1024, LDO = 1024;
constexpr int KROW = 400;
constexpr int SHM_V = KVBLK * DVV * 2, SHM_K = KVBLK * KROW, SHM_WS = NW * 64 * 4, SHM_QR = NW * 4096, SHM_ATTN = 2 * SHM_V + 2 * SHM_K + SHM_WS + SHM_QR;
constexpr float THRL = 11.5f;
#define SBAR() __builtin_amdgcn_sched_barrier(0)
__device__ __forceinline__ int crow(int r, int hi) { return (r & 3) + 8 * (r >> 2) + 4 * hi; }
__device__ __forceinline__ unsigned cvtpk(float lo, float hi) { unsigned r; asm volatile("v_cvt_pk_bf16_f32 %0, %1, %2" : "=v"(r) : "v"(lo), "v"(hi)); return r; }

__device__ __forceinline__ void partialSM(f32x16& p0, f32x16& p1, float& m_reg, float& mn, float& alpha) {
  float pmax = p0[0]; for (int r = 1; r < 16; ++r) pmax = fmaxf(pmax, p0[r]); for (int r = 0; r < 16; ++r) pmax = fmaxf(pmax, p1[r]);
  { auto rr = __builtin_amdgcn_permlane32_swap(__float_as_uint(pmax), __float_as_uint(pmax), false, false);
    pmax = fmaxf(__uint_as_float(rr[0]), __uint_as_float(rr[1])); }
  if (__builtin_expect(__all(pmax - m_reg <= THRL), 1)) { mn = m_reg; alpha = 1.f; }
  else { mn = fmaxf(m_reg, pmax); alpha = __builtin_amdgcn_exp2f(m_reg - mn); m_reg = mn; }
  for (int r = 0; r < 16; ++r) p0[r] = p0[r] - mn; for (int r = 0; r < 16; ++r) p1[r] = p1[r] - mn;
  for (int r = 0; r < 16; ++r) p0[r] = __builtin_amdgcn_exp2f(p0[r]);
}
__device__ __forceinline__ void finishSM(f32x16& p0, f32x16& p1, float alpha, float& l_reg, bf16x8& pa0, bf16x8& pa1, bf16x8& pa2, bf16x8& pa3) {
  for (int r = 0; r < 16; ++r) p1[r] = __builtin_amdgcn_exp2f(p1[r]);
  float ps = 0; for (int r = 0; r < 16; ++r) ps += p0[r]; for (int r = 0; r < 16; ++r) ps += p1[r];
  { auto rr = __builtin_amdgcn_permlane32_swap(__float_as_uint(ps), __float_as_uint(ps), false, false);
    ps = __uint_as_float(rr[0]) + __uint_as_float(rr[1]); }
  l_reg = l_reg * alpha + ps;
#define PK4(P, BASE, OUT) do { unsigned a0 = cvtpk(P[BASE + 0], P[BASE + 1]), a1 = cvtpk(P[BASE + 2], P[BASE + 3]);   \
    unsigned b0 = cvtpk(P[BASE + 4], P[BASE + 5]), b1 = cvtpk(P[BASE + 6], P[BASE + 7]);                              \
    auto r0 = __builtin_amdgcn_permlane32_swap(a0, b0, false, false); auto r1 = __builtin_amdgcn_permlane32_swap(a1, b1, false, false); \
    u32x4 w = {r0[0], r1[0], r0[1], r1[1]}; OUT = *reinterpret_cast<bf16x8*>(&w); } while (0)
  PK4(p0, 0, pa0); PK4(p0, 8, pa1); PK4(p1, 0, pa2); PK4(p1, 8, pa3);
#undef PK4
}
__device__ __forceinline__ float softmaxPP(f32x16& p0, f32x16& p1, float& m_reg, float& l_reg, bool first, bf16x8& pa0, bf16x8& pa1, bf16x8& pa2, bf16x8& pa3) {
  float a0 = fmaxf(fmaxf(p0[0], p0[1]), fmaxf(p0[2], p0[3])), a1 = fmaxf(fmaxf(p0[4], p0[5]), fmaxf(p0[6], p0[7])), a2 = fmaxf(fmaxf(p0[8], p0[9]), fmaxf(p0[10], p0[11])), a3 = fmaxf(fmaxf(p0[12], p0[13]), fmaxf(p0[14], p0[15]));
  a0 = fmaxf(a0, fmaxf(fmaxf(p1[0], p1[1]), fmaxf(p1[2], p1[3]))); a1 = fmaxf(a1, fmaxf(fmaxf(p1[4], p1[5]), fmaxf(p1[6], p1[7]))); a2 = fmaxf(a2, fmaxf(fmaxf(p1[8], p1[9]), fmaxf(p1[10], p1[11]))); a3 = fmaxf(a3, fmaxf(fmaxf(p1[12], p1[13]), fmaxf(p1[14], p1[15])));
  float pmax = fmaxf(fmaxf(a0, a1), fmaxf(a2, a3));
  { auto rr = __builtin_amdgcn_permlane32_swap(__float_as_uint(pmax), __float_as_uint(pmax), false, false); pmax = fmaxf(__uint_as_float(rr[0]), __uint_as_float(rr[1])); }
  float alpha = 1.f;
  if (__builtin_expect(first || __any(pmax - m_reg > THRL), 0)) { const float mn = first ? pmax : fmaxf(pmax, m_reg); alpha = first ? 1.f : __builtin_amdgcn_exp2f(m_reg - mn); m_reg = mn; }
  for (int r = 0; r < 16; ++r) { p0[r] -= m_reg; p1[r] -= m_reg; }
  for (int r = 0; r < 16; ++r) p0[r] = __builtin_amdgcn_exp2f(p0[r]);
  for (int r = 0; r < 16; ++r) p1[r] = __builtin_amdgcn_exp2f(p1[r]);
  float s0 = (p0[0] + p0[1]) + (p0[2] + p0[3]), s1 = (p0[4] + p0[5]) + (p0[6] + p0[7]), s2 = (p0[8] + p0[9]) + (p0[10] + p0[11]), s3 = (p0[12] + p0[13]) + (p0[14] + p0[15]);
  s0 += (p1[0] + p1[1]) + (p1[2] + p1[3]); s1 += (p1[4] + p1[5]) + (p1[6] + p1[7]); s2 += (p1[8] + p1[9]) + (p1[10] + p1[11]); s3 += (p1[12] + p1[13]) + (p1[14] + p1[15]);
  float ps = (s0 + s1) + (s2 + s3);
  { auto rr = __builtin_amdgcn_permlane32_swap(__float_as_uint(ps), __float_as_uint(ps), false, false); ps = __uint_as_float(rr[0]) + __uint_as_float(rr[1]); }
  l_reg = l_reg * alpha + ps;
#define PK4(P, BASE, OUT) do { unsigned a0_ = cvtpk(P[BASE + 0], P[BASE + 1]), a1_ = cvtpk(P[BASE + 2], P[BASE + 3]);   \
    unsigned b0_ = cvtpk(P[BASE + 4], P[BASE + 5]), b1_ = cvtpk(P[BASE + 6], P[BASE + 7]);                              \
    auto r0 = __builtin_amdgcn_permlane32_swap(a0_, b0_, false, false); auto r1 = __builtin_amdgcn_permlane32_swap(a1_, b1_, false, false); \
    u32x4 w = {r0[0], r1[0], r0[1], r1[1]}; OUT = *reinterpret_cast<bf16x8*>(&w); } while (0)
  PK4(p0, 0, pa0); PK4(p0, 8, pa1); PK4(p1, 0, pa2); PK4(p1, 8, pa3);
#undef PK4
  return alpha;
}
__device__ __forceinline__ void qkt(f32x16& p0, f32x16& p1, const char* Ks, const bf16x8* qr, const char* Qrl, int r32, int hi) {
  p0 = f32x16{}; p1 = f32x16{};
#pragma unroll
  for (int d0 = 0; d0 < 12; ++d0) { const int cb = (d0 * 16 + hi * 8) * 2;
    const bf16x8 qf = (d0 < 8) ? qr[d0 < 8 ? d0 : 0] : *reinterpret_cast<const bf16x8*>(Qrl + (d0 - 8) * 1024);
    bf16x8 b0 = *reinterpret_cast<const bf16x8*>(Ks + r32 * KROW + cb);
    bf16x8 b1 = *reinterpret_cast<const bf16x8*>(Ks + (32 + r32) * KROW + cb);
    p0 = __builtin_amdgcn_mfma_f32_32x32x16_bf16(b0, qf, p0, 0, 0, 0);
    p1 = __builtin_amdgcn_mfma_f32_32x32x16_bf16(b1, qf, p1, 0, 0, 0); }
}
__device__ __forceinline__ int v_st(int k, int c) { const int kk = (k & ~0xC) | ((k & 4) << 1) | ((k & 8) >> 1); return ((kk >> 3) * 4 + (c >> 5)) * 512 + ((kk & 7) * 32 + (c & 31)) * 2; }
__device__ __forceinline__ int v_rd_base(int lane) { return ((lane & 3) << 3) | (((lane >> 2) & 3) << 6) | (((lane >> 4) & 1) << 5) | (((lane >> 5) & 1) << 8); }
constexpr int v_rd_off(int d0, int ks, int half) { return d0 * 512 + ks * 4096 + half * 2048; }
template <int OFF> __device__ __forceinline__ s16x4 tr_read(int vb) {
  s16x4 r; asm volatile("ds_read_b64_tr_b16 %0, %1 offset:%2" : "=&v"(r) : "v"(vb), "i"(OFF) : "memory"); return r;
}
template <int D0> __device__ __forceinline__ void pv_one(f32x16& od, int vb, bf16x8 pa0, bf16x8 pa1, bf16x8 pa2, bf16x8 pa3) {
  const s16x4 l0 = tr_read<v_rd_off(D0, 0, 0)>(vb), h0 = tr_read<v_rd_off(D0, 0, 1)>(vb), l1 = tr_read<v_rd_off(D0, 1, 0)>(vb), h1 = tr_read<v_rd_off(D0, 1, 1)>(vb);
  const s16x4 l2 = tr_read<v_rd_off(D0, 2, 0)>(vb), h2 = tr_read<v_rd_off(D0, 2, 1)>(vb), l3 = tr_read<v_rd_off(D0, 3, 0)>(vb), h3 = tr_read<v_rd_off(D0, 3, 1)>(vb);
  asm volatile("s_waitcnt lgkmcnt(0)" ::: "memory"); SBAR();
#define PK(L, H) (bf16x8){L[0], L[1], L[2], L[3], H[0], H[1], H[2], H[3]}
  od = __builtin_amdgcn_mfma_f32_32x32x16_bf16(pa0, PK(l0, h0), od, 0, 0, 0);
  od = __builtin_amdgcn_mfma_f32_32x32x16_bf16(pa1, PK(l1, h1), od, 0, 0, 0);
  od = __builtin_amdgcn_mfma_f32_32x32x16_bf16(pa2, PK(l2, h2), od, 0, 0, 0);
  od = __builtin_amdgcn_mfma_f32_32x32x16_bf16(pa3, PK(l3, h3), od, 0, 0, 0);
#undef PK
}
__device__ __forceinline__ void pv_d0(f32x16* o, int vb, bf16x8 pa0, bf16x8 pa1, bf16x8 pa2, bf16x8 pa3) {
  pv_one<0>(o[0], vb, pa0, pa1, pa2, pa3); pv_one<1>(o[1], vb, pa0, pa1, pa2, pa3); pv_one<2>(o[2], vb, pa0, pa1, pa2, pa3); pv_one<3>(o[3], vb, pa0, pa1, pa2, pa3);
}
typedef unsigned short bf16r;
typedef __attribute__((address_space(3))) const char* lcp;
constexpr int KBLK = 3200, SHM_K3 = 8 * KBLK, SHM_V3 = KVBLK * DVV * 2, NSLOT = 3;
constexpr int LDS_K3 = 0, LDS_V3 = NSLOT * SHM_K3, LDS_WS3 = LDS_V3 + NSLOT * SHM_V3, SHM_ATTN3 = LDS_WS3 + NW * 64 * 4;
__device__ __forceinline__ void glds16(const void* gsrc, unsigned lds_dst) { unsigned keep;
  asm volatile("s_mov_b32 %0, m0\n\ts_mov_b32 m0, %2\n\ts_nop 0\n\tglobal_load_lds_dwordx4 %1, off\n\ts_mov_b32 m0, %0" : "=&s"(keep) : "v"(gsrc), "s"(lds_dst) : "memory"); }
__device__ __forceinline__ void qkt3(f32x16& p0, f32x16& p1, const lcp (&kp)[4], int ko, const bf16x8* qr) {
  typedef __attribute__((address_space(3))) const bf16x8* lfrag;
  p0 = f32x16{}; p1 = f32x16{};
#pragma unroll
  for (int d0 = 0; d0 < 12; ++d0) { const lcp a = kp[d0 & 3] + ko + 128 * (d0 >> 2);
    const bf16x8 b0 = *(lfrag)(a), b1 = *(lfrag)(a + 4 * KBLK);
    p0 = __builtin_amdgcn_mfma_f32_32x32x16_bf16(b0, qr[d0], p0, 0, 0, 0);
    p1 = __builtin_amdgcn_mfma_f32_32x32x16_bf16(b1, qr[d0], p1, 0, 0, 0); }
}
__device__ __forceinline__ void attn_unit(const bf16r* __restrict__ Qb, const bf16r* __restrict__ Kh, const bf16r* __restrict__ Vh, bf16r* __restrict__ Ob, const float* __restrict__ tab, int seq, char* lds, int wid) {
  const int lane = hw_lane(), r32 = lane & 31, hi = lane >> 5;
  const unsigned lds0 = (unsigned)(uintptr_t)lds;
  float* wsf = (float*)(lds + LDS_WS3) + wid * 64; float* li_l = wsf; float* al_l = wsf + 32;
  float m_reg = 0.f, l_reg = 0; f32x16 o[4] = {}; bf16x8 qr[12];
  const bf16r* Qw = Qb + (long)(wid * QBLK + r32) * LDQ + hi * 8;
#pragma unroll
  for (int d0 = 0; d0 < 8; ++d0) qr[d0] = *reinterpret_cast<const bf16x8*>(Qw + d0 * 16);
  { const float* tr = tab + (long)(wid * QBLK + r32) * 64 + hi * 8;
#pragma unroll
    for (int d0 = 8; d0 < 12; ++d0) { const u32x4 qv = *reinterpret_cast<const u32x4*>(Qw + d0 * 16);
      const float4 t0 = *reinterpret_cast<const float4*>(tr + (d0 - 8) * 16), t1 = *reinterpret_cast<const float4*>(tr + (d0 - 8) * 16 + 4);
      u32x4 w;
#define ROT(Q_, C_, S_) cvtpk(__uint_as_float((Q_) << 16) * (C_) - __uint_as_float((Q_) & 0xffff0000u) * (S_), __uint_as_float((Q_) << 16) * (S_) + __uint_as_float((Q_) & 0xffff0000u) * (C_))
      w[0] = ROT(qv[0], t0.x, t0.y); w[1] = ROT(qv[1], t0.z, t0.w); w[2] = ROT(qv[2], t1.x, t1.y); w[3] = ROT(qv[3], t1.z, t1.w);
#undef ROT
      qr[d0] = *reinterpret_cast<bf16x8*>(&w); } }
  int kof[3], vof[2];
#pragma unroll
  for (int i = 0; i < 3; ++i) { const int ob = i * 1024 + 16 * lane, ri = ob / 384, sp = (ob - ri * 384) >> 4, sl = (sp & ~7) | ((sp & 7) ^ ri); kof[i] = (8 * wid + ri) * LDK + sl * 8; }
#pragma unroll
  for (int i = 0; i < 2; ++i) { const int kk = 8 * wid + ((lane & 31) >> 2), k = (kk & ~0xC) | ((kk & 4) << 1) | ((kk & 8) >> 1), c = (2 * i + (lane >> 5)) * 32 + (lane & 3) * 8; vof[i] = k * LDV + c; }
  const unsigned kdst = lds0 + LDS_K3 + wid * KBLK, vdst = lds0 + LDS_V3 + wid * 2048;
#define DMA_KV(kt, ks, vt, vs) do { const bf16r* kb_ = Kh + (long)(kt) * KVBLK * LDK; const bf16r* vb_ = Vh + (long)(vt) * KVBLK * LDV; const unsigned kd_ = (unsigned)__builtin_amdgcn_readfirstlane(kdst + (ks) * SHM_K3), vd_ = (unsigned)__builtin_amdgcn_readfirstlane(vdst + (vs) * SHM_V3); \
    glds16(kb_ + kof[0], kd_); glds16(kb_ + kof[1], kd_ + 1024); glds16(kb_ + kof[2], kd_ + 2048); glds16(vb_ + vof[0], vd_); glds16(vb_ + vof[1], vd_ + 1024); } while (0)
#define WAIT_BAR5() asm volatile("s_waitcnt vmcnt(5)\n\ts_barrier" ::: "memory")
  lcp kp[4];
  { const int ri = r32 & 7; const lcp kb = (lcp)lds + LDS_K3 + (r32 >> 3) * KBLK + ri * 384;
#pragma unroll
    for (int m = 0; m < 4; ++m) kp[m] = kb + 16 * ((2 * m + hi) ^ ri); }
  const int vb0 = (int)(lds0 + LDS_V3) + v_rd_base(lane);
#define RESC(a) do { if (__any((a) < 1.f)) { if (hi == 0) al_l[r32] = (a); asm volatile("s_waitcnt lgkmcnt(0)" ::: "memory"); \
    for (int d = 0; d < 4; ++d) for (int r = 0; r < 16; ++r) o[d][r] *= al_l[crow(r, hi)]; } } while (0)
  f32x16 p0, p1; float al; bf16x8 pa0, pa1, pa2, pa3; const int NT = seq / KVBLK;
  int s0 = 0;
#define S1() (s0 == 2 ? 0 : s0 + 1)
#define S2() (s0 == 0 ? 2 : s0 - 1)
#define CLAMP(t) ((t) < NT ? (t) : NT - 1)
#define BAR() asm volatile("s_barrier" ::: "memory")
#define LGKM(n) do { asm volatile("s_waitcnt lgkmcnt(" #n ")" ::: "memory"); SBAR(); } while (0)
  const int kq[4] = {(int)(uintptr_t)kp[0], (int)(uintptr_t)kp[1], (int)(uintptr_t)kp[2], (int)(uintptr_t)kp[3]};
  DMA_KV(0, 0, 0, 0); DMA_KV(1, 1, 0, 0);
  asm volatile("s_waitcnt vmcnt(0)\n\ts_barrier" ::: "memory");
#ifndef ATT_HALF
#define ATT_HALF(w) ((w) >= 4)
#endif
  if (ATT_HALF(wid)) BAR();
#define KRD(F0, F1, A, OFF) asm volatile("ds_read_b128 %0, %2 offset:%3\n\tds_read_b128 %1, %2 offset:%4" : "=&v"(F0), "=&v"(F1) : "v"(A), "i"(OFF), "i"((OFF) + 4 * KBLK) : "memory")
#define VRD(SET, D0) do { SET[0] = tr_read<v_rd_off(D0, 0, 0)>(vb); SET[1] = tr_read<v_rd_off(D0, 0, 1)>(vb); SET[2] = tr_read<v_rd_off(D0, 1, 0)>(vb); SET[3] = tr_read<v_rd_off(D0, 1, 1)>(vb); \
    SET[4] = tr_read<v_rd_off(D0, 2, 0)>(vb); SET[5] = tr_read<v_rd_off(D0, 2, 1)>(vb); SET[6] = tr_read<v_rd_off(D0, 3, 0)>(vb); SET[7] = tr_read<v_rd_off(D0, 3, 1)>(vb); } while (0)
#define PKV(L, H) (bf16x8){L[0], L[1], L[2], L[3], H[0], H[1], H[2], H[3]}
#define PVG(OD, SET) do { if (ATT_EXP == 2) { asm volatile("" :: "v"(SET[0]), "v"(SET[7])); break; } OD = __builtin_amdgcn_mfma_f32_32x32x16_bf16(pa0, PKV(SET[0], SET[1]), OD, 0, 0, 0); OD = __builtin_amdgcn_mfma_f32_32x32x16_bf16(pa1, PKV(SET[2], SET[3]), OD, 0, 0, 0); \
    OD = __builtin_amdgcn_mfma_f32_32x32x16_bf16(pa2, PKV(SET[4], SET[5]), OD, 0, 0, 0); OD = __builtin_amdgcn_mfma_f32_32x32x16_bf16(pa3, PKV(SET[6], SET[7]), OD, 0, 0, 0); } while (0)
#define QK(F, D0) do { if (ATT_EXP != 2) { p0 = __builtin_amdgcn_mfma_f32_32x32x16_bf16(F[0], qr[D0], p0, 0, 0, 0); p1 = __builtin_amdgcn_mfma_f32_32x32x16_bf16(F[1], qr[D0], p1, 0, 0, 0); } else { asm volatile("" :: "v"(F[0]), "v"(F[1])); } } while (0)
#define QK0(F) do { const f32x16 z_ = {}; p0 = __builtin_amdgcn_mfma_f32_32x32x16_bf16(F[0], qr[0], z_, 0, 0, 0); p1 = __builtin_amdgcn_mfma_f32_32x32x16_bf16(F[1], qr[0], z_, 0, 0, 0); } while (0)
#define MPH(PREV) do { const int ko_ = s0 * SHM_K3; const int a0_ = kq[0] + ko_, a1_ = kq[1] + ko_, a2_ = kq[2] + ko_, a3_ = kq[3] + ko_; const int vb = vb0 + S2() * SHM_V3; \
    bf16x8 kf0[2], kf1[2], kf2[2]; s16x4 va[8], vc[8]; \
    __builtin_amdgcn_s_setprio(1); SBAR(); \
    KRD(kf0[0], kf0[1], a0_, 0); KRD(kf1[0], kf1[1], a1_, 0); VRD(va, 0); \
    KRD(kf2[0], kf2[1], a2_, 0);   LGKM(12); QK0(kf0); \
    KRD(kf0[0], kf0[1], a3_, 0);   LGKM(12); QK(kf1, 1); \
    KRD(kf1[0], kf1[1], a0_, 128); LGKM(4);  QK(kf2, 2); \
    KRD(kf2[0], kf2[1], a1_, 128); LGKM(4);  QK(kf0, 3); \
    KRD(kf0[0], kf0[1], a2_, 128); LGKM(4);  QK(kf1, 4); \
    KRD(kf1[0], kf1[1], a3_, 128); LGKM(4);  QK(kf2, 5); \
    KRD(kf2[0], kf2[1], a0_, 256); LGKM(4);  QK(kf0, 6); \
    KRD(kf0[0], kf0[1], a1_, 256); LGKM(4);  QK(kf1, 7); \
    KRD(kf1[0], kf1[1], a2_, 256); LGKM(4);  QK(kf2, 8); \
    KRD(kf2[0], kf2[1], a3_, 256); LGKM(4);  QK(kf0, 9); \
    LGKM(2); QK(kf1, 10); \
    LGKM(0); QK(kf2, 11); \
    if (PREV) { VRD(vc, 1); LGKM(8); PVG(o[0], va); VRD(va, 2); LGKM(8); PVG(o[1], vc); VRD(vc, 3); LGKM(8); PVG(o[2], va); LGKM(0); PVG(o[3], vc); } \
    __builtin_amdgcn_s_setprio(0); asm volatile("s_waitcnt vmcnt(0)\n\ts_barrier" ::: "memory"); } while (0)
#ifndef ATT_EXP
#define ATT_EXP 0
#endif
#define VPH(j) do { if (ATT_EXP != 4) DMA_KV(CLAMP((j) + 2), S2(), CLAMP((j) + 1), S1()); if (ATT_EXP != 1) { al = softmaxPP(p0, p1, m_reg, l_reg, (j) == 0, pa0, pa1, pa2, pa3); RESC(al); } else { asm volatile("" : "+v"(p0), "+v"(p1)); } s0 = S1(); BAR(); } while (0)
  MPH(false); VPH(0);
#pragma unroll 1
  for (int j = 1; j < NT; ++j) { MPH(true); VPH(j); }
  pv_d0(o, vb0 + S2() * SHM_V3, pa0, pa1, pa2, pa3);
  if (!ATT_HALF(wid)) BAR();
  if (hi == 0) li_l[r32] = l_reg; asm volatile("s_waitcnt lgkmcnt(0)" ::: "memory");
  float rli[16];
#pragma unroll
  for (int r = 0; r < 16; ++r) rli[r] = __builtin_amdgcn_rcpf(li_l[crow(r, hi)]);
  bf16r* Ow = Ob + (long)(wid * QBLK) * LDO;
#pragma unroll
  for (int r = 0; r < 16; ++r) { const int orow = crow(r, hi);
#pragma unroll
    for (int d0 = 0; d0 < 4; ++d0) { unsigned w = cvtpk(o[d0][r] * rli[r], 0.f); if (ATT_EXP != 0) w = 0u;   Ow[(long)orow * LDO + d0 * 32 + r32] = (bf16r)(w & 0xffffu); } }
  asm volatile("s_waitcnt vmcnt(0) lgkmcnt(0)\n\ts_barrier" ::: "memory");
#undef DMA_KV
#undef WAIT_BAR5
#undef RESC
#undef S1
#undef S2
#undef CLAMP
#undef BAR
#undef MPH
#undef VPH
#undef LGKM
#undef KRD
#undef VRD
#undef PKV
#undef PVG
#undef QK
#undef QK0
}
#undef SBAR
}

namespace fftc {
#define FGAS __attribute__((address_space(1)))
typedef float f2 __attribute__((ext_vector_type(2)));
typedef __attribute__((address_space(3))) f2 lf2;
constexpr int L = 16384;
constexpr int FFT_LDS_BYTES = 17920 * 8;
__device__ static const float TW64C[32] = { 1.000000000e+00f, 9.951847267e-01f, 9.807852804e-01f, 9.569403357e-01f, 9.238795325e-01f, 8.819212643e-01f, 8.314696123e-01f, 7.730104534e-01f, 7.071067812e-01f, 6.343932842e-01f, 5.555702330e-01f, 4.713967368e-01f, 3.826834324e-01f, 2.902846773e-01f, 1.950903220e-01f, 9.801714033e-02f, 0.0f, -9.801714033e-02f, -1.950903220e-01f, -2.902846773e-01f, -3.826834324e-01f, -4.713967368e-01f, -5.555702330e-01f, -6.343932842e-01f, -7.071067812e-01f, -7.730104534e-01f, -8.314696123e-01f, -8.819212643e-01f, -9.238795325e-01f, -9.569403357e-01f, -9.807852804e-01f, -9.951847267e-01f };
__device__ static const float TW64S[32] = { 0.000000000e+00f, 9.801714033e-02f, 1.950903220e-01f, 2.902846773e-01f, 3.826834324e-01f, 4.713967368e-01f, 5.555702330e-01f, 6.343932842e-01f, 7.071067812e-01f, 7.730104534e-01f, 8.314696123e-01f, 8.819212643e-01f, 9.238795325e-01f, 9.569403357e-01f, 9.807852804e-01f, 9.951847267e-01f, 1.000000000e+00f, 9.951847267e-01f, 9.807852804e-01f, 9.569403357e-01f, 9.238795325e-01f, 8.819212643e-01f, 8.314696123e-01f, 7.730104534e-01f, 7.071067812e-01f, 6.343932842e-01f, 5.555702330e-01f, 4.713967368e-01f, 3.826834324e-01f, 2.902846773e-01f, 1.950903220e-01f, 9.801714033e-02f };
__device__ __forceinline__ f2 cmul(f2 a, f2 w) { return (f2){a.x * w.x - a.y * w.y, a.x * w.y + a.y * w.x}; }
template <bool INV> __device__ __forceinline__ f2 twmul(f2 d, int tw) {
    if (tw == 0) return d;
    if (tw == 16) return INV ? (f2){-d.y, d.x} : (f2){d.y, -d.x};
    const float c = TW64C[tw], s = TW64S[tw];
    return INV ? (f2){d.x * c - d.y * s, d.y * c + d.x * s} : (f2){d.x * c + d.y * s, d.y * c - d.x * s};
}
template <int N, int S, bool INV> __device__ __forceinline__ void dif_stage(f2 (&v)[N]) {
#pragma unroll
    for (int blk = 0; blk < N; blk += 2 * S)
#pragma unroll
        for (int i = 0; i < S; ++i) { const f2 a = v[blk + i], b = v[blk + i + S]; v[blk + i] = a + b; v[blk + i + S] = twmul<INV>(a - b, i * (32 / S)); }
    if constexpr (S > 1) dif_stage<N, S / 2, INV>(v);
}
constexpr int bitrev(int k, int bits) { int r = 0; for (int b = 0; b < bits; ++b) r |= ((k >> b) & 1) << (bits - 1 - b); return r; }
template <int N, bool INV> __device__ __forceinline__ void dft(f2 (&v)[N]) {
    dif_stage<N, N / 2, INV>(v);
    constexpr int bits = (N == 32) ? 5 : 4;
    f2 t[N];
#pragma unroll
    for (int k = 0; k < N; ++k) t[k] = v[bitrev(k, bits)];
#pragma unroll
    for (int k = 0; k < N; ++k) v[k] = t[k];
}
template <bool CONJ> __device__ __forceinline__ void apply_pow32(f2 (&v)[32], f2 w) {
    if (CONJ) w.y = -w.y;
    f2 lo[8]; lo[0] = (f2){1.f, 0.f}; lo[1] = w; lo[2] = cmul(w, w); lo[3] = cmul(lo[2], w); lo[4] = cmul(lo[2], lo[2]); lo[5] = cmul(lo[4], w); lo[6] = cmul(lo[4], lo[2]); lo[7] = cmul(lo[4], lo[3]);
#pragma unroll
    for (int k = 1; k < 32; ++k) if (k & 7) v[k] = cmul(v[k], lo[k & 7]);
    const f2 p8 = cmul(lo[4], lo[4]), p16 = cmul(p8, p8), p24 = cmul(p16, p8);
#pragma unroll
    for (int k = 8; k < 16; ++k) v[k] = cmul(v[k], p8);
#pragma unroll
    for (int k = 16; k < 24; ++k) v[k] = cmul(v[k], p16);
#pragma unroll
    for (int k = 24; k < 32; ++k) v[k] = cmul(v[k], p24);
}
__device__ __forceinline__ int opaque(int x) { asm volatile("" : "+v"(x)); return x; }
__device__ __forceinline__ f2 cis_pi(float x) { float s, c; sincospif(x, &s, &c); return (f2){c, s}; }
#define FPHYS(d1, d2, d3) ((d1) * 560 + (d2) * 17 + (d3))
#define FSYNC() __syncthreads()
__device__ __forceinline__ void pass1_fwd(lf2* X, f2 (&v)[32], int tid) {
    tid = opaque(tid);
    dft<32, false>(v);
    apply_pow32<false>(v, cis_pi(-(float)tid * (2.0f / L)));
    const int base = (tid >> 4) * 17 + (tid & 15);
#pragma unroll
    for (int k = 0; k < 32; ++k) X[base + k * 560] = v[k];
}
__device__ __forceinline__ void pass1_inv(const lf2* X, f2 (&v)[32], int tid) {
    tid = opaque(tid);
    const int base = (tid >> 4) * 17 + (tid & 15);
#pragma unroll
    for (int k = 0; k < 32; ++k) v[k] = X[base + k * 560];
    apply_pow32<true>(v, cis_pi(-(float)tid * (2.0f / L)));
    dft<32, true>(v);
}
template <bool INV> __device__ __forceinline__ void pass2(lf2* X, int tid) {
    tid = opaque(tid);
    const int base = (tid >> 4) * 560 + (tid & 15); f2 v[32];
#pragma unroll
    for (int k = 0; k < 32; ++k) v[k] = X[base + k * 17];
    const f2 w = cis_pi(-(float)(tid & 15) * (2.0f / 512.0f));
    if (INV) { apply_pow32<true>(v, w); dft<32, true>(v); } else { dft<32, false>(v); apply_pow32<false>(v, w); }
#pragma unroll
    for (int k = 0; k < 32; ++k) X[base + k * 17] = v[k];
}
template <bool KMODE> __device__ __forceinline__ void pass3(lf2* X, f2* KS, int tid) {
    typedef float f4 __attribute__((ext_vector_type(4)));
    tid = opaque(tid);
#pragma unroll 1
    for (int i = 0; i < 2; ++i) { const int base = ((tid >> 5) + 16 * i) * 560 + (tid & 31) * 17; f2 u[16]; FGAS f4* ks = (FGAS f4*)(KS + (size_t)(i * 512 + tid) * 16);
#pragma unroll
        for (int k = 0; k < 16; ++k) u[k] = X[base + k];
        dft<16, false>(u);
        if (KMODE) {
#pragma unroll
            for (int k = 0; k < 8; ++k) ks[k] = (f4){u[2 * k].x, u[2 * k].y, u[2 * k + 1].x, u[2 * k + 1].y};
        } else {
#pragma unroll
            for (int k = 0; k < 8; ++k) { const f4 w = ks[k]; u[2 * k] = cmul(u[2 * k], (f2){w.x, w.y}); u[2 * k + 1] = cmul(u[2 * k + 1], (f2){w.z, w.w}); }
            dft<16, true>(u);
#pragma unroll
            for (int k = 0; k < 16; ++k) X[base + k] = u[k];
        } }
}
__device__ __forceinline__ void kernel_spectrum(lf2* X, f2 (&v)[32], f2* KS, int tid) {
    pass1_fwd(X, v, tid); FSYNC(); pass2<false>(X, tid); FSYNC(); pass3<true>(X, KS, tid); FSYNC();
}
__device__ __forceinline__ void conv_roundtrip(lf2* X, f2 (&v)[32], f2* KS, int tid) {
    pass1_fwd(X, v, tid); FSYNC(); pass2<false>(X, tid); FSYNC(); pass3<false>(X, KS, tid); FSYNC(); pass2<true>(X, tid); FSYNC(); pass1_inv(X, v, tid); FSYNC();
}
__device__ __forceinline__ void modulate(f2 (&v)[32], int tid) {
    const f2 wj = cis_pi(-(float)opaque(tid) * (1.0f / L));
#pragma unroll
    for (int k = 0; k < 32; ++k) v[k] = twmul<false>(cmul(v[k], wj), k);
}
__device__ __forceinline__ void demodulate(f2 (&v)[32], int tid) {
    f2 wj = cis_pi(-(float)opaque(tid) * (1.0f / L)); wj.y = -wj.y;
#pragma unroll
    for (int k = 0; k < 32; ++k) v[k] = twmul<true>(cmul(v[k], wj), k);
}
__device__ __forceinline__ float bf2f(unsigned short u) { return __uint_as_float((unsigned)u << 16); }
__device__ __forceinline__ unsigned short f2bf_rne(float f) { unsigned u = __float_as_uint(f); return (unsigned short)((u + 0x7fffu + ((u >> 16) & 1u)) >> 16); }
template <typename T> __device__ __forceinline__ FGAS T* pstep(FGAS T* p, int n) { p += n; asm volatile("" : "+v"(p)); return p; }
template <int MODE> __device__ __forceinline__ void hyena_channel(lf2* X, const float* z0, const float* z1, const float* hf, const float* hb,
                                                                        const unsigned short* g0, const unsigned short* g1, float dbias, float* zo0, float* zo1,
                                                                        unsigned short* o0, unsigned short* o1, f2* stash, f2* KS, int tid) {
    f2 v[32];
    { FGAS const float* pf = (FGAS const float*)hf + opaque(tid); FGAS const float* pb = (FGAS const float*)hb + ((L - opaque(tid)) & (L - 1));
#pragma unroll
      for (int k = 0; k < 32; ++k) { v[k] = (f2){*pf + *pb, 0.f}; pf = pstep(pf, 512); pb = (k == 0) ? pstep((FGAS const float*)hb + (L - 512 - tid), 0) : pstep(pb, -512); } }
    kernel_spectrum(X, v, KS, tid);
    { FGAS const float* p0 = (FGAS const float*)z0 + opaque(tid); FGAS const float* p1 = (FGAS const float*)z1 + opaque(tid);
#pragma unroll
      for (int k = 0; k < 32; ++k) { v[k] = (f2){*p0, *p1}; p0 = pstep(p0, 512); p1 = pstep(p1, 512); } }
    conv_roundtrip(X, v, KS, tid);
    { FGAS f2* ps = (FGAS f2*)stash + opaque(tid);
#pragma unroll
      for (int k = 0; k < 32; ++k) { *ps = v[k]; ps = pstep(ps, 512); } }
    { FGAS const float* pf = (FGAS const float*)hf + opaque(tid); FGAS const float* pb = (FGAS const float*)hb + ((L - opaque(tid)) & (L - 1));
#pragma unroll
      for (int k = 0; k < 32; ++k) { const float hbv = *pb; v[k] = (f2){*pf + ((k == 0 && tid == 0) ? hbv : -hbv), 0.f}; pf = pstep(pf, 512); pb = (k == 0) ? pstep((FGAS const float*)hb + (L - 512 - tid), 0) : pstep(pb, -512); } }
    modulate(v, tid);
    kernel_spectrum(X, v, KS, tid);
    { FGAS const float* p0 = (FGAS const float*)z0 + opaque(tid); FGAS const float* p1 = (FGAS const float*)z1 + opaque(tid);
#pragma unroll
      for (int k = 0; k < 32; ++k) { v[k] = (f2){*p0, *p1}; p0 = pstep(p0, 512); p1 = pstep(p1, 512); } }
    modulate(v, tid);
    conv_roundtrip(X, v, KS, tid);
    demodulate(v, tid);
    const float sc = 1.0f / (2.0f * L);
    { FGAS const f2* ps = (FGAS const f2*)stash + opaque(tid); FGAS const float* p0 = (FGAS const float*)z0 + opaque(tid); FGAS const float* p1 = (FGAS const float*)z1 + opaque(tid); FGAS const unsigned short* q0 = (FGAS const unsigned short*)g0 + opaque(tid); FGAS const unsigned short* q1 = (FGAS const unsigned short*)g1 + opaque(tid);
      FGAS float* w0 = (FGAS float*)zo0 + opaque(tid); FGAS float* w1 = (FGAS float*)zo1 + opaque(tid); FGAS unsigned short* b0 = (FGAS unsigned short*)o0 + opaque(tid); FGAS unsigned short* b1 = (FGAS unsigned short*)o1 + opaque(tid);
#pragma unroll
      for (int k = 0; k < 32; ++k) { const f2 y = (*ps + v[k]) * sc;
          const float r0 = bf2f(*q0) * (y.x + dbias * *p0), r1 = bf2f(*q1) * (y.y + dbias * *p1);
          if (MODE == 1) { *b0 = f2bf_rne(r0); *b1 = f2bf_rne(r1); b0 = pstep(b0, 512); b1 = pstep(b1, 512); } else if (MODE == 0) { *w0 = r0; *w1 = r1; w0 = pstep(w0, 512); w1 = pstep(w1, 512); } else { asm volatile("" :: "v"(r0), "v"(r1)); }
          ps = pstep(ps, 512); p0 = pstep(p0, 512); p1 = pstep(p1, 512); q0 = pstep(q0, 512); q1 = pstep(q1, 512); } }
}
#undef FPHYS
#undef FGAS
}

constexpr int BATCH = 2, SEQ = 16384, DM = 1024, T = BATCH * SEQ;
constexpr int NH = 8, DNOPE = 128, DROPE = 64, DQK = 192, DVH = 128, QLORA = 384, KVLORA = 256, MLA_IN = 704, MLA_INP = 768;
constexpr int DFF = 2816, NUP = 2 * DFF;
constexpr int HF = 64, HEMB = 33, HKP = 256;
constexpr float LN_EPS = 1e-5f, RMS_EPS = 1e-6f;
constexpr float DN_ALPHA = 1.4142135623730951f;
constexpr float QSCALE = 0.07216878364870322f * 1.4426950408889634f;
constexpr int NWAVES = 8;

constexpr size_t MiB = 1u << 20;
constexpr size_t WS_CTL = 0, CTL_ZERO_BYTES = 1 * MiB;
constexpr size_t WS_WIN = 2 * MiB, WS_WUQ = 4 * MiB, WS_WUKV = 6 * MiB, WS_WO = 7 * MiB, WS_WHIN = 9 * MiB, WS_WHO = 15 * MiB, WS_WUP = 17 * MiB, WS_WDN = 39 * MiB, WS_WFO = 50 * MiB, WS_H3 = 52 * MiB;
constexpr size_t WS_XB = 60 * MiB;
constexpr size_t WS_XF = 124 * MiB;
constexpr size_t WS_S = 252 * MiB;
constexpr size_t WS_END = 512 * MiB;
constexpr size_t WS_CQN = WS_XF, WS_CKVN = WS_XF + 24 * MiB, WS_ROPE = WS_XF + 40 * MiB;
constexpr size_t WS_Q = WS_S, WS_K = WS_S + 96 * MiB, WS_V = WS_S + 192 * MiB;
constexpr size_t WS_UH = WS_S;
constexpr size_t WS_U = WS_S;
constexpr size_t WS_VC0 = WS_XB, WS_VC1 = WS_S + 192 * MiB;
constexpr size_t WS_KT = WS_S, WS_STASH = WS_S + 128 * MiB, WS_KSPEC = WS_S + 160 * MiB;
constexpr int CW_TMO = 0, CW_CODE = 1, CW_BAR = 4096, CW_CHK = 8192;

constexpr int RING_BYTES = 131072;
constexpr int LDS_BYTES = 147456;
constexpr int MISC_OFF = LDS_BYTES - 512;
static_assert(fftc::FFT_LDS_BYTES <= MISC_OFF && attn::SHM_ATTN3 <= RING_BYTES, "LDS map");

typedef pg8::bf16_t bf16;
typedef unsigned u32x4t __attribute__((ext_vector_type(4)));
typedef unsigned u32x2t __attribute__((ext_vector_type(2)));
typedef float f32x2 __attribute__((ext_vector_type(2)));
__device__ __forceinline__ float wave_sum(float v) {
#pragma unroll
    for (int o = 1; o < 64; o <<= 1) v += __shfl_xor(v, o);
    return v;
}
__device__ __forceinline__ float bf_lo(unsigned w) { return __uint_as_float(w << 16); }
__device__ __forceinline__ float bf_hi(unsigned w) { return __uint_as_float(w & 0xffff0000u); }
__device__ __forceinline__ unsigned pkbf(float lo, float hi) { return pg8::cvt_pk_bf16(lo, hi); }

template <class ColMap> __device__ __forceinline__ void transpose_item(const float* W, int K, int N, bf16* WT, int ldk, LAS float* scr, int item, int nblk, int lane, const ColMap& cm) {
    const int kb = item / nblk, nb = item % nblk, k0 = 64 * kb, n0 = 32 * nb;
    const int sc = cm(n0 + (lane & 31));
#pragma unroll 8
    for (int i = 0; i < 32; ++i) { const int kk = 2 * i + (lane >> 5); scr[kk * 33 + (lane & 31)] = (sc >= 0) ? W[(size_t)(k0 + kk) * N + sc] : 0.f; }
    asm volatile("s_waitcnt lgkmcnt(0)" ::: "memory");
    const int c = lane & 7;
#pragma unroll
    for (int j = 0; j < 4; ++j) { const int n = (lane >> 3) + 8 * j; const LAS float* s = scr + (8 * c) * 33 + n;
        u32x4t o; o.x = pkbf(s[0 * 33], s[1 * 33]); o.y = pkbf(s[2 * 33], s[3 * 33]); o.z = pkbf(s[4 * 33], s[5 * 33]); o.w = pkbf(s[6 * 33], s[7 * 33]);
        *(u32x4t*)(WT + (size_t)(n0 + n) * ldk + k0 + 8 * c) = o; }
    asm volatile("s_waitcnt lgkmcnt(0)" ::: "memory");
}
struct CmIdent { __device__ __forceinline__ int operator()(int n) const { return n; } };
struct CmWin { __device__ __forceinline__ int operator()(int n) const { if (n < 640) return n; if (n >= 704) return -1; const int i = n - 640; return 640 + (i & 1) * 32 + (i >> 1); } };
struct CmWuq { __device__ __forceinline__ int operator()(int n) const { const int h = n / 192, d = n - h * 192; if (d < 128) return n; const int i = d - 128; return h * 192 + 128 + (i & 1) * 32 + (i >> 1); } };
struct CmWukv { __device__ __forceinline__ int operator()(int n) const { const int v = n >> 10, r = n & 1023, h = r >> 7, d = r & 127; return h * 256 + v * 128 + d; } };
struct CmWup { __device__ __forceinline__ int operator()(int n) const { const int pn = n >> 8, r = n & 255; return (r < 128) ? (pn * 128 + r) : (DFF + pn * 128 + (r - 128)); } };

struct Args {
    const float* in[27]; float* out; unsigned char* ws; int ph_lo, ph_hi;
};
enum { I_X = 0, I_POS, I_MLA_WIN, I_MLA_GQ, I_MLA_WUQ, I_MLA_GKV, I_MLA_WUKV, I_MLA_WO, I_HY_WIN, I_HY_WSHORT, I_HY_FW1, I_HY_FB1, I_HY_FW2, I_HY_FB2, I_HY_FW3, I_HY_FB3, I_HY_FREQ,
       I_HY_FWOUT, I_HY_DBIAS, I_HY_WO, I_FFN_WUP, I_FFN_WCONV, I_FFN_WDOWN, I_LN1G, I_LN1B, I_LN2G, I_LN2B };

__device__ __forceinline__ void ln_rows(const float* Y, float* OF, bf16* OB, const float* g, const float* b, int gw, int ngw, int lane, float omul = 1.0f) {
    f32x4 gv[4], bv[4];
#pragma unroll
    for (int j = 0; j < 4; ++j) { gv[j] = *(const f32x4*)(g + 4 * lane + 256 * j); bv[j] = *(const f32x4*)(b + 4 * lane + 256 * j); }
    for (int m = gw; m < T; m += ngw) {
        const f32x4* xr = (const f32x4*)(Y + (size_t)m * DM) + lane;
        f32x4 v[4]; float s = 0.f;
#pragma unroll
        for (int j = 0; j < 4; ++j) { v[j] = xr[64 * j]; s += (v[j].x + v[j].y) + (v[j].z + v[j].w); }
        const float mean = wave_sum(s) * (1.f / DM); float s2 = 0.f;
#pragma unroll
        for (int j = 0; j < 4; ++j) { v[j] = v[j] - mean; s2 += (v[j].x * v[j].x + v[j].y * v[j].y) + (v[j].z * v[j].z + v[j].w * v[j].w); }
        const float rstd = 1.f / sqrtf(wave_sum(s2) * (1.f / DM) + LN_EPS);
        f32x4* of = (f32x4*)(OF + (size_t)m * DM) + lane;
#pragma unroll
        for (int j = 0; j < 4; ++j) { v[j] = (v[j] * rstd * gv[j] + bv[j]) * omul;
            of[64 * j] = v[j]; }
        if (OB) { u32x2t* ob = (u32x2t*)(OB + (size_t)m * DM) + lane;
#pragma unroll
            for (int j = 0; j < 4; ++j) { u32x2t w; w.x = pkbf(v[j].x, v[j].y); w.y = pkbf(v[j].z, v[j].w); ob[64 * j] = w; } }
    }
}

__device__ __forceinline__ void mla_norm_rope(const float* H1, const float* gq, const float* gkv, const f32x2* tab, bf16* CQN, bf16* CKVN, bf16* Kb, int gw, int ngw, int lane) {
    float gqv[6], gkvv[4];
#pragma unroll
    for (int k = 0; k < 6; ++k) gqv[k] = gq[lane + 64 * k];
#pragma unroll
    for (int k = 0; k < 4; ++k) gkvv[k] = gkv[lane + 64 * k];
    for (int t = gw; t < T; t += ngw) {
        const float* h = H1 + (size_t)t * MLA_INP;
        float q[6], kv[4]; float sq = 0.f, sk = 0.f;
#pragma unroll
        for (int k = 0; k < 6; ++k) { q[k] = h[lane + 64 * k]; sq += q[k] * q[k]; }
#pragma unroll
        for (int k = 0; k < 4; ++k) { kv[k] = h[QLORA + lane + 64 * k]; sk += kv[k] * kv[k]; }
        const f32x2 xr = *(const f32x2*)(h + 640 + 2 * (lane & 31));
        const float rq = 1.f / sqrtf(wave_sum(sq) * (1.f / QLORA) + RMS_EPS), rk = 1.f / sqrtf(wave_sum(sk) * (1.f / KVLORA) + RMS_EPS);
#pragma unroll
        for (int k = 0; k < 6; ++k) CQN[(size_t)t * QLORA + lane + 64 * k] = (bf16)(pkbf(q[k] * rq * gqv[k], 0.f) & 0xffffu);
#pragma unroll
        for (int k = 0; k < 4; ++k) CKVN[(size_t)t * KVLORA + lane + 64 * k] = (bf16)(pkbf(kv[k] * rk * gkvv[k], 0.f) & 0xffffu);
        const f32x2 cs = tab[(size_t)t * 32 + (lane & 31)];
        const unsigned w = pkbf(xr.x * cs.x - xr.y * cs.y, xr.x * cs.y + xr.y * cs.x);
        unsigned* kr = (unsigned*)(Kb + (size_t)t * 1536 + 128) + (lane & 31);
        if (lane < 32) {
#pragma unroll
            for (int hh = 0; hh < NH; ++hh) kr[hh * 96] = w; }
    }
}

__device__ __forceinline__ void ffn_conv_silu(const bf16* UH, const float* wconv  , bf16* HACT  , int gw, int ngw, int lane) {
    constexpr int RB = 32, NRB = SEQ / RB, NCC = 6;
    for (int it = gw; it < NRB * NCC; it += ngw) {
        const int rb = it / NCC, cc = it - rb * NCC, c = cc * 512 + lane * 8;
        if (c >= DFF) continue;
        const int pn = c >> 7, ucol = pn * 256 + (c & 127);
        float wa[3][8], wg[3][8];
#pragma unroll
        for (int k = 0; k < 3; ++k)
#pragma unroll
            for (int e = 0; e < 8; ++e) { wa[k][e] = wconv[k * NUP + c + e]; wg[k][e] = wconv[k * NUP + DFF + c + e]; }
        const int r0 = rb * RB;
        const bf16* up = UH + ucol;
        const u32x4t zero = {0u, 0u, 0u, 0u};
        u32x4t ra[6], rg[6];
        ra[0] = zero; rg[0] = zero;
        if (r0 > 0) { ra[0] = *(const u32x4t*)(up + (size_t)(r0 - 1) * NUP); rg[0] = *(const u32x4t*)(up + (size_t)(r0 - 1) * NUP + 128); }
        ra[1] = *(const u32x4t*)(up + (size_t)r0 * NUP); rg[1] = *(const u32x4t*)(up + (size_t)r0 * NUP + 128);
#pragma unroll 1
        for (int r = r0; r < r0 + RB; r += 4) {
#pragma unroll
            for (int j = 1; j <= 4; ++j) { const int rr = r + j; if (rr < SEQ) { ra[1 + j] = *(const u32x4t*)(up + (size_t)rr * NUP); rg[1 + j] = *(const u32x4t*)(up + (size_t)rr * NUP + 128); } else { ra[1 + j] = zero; rg[1 + j] = zero; } }
#pragma unroll
            for (int j = 0; j < 4; ++j) {
                float o[8];
#pragma unroll
                for (int e2 = 0; e2 < 4; ++e2) {
                    const float a0 = wa[0][2 * e2] * bf_lo(ra[j][e2]) + wa[1][2 * e2] * bf_lo(ra[j + 1][e2]) + wa[2][2 * e2] * bf_lo(ra[j + 2][e2]);
                    const float a1 = wa[0][2 * e2 + 1] * bf_hi(ra[j][e2]) + wa[1][2 * e2 + 1] * bf_hi(ra[j + 1][e2]) + wa[2][2 * e2 + 1] * bf_hi(ra[j + 2][e2]);
                    const float g0 = wg[0][2 * e2] * bf_lo(rg[j][e2]) + wg[1][2 * e2] * bf_lo(rg[j + 1][e2]) + wg[2][2 * e2] * bf_lo(rg[j + 2][e2]);
                    const float g1 = wg[0][2 * e2 + 1] * bf_hi(rg[j][e2]) + wg[1][2 * e2 + 1] * bf_hi(rg[j + 1][e2]) + wg[2][2 * e2 + 1] * bf_hi(rg[j + 2][e2]);
                    o[2 * e2] = a0 * g0 * __builtin_amdgcn_rcpf(1.f + __expf(-g0)); o[2 * e2 + 1] = a1 * g1 * __builtin_amdgcn_rcpf(1.f + __expf(-g1)); }
                u32x4t w; w.x = pkbf(o[0], o[1]); w.y = pkbf(o[2], o[3]); w.z = pkbf(o[4], o[5]); w.w = pkbf(o[6], o[7]);
                *(u32x4t*)(HACT + (size_t)(r + j) * DFF + c) = w;
            }
            ra[0] = ra[4]; rg[0] = rg[4]; ra[1] = ra[5]; rg[1] = rg[5];
        }
    }
}

__device__ __forceinline__ void hy_conv_transpose(const bf16* U  , const float* wshort  , float* VC0, float* VC1, bf16* G1C, bf16* G2C, LAS unsigned* scr, int gw, int ngw, int lane) {
    constexpr int NTT = T / 64, NCT = 3072 / 64;
    for (int it = gw; it < NTT * NCT; it += ngw) {
        const int ct = it % NCT, tt = it / NCT, b = tt / (SEQ / 64), t0 = (tt % (SEQ / 64)) * 64, c0 = ct * 64;
        const int r8 = lane >> 3, c8 = lane & 7;
#pragma unroll
        for (int i = 0; i < 9; ++i) { const int row = r8 + 8 * i; if (row < 66) { const int tok = t0 - 1 + row; u32x4t v = {0u, 0u, 0u, 0u};
                if (tok >= 0 && tok < SEQ) v = *(const u32x4t*)(U + ((size_t)b * SEQ + tok) * 3072 + c0 + c8 * 8);
                LAS unsigned* d = scr + row * 33 + c8 * 4; d[0] = v.x; d[1] = v.y; d[2] = v.z; d[3] = v.w; } }
        asm volatile("s_waitcnt lgkmcnt(0)" ::: "memory");
        const int part = c0 >> 10, chb = c0 & 1023;
        const float wl0 = wshort[c0 + lane], wl1 = wshort[3072 + c0 + lane], wl2 = wshort[6144 + c0 + lane];
#pragma unroll
        for (int cp = 0; cp < 32; ++cp) {
            const unsigned a0 = scr[lane * 33 + cp], a1 = scr[(lane + 1) * 33 + cp], a2 = scr[(lane + 2) * 33 + cp];
            #define RL(x, i) __int_as_float(__builtin_amdgcn_readlane(__float_as_int(x), (i)))
            const float w00 = RL(wl0, 2 * cp), w10 = RL(wl1, 2 * cp), w20 = RL(wl2, 2 * cp), w01 = RL(wl0, 2 * cp + 1), w11 = RL(wl1, 2 * cp + 1), w21 = RL(wl2, 2 * cp + 1);
#undef RL
            const float v0 = w00 * bf_lo(a0) + w10 * bf_lo(a1) + w20 * bf_lo(a2), v1 = w01 * bf_hi(a0) + w11 * bf_hi(a1) + w21 * bf_hi(a2);
            const size_t o = (size_t)(chb + 2 * cp) * SEQ + t0 + lane;
            if (part == 0) { float* d = b ? VC1 : VC0; d[o] = v0; d[o + SEQ] = v1; }
            else { bf16* d = (part == 1 ? G1C : G2C) + (size_t)b * 1024 * SEQ; d[o] = (bf16)(pkbf(v0, 0.f) & 0xffffu); d[o + SEQ] = (bf16)(pkbf(v1, 0.f) & 0xffffu); }
        }
        asm volatile("s_waitcnt lgkmcnt(0)" ::: "memory");
    }
}
__device__ __forceinline__ void hy_transpose_back(const bf16* Z3C, bf16* XB, LAS unsigned* scr, int gw, int ngw, int lane) {
    constexpr int NTT = T / 64, NCT = 1024 / 64;
    for (int it = gw; it < NTT * NCT; it += ngw) {
        const int ct = it % NCT, tt = it / NCT, b = tt / (SEQ / 64), t0 = (tt % (SEQ / 64)) * 64, c0 = ct * 64;
        const bf16* src = Z3C + ((size_t)b * 1024 + c0) * SEQ + t0 + lane;
#pragma unroll 8
        for (int cp = 0; cp < 32; ++cp) { const unsigned lo = src[(size_t)(2 * cp) * SEQ], hi = src[(size_t)(2 * cp + 1) * SEQ]; scr[lane * 33 + cp] = lo | (hi << 16); }
        asm volatile("s_waitcnt lgkmcnt(0)" ::: "memory");
        const int r8 = lane >> 3, c8 = lane & 7;
#pragma unroll
        for (int i = 0; i < 8; ++i) { const int row = r8 + 8 * i; const LAS unsigned* s = scr + row * 33 + c8 * 4; u32x4t v; v.x = s[0]; v.y = s[1]; v.z = s[2]; v.w = s[3];
            *(u32x4t*)(XB + ((size_t)b * SEQ + t0 + row) * DM + c0 + c8 * 8) = v; }
        asm volatile("s_waitcnt lgkmcnt(0)" ::: "memory");
    }
}

#ifdef SELFCHECK
__device__ __forceinline__ float blk_sum(float v, LAS float* red, int tid_) {
    v = wave_sum(v); __syncthreads(); if ((tid_ & 63) == 0) red[tid_ >> 6] = v; __syncthreads();
    float t = 0.f; for (int i = 0; i < NWAVES; ++i) t += red[i]; __syncthreads(); return t;
}
__device__ __forceinline__ void chk_flag(unsigned* flag, float err2, float ref2, unsigned bit, int tid_) {
    if (tid_ == 0 && !(err2 <= SELFCHECK_TOL * SELFCHECK_TOL * ref2)) atomicOr(flag, bit);
}
__device__ __forceinline__ void selfcheck_mla(const Args& args, LAS unsigned char* ldsl, int bxx, int tid_) {
    unsigned* flag = (unsigned*)(args.ws + WS_CTL) + CW_CHK;
    const bf16* Qb_ = (const bf16*)(args.ws + WS_Q); const bf16* Kb_ = (const bf16*)(args.ws + WS_K); const bf16* Vb_ = (const bf16*)(args.ws + WS_V); const bf16* O_ = (const bf16*)(args.ws + WS_XB);
    const int* pos = (const int*)args.in[I_POS];
    LAS float* red = (LAS float*)(ldsl + 140000);
    if (bxx < 64) {
        const int t = bxx * (T / 64) + (bxx * 37) % 512;
        LAS float* h = (LAS float*)ldsl; LAS float* cq = h + 704; LAS float* ckv = cq + 384;
        const float* x = args.in[I_X] + (size_t)t * DM; const float* w_in = args.in[I_MLA_WIN];
        for (int j = tid_; j < MLA_IN; j += 512) { float a = 0.f; for (int k = 0; k < DM; ++k) a += x[k] * w_in[(size_t)k * MLA_IN + j]; h[j] = a; }
        __syncthreads();
        float sq = 0.f, sk = 0.f; for (int k = 0; k < QLORA; ++k) sq += h[k] * h[k]; for (int k = 0; k < KVLORA; ++k) sk += h[QLORA + k] * h[QLORA + k];
        const float rq = 1.f / sqrtf(sq / QLORA + RMS_EPS), rk = 1.f / sqrtf(sk / KVLORA + RMS_EPS);
        for (int k = tid_; k < QLORA; k += 512) cq[k] = h[k] * rq * args.in[I_MLA_GQ][k];
        for (int k = tid_; k < KVLORA; k += 512) ckv[k] = h[QLORA + k] * rk * args.in[I_MLA_GKV][k];
        __syncthreads();
        {
            float e2 = 0.f, r2 = 0.f; const float* w = args.in[I_MLA_WUQ];
            for (int n = tid_; n < NH * DQK; n += 512) { const int o = CmWuq()(n); float a = 0.f; for (int k = 0; k < QLORA; ++k) a += cq[k] * w[(size_t)k * (NH * DQK) + o];
                a *= QSCALE; const float g = __uint_as_float((unsigned)Qb_[(size_t)t * 1536 + n] << 16); e2 += (a - g) * (a - g); r2 += a * a; }
            e2 = blk_sum(e2, red, tid_); r2 = blk_sum(r2, red, tid_); chk_flag(flag, e2, r2, 1u, tid_);
        }
        {
            float e2 = 0.f, r2 = 0.f, e3 = 0.f, r3 = 0.f; const float* w = args.in[I_MLA_WUKV];
            for (int n = tid_; n < NH * 256; n += 512) { const int o = CmWukv()(n); float a = 0.f; for (int k = 0; k < KVLORA; ++k) a += ckv[k] * w[(size_t)k * (NH * 256) + o];
                if (n < 1024) { const float g = __uint_as_float((unsigned)Kb_[(size_t)t * 1536 + (n >> 7) * 192 + (n & 127)] << 16); e2 += (a - g) * (a - g); r2 += a * a; }
                else { const float g = __uint_as_float((unsigned)Vb_[(size_t)t * 1024 + n - 1024] << 16); e3 += (a - g) * (a - g); r3 += a * a; } }
            e2 = blk_sum(e2, red, tid_); r2 = blk_sum(r2, red, tid_); chk_flag(flag, e2, r2, 2u, tid_);
            e3 = blk_sum(e3, red, tid_); r3 = blk_sum(r3, red, tid_); chk_flag(flag, e3, r3, 8u, tid_);
        }
        {
            float e2 = 0.f, r2 = 0.f;
            if (tid_ < 256) { const int hh = tid_ >> 5, i = tid_ & 31; const float inv = powf(10000.0f, -(float)i / 32.0f); float s, c; sincosf((float)pos[t] * inv, &s, &c);
                const float x1 = h[640 + i], x2 = h[672 + i], a1 = x1 * c - x2 * s, a2 = x1 * s + x2 * c;
                const float g1 = __uint_as_float((unsigned)Kb_[(size_t)t * 1536 + hh * 192 + 128 + 2 * i] << 16), g2 = __uint_as_float((unsigned)Kb_[(size_t)t * 1536 + hh * 192 + 129 + 2 * i] << 16);
                e2 = (a1 - g1) * (a1 - g1) + (a2 - g2) * (a2 - g2); r2 = a1 * a1 + a2 * a2; }
            e2 = blk_sum(e2, red, tid_); r2 = blk_sum(r2, red, tid_); chk_flag(flag, e2, r2, 4u, tid_);
        }
    } else if (bxx < 192) {
        const int sidx = bxx - 64, b = sidx & 1, hh = (sidx >> 1) & 7, row = (sidx * 509 + 13) % SEQ; const size_t t = (size_t)b * SEQ + row;
        LAS float* sc = (LAS float*)ldsl;
        LAS float* q = sc + SEQ;
        if (tid_ < DQK) { float v = __uint_as_float((unsigned)Qb_[t * 1536 + hh * DQK + tid_] << 16);
            if (tid_ >= 128) { const int i = (tid_ - 128) >> 1; const float inv = powf(10000.0f, -(float)i / 32.0f); float s, c; sincosf((float)pos[t] * inv, &s, &c);
                const float o = __uint_as_float((unsigned)Qb_[t * 1536 + hh * DQK + (tid_ ^ 1)] << 16);
                v = (tid_ & 1) ? (o * s + v * c) : (v * c - o * s); }
            q[tid_] = v; }
        __syncthreads();
        float mx = -1e30f;
        for (int k = tid_; k < SEQ; k += 512) { const bf16* kr = Kb_ + ((size_t)b * SEQ + k) * 1536 + hh * DQK; float a = 0.f; for (int d = 0; d < DQK; ++d) a += q[d] * __uint_as_float((unsigned)kr[d] << 16); sc[k] = a; mx = fmaxf(mx, a); }
        for (int o = 1; o < 64; o <<= 1) mx = fmaxf(mx, __shfl_xor(mx, o));
        __syncthreads(); if ((tid_ & 63) == 0) red[tid_ >> 6] = mx; __syncthreads(); for (int i = 0; i < NWAVES; ++i) mx = fmaxf(mx, red[i]); __syncthreads();
        float ls = 0.f; for (int k = tid_; k < SEQ; k += 512) { const float p = exp2f(sc[k] - mx); sc[k] = p; ls += p; }
        ls = blk_sum(ls, red, tid_);
        const int d = tid_ & 127, part = tid_ >> 7; float a = 0.f;
        for (int k = part * 4096; k < (part + 1) * 4096; ++k) a += sc[k] * __uint_as_float((unsigned)Vb_[((size_t)b * SEQ + k) * 1024 + hh * DVH + d] << 16);
        LAS float* op = q + 256; op[tid_] = a; __syncthreads();
        float e2 = 0.f, r2 = 0.f;
        if (tid_ < 128) { const float o = (op[tid_] + op[tid_ + 128] + op[tid_ + 256] + op[tid_ + 384]) / ls; const float g = __uint_as_float((unsigned)O_[t * 1024 + hh * DVH + tid_] << 16); e2 = (o - g) * (o - g); r2 = o * o; }
        e2 = blk_sum(e2, red, tid_); r2 = blk_sum(r2, red, tid_); chk_flag(flag, e2, r2, 16u, tid_);
    }
}
#endif
#ifndef MK_PER_PHASE
#define MK_PER_PHASE 0
#endif
constexpr int N_PHASES = 30;
constexpr int GEMM_SP2 = true, GEMM_ALIGN = true;

__global__ void __launch_bounds__(NWAVES * 64, 2) mega_fwd(Args args) {
    extern __shared__ __attribute__((aligned(16))) unsigned char lds[];
    LAS unsigned char* ldsl = (LAS unsigned char*)lds;
    volatile LAS unsigned* MISC = (volatile LAS unsigned*)(ldsl + MISC_OFF);
    const int wave = __builtin_amdgcn_readfirstlane((int)threadIdx.x >> 6);
#define lane hw_lane()
#define tid (wave * 64 + hw_lane())
#define G ((int)gridDim.x)
#define bx ((int)blockIdx.x)
#define gw (bx * NWAVES + wave)
#define ngw (G * NWAVES)
    { const int t_ = tid; if (t_ < 128) MISC[t_] = 0u; }
    __syncthreads();
    if (!MK_PER_PHASE) (void)xcd_barrier_post((unsigned*)(args.ws + WS_CTL) + CW_BAR, MISC + 8, (unsigned)wave);
    const int lo = args.ph_lo, hi = args.ph_hi;
#ifdef ONLY_PHASE
#define IN(k) ((k) == ONLY_PHASE && lo <= (k) && (k) < hi)
#else
#define IN(k) (lo <= (k) && (k) < hi)
#endif
#define GRIDBAR() do { XcdBarrier bar_; bar_.bar = (unsigned*)(args.ws + WS_CTL) + CW_BAR; bar_.x = xb_xcc_id(); bar_.st = MISC + 8; bar_.wv = (unsigned)wave; xcd_barrier(bar_); } while (0)
#define SEAM(k) do { if (IN(k) && IN((k) + 1)) GRIDBAR(); } while (0)
#ifndef PROBE_DUP
#define PROBE_DUP (-1)
#define PROBE_REP 1
#endif
#define RUN(k, REAL, DUMMY) do { if (IN(k)) { if (PROBE_DUP == (k)) { for (int rep_ = 0; rep_ < PROBE_REP; ++rep_) { DUMMY; GRIDBAR(); } } REAL; } } while (0)

#define P_(T_, off) ((T_*)(args.ws + (off)))
#define Win_t P_(bf16, WS_WIN)
#define Wuq_t P_(bf16, WS_WUQ)
#define Wukv_t P_(bf16, WS_WUKV)
#define Wo_t P_(bf16, WS_WO)
#define Whin_t P_(bf16, WS_WHIN)
#define Who_t P_(bf16, WS_WHO)
#define Wup_t P_(bf16, WS_WUP)
#define Wdn_t P_(bf16, WS_WDN)
#define Wfo_t P_(bf16, WS_WFO)
#define H3 P_(bf16, WS_H3)
#define XB P_(bf16, WS_XB)
#define XF P_(float, WS_XF)
#define CQN P_(bf16, WS_CQN)
#define CKVN P_(bf16, WS_CKVN)
#define ROPE P_(f32x2, WS_ROPE)
#define Qb P_(bf16, WS_Q)
#define Kb P_(bf16, WS_K)
#define Vb P_(bf16, WS_V)
#define UH P_(bf16, WS_UH)
#define U P_(bf16, WS_U)
#define VC0 P_(float, WS_VC0)
#define VC1 P_(float, WS_VC1)
#define KT P_(float, WS_KT)
#define STASH P_(fftc::f2, WS_STASH)
#define KSPEC P_(fftc::f2, WS_KSPEC)
#define OUT (args.out)
#define H1 (args.out)
#define HACT ((bf16*)args.out)
#define G1C ((bf16*)args.out)
#define G2C ((bf16*)args.out + (size_t)2 * 1024 * SEQ)
#define Z3C ((bf16*)args.out)
#define GEMM(EPI, A_, B_, M_, N_, K_, ...) do { pg8::Gemm g{(A_), (B_), (M_), (N_), (K_)}; pg8::StaticOrder S; S.init((M_), (N_), G, bx); pg8::EPI E{__VA_ARGS__}; \
        pg8::gemm_phase<pg8::EPI, pg8::StaticOrder, GEMM_ALIGN, GEMM_SP2>(ldsl, g, S, E, wave); } while (0)

    if (IN(0)) for (int prep_ = 0; prep_ < ((PROBE_DUP == 0) ? 1 + PROBE_REP : 1); ++prep_) {
        if (prep_) GRIDBAR();
        LAS float* scr = (LAS float*)(ldsl + wave * 16384);
        {
            int base = 0;
#define TR(W_, K_, N_, WT_, NP_, LDK_, CM_) do { const int nblk_ = (NP_) / 32, nit_ = ((K_) / 64) * nblk_; \
                for (int it_ = (gw + ngw - base % ngw) % ngw; it_ < nit_; it_ += ngw) transpose_item((W_), (K_), (N_), (WT_), (LDK_), scr, it_, nblk_, lane, CM_); base += nit_; } while (0)
            TR(args.in[I_MLA_WIN], DM, MLA_IN, Win_t, MLA_INP, DM, CmWin());
            TR(args.in[I_MLA_WUQ], QLORA, NH * DQK, Wuq_t, NH * DQK, QLORA, CmWuq());
            TR(args.in[I_MLA_WUKV], KVLORA, NH * 256, Wukv_t, NH * 256, KVLORA, CmWukv());
            TR(args.in[I_MLA_WO], DM, DM, Wo_t, DM, DM, CmIdent());
            TR(args.in[I_HY_WIN], DM, 3 * DM, Whin_t, 3 * DM, DM, CmIdent());
            TR(args.in[I_HY_WO], DM, DM, Who_t, DM, DM, CmIdent());
            TR(args.in[I_FFN_WUP], DM, NUP, Wup_t, NUP, DM, CmWup());
            TR(args.in[I_FFN_WUP] + (size_t)DM * NUP, DM, NUP, Wup_t + (size_t)NUP * DM, NUP, DM, CmWup());
            TR(args.in[I_FFN_WDOWN], DFF, DM, Wdn_t, DM, DFF, CmIdent());
            TR(args.in[I_FFN_WDOWN] + (size_t)DFF * DM, DFF, DM, Wdn_t + (size_t)DM * DFF, DM, DFF, CmIdent());
            TR(args.in[I_HY_FWOUT], HF, 4 * DM, Wfo_t, 4 * DM, HKP, CmIdent());
#undef TR
        }
        for (size_t i = (size_t)gw * 64 + lane; i < (size_t)4096 * 24; i += (size_t)ngw * 64) { const size_t r = i / 24, c = i % 24; *(u32x4t*)(Wfo_t + r * HKP + 64 + c * 8) = (u32x4t){0u, 0u, 0u, 0u}; }
        for (size_t i = (size_t)gw * 64 + lane; i < (size_t)SEQ * 24; i += (size_t)ngw * 64) { const size_t r = i / 24, c = i % 24; *(u32x4t*)(H3 + r * HKP + 64 + c * 8) = (u32x4t){0u, 0u, 0u, 0u}; }
        { const float* x_in = args.in[I_X];
          for (size_t i = (size_t)gw * 64 + lane; i < (size_t)T * DM / 8; i += (size_t)ngw * 64) { const f32x4 a = *(const f32x4*)(x_in + i * 8), b = *(const f32x4*)(x_in + i * 8 + 4);
            u32x4t w; w.x = pkbf(a.x, a.y); w.y = pkbf(a.z, a.w); w.z = pkbf(b.x, b.y); w.w = pkbf(b.z, b.w); *(u32x4t*)(XB + i * 8) = w; } }
        { const int* pos = (const int*)args.in[I_POS];
          for (size_t i = (size_t)gw * 64 + lane; i < (size_t)T * 32; i += (size_t)ngw * 64) { const int t = (int)(i >> 5), k = (int)(i & 31);
              const double inv = exp(-(double)k * (9.210340371976184 / 32.0)); const double ang = (double)pos[t] * inv; double s, c; sincos(ang, &s, &c); ROPE[i] = (f32x2){(float)c, (float)s}; } }
        { const float* fw1 = args.in[I_HY_FW1]; const float* fb1 = args.in[I_HY_FB1]; const float* fw2 = args.in[I_HY_FW2]; const float* fb2 = args.in[I_HY_FB2];
          const float* fw3 = args.in[I_HY_FW3]; const float* fb3 = args.in[I_HY_FB3]; const float fr = args.in[I_HY_FREQ][lane];
          for (int l = gw; l < SEQ; l += ngw) {
              const float tt = (float)l / (float)(SEQ - 1); const float w = 6.283185307179586f * (float)l / (float)SEQ;
              float z = 0.f;
              if (lane == 0) z = tt;
              else if (lane <= 16) { const float f = 1e-4f + (float)(lane - 1) * ((15.0f - 1e-4f) / 15.0f); z = cosf(f * w); }
              else if (lane <= 32) { const float f = 1e-4f + (float)(lane - 17) * ((15.0f - 1e-4f) / 15.0f); z = -sinf(f * w); }
              float a = fb1[lane];
#pragma unroll
              for (int i = 0; i < HEMB; ++i) a += __shfl(z, i) * fw1[i * HF + lane];
              float h = sinf(fr * a);
              a = fb2[lane];
#pragma unroll 8
              for (int i = 0; i < HF; ++i) a += __shfl(h, i) * fw2[i * HF + lane];
              h = sinf(fr * a);
              a = fb3[lane];
#pragma unroll 8
              for (int i = 0; i < HF; ++i) a += __shfl(h, i) * fw3[i * HF + lane];
              h = sinf(fr * a);
              H3[(size_t)l * HKP + lane] = (bf16)(pkbf(h, 0.f) & 0xffffu);
          } }
    }
    SEAM(0);
#define B1 GEMM(EpiF32, XB, Win_t, T, MLA_INP, DM, H1, MLA_INP)
    RUN(1, B1, B1);
    SEAM(1);
#define B2 mla_norm_rope(H1, args.in[I_MLA_GQ], args.in[I_MLA_GKV], ROPE, CQN, CKVN, Kb, gw, ngw, lane)
    RUN(2, B2, B2);
    SEAM(2);
#define B3 do { GEMM(EpiBf16, CQN, Wuq_t, T, NH * DQK, QLORA, Qb, NH * DQK, QSCALE); GEMM(EpiKV, CKVN, Wukv_t, T, NH * 256, KVLORA, Kb, Vb); } while (0)
    RUN(3, B3, B3);
    SEAM(3);
#define B4 do { for (int u = bx; u < BATCH * NH * (SEQ / 256); u += G) { const int qb = u & 63, h = (u >> 6) & 7, b = u >> 9; const size_t r0 = (size_t)b * SEQ + (size_t)qb * 256; \
            attn::attn_unit(Qb + r0 * 1536 + h * DQK, Kb + (size_t)b * SEQ * 1536 + h * DQK, Vb + (size_t)b * SEQ * 1024 + h * DVH, XB + r0 * 1024 + h * DVH, (const float*)(ROPE + r0 * 32), SEQ, (char*)lds, wave); } } while (0)
    RUN(4, B4, B4);
#ifdef SELFCHECK
    if (IN(4) && IN(5)) { GRIDBAR(); selfcheck_mla(args, ldsl, bx, tid); }
#endif
    SEAM(4);
#define B5 GEMM(EpiResid, XB, Wo_t, T, DM, DM, args.in[I_X], XF, DN_ALPHA)
    RUN(5, B5, B5);
    SEAM(5);
    RUN(6, ln_rows(XF, XF, XB, args.in[I_LN1G], args.in[I_LN1B], gw, ngw, lane), ln_rows(XF, OUT, XB, args.in[I_LN1G], args.in[I_LN1B], gw, ngw, lane));
    SEAM(6);
#define FFN_UP(layer, hb) GEMM(EpiBf16, XB + (size_t)(hb) * SEQ * DM, Wup_t + (size_t)(layer) * NUP * DM, SEQ, NUP, DM, UH, NUP, 1.0f)
#define FFN_CV(layer) ffn_conv_silu(UH, args.in[I_FFN_WCONV] + (size_t)(layer) * 3 * NUP, HACT, gw, ngw, lane)
#define FFN_DN(layer, hb, OUT_) GEMM(EpiResid, HACT, Wdn_t + (size_t)(layer) * DM * DFF, SEQ, DM, DFF, XF + (size_t)(hb) * SEQ * DM, (OUT_), DN_ALPHA)
#define FFN_HALF(p, layer, hb) \
    RUN(p, FFN_UP(layer, hb), FFN_UP(layer, hb)); SEAM(p); \
    RUN((p) + 1, FFN_CV(layer), FFN_CV(layer)); SEAM((p) + 1); \
    RUN((p) + 2, FFN_DN(layer, hb, XF + (size_t)(hb) * SEQ * DM), FFN_DN(layer, hb, P_(float, WS_S + 180 * MiB))); SEAM((p) + 2);
    FFN_HALF(7, 0, 0)
    FFN_HALF(10, 0, 1)
    RUN(13, ln_rows(XF, XF, XB, args.in[I_LN2G], args.in[I_LN2B], gw, ngw, lane), ln_rows(XF, P_(float, WS_S), XB, args.in[I_LN2G], args.in[I_LN2B], gw, ngw, lane));
    SEAM(13);
#define B14 GEMM(EpiBf16, XB, Whin_t, T, 3 * DM, DM, U, 3 * DM, 1.0f)
    RUN(14, B14, B14);
    SEAM(14);
#define B15 hy_conv_transpose(U, args.in[I_HY_WSHORT], VC0, VC1, G1C, G2C, (LAS unsigned*)(ldsl + wave * 16384), gw, ngw, lane)
    RUN(15, B15, B15);
    SEAM(15);
#define HY_FILT(od) GEMM(EpiFilt, H3, Wfo_t + (size_t)(od) * 2048 * HKP, SEQ, 2 * DM, HKP, KT, SEQ, -120.39728043259360f, (40.54651081081644f + 120.39728043259360f) / 1023.0f, 1.0f / (float)(SEQ - 1))
#define HY_FFT(MODE_, GC_, DB_) do { for (int c = bx; c < DM; c += G) { const size_t co = (size_t)c * SEQ; \
            fftc::hyena_channel<MODE_>((fftc::lf2*)ldsl, VC0 + co, VC1 + co, KT + co, KT + (size_t)DM * SEQ + co, (GC_) + co, (GC_) + (size_t)DM * SEQ + co, args.in[I_HY_DBIAS][(DB_) + c], \
                                       VC0 + co, VC1 + co, Z3C + co, Z3C + (size_t)DM * SEQ + co, STASH + (size_t)bx * SEQ, KSPEC + (size_t)bx * SEQ, tid); } } while (0)
    RUN(16, HY_FILT(0), HY_FILT(0)); SEAM(16);
    RUN(17, HY_FFT(0, G1C, 0), HY_FFT(2, G1C, 0)); SEAM(17);
    RUN(18, HY_FILT(1), HY_FILT(1)); SEAM(18);
    RUN(19, HY_FFT(1, G2C, DM), HY_FFT(1, G2C, DM)); SEAM(19);
#define B20 hy_transpose_back(Z3C, XB, (LAS unsigned*)(ldsl + wave * 16384), gw, ngw, lane)
    RUN(20, B20, B20);
    SEAM(20);
    RUN(21, GEMM(EpiResid, XB, Who_t, T, DM, DM, XF, XF, DN_ALPHA), GEMM(EpiResid, XB, Who_t, T, DM, DM, XF, P_(float, WS_S), DN_ALPHA));
    SEAM(21);
    RUN(22, ln_rows(XF, XF, XB, args.in[I_LN1G] + DM, args.in[I_LN1B] + DM, gw, ngw, lane), ln_rows(XF, P_(float, WS_S), XB, args.in[I_LN1G] + DM, args.in[I_LN1B] + DM, gw, ngw, lane));
    SEAM(22);
    FFN_HALF(23, 1, 0)
    FFN_HALF(26, 1, 1)
#ifdef SELFCHECK
    if (IN(29)) { const unsigned mask = __hip_atomic_load((unsigned*)(args.ws + WS_CTL) + CW_CHK, __ATOMIC_RELAXED, __HIP_MEMORY_SCOPE_AGENT);
        ln_rows(XF, OUT, nullptr, args.in[I_LN2G] + DM, args.in[I_LN2B] + DM, gw, ngw, lane, 1.0f + 0.1f * (float)mask); }
#else
    RUN(29, ln_rows(XF, OUT, nullptr, args.in[I_LN2G] + DM, args.in[I_LN2B] + DM, gw, ngw, lane), ln_rows(XF, OUT, nullptr, args.in[I_LN2G] + DM, args.in[I_LN2B] + DM, gw, ngw, lane));
#endif
#undef IN
#undef SEAM
#undef lane
#undef tid
#undef G
#undef bx
#undef gw
#undef ngw
}

extern "C" void kernel_launch(void* const* d_in, const int* in_sizes, int n_in, void* d_out, int out_size, void* d_ws, size_t ws_size, hipStream_t stream) {
    static int grid = 0;
    if (grid == 0) {
        if (n_in != 27 || in_sizes[0] != T * DM || out_size != T * DM || ws_size < WS_END) { fprintf(stderr, "kernel_launch: shape/workspace mismatch (n_in %d, in0 %d, out %d, ws %zu)\n", n_in, n_in > 0 ? in_sizes[0] : -1, out_size, ws_size); grid = -1; return; }
        int dev = 0, cus = 0, per_cu = 0;
        if (hipGetDevice(&dev) != hipSuccess || hipDeviceGetAttribute(&cus, hipDeviceAttributeMultiprocessorCount, dev) != hipSuccess) { grid = -1; return; }
        if (hipFuncSetAttribute((const void*)mega_fwd, hipFuncAttributeMaxDynamicSharedMemorySize, LDS_BYTES) != hipSuccess) { fprintf(stderr, "kernel_launch: hipFuncSetAttribute failed\n"); grid = -1; return; }
        if (hipOccupancyMaxActiveBlocksPerMultiprocessor(&per_cu, (const void*)mega_fwd, NWAVES * 64, LDS_BYTES) != hipSuccess || per_cu < 1) { fprintf(stderr, "kernel_launch: occupancy query says %d\n", per_cu); }
        (void)hipGetLastError();
        grid = cus;
    }
    if (grid < 0) return;
    if (hipMemsetAsync((char*)d_ws + WS_CTL, 0, CTL_ZERO_BYTES, stream) != hipSuccess) return;
    Args a{};
    for (int i = 0; i < 27; ++i) a.in[i] = (const float*)d_in[i];
    a.out = (float*)d_out; a.ws = (unsigned char*)d_ws;
#if MK_PER_PHASE
    for (int p = 0; p < N_PHASES; ++p) { a.ph_lo = p; a.ph_hi = p + 1; hipLaunchKernelGGL(mega_fwd, dim3(grid), dim3(NWAVES * 64), LDS_BYTES, stream, a); }
#else
    a.ph_lo = 0; a.ph_hi = N_PHASES; hipLaunchKernelGGL(mega_fwd, dim3(grid), dim3(NWAVES * 64), LDS_BYTES, stream, a);
#endif
}
```

```cpp
#include <hip/hip_runtime.h>
#include <cstdio>
#include <cstdint>
__device__ __forceinline__ int hw_lane() { int l; asm volatile("v_mbcnt_lo_u32_b32 %0, -1, 0\n\tv_mbcnt_hi_u32_b32 %0, -1, %0" : "=v"(l)); return l; }
namespace pg8 {
#define PG8_LAS __attribute__((address_space(3)))
typedef unsigned short bf16_t;
typedef short bf16x8 __attribute__((ext_vector_type(8)));
typedef float f32x4 __attribute__((ext_vector_type(4)));
typedef unsigned u32x4 __attribute__((ext_vector_type(4)));
constexpr int BM = 256, BK = 64, HALF = 128, HTB = HALF * BK * 2  , STAGE_BYTES = 8 * HTB, NXCD = 8, WGM = 8;

__host__ __device__ __forceinline__ int lds_byte(int r, int c) { const int st = (r >> 4) * 2 + (c >> 5), rr = r & 15, cc = c & 31, ob = rr * 64 + cc * 2; return st * 1024 + (ob ^ (((ob >> 9) & 1) << 5)); }
__host__ __device__ __forceinline__ void stage_rc(int b, int& R, int& C) { const int st = b / 1024, sb = b % 1024, swz = sb ^ (((sb >> 9) & 1) << 5); R = (st >> 1) * 16 + swz / 64; C = (st & 1) * 32 + (swz % 64) / 2; }
__host__ __device__ __forceinline__ int perm32(int rho) { const int n = rho >> 4, i = rho & 15; return 8 * (i >> 2) + 4 * n + (i & 3); }

struct Unit { int pm, pn; };
struct Gemm { const bf16_t* A; const bf16_t* Bt; int M, N, K; };

struct StaticOrder {
    int nM, nN, nwg, G, c;
    __host__ __device__ void init(int M, int N, int G_, int c_) { nM = M / BM; nN = N / BM; nwg = nM * nN; G = G_; c = c_; }
    __host__ __device__ bool next(int i, Unit& u) const {
        const long L = (long)i * G + c; if (L >= nwg) return false;
        int wgid = (int)L; { const int q = nwg / NXCD, r = nwg % NXCD, xcd = wgid % NXCD, off = wgid / NXCD; wgid = (xcd < r ? xcd * (q + 1) : r * (q + 1) + (xcd - r) * q) + off; }
        const int nig = WGM * nN, gid = wgid / nig, fm = gid * WGM, gsz = (nM - fm) < WGM ? (nM - fm) : WGM;
        u.pm = fm + ((wgid % nig) % gsz); u.pn = (wgid % nig) / gsz; return true;
    }
    __device__ __forceinline__ void a_ready(const Unit&) const {}
    __device__ __forceinline__ void done(const Unit&) const {}
};

__device__ __forceinline__ unsigned cvt_pk_bf16(float lo, float hi) { unsigned r; asm volatile("v_cvt_pk_bf16_f32 %0, %1, %2" : "=v"(r) : "v"(lo), "v"(hi)); return r; }
typedef float f32x2 __attribute__((ext_vector_type(2)));

struct EpiF32 {
    static constexpr bool PERM = false, AFTER_DRAIN = false;
    float* C; int ldc;
    __device__ __forceinline__ void operator()(const f32x4 (&acc)[2][2][4][2], const Unit& u_, int wr, int wc, int fr, int fq) const {
        Unit u = u_; asm volatile("" : "+s"(u.pm), "+s"(u.pn)); { const int l_ = hw_lane(); fr = l_ & 15; fq = l_ >> 4; }
        const int row0 = u.pm * BM + wr * 64 + fr, col0 = u.pn * BM + wc * 32 + 4 * fq;
#pragma unroll
        for (int ai = 0; ai < 2; ++ai)
#pragma unroll
            for (int m = 0; m < 4; ++m) { float* rowp = C + (size_t)(row0 + ai * HALF + m * 16) * ldc + col0;
#pragma unroll
                for (int bj = 0; bj < 2; ++bj)
#pragma unroll
                    for (int n = 0; n < 2; ++n) *(f32x4*)(rowp + bj * HALF + n * 16) = acc[ai][bj][m][n]; }
    }
};
struct EpiBf16 {
    static constexpr bool PERM = true, AFTER_DRAIN = false;
    bf16_t* O; int ldc; float scale;
    __device__ __forceinline__ void operator()(const f32x4 (&acc)[2][2][4][2], const Unit& u_, int wr, int wc, int fr, int fq) const {
        Unit u = u_; asm volatile("" : "+s"(u.pm), "+s"(u.pn)); { const int l_ = hw_lane(); fr = l_ & 15; fq = l_ >> 4; }
        const int row0 = u.pm * BM + wr * 64 + fr, col0 = u.pn * BM + wc * 32 + 8 * fq;
#pragma unroll
        for (int ai = 0; ai < 2; ++ai)
#pragma unroll
            for (int m = 0; m < 4; ++m) { bf16_t* rowp = O + (size_t)(row0 + ai * HALF + m * 16) * ldc + col0;
#pragma unroll
                for (int bj = 0; bj < 2; ++bj) { const f32x4 v0 = acc[ai][bj][m][0] * scale, v1 = acc[ai][bj][m][1] * scale;
                    u32x4 w; w.x = cvt_pk_bf16(v0[0], v0[1]); w.y = cvt_pk_bf16(v0[2], v0[3]); w.z = cvt_pk_bf16(v1[0], v1[1]); w.w = cvt_pk_bf16(v1[2], v1[3]);
                    *(u32x4*)(rowp + bj * HALF) = w; } }
    }
};
struct EpiResid {
    static constexpr bool PERM = false, AFTER_DRAIN = false;
    const float* base; float* out; float alpha;
    __device__ __forceinline__ void operator()(const f32x4 (&acc)[2][2][4][2], const Unit& u_, int wr, int wc, int fr, int fq) const {
        Unit u = u_; asm volatile("" : "+s"(u.pm), "+s"(u.pn)); { const int l_ = hw_lane(); fr = l_ & 15; fq = l_ >> 4; }
        const int row0 = u.pm * BM + wr * 64 + fr, col0 = u.pn * BM + wc * 32 + 4 * fq;
#pragma unroll
        for (int ai = 0; ai < 2; ++ai)
#pragma unroll
            for (int m = 0; m < 4; ++m) { const size_t off = (size_t)(row0 + ai * HALF + m * 16) * 1024 + col0;
#pragma unroll
                for (int bj = 0; bj < 2; ++bj)
#pragma unroll
                    for (int n = 0; n < 2; ++n) { const f32x4 bs = *(const f32x4*)(base + off + bj * HALF + n * 16);
                        *(f32x4*)(out + off + bj * HALF + n * 16) = bs * alpha + acc[ai][bj][m][n]; }
                if (m & 1) asm volatile("" ::: "memory"); }
    }
};
struct EpiKV {
    static constexpr bool PERM = true, AFTER_DRAIN = false;
    unsigned char* Kb; bf16_t* Vb;
    __device__ __forceinline__ void operator()(const f32x4 (&acc)[2][2][4][2], const Unit& u_, int wr, int wc, int fr, int fq) const {
        Unit u = u_; asm volatile("" : "+s"(u.pm), "+s"(u.pn)); { const int l_ = hw_lane(); fr = l_ & 15; fq = l_ >> 4; }
        const int row0 = u.pm * BM + wr * 64 + fr, col0 = u.pn * BM + wc * 32 + 8 * fq;
        typedef unsigned u32x2 __attribute__((ext_vector_type(2)));
#pragma unroll
        for (int bj = 0; bj < 2; ++bj) { const int c = col0 + bj * HALF; const bool isk = c < 1024;
#pragma unroll
            for (int ai = 0; ai < 2; ++ai)
#pragma unroll
                for (int m = 0; m < 4; ++m) { const int row = row0 + ai * HALF + m * 16; const f32x4 v0 = acc[ai][bj][m][0], v1 = acc[ai][bj][m][1];
                    if (isk) { u32x2 w; int t = __builtin_amdgcn_cvt_pk_fp8_f32(v0[0], v0[1], 0, false); t = __builtin_amdgcn_cvt_pk_fp8_f32(v0[2], v0[3], t, true); w.x = (unsigned)t;
                        t = __builtin_amdgcn_cvt_pk_fp8_f32(v1[0], v1[1], 0, false); t = __builtin_amdgcn_cvt_pk_fp8_f32(v1[2], v1[3], t, true); w.y = (unsigned)t;
                        *(u32x2*)(Kb + (size_t)row * 1536 + (c >> 7) * 192 + (c & 127)) = w; }
                    else { u32x4 w; w.x = cvt_pk_bf16(v0[0], v0[1]); w.y = cvt_pk_bf16(v0[2], v0[3]); w.z = cvt_pk_bf16(v1[0], v1[1]); w.w = cvt_pk_bf16(v1[2], v1[3]);
                        *(u32x4*)(Vb + (size_t)row * 1024 + (c - 1024)) = w; } } }
    }
};
#define DPP_SHR1 0x111
#define DPP_SHL1 0x101
#define DPP_SHL15 0x10F
#define DPP_SHR15 0x11F
template <int CTRL> __device__ __forceinline__ float dpp_mov(float old, float src) { return __int_as_float(__builtin_amdgcn_update_dpp(__float_as_int(old), __float_as_int(src), CTRL, 0xF, 0xF, false)); }
struct EpiConvSilu {
    static constexpr bool PERM = true, AFTER_DRAIN = false;
    bf16_t* H; const float* wcv; float* halo; PG8_LAS float* ex;
    __device__ __forceinline__ void operator()(const f32x4 (&acc)[2][2][4][2], const Unit& u_, int wr, int wc, int fr, int fq) const {
        Unit u = u_; asm volatile("" : "+s"(u.pm), "+s"(u.pn)); { const int l_ = hw_lane(); fr = l_ & 15; fq = l_ >> 4; }
        const int hc0 = wc * 32 + 8 * fq;
#pragma unroll
        for (int ai = 0; ai < 2; ++ai)
#pragma unroll
            for (int bj = 0; bj < 2; ++bj)
#pragma unroll
                for (int n = 0; n < 2; ++n) {
                    if (fr == 0)  *(PG8_LAS f32x4*)(ex + ((ai * 2 + wr) * 2 + 0) * 256 + bj * 128 + hc0 + 4 * n) = acc[ai][bj][0][n];
                    if (fr == 15) *(PG8_LAS f32x4*)(ex + ((ai * 2 + wr) * 2 + 1) * 256 + bj * 128 + hc0 + 4 * n) = acc[ai][bj][3][n]; }
        if (wr == 0 && fr < 2) {
#pragma unroll
            for (int bj = 0; bj < 2; ++bj)
#pragma unroll
                for (int n = 0; n < 2; ++n) *(f32x4*)(halo + ((size_t)u.pm * 4 + fr) * 5632 + u.pn * 256 + bj * 128 + hc0 + 4 * n) = acc[0][bj][0][n]; }
        if (wr == 1 && fr >= 14) {
#pragma unroll
            for (int bj = 0; bj < 2; ++bj)
#pragma unroll
                for (int n = 0; n < 2; ++n) *(f32x4*)(halo + ((size_t)u.pm * 4 + 2 + (fr - 14)) * 5632 + u.pn * 256 + bj * 128 + hc0 + 4 * n) = acc[1][bj][3][n]; }
        asm volatile("s_waitcnt lgkmcnt(0)" ::: "memory"); __builtin_amdgcn_s_barrier(); asm volatile("" ::: "memory");
        float wv[2][3][8];
        { const int cg = u.pn * 128 + hc0;
#pragma unroll
          for (int bj = 0; bj < 2; ++bj)
#pragma unroll
            for (int k = 0; k < 3; ++k) { const f32x4 t0 = *(const f32x4*)(wcv + k * 5632 + bj * 2816 + cg), t1 = *(const f32x4*)(wcv + k * 5632 + bj * 2816 + cg + 4);
                wv[bj][k][0] = t0[0]; wv[bj][k][1] = t0[1]; wv[bj][k][2] = t0[2]; wv[bj][k][3] = t0[3]; wv[bj][k][4] = t1[0]; wv[bj][k][5] = t1[1]; wv[bj][k][6] = t1[2]; wv[bj][k][7] = t1[3]; } }
#pragma unroll
        for (int ai = 0; ai < 2; ++ai) {
            const int ch = ai * 2 + wr, cp = ch > 0 ? ch - 1 : 0, cn = ch < 3 ? ch + 1 : 3;
            f32x4 pe[2][2], ne[2][2];
#pragma unroll
            for (int bj = 0; bj < 2; ++bj)
#pragma unroll
                for (int n = 0; n < 2; ++n) { pe[bj][n] = *(const PG8_LAS f32x4*)(ex + (cp * 2 + 1) * 256 + bj * 128 + hc0 + 4 * n); ne[bj][n] = *(const PG8_LAS f32x4*)(ex + (cn * 2 + 0) * 256 + bj * 128 + hc0 + 4 * n); }
#pragma unroll
            for (int m = 0; m < 4; ++m) {
                float hv[2][8];
#pragma unroll
                for (int bj = 0; bj < 2; ++bj)
#pragma unroll
                    for (int n = 0; n < 2; ++n)
#pragma unroll
                        for (int j = 0; j < 4; ++j) {
                            const float cur = acc[ai][bj][m][n][j];
                            const float pin = (m > 0) ? dpp_mov<DPP_SHL15>(0.f, acc[ai][bj][m > 0 ? m - 1 : 0][n][j]) : pe[bj][n][j];
                            const float nin = (m < 3) ? dpp_mov<DPP_SHR15>(0.f, acc[ai][bj][m < 3 ? m + 1 : 3][n][j]) : ne[bj][n][j];
                            const float prv = dpp_mov<DPP_SHR1>(pin, cur), nxt = dpp_mov<DPP_SHL1>(nin, cur);
                            hv[bj][4 * n + j] = wv[bj][0][4 * n + j] * prv + wv[bj][1][4 * n + j] * cur + wv[bj][2][4 * n + j] * nxt; }
                float o[8];
#pragma unroll
                for (int i = 0; i < 8; ++i) o[i] = hv[0][i] * hv[1][i] * __builtin_amdgcn_rcpf(1.f + __expf(-hv[1][i]));
                u32x4 w; w.x = cvt_pk_bf16(o[0], o[1]); w.y = cvt_pk_bf16(o[2], o[3]); w.z = cvt_pk_bf16(o[4], o[5]); w.w = cvt_pk_bf16(o[6], o[7]);
                *(u32x4*)(H + (size_t)(u.pm * BM + ai * HALF + wr * 64 + m * 16 + fr) * 2816 + u.pn * 128 + hc0) = w;
            }
        }
        asm volatile("s_waitcnt lgkmcnt(0)" ::: "memory"); __builtin_amdgcn_s_barrier(); asm volatile("" ::: "memory");
    }
};

struct EpiFilt {
    static constexpr bool PERM = false, AFTER_DRAIN = false;
    float* KT; int L; float d0, dstep, tinv;
    __device__ __forceinline__ void operator()(const f32x4 (&acc)[2][2][4][2], const Unit& u_, int wr, int wc, int fr, int fq) const {
        Unit u = u_; asm volatile("" : "+s"(u.pm), "+s"(u.pn)); { const int l_ = hw_lane(); fr = l_ & 15; fq = l_ >> 4; }
        const int row0 = u.pm * BM + wr * 64 + fr, col0 = u.pn * BM + wc * 32 + 4 * fq;
#pragma unroll
        for (int bj = 0; bj < 2; ++bj)
#pragma unroll
            for (int n = 0; n < 2; ++n) { const int c = col0 + bj * HALF + n * 16;
#pragma unroll
                for (int j = 0; j < 4; ++j) { const int cc = c + j, ch = cc & 1023; const float nd = -__builtin_fabsf(d0 + (float)ch * dstep) * tinv; float* dst = KT + (size_t)cc * L;
#pragma unroll
                    for (int ai = 0; ai < 2; ++ai)
#pragma unroll
                        for (int m = 0; m < 4; ++m) { const int l = row0 + ai * HALF + m * 16; dst[l] = acc[ai][bj][m][n][j] * __expf(nd * (float)l); } } }
    }
};

template <class Epi, class Sched, bool ALIGN_EPI = false, bool SP2 = false>
__device__ __forceinline__ void gemm_phase(PG8_LAS unsigned char* lds, const Gemm g, const Sched& S, const Epi& E, int wid_in) {
    const int wid = wid_in, lane = hw_lane(), tid = wid * 64 + lane, wr = wid >> 2, wc = wid & 3, fr = lane & 15, fq = lane >> 4;
    const int K = g.K, nt = K / BK;
    unsigned voffA[2], voffB[2];
#pragma unroll
    for (int i = 0; i < 2; ++i) { int R, C; stage_rc(tid * 16 + i * 8192, R, C); const int Rb = Epi::PERM ? ((R & ~31) + perm32(R & 31)) : R;
        voffA[i] = (unsigned)(R * K + C) * 2u; voffB[i] = (unsigned)(Rb * K + C) * 2u; }
    const size_t kstep = (size_t)(BK * 2);
    const size_t hstep = (size_t)HALF * K * 2;
    const size_t tstep = 2 * hstep;
    const unsigned ldsw = (unsigned)wid * 1024u;
    const int aoff = lds_byte(wr * 64 + fr, fq * 8), boff = lds_byte(wc * 32 + fr, fq * 8);
#define PG8_SA(b, h) (((b) * 2 + (h)) * HTB)
#define PG8_SB(b, h) ((4 + (b) * 2 + (h)) * HTB)
#define PG8_STAGE(bufoff, gbase, voff) do { _Pragma("unroll") for (int _i = 0; _i < 2; ++_i) \
        __builtin_amdgcn_global_load_lds((const unsigned*)((const char*)(gbase) + (voff)[_i]), (PG8_LAS unsigned*)(lds + (bufoff) + ldsw + _i * 8192), 16, 0, 0); } while (0)
#define PG8_LDA(dst, b, h) do { _Pragma("unroll") for (int m = 0; m < 4; ++m) _Pragma("unroll") for (int k = 0; k < 2; ++k) dst[m][k] = *(const PG8_LAS bf16x8*)(lds + PG8_SA(b, h) + aoff + m * 2048 + k * 1024); } while (0)
#define PG8_LDB(dst, b, h) do { _Pragma("unroll") for (int n = 0; n < 2; ++n) _Pragma("unroll") for (int k = 0; k < 2; ++k) dst[n][k] = *(const PG8_LAS bf16x8*)(lds + PG8_SB(b, h) + boff + n * 2048 + k * 1024); } while (0)
#define PG8_MMA(ai, bj, At, Bt) do { __builtin_amdgcn_s_setprio(1); _Pragma("unroll") for (int m = 0; m < 4; ++m) _Pragma("unroll") for (int n = 0; n < 2; ++n) _Pragma("unroll") for (int k = 0; k < 2; ++k) \
        acc[ai][bj][m][n] = __builtin_amdgcn_mfma_f32_16x16x32_bf16(Bt[n][k], At[m][k], acc[ai][bj][m][n], 0, 0, 0); __builtin_amdgcn_s_setprio(0); } while (0)
#define PG8_WAIT_V(n) asm volatile("s_waitcnt vmcnt(" #n ")" ::: "memory")
#define PG8_WAIT_L(n) asm volatile("s_waitcnt lgkmcnt(" #n ")" ::: "memory")
#define PG8_BAR __builtin_amdgcn_s_barrier()
#define PG8_SCHED __builtin_amdgcn_sched_barrier(0)
    Unit cur, nxt; int ui = 0;
    if (!S.next(0, cur)) return;
    f32x4 acc[2][2][4][2];
#pragma unroll
    for (int a = 0; a < 2; ++a)
#pragma unroll
        for (int b = 0; b < 2; ++b)
#pragma unroll
            for (int m = 0; m < 4; ++m)
#pragma unroll
                for (int n = 0; n < 2; ++n) acc[a][b][m][n] = (f32x4){0.f, 0.f, 0.f, 0.f};
    bf16x8 At[4][2], B0[2][2], B1[2][2];
    const char* cA = (const char*)g.A + (size_t)cur.pm * tstep; const char* cB = (const char*)g.Bt + (size_t)cur.pn * tstep;
    S.a_ready(cur);
    if constexpr (SP2) {
        PG8_STAGE(PG8_SB(0, 0), cB, voffB); PG8_STAGE(PG8_SB(0, 1), cB + hstep, voffB); PG8_STAGE(PG8_SA(0, 0), cA, voffA); PG8_STAGE(PG8_SA(0, 1), cA + hstep, voffA);
        if (wr == 1) PG8_BAR;
        PG8_WAIT_V(2); PG8_BAR;
        PG8_STAGE(PG8_SB(1, 0), cB + kstep, voffB); PG8_STAGE(PG8_SA(1, 0), cA + kstep, voffA); PG8_STAGE(PG8_SB(1, 1), cB + hstep + kstep, voffB);
        PG8_WAIT_V(6); PG8_BAR;
    } else {
        PG8_STAGE(PG8_SB(0, 0), cB, voffB); PG8_STAGE(PG8_SA(0, 0), cA, voffA); PG8_STAGE(PG8_SB(0, 1), cB + hstep, voffB); PG8_STAGE(PG8_SA(0, 1), cA + hstep, voffA);
        if (wr == 1) PG8_BAR;
        PG8_WAIT_V(4); PG8_BAR;
        PG8_STAGE(PG8_SB(1, 0), cB + kstep, voffB); PG8_STAGE(PG8_SA(1, 0), cA + kstep, voffA); PG8_STAGE(PG8_SB(1, 1), cB + hstep + kstep, voffB);
        PG8_WAIT_V(6); PG8_BAR;
    }
    for (;;) {
        const bool has_next = S.next(ui + 1, nxt);
        const char* nA = has_next ? (const char*)g.A + (size_t)nxt.pm * tstep : cA; const char* nB = has_next ? (const char*)g.Bt + (size_t)nxt.pn * tstep : cB;
        for (int t = 0; t < nt; t += 2) {
            const bool last = (t == nt - 2);
            const char* a1 = cA + (size_t)(t + 1) * kstep;
            const char* a2 = last ? nA : cA + (size_t)(t + 2) * kstep; const char* b2 = last ? nB : cB + (size_t)(t + 2) * kstep;
            const char* a3 = a2 + kstep; const char* b3 = b2 + kstep;
            if (last && has_next) S.a_ready(nxt);
            if constexpr (SP2) {
            PG8_LDB(B0, 0, 0); PG8_LDB(B1, 0, 1); PG8_SCHED; PG8_LDA(At, 0, 0); PG8_STAGE(PG8_SA(1, 1), a1 + hstep, voffA);
            PG8_WAIT_V(8); PG8_WAIT_L(0); PG8_BAR; PG8_MMA(0, 0, At, B0); PG8_MMA(0, 1, At, B1); PG8_BAR; PG8_SCHED;
            PG8_LDA(At, 0, 1); PG8_STAGE(PG8_SB(0, 0), b2, voffB); PG8_STAGE(PG8_SB(0, 1), b2 + hstep, voffB); PG8_STAGE(PG8_SA(0, 0), a2, voffA);
            PG8_WAIT_V(8); PG8_WAIT_L(0); PG8_BAR; PG8_MMA(1, 0, At, B0); PG8_MMA(1, 1, At, B1); PG8_BAR; PG8_SCHED;
            PG8_LDB(B0, 1, 0); PG8_LDB(B1, 1, 1); PG8_SCHED; PG8_LDA(At, 1, 0); PG8_STAGE(PG8_SA(0, 1), a2 + hstep, voffA);
            PG8_WAIT_V(8); PG8_WAIT_L(0); PG8_BAR; PG8_MMA(0, 0, At, B0); PG8_MMA(0, 1, At, B1); PG8_BAR; PG8_SCHED;
            PG8_LDA(At, 1, 1); PG8_STAGE(PG8_SB(1, 0), b3, voffB); PG8_STAGE(PG8_SB(1, 1), b3 + hstep, voffB); PG8_STAGE(PG8_SA(1, 0), a3, voffA);
            PG8_WAIT_V(8); PG8_WAIT_L(0); PG8_BAR; PG8_MMA(1, 0, At, B0); PG8_MMA(1, 1, At, B1); PG8_BAR; PG8_SCHED;
            } else {
            PG8_LDB(B0, 0, 0); PG8_SCHED; PG8_LDA(At, 0, 0); PG8_STAGE(PG8_SA(1, 1), a1 + hstep, voffA);
            PG8_WAIT_L(8); PG8_BAR; PG8_WAIT_L(0); PG8_MMA(0, 0, At, B0); PG8_BAR; PG8_SCHED;
            PG8_LDB(B1, 0, 1); PG8_STAGE(PG8_SB(0, 0), b2, voffB);
            PG8_BAR; PG8_WAIT_L(0); PG8_MMA(0, 1, At, B1); PG8_BAR;
            PG8_LDA(At, 0, 1); PG8_STAGE(PG8_SA(0, 0), a2, voffA);
            PG8_BAR; PG8_WAIT_L(0); PG8_MMA(1, 0, At, B0); PG8_BAR; PG8_SCHED;
            PG8_STAGE(PG8_SB(0, 1), b2 + hstep, voffB);
            PG8_WAIT_V(6); PG8_BAR; PG8_MMA(1, 1, At, B1); PG8_BAR;
            PG8_LDB(B0, 1, 0); PG8_SCHED; PG8_LDA(At, 1, 0); PG8_STAGE(PG8_SA(0, 1), a2 + hstep, voffA);
            PG8_WAIT_L(8); PG8_BAR; PG8_WAIT_L(0); PG8_MMA(0, 0, At, B0); PG8_BAR; PG8_SCHED;
            PG8_LDB(B1, 1, 1); PG8_STAGE(PG8_SB(1, 0), b3, voffB);
            PG8_BAR; PG8_WAIT_L(0); PG8_MMA(0, 1, At, B1); PG8_BAR;
            PG8_LDA(At, 1, 1); PG8_STAGE(PG8_SA(1, 0), a3, voffA);
            PG8_BAR; PG8_WAIT_L(0); PG8_MMA(1, 0, At, B0); PG8_BAR; PG8_SCHED;
            PG8_STAGE(PG8_SB(1, 1), b3 + hstep, voffB);
            PG8_WAIT_V(6); PG8_BAR; PG8_MMA(1, 1, At, B1); PG8_BAR;
            }
        }
        if constexpr (ALIGN_EPI) { if (wr == 0) PG8_BAR; }
        if constexpr (!Epi::AFTER_DRAIN) { E(acc, cur, wr, wc, fr, fq); S.done(cur); }
        if (!has_next) break;
#pragma unroll
        for (int a = 0; a < 2; ++a)
#pragma unroll
            for (int b = 0; b < 2; ++b)
#pragma unroll
                for (int m = 0; m < 4; ++m)
#pragma unroll
                    for (int n = 0; n < 2; ++n) acc[a][b][m][n] = (f32x4){0.f, 0.f, 0.f, 0.f};
        cur = nxt; cA = nA; cB = nB; ++ui;
        if constexpr (ALIGN_EPI) { if (wr == 1) PG8_BAR; }
    }
    PG8_WAIT_V(0);
    if constexpr (!ALIGN_EPI) { if (wr == 0) PG8_BAR; }
    PG8_BAR;
    if constexpr (Epi::AFTER_DRAIN) { E.fused(acc, cur, wr, wc, fr, fq, lds, wid, lane); S.done(cur); }
#undef PG8_SA
#undef PG8_SB
#undef PG8_STAGE
#undef PG8_LDA
#undef PG8_LDB
#undef PG8_MMA
#undef PG8_WAIT_V
#undef PG8_WAIT_L
#undef PG8_BAR
#undef PG8_SCHED
}
}
#define GAS __attribute__((address_space(1)))
#define LAS __attribute__((address_space(3)))
typedef unsigned short bf16;
typedef unsigned v4u __attribute__((ext_vector_type(4)));
typedef float f32x4 __attribute__((ext_vector_type(4)));
typedef short bf16x8 __attribute__((ext_vector_type(8)));
typedef GAS unsigned gu32;
typedef GAS unsigned long long gu64;
#define RLX_AGENT __ATOMIC_RELAXED, __HIP_MEMORY_SCOPE_AGENT
#define LDS_WAIT() asm volatile("s_waitcnt lgkmcnt(0)" ::: "memory")
#define VM_WAIT() asm volatile("s_waitcnt vmcnt(0)" ::: "memory")
__device__ __forceinline__ unsigned long long rt() { return __builtin_amdgcn_s_memrealtime(); }
__device__ __forceinline__ unsigned f2bf(float f) { unsigned u = __builtin_bit_cast(unsigned, f); return (u + 0x7fffu + ((u >> 16) & 1u)) >> 16; }
__device__ __forceinline__ unsigned pk2(float lo, float hi) { return f2bf(lo) | (f2bf(hi) << 16); }

#define XB_TMO      128
#define XB_XCNT(j)  (256  + 64 * (j))
#define XB_XSUB(j)  (1280 + 64 * (j))
#define XB_XGEN(j)  (2304 + 64 * (j))
#define XB_TOP      3328
#define XB_TOPGEN   3392
#define XCD_BAR_WORDS 3456
#define XB_SPIN_CAP (1u << 18)

__device__ __forceinline__ unsigned xb_ld(unsigned* p)              { return __hip_atomic_load(p, __ATOMIC_RELAXED, __HIP_MEMORY_SCOPE_AGENT); }
__device__ __forceinline__ unsigned xb_add(unsigned* p, unsigned v) { return __hip_atomic_fetch_add(p, v, __ATOMIC_RELAXED, __HIP_MEMORY_SCOPE_AGENT); }
__device__ __forceinline__ unsigned xb_xcc_id() { return (unsigned)__builtin_amdgcn_s_getreg((3 << 11) | 20) & 0xFu; }
#define XB_SPIN(cond, bar) do { unsigned _sp = 0; while (cond) { __builtin_amdgcn_s_sleep(1); \
    if ((++_sp & 255u) == 0u) { if (xb_ld(&(bar)[XB_TMO])) break; if (_sp > XB_SPIN_CAP) { atomicAdd(&(bar)[XB_TMO], 1u); break; } } } } while (0)

struct XcdBarrier {
    unsigned* bar; unsigned x; unsigned wv;
    volatile LAS unsigned* st;
};

__device__ __forceinline__ XcdBarrier xcd_barrier_post(unsigned* bar, volatile LAS unsigned* st, unsigned wv) {
    XcdBarrier b; b.bar = bar; b.x = xb_xcc_id(); b.st = st; b.wv = wv;
    if (wv == 0u && hw_lane() == 0) (void)xb_add(&bar[XB_XCNT(b.x)], 1u);
    return b;
}
__device__ __forceinline__ void xcd_barrier_complete(unsigned* bar, unsigned x, unsigned& nloc, unsigned& nx) {
    const unsigned G = gridDim.x * gridDim.y * gridDim.z;
    unsigned sum, cnt, mine, sp = 0u;
    for (;;) {
        sum = 0u; cnt = 0u; mine = 0u;
#pragma unroll
        for (unsigned j = 0; j < 16; ++j) { const unsigned c = xb_ld(&bar[XB_XCNT(j)]); sum += c; cnt += (c > 0u) ? 1u : 0u; mine = (j == x) ? c : mine; }
        if (sum == G) break;
        __builtin_amdgcn_s_sleep(1);
        if ((++sp & 255u) == 0u) { if (xb_ld(&bar[XB_TMO])) break; if (sp > XB_SPIN_CAP) { atomicAdd(&bar[XB_TMO], 1u); break; } }
    }
    nloc = mine > 0u ? mine : 1u; nx = cnt > 0u ? cnt : 1u;
}

__device__ __forceinline__ void xcd_barrier(const XcdBarrier& b) {
    asm volatile("s_waitcnt vmcnt(0)" ::: "memory");
    __syncthreads();
    if (b.wv == 0u && hw_lane() == 0) {
        unsigned* bar = b.bar;
        __builtin_amdgcn_s_waitcnt(0);
        unsigned nloc = b.st[0], nx = b.st[1];
        if (nloc == 0u) { xcd_barrier_complete(bar, b.x, nloc, nx); b.st[0] = nloc; b.st[1] = nx; }
        const unsigned old = xb_add(&bar[XB_XSUB(b.x)], 1u);
        const unsigned gen = old / nloc;
        if (old + 1u == (gen + 1u) * nloc) {
            __builtin_amdgcn_fence(__ATOMIC_RELEASE, "agent");
            asm volatile("s_waitcnt vmcnt(0)" ::: "memory");
            const unsigned og = xb_add(&bar[XB_TOP], 1u);
            const unsigned tg = og / nx;
            if (og + 1u == (tg + 1u) * nx) xb_add(&bar[XB_TOPGEN], 1u);
            else XB_SPIN(xb_ld(&bar[XB_TOPGEN]) == tg, bar);
            __builtin_amdgcn_fence(__ATOMIC_ACQUIRE, "agent");
            xb_add(&bar[XB_XGEN(b.x)], 1u);
            asm volatile("s_waitcnt vmcnt(0)" ::: "memory");
        } else {
            XB_SPIN(xb_ld(&bar[XB_XGEN(b.x)]) == gen, bar);
            __builtin_amdgcn_fence(__ATOMIC_ACQUIRE, "agent");
            asm volatile("s_waitcnt vmcnt(0)" ::: "memory");
        }
    }
    __syncthreads();
}
namespace attn {
using bf16x8 = __attribute__((ext_vector_type(8))) short;
using s16x4  = __attribute__((ext_vector_type(4))) short;
using f32x16 = __attribute__((ext_vector_type(16))) float;
using u32x4  = __attribute__((ext_vector_type(4))) unsigned;
constexpr int NW = 8, QBLK = 32, KVBLK = 64, DQ = 192, DVV = 128;
constexpr int LDQ = 1536, LDK = 1536, LDV = 1024, LDO = 1024;
constexpr int KROW = 400;
constexpr int SHM_V = KVBLK * DVV * 2, SHM_K = KVBLK * KROW, SHM_WS = NW * 64 * 4, SHM_QR = NW * 4096, SHM_ATTN = 2 * SHM_V + 2 * SHM_K + SHM_WS + SHM_QR;
constexpr float THRL = 11.5f;
#define SBAR() __builtin_amdgcn_sched_barrier(0)
__device__ __forceinline__ int crow(int r, int hi) { return (r & 3) + 8 * (r >> 2) + 4 * hi; }
__device__ __forceinline__ unsigned cvtpk(float lo, float hi) { unsigned r; asm volatile("v_cvt_pk_bf16_f32 %0, %1, %2" : "=v"(r) : "v"(lo), "v"(hi)); return r; }

__device__ __forceinline__ void partialSM(f32x16& p0, f32x16& p1, float& m_reg, float& mn, float& alpha) {
  float pmax = p0[0]; for (int r = 1; r < 16; ++r) pmax = fmaxf(pmax, p0[r]); for (int r = 0; r < 16; ++r) pmax = fmaxf(pmax, p1[r]);
  { auto rr = __builtin_amdgcn_permlane32_swap(__float_as_uint(pmax), __float_as_uint(pmax), false, false);
    pmax = fmaxf(__uint_as_float(rr[0]), __uint_as_float(rr[1])); }
  if (__builtin_expect(__all(pmax - m_reg <= THRL), 1)) { mn = m_reg; alpha = 1.f; }
  else { mn = fmaxf(m_reg, pmax); alpha = __builtin_amdgcn_exp2f(m_reg - mn); m_reg = mn; }
  for (int r = 0; r < 16; ++r) p0[r] = p0[r] - mn; for (int r = 0; r < 16; ++r) p1[r] = p1[r] - mn;
  for (int r = 0; r < 16; ++r) p0[r] = __builtin_amdgcn_exp2f(p0[r]);
}
__device__ __forceinline__ void finishSM(f32x16& p0, f32x16& p1, float alpha, float& l_reg, bf16x8& pa0, bf16x8& pa1, bf16x8& pa2, bf16x8& pa3) {
  for (int r = 0; r < 16; ++r) p1[r] = __builtin_amdgcn_exp2f(p1[r]);
  float ps = 0; for (int r = 0; r < 16; ++r) ps += p0[r]; for (int r = 0; r < 16; ++r) ps += p1[r];
  { auto rr = __builtin_amdgcn_permlane32_swap(__float_as_uint(ps), __float_as_uint(ps), false, false);
    ps = __uint_as_float(rr[0]) + __uint_as_float(rr[1]); }
  l_reg = l_reg * alpha + ps;
#define PK4(P, BASE, OUT) do { unsigned a0 = cvtpk(P[BASE + 0], P[BASE + 1]), a1 = cvtpk(P[BASE + 2], P[BASE + 3]);   \
    unsigned b0 = cvtpk(P[BASE + 4], P[BASE + 5]), b1 = cvtpk(P[BASE + 6], P[BASE + 7]);                              \
    auto r0 = __builtin_amdgcn_permlane32_swap(a0, b0, false, false); auto r1 = __builtin_amdgcn_permlane32_swap(a1, b1, false, false); \
    u32x4 w = {r0[0], r1[0], r0[1], r1[1]}; OUT = *reinterpret_cast<bf16x8*>(&w); } while (0)
  PK4(p0, 0, pa0); PK4(p0, 8, pa1); PK4(p1, 0, pa2); PK4(p1, 8, pa3);
#undef PK4
}
__device__ __forceinline__ float softmaxPP(f32x16& p0, f32x16& p1, float& m_reg, f32x16& negm, float& l_reg, bool first, bf16x8& pa0, bf16x8& pa1, bf16x8& pa2, bf16x8& pa3) {
  float a0 = fmaxf(fmaxf(p0[0], p0[1]), fmaxf(p0[2], p0[3])), a1 = fmaxf(fmaxf(p0[4], p0[5]), fmaxf(p0[6], p0[7])), a2 = fmaxf(fmaxf(p0[8], p0[9]), fmaxf(p0[10], p0[11])), a3 = fmaxf(fmaxf(p0[12], p0[13]), fmaxf(p0[14], p0[15]));
  a0 = fmaxf(a0, fmaxf(fmaxf(p1[0], p1[1]), fmaxf(p1[2], p1[3]))); a1 = fmaxf(a1, fmaxf(fmaxf(p1[4], p1[5]), fmaxf(p1[6], p1[7]))); a2 = fmaxf(a2, fmaxf(fmaxf(p1[8], p1[9]), fmaxf(p1[10], p1[11]))); a3 = fmaxf(a3, fmaxf(fmaxf(p1[12], p1[13]), fmaxf(p1[14], p1[15])));
  float pmax = fmaxf(fmaxf(a0, a1), fmaxf(a2, a3));
  { auto rr = __builtin_amdgcn_permlane32_swap(__float_as_uint(pmax), __float_as_uint(pmax), false, false); pmax = fmaxf(__uint_as_float(rr[0]), __uint_as_float(rr[1])); }
  float alpha = 1.f;
  if (__builtin_expect(first || __any(pmax > THRL), 0)) { const float dl = first ? pmax : fmaxf(pmax, 0.f); alpha = first ? 1.f : __builtin_amdgcn_exp2f(-dl); m_reg += dl;
    for (int r = 0; r < 16; ++r) { p0[r] -= dl; p1[r] -= dl; }
    for (int r = 0; r < 16; ++r) negm[r] = -m_reg; }
  for (int r = 0; r < 16; ++r) p0[r] = __builtin_amdgcn_exp2f(p0[r]);
  for (int r = 0; r < 16; ++r) p1[r] = __builtin_amdgcn_exp2f(p1[r]);
  float s0 = (p0[0] + p0[1]) + (p0[2] + p0[3]), s1 = (p0[4] + p0[5]) + (p0[6] + p0[7]), s2 = (p0[8] + p0[9]) + (p0[10] + p0[11]), s3 = (p0[12] + p0[13]) + (p0[14] + p0[15]);
  s0 += (p1[0] + p1[1]) + (p1[2] + p1[3]); s1 += (p1[4] + p1[5]) + (p1[6] + p1[7]); s2 += (p1[8] + p1[9]) + (p1[10] + p1[11]); s3 += (p1[12] + p1[13]) + (p1[14] + p1[15]);
  float ps = (s0 + s1) + (s2 + s3);
  { auto rr = __builtin_amdgcn_permlane32_swap(__float_as_uint(ps), __float_as_uint(ps), false, false); ps = __uint_as_float(rr[0]) + __uint_as_float(rr[1]); }
  l_reg = l_reg * alpha + ps;
#define PK4(P, BASE, OUT) do { unsigned a0_ = cvtpk(P[BASE + 0], P[BASE + 1]), a1_ = cvtpk(P[BASE + 2], P[BASE + 3]);   \
    unsigned b0_ = cvtpk(P[BASE + 4], P[BASE + 5]), b1_ = cvtpk(P[BASE + 6], P[BASE + 7]);                              \
    auto r0 = __builtin_amdgcn_permlane32_swap(a0_, b0_, false, false); auto r1 = __builtin_amdgcn_permlane32_swap(a1_, b1_, false, false); \
    u32x4 w = {r0[0], r1[0], r0[1], r1[1]}; OUT = *reinterpret_cast<bf16x8*>(&w); } while (0)
  PK4(p0, 0, pa0); PK4(p0, 8, pa1); PK4(p1, 0, pa2); PK4(p1, 8, pa3);
#undef PK4
  return alpha;
}
__device__ __forceinline__ void qkt(f32x16& p0, f32x16& p1, const char* Ks, const bf16x8* qr, const char* Qrl, int r32, int hi) {
  p0 = f32x16{}; p1 = f32x16{};
#pragma unroll
  for (int d0 = 0; d0 < 12; ++d0) { const int cb = (d0 * 16 + hi * 8) * 2;
    const bf16x8 qf = (d0 < 8) ? qr[d0 < 8 ? d0 : 0] : *reinterpret_cast<const bf16x8*>(Qrl + (d0 - 8) * 1024);
    bf16x8 b0 = *reinterpret_cast<const bf16x8*>(Ks + r32 * KROW + cb);
    bf16x8 b1 = *reinterpret_cast<const bf16x8*>(Ks + (32 + r32) * KROW + cb);
    p0 = __builtin_amdgcn_mfma_f32_32x32x16_bf16(b0, qf, p0, 0, 0, 0);
    p1 = __builtin_amdgcn_mfma_f32_32x32x16_bf16(b1, qf, p1, 0, 0, 0); }
}
__device__ __forceinline__ int v_st(int k, int c) { const int kk = (k & ~0xC) | ((k & 4) << 1) | ((k & 8) >> 1); return ((kk >> 3) * 4 + (c >> 5)) * 512 + ((kk & 7) * 32 + (c & 31)) * 2; }
__device__ __forceinline__ int v_rd_base(int lane) { return ((lane & 3) << 3) | (((lane >> 2) & 3) << 6) | (((lane >> 4) & 1) << 5) | (((lane >> 5) & 1) << 8); }
constexpr int v_rd_off(int d0, int ks, int half) { return d0 * 512 + ks * 4096 + half * 2048; }
template <int OFF> __device__ __forceinline__ s16x4 tr_read(int vb) {
  s16x4 r; asm volatile("ds_read_b64_tr_b16 %0, %1 offset:%2" : "=&v"(r) : "v"(vb), "i"(OFF) : "memory"); return r;
}
template <int D0> __device__ __forceinline__ void pv_one(f32x16& od, int vb, bf16x8 pa0, bf16x8 pa1, bf16x8 pa2, bf16x8 pa3) {
  const s16x4 l0 = tr_read<v_rd_off(D0, 0, 0)>(vb), h0 = tr_read<v_rd_off(D0, 0, 1)>(vb), l1 = tr_read<v_rd_off(D0, 1, 0)>(vb), h1 = tr_read<v_rd_off(D0, 1, 1)>(vb);
  const s16x4 l2 = tr_read<v_rd_off(D0, 2, 0)>(vb), h2 = tr_read<v_rd_off(D0, 2, 1)>(vb), l3 = tr_read<v_rd_off(D0, 3, 0)>(vb), h3 = tr_read<v_rd_off(D0, 3, 1)>(vb);
  asm volatile("s_waitcnt lgkmcnt(0)" ::: "memory"); SBAR();
#define PK(L, H) (bf16x8){L[0], L[1], L[2], L[3], H[0], H[1], H[2], H[3]}
  od = __builtin_amdgcn_mfma_f32_32x32x16_bf16(pa0, PK(l0, h0), od, 0, 0, 0);
  od = __builtin_amdgcn_mfma_f32_32x32x16_bf16(pa1, PK(l1, h1), od, 0, 0, 0);
  od = __builtin_amdgcn_mfma_f32_32x32x16_bf16(pa2, PK(l2, h2), od, 0, 0, 0);
  od = __builtin_amdgcn_mfma_f32_32x32x16_bf16(pa3, PK(l3, h3), od, 0, 0, 0);
#undef PK
}
__device__ __forceinline__ void pv_d0(f32x16* o, int vb, bf16x8 pa0, bf16x8 pa1, bf16x8 pa2, bf16x8 pa3) {
  pv_one<0>(o[0], vb, pa0, pa1, pa2, pa3); pv_one<1>(o[1], vb, pa0, pa1, pa2, pa3); pv_one<2>(o[2], vb, pa0, pa1, pa2, pa3); pv_one<3>(o[3], vb, pa0, pa1, pa2, pa3);
}
typedef unsigned short bf16r;
typedef int v8i __attribute__((ext_vector_type(8)));
typedef int v4i __attribute__((ext_vector_type(4)));
constexpr int KROWB = 192, LDKB = 1536, SHM_K3 = KVBLK * KROWB, SHM_V3 = KVBLK * DVV * 2, NSLOT = 3;
constexpr int LDS_K3 = 0, LDS_V3 = NSLOT * SHM_K3, LDS_WS3 = LDS_V3 + NSLOT * SHM_V3, SHM_ATTN3 = LDS_WS3 + NW * 64 * 4;
__device__ __forceinline__ void glds16(const void* gsrc, unsigned lds_dst) { unsigned keep;
  asm volatile("s_mov_b32 %0, m0\n\ts_mov_b32 m0, %2\n\ts_nop 0\n\tglobal_load_lds_dwordx4 %1, off\n\ts_mov_b32 m0, %0" : "=&s"(keep) : "v"(gsrc), "s"(lds_dst) : "memory"); }
__device__ __forceinline__ int pk8(float a, float b, float c, float d) { int t = __builtin_amdgcn_cvt_pk_fp8_f32(a, b, 0, false); return __builtin_amdgcn_cvt_pk_fp8_f32(c, d, t, true); }
__device__ __forceinline__ float bfl(unsigned w) { return __uint_as_float(w << 16); }
__device__ __forceinline__ float bfh(unsigned w) { return __uint_as_float(w & 0xffff0000u); }
__device__ __forceinline__ void attn_unit(const bf16r* __restrict__ Qb, const unsigned char* __restrict__ Kh, const bf16r* __restrict__ Vh, bf16r* __restrict__ Ob, const float* __restrict__ tab, int seq, char* lds, int wid) {
  const int lane = hw_lane(), r32 = lane & 31, hi = lane >> 5;
  const unsigned lds0 = (unsigned)(uintptr_t)lds;
  float* wsf = (float*)(lds + LDS_WS3) + wid * 64; float* li_l = wsf; float* al_l = wsf + 32;
  float m_reg = 0.f, l_reg = 0; f32x16 o[4] = {}; v8i qf[3]; f32x16 negm = {}; asm volatile("" : "+v"(negm));
  { const bf16r* Qw = Qb + (long)(wid * QBLK + r32) * LDQ + hi * 32;
#pragma unroll
    for (int s = 0; s < 2; ++s) { u32x4 q4[4];
#pragma unroll
      for (int i = 0; i < 4; ++i) q4[i] = *reinterpret_cast<const u32x4*>(Qw + s * 64 + i * 8);
#pragma unroll
      for (int i = 0; i < 4; ++i) { qf[s][2 * i] = pk8(bfl(q4[i][0]), bfh(q4[i][0]), bfl(q4[i][1]), bfh(q4[i][1])); qf[s][2 * i + 1] = pk8(bfl(q4[i][2]), bfh(q4[i][2]), bfl(q4[i][3]), bfh(q4[i][3])); } }
    { const float* tr = tab + (long)(wid * QBLK + r32) * 64 + hi * 32;
#pragma unroll
      for (int i = 0; i < 4; ++i) { const u32x4 qv = *reinterpret_cast<const u32x4*>(Qw + 128 + i * 8);
        const float4 t0 = *reinterpret_cast<const float4*>(tr + i * 8), t1 = *reinterpret_cast<const float4*>(tr + i * 8 + 4);
        float r_[8];
#define ROT(K_, Q_, C_, S_) do { r_[K_] = bfl(Q_) * (C_) - bfh(Q_) * (S_); r_[K_ + 1] = bfl(Q_) * (S_) + bfh(Q_) * (C_); } while (0)
        ROT(0, qv[0], t0.x, t0.y); ROT(2, qv[1], t0.z, t0.w); ROT(4, qv[2], t1.x, t1.y); ROT(6, qv[3], t1.z, t1.w);
#undef ROT
        qf[2][2 * i] = pk8(r_[0], r_[1], r_[2], r_[3]); qf[2][2 * i + 1] = pk8(r_[4], r_[5], r_[6], r_[7]); } } }
  int kof[2], vof[2];
#pragma unroll
  for (int i = 0; i < 2; ++i) { const int ob = (wid + 8 * i) * 1024 + 16 * lane, row = ob / KROWB, pp = (ob - row * KROWB) >> 4, sl = pp ^ ((row >> 2) & 3); kof[i] = row * LDKB + sl * 16; }
#pragma unroll
  for (int i = 0; i < 2; ++i) { const int kk = 8 * wid + ((lane & 31) >> 2), k = (kk & ~0xC) | ((kk & 4) << 1) | ((kk & 8) >> 1), c = (2 * i + (lane >> 5)) * 32 + (lane & 3) * 8; vof[i] = k * LDV + c; }
  const unsigned kdst = lds0 + LDS_K3 + wid * 1024, vdst = lds0 + LDS_V3 + wid * 2048;
#define DMA_KV(kt, ks, vt, vs) do { const unsigned char* kb_ = Kh + (long)(kt) * KVBLK * LDKB; const bf16r* vb_ = Vh + (long)(vt) * KVBLK * LDV; const unsigned kd_ = (unsigned)__builtin_amdgcn_readfirstlane(kdst + (ks) * SHM_K3), vd_ = (unsigned)__builtin_amdgcn_readfirstlane(vdst + (vs) * SHM_V3); \
    glds16(kb_ + kof[0], kd_); if (wid < 4) glds16(kb_ + kof[1], kd_ + 8192); glds16(vb_ + vof[0], vd_); glds16(vb_ + vof[1], vd_ + 1024); } while (0)
  int kq[2];
  { const int x = (r32 >> 2) & 3; const int kb = (int)lds0 + LDS_K3 + r32 * KROWB; kq[0] = kb + 16 * ((2 * hi) ^ x); kq[1] = kb + 16 * ((2 * hi + 1) ^ x); }
  const int vb0 = (int)(lds0 + LDS_V3) + v_rd_base(lane);
#define RESC(a) do { if (__any((a) < 1.f)) { if (hi == 0) al_l[r32] = (a); asm volatile("s_waitcnt lgkmcnt(0)" ::: "memory"); \
    for (int d = 0; d < 4; ++d) for (int r = 0; r < 16; ++r) o[d][r] *= al_l[crow(r, hi)]; } } while (0)
  f32x16 p0, p1; float al; bf16x8 pa0, pa1, pa2, pa3; const int NT = seq / KVBLK;
  int s0 = 0;
#define S1() (s0 == 2 ? 0 : s0 + 1)
#define S2() (s0 == 0 ? 2 : s0 - 1)
#define CLAMP(t) ((t) < NT ? (t) : NT - 1)
#define BAR() asm volatile("s_barrier" ::: "memory")
#define LGKM(n) do { asm volatile("s_waitcnt lgkmcnt(" #n ")" ::: "memory"); SBAR(); } while (0)
  DMA_KV(0, 0, 0, 0); DMA_KV(1, 1, 0, 0);
  asm volatile("s_waitcnt vmcnt(0)\n\ts_barrier" ::: "memory");
#ifndef ATT_HALF
#define ATT_HALF(w) ((w) >= 4)
#endif
  if (ATT_HALF(wid)) BAR();
#define KRD(F0, F1, OFF) asm volatile("ds_read_b128 %0, %4 offset:%6\n\tds_read_b128 %1, %5 offset:%6\n\tds_read_b128 %2, %4 offset:%7\n\tds_read_b128 %3, %5 offset:%7" \
    : "=&v"(F0##l), "=&v"(F0##h), "=&v"(F1##l), "=&v"(F1##h) : "v"(a0_), "v"(a1_), "i"(OFF), "i"((OFF) + 32 * KROWB) : "memory")
#define VRD(SET, D0) do { SET[0] = tr_read<v_rd_off(D0, 0, 0)>(vb); SET[1] = tr_read<v_rd_off(D0, 0, 1)>(vb); SET[2] = tr_read<v_rd_off(D0, 1, 0)>(vb); SET[3] = tr_read<v_rd_off(D0, 1, 1)>(vb); \
    SET[4] = tr_read<v_rd_off(D0, 2, 0)>(vb); SET[5] = tr_read<v_rd_off(D0, 2, 1)>(vb); SET[6] = tr_read<v_rd_off(D0, 3, 0)>(vb); SET[7] = tr_read<v_rd_off(D0, 3, 1)>(vb); } while (0)
#define PKV(L, H) (bf16x8){L[0], L[1], L[2], L[3], H[0], H[1], H[2], H[3]}
#define PVG(OD, SET) do { OD = __builtin_amdgcn_mfma_f32_32x32x16_bf16(pa0, PKV(SET[0], SET[1]), OD, 0, 0, 0); OD = __builtin_amdgcn_mfma_f32_32x32x16_bf16(pa1, PKV(SET[2], SET[3]), OD, 0, 0, 0); \
    OD = __builtin_amdgcn_mfma_f32_32x32x16_bf16(pa2, PKV(SET[4], SET[5]), OD, 0, 0, 0); OD = __builtin_amdgcn_mfma_f32_32x32x16_bf16(pa3, PKV(SET[6], SET[7]), OD, 0, 0, 0); } while (0)
#define F8(L, H) (v8i){L[0], L[1], L[2], L[3], H[0], H[1], H[2], H[3]}
#define QK8(F0, F1, S, C0, C1) do { p0 = __builtin_amdgcn_mfma_scale_f32_32x32x64_f8f6f4(F8(F0##l, F0##h), qf[S], C0, 0, 0, 0, 0, 0, 0); p1 = __builtin_amdgcn_mfma_scale_f32_32x32x64_f8f6f4(F8(F1##l, F1##h), qf[S], C1, 0, 0, 0, 0, 0, 0); } while (0)
#define MPH(PREV) do { const int ko_ = s0 * SHM_K3; const int a0_ = kq[0] + ko_, a1_ = kq[1] + ko_; const int vb = vb0 + S2() * SHM_V3; \
    v4i ka0l, ka0h, ka1l, ka1h, kb0l, kb0h, kb1l, kb1h; s16x4 va[8], vc[8]; \
    __builtin_amdgcn_s_setprio(1); SBAR(); \
    KRD(ka0, ka1, 0); KRD(kb0, kb1, 64); VRD(va, 0);           \
    LGKM(12); QK8(ka0, ka1, 0, negm, negm); \
    KRD(ka0, ka1, 128);                                        \
    LGKM(12); QK8(kb0, kb1, 1, p0, p1); \
    LGKM(0);  QK8(ka0, ka1, 2, p0, p1); \
    if (PREV) { VRD(vc, 1); LGKM(8); PVG(o[0], va); VRD(va, 2); LGKM(8); PVG(o[1], vc); VRD(vc, 3); LGKM(8); PVG(o[2], va); LGKM(0); PVG(o[3], vc); } \
    __builtin_amdgcn_s_setprio(0); asm volatile("s_waitcnt vmcnt(0)\n\ts_barrier" ::: "memory"); } while (0)
#define VPH(j) do { DMA_KV(CLAMP((j) + 2), S2(), CLAMP((j) + 1), S1()); al = softmaxPP(p0, p1, m_reg, negm, l_reg, (j) == 0, pa0, pa1, pa2, pa3); RESC(al); s0 = S1(); BAR(); } while (0)
  MPH(false); VPH(0);
#pragma unroll 1
  for (int j = 1; j < NT; ++j) { MPH(true); VPH(j); }
  pv_d0(o, vb0 + S2() * SHM_V3, pa0, pa1, pa2, pa3);
  if (!ATT_HALF(wid)) BAR();
  if (hi == 0) li_l[r32] = l_reg; asm volatile("s_waitcnt lgkmcnt(0)" ::: "memory");
  float rli[16];
#pragma unroll
  for (int r = 0; r < 16; ++r) rli[r] = __builtin_amdgcn_rcpf(li_l[crow(r, hi)]);
  bf16r* Ow = Ob + (long)(wid * QBLK) * LDO;
#pragma unroll
  for (int r = 0; r < 16; ++r) { const int orow = crow(r, hi);
#pragma unroll
    for (int d0 = 0; d0 < 4; ++d0) { const unsigned w = cvtpk(o[d0][r] * rli[r], 0.f); Ow[(long)orow * LDO + d0 * 32 + r32] = (bf16r)(w & 0xffffu); } }
  asm volatile("s_waitcnt vmcnt(0) lgkmcnt(0)\n\ts_barrier" ::: "memory");
#undef DMA_KV
#undef RESC
#undef S1
#undef S2
#undef CLAMP
#undef BAR
#undef LGKM
#undef KRD
#undef VRD
#undef PKV
#undef PVG
#undef F8
#undef QK8
#undef MPH
#undef VPH
}
#undef SBAR
}

namespace fftc {
#define FGAS __attribute__((address_space(1)))
typedef float f2 __attribute__((ext_vector_type(2)));
typedef __attribute__((address_space(3))) f2 lf2;
constexpr int L = 16384;
constexpr int FFT_LDS_BYTES = 17920 * 8;
__device__ static const float TW64C[32] = { 1.000000000e+00f, 9.951847267e-01f, 9.807852804e-01f, 9.569403357e-01f, 9.238795325e-01f, 8.819212643e-01f, 8.314696123e-01f, 7.730104534e-01f, 7.071067812e-01f, 6.343932842e-01f, 5.555702330e-01f, 4.713967368e-01f, 3.826834324e-01f, 2.902846773e-01f, 1.950903220e-01f, 9.801714033e-02f, 0.0f, -9.801714033e-02f, -1.950903220e-01f, -2.902846773e-01f, -3.826834324e-01f, -4.713967368e-01f, -5.555702330e-01f, -6.343932842e-01f, -7.071067812e-01f, -7.730104534e-01f, -8.314696123e-01f, -8.819212643e-01f, -9.238795325e-01f, -9.569403357e-01f, -9.807852804e-01f, -9.951847267e-01f };
__device__ static const float TW64S[32] = { 0.000000000e+00f, 9.801714033e-02f, 1.950903220e-01f, 2.902846773e-01f, 3.826834324e-01f, 4.713967368e-01f, 5.555702330e-01f, 6.343932842e-01f, 7.071067812e-01f, 7.730104534e-01f, 8.314696123e-01f, 8.819212643e-01f, 9.238795325e-01f, 9.569403357e-01f, 9.807852804e-01f, 9.951847267e-01f, 1.000000000e+00f, 9.951847267e-01f, 9.807852804e-01f, 9.569403357e-01f, 9.238795325e-01f, 8.819212643e-01f, 8.314696123e-01f, 7.730104534e-01f, 7.071067812e-01f, 6.343932842e-01f, 5.555702330e-01f, 4.713967368e-01f, 3.826834324e-01f, 2.902846773e-01f, 1.950903220e-01f, 9.801714033e-02f };
__device__ __forceinline__ f2 cmul(f2 a, f2 w) { return (f2){a.x * w.x - a.y * w.y, a.x * w.y + a.y * w.x}; }
template <bool INV> __device__ __forceinline__ f2 twmul(f2 d, int tw) {
    if (tw == 0) return d;
    if (tw == 16) return INV ? (f2){-d.y, d.x} : (f2){d.y, -d.x};
    const float c = TW64C[tw], s = TW64S[tw];
    return INV ? (f2){d.x * c - d.y * s, d.y * c + d.x * s} : (f2){d.x * c + d.y * s, d.y * c - d.x * s};
}
template <int N, int S, bool INV> __device__ __forceinline__ void dif_stage(f2 (&v)[N]) {
#pragma unroll
    for (int blk = 0; blk < N; blk += 2 * S)
#pragma unroll
        for (int i = 0; i < S; ++i) { const f2 a = v[blk + i], b = v[blk + i + S]; v[blk + i] = a + b; v[blk + i + S] = twmul<INV>(a - b, i * (32 / S)); }
    if constexpr (S > 1) dif_stage<N, S / 2, INV>(v);
}
constexpr int bitrev(int k, int bits) { int r = 0; for (int b = 0; b < bits; ++b) r |= ((k >> b) & 1) << (bits - 1 - b); return r; }
template <int N, bool INV> __device__ __forceinline__ void dft(f2 (&v)[N]) {
    dif_stage<N, N / 2, INV>(v);
    constexpr int bits = (N == 32) ? 5 : 4;
    f2 t[N];
#pragma unroll
    for (int k = 0; k < N; ++k) t[k] = v[bitrev(k, bits)];
#pragma unroll
    for (int k = 0; k < N; ++k) v[k] = t[k];
}
template <bool CONJ> __device__ __forceinline__ void apply_pow32(f2 (&v)[32], f2 w) {
    if (CONJ) w.y = -w.y;
    f2 lo[8]; lo[0] = (f2){1.f, 0.f}; lo[1] = w; lo[2] = cmul(w, w); lo[3] = cmul(lo[2], w); lo[4] = cmul(lo[2], lo[2]); lo[5] = cmul(lo[4], w); lo[6] = cmul(lo[4], lo[2]); lo[7] = cmul(lo[4], lo[3]);
#pragma unroll
    for (int k = 1; k < 32; ++k) if (k & 7) v[k] = cmul(v[k], lo[k & 7]);
    const f2 p8 = cmul(lo[4], lo[4]), p16 = cmul(p8, p8), p24 = cmul(p16, p8);
#pragma unroll
    for (int k = 8; k < 16; ++k) v[k] = cmul(v[k], p8);
#pragma unroll
    for (int k = 16; k < 24; ++k) v[k] = cmul(v[k], p16);
#pragma unroll
    for (int k = 24; k < 32; ++k) v[k] = cmul(v[k], p24);
}
__device__ __forceinline__ int opaque(int x) { asm volatile("" : "+v"(x)); return x; }
__device__ __forceinline__ f2 cis_pi(float x) { float s, c; sincospif(x, &s, &c); return (f2){c, s}; }
#define FPHYS(d1, d2, d3) ((d1) * 560 + (d2) * 17 + (d3))
#define FSYNC() __syncthreads()
__device__ __forceinline__ void pass1_fwd(lf2* X, f2 (&v)[32], int tid) {
    tid = opaque(tid);
    dft<32, false>(v);
    apply_pow32<false>(v, cis_pi(-(float)tid * (2.0f / L)));
    const int base = (tid >> 4) * 17 + (tid & 15);
#pragma unroll
    for (int k = 0; k < 32; ++k) X[base + k * 560] = v[k];
}
__device__ __forceinline__ void pass1_inv(const lf2* X, f2 (&v)[32], int tid) {
    tid = opaque(tid);
    const int base = (tid >> 4) * 17 + (tid & 15);
#pragma unroll
    for (int k = 0; k < 32; ++k) v[k] = X[base + k * 560];
    apply_pow32<true>(v, cis_pi(-(float)tid * (2.0f / L)));
    dft<32, true>(v);
}
template <bool INV> __device__ __forceinline__ void pass2(lf2* X, int tid) {
    tid = opaque(tid);
    const int base = (tid >> 4) * 560 + (tid & 15); f2 v[32];
#pragma unroll
    for (int k = 0; k < 32; ++k) v[k] = X[base + k * 17];
    const f2 w = cis_pi(-(float)(tid & 15) * (2.0f / 512.0f));
    if (INV) { apply_pow32<true>(v, w); dft<32, true>(v); } else { dft<32, false>(v); apply_pow32<false>(v, w); }
#pragma unroll
    for (int k = 0; k < 32; ++k) X[base + k * 17] = v[k];
}
template <bool KMODE> __device__ __forceinline__ void pass3(lf2* X, f2* KS, int tid) {
    typedef float f4 __attribute__((ext_vector_type(4)));
    tid = opaque(tid);
#pragma unroll 1
    for (int i = 0; i < 2; ++i) { const int base = ((tid >> 5) + 16 * i) * 560 + (tid & 31) * 17; f2 u[16]; FGAS f4* ks = (FGAS f4*)(KS + (size_t)(i * 512 + tid) * 16);
#pragma unroll
        for (int k = 0; k < 16; ++k) u[k] = X[base + k];
        dft<16, false>(u);
        if (KMODE) {
#pragma unroll
            for (int k = 0; k < 8; ++k) ks[k] = (f4){u[2 * k].x, u[2 * k].y, u[2 * k + 1].x, u[2 * k + 1].y};
        } else {
#pragma unroll
            for (int k = 0; k < 8; ++k) { const f4 w = ks[k]; u[2 * k] = cmul(u[2 * k], (f2){w.x, w.y}); u[2 * k + 1] = cmul(u[2 * k + 1], (f2){w.z, w.w}); }
            dft<16, true>(u);
#pragma unroll
            for (int k = 0; k < 16; ++k) X[base + k] = u[k];
        } }
}
__device__ __forceinline__ void kernel_spectrum(lf2* X, f2 (&v)[32], f2* KS, int tid) {
    pass1_fwd(X, v, tid); FSYNC(); pass2<false>(X, tid); FSYNC(); pass3<true>(X, KS, tid); FSYNC();
}
__device__ __forceinline__ void conv_roundtrip(lf2* X, f2 (&v)[32], f2* KS, int tid) {
    pass1_fwd(X, v, tid); FSYNC(); pass2<false>(X, tid); FSYNC(); pass3<false>(X, KS, tid); FSYNC(); pass2<true>(X, tid); FSYNC(); pass1_inv(X, v, tid); FSYNC();
}
__device__ __forceinline__ void modulate(f2 (&v)[32], int tid) {
    const f2 wj = cis_pi(-(float)opaque(tid) * (1.0f / L));
#pragma unroll
    for (int k = 0; k < 32; ++k) v[k] = twmul<false>(cmul(v[k], wj), k);
}
__device__ __forceinline__ void demodulate(f2 (&v)[32], int tid) {
    f2 wj = cis_pi(-(float)opaque(tid) * (1.0f / L)); wj.y = -wj.y;
#pragma unroll
    for (int k = 0; k < 32; ++k) v[k] = twmul<true>(cmul(v[k], wj), k);
}
__device__ __forceinline__ float bf2f(unsigned short u) { return __uint_as_float((unsigned)u << 16); }
__device__ __forceinline__ unsigned short f2bf_rne(float f) { unsigned u = __float_as_uint(f); return (unsigned short)((u + 0x7fffu + ((u >> 16) & 1u)) >> 16); }
template <typename T> __device__ __forceinline__ FGAS T* pstep(FGAS T* p, int n) { p += n; asm volatile("" : "+v"(p)); return p; }
template <int MODE> __device__ __forceinline__ void hyena_channel(lf2* X, const float* z0, const float* z1, const float* hf, const float* hb,
                                                                        const unsigned short* g0, const unsigned short* g1, float dbias, float* zo0, float* zo1,
                                                                        unsigned short* o0, unsigned short* o1, f2* stash, f2* KS, int tid) {
    f2 v[32];
    { FGAS const float* pf = (FGAS const float*)hf + opaque(tid); FGAS const float* pb = (FGAS const float*)hb + ((L - opaque(tid)) & (L - 1));
#pragma unroll
      for (int k = 0; k < 32; ++k) { v[k] = (f2){*pf + *pb, 0.f}; pf = pstep(pf, 512); pb = (k == 0) ? pstep((FGAS const float*)hb + (L - 512 - tid), 0) : pstep(pb, -512); } }
    kernel_spectrum(X, v, KS, tid);
    { FGAS const float* p0 = (FGAS const float*)z0 + opaque(tid); FGAS const float* p1 = (FGAS const float*)z1 + opaque(tid);
#pragma unroll
      for (int k = 0; k < 32; ++k) { v[k] = (f2){*p0, *p1}; p0 = pstep(p0, 512); p1 = pstep(p1, 512); } }
    conv_roundtrip(X, v, KS, tid);
    { FGAS f2* ps = (FGAS f2*)stash + opaque(tid);
#pragma unroll
      for (int k = 0; k < 32; ++k) { *ps = v[k]; ps = pstep(ps, 512); } }
    { FGAS const float* pf = (FGAS const float*)hf + opaque(tid); FGAS const float* pb = (FGAS const float*)hb + ((L - opaque(tid)) & (L - 1));
#pragma unroll
      for (int k = 0; k < 32; ++k) { const float hbv = *pb; v[k] = (f2){*pf + ((k == 0 && tid == 0) ? hbv : -hbv), 0.f}; pf = pstep(pf, 512); pb = (k == 0) ? pstep((FGAS const float*)hb + (L - 512 - tid), 0) : pstep(pb, -512); } }
    modulate(v, tid);
    kernel_spectrum(X, v, KS, tid);
    { FGAS const float* p0 = (FGAS const float*)z0 + opaque(tid); FGAS const float* p1 = (FGAS const float*)z1 + opaque(tid);
#pragma unroll
      for (int k = 0; k < 32; ++k) { v[k] = (f2){*p0, *p1}; p0 = pstep(p0, 512); p1 = pstep(p1, 512); } }
    modulate(v, tid);
    conv_roundtrip(X, v, KS, tid);
    demodulate(v, tid);
    const float sc = 1.0f / (2.0f * L);
    { FGAS const f2* ps = (FGAS const f2*)stash + opaque(tid); FGAS const float* p0 = (FGAS const float*)z0 + opaque(tid); FGAS const float* p1 = (FGAS const float*)z1 + opaque(tid); FGAS const unsigned short* q0 = (FGAS const unsigned short*)g0 + opaque(tid); FGAS const unsigned short* q1 = (FGAS const unsigned short*)g1 + opaque(tid);
      FGAS float* w0 = (FGAS float*)zo0 + opaque(tid); FGAS float* w1 = (FGAS float*)zo1 + opaque(tid); FGAS unsigned short* b0 = (FGAS unsigned short*)o0 + opaque(tid); FGAS unsigned short* b1 = (FGAS unsigned short*)o1 + opaque(tid);
#pragma unroll
      for (int k = 0; k < 32; ++k) { const f2 y = (*ps + v[k]) * sc;
          const float r0 = bf2f(*q0) * (y.x + dbias * *p0), r1 = bf2f(*q1) * (y.y + dbias * *p1);
          if (MODE == 1) { *b0 = f2bf_rne(r0); *b1 = f2bf_rne(r1); b0 = pstep(b0, 512); b1 = pstep(b1, 512); } else if (MODE == 0) { *w0 = r0; *w1 = r1; w0 = pstep(w0, 512); w1 = pstep(w1, 512); } else { asm volatile("" :: "v"(r0), "v"(r1)); }
          ps = pstep(ps, 512); p0 = pstep(p0, 512); p1 = pstep(p1, 512); q0 = pstep(q0, 512); q1 = pstep(q1, 512); } }
}
#undef FPHYS
#undef FGAS
}

constexpr int BATCH = 2, SEQ = 16384, DM = 1024, T = BATCH * SEQ;
constexpr int NH = 8, DNOPE = 128, DROPE = 64, DQK = 192, DVH = 128, QLORA = 384, KVLORA = 256, MLA_IN = 704, MLA_INP = 768;
constexpr int DFF = 2816, NUP = 2 * DFF;
constexpr int HF = 64, HEMB = 33, HKP = 256;
constexpr float LN_EPS = 1e-5f, RMS_EPS = 1e-6f;
constexpr float DN_ALPHA = 1.4142135623730951f;
constexpr float QSCALE = 0.07216878364870322f * 1.4426950408889634f;
constexpr int NWAVES = 8;

constexpr size_t MiB = 1u << 20;
constexpr size_t WS_CTL = 0, CTL_ZERO_BYTES = 1 * MiB;
constexpr size_t WS_WIN = 2 * MiB, WS_WUQ = 4 * MiB, WS_WUKV = 6 * MiB, WS_WO = 7 * MiB, WS_WHIN = 9 * MiB, WS_WHO = 15 * MiB, WS_WUP = 17 * MiB, WS_WDN = 39 * MiB, WS_WFO = 50 * MiB, WS_H3 = 52 * MiB;
constexpr size_t WS_XB = 60 * MiB;
constexpr size_t WS_XF = 124 * MiB;
constexpr size_t WS_S = 252 * MiB;
constexpr size_t WS_END = 512 * MiB;
constexpr size_t WS_CQN = WS_XF, WS_CKVN = WS_XF + 24 * MiB, WS_ROPE = WS_XF + 40 * MiB;
constexpr size_t WS_Q = WS_S, WS_K = WS_S + 96 * MiB, WS_V = WS_S + 192 * MiB;
constexpr size_t WS_UH = WS_S;
constexpr size_t WS_U = WS_S;
constexpr size_t WS_VC0 = WS_XB, WS_VC1 = WS_S + 192 * MiB;
constexpr size_t WS_KT = WS_S, WS_STASH = WS_S + 128 * MiB, WS_KSPEC = WS_S + 160 * MiB;
constexpr int CW_TMO = 0, CW_CODE = 1, CW_BAR = 4096, CW_CHK = 8192;

constexpr int RING_BYTES = 131072;
constexpr int LDS_BYTES = 147456;
constexpr int MISC_OFF = LDS_BYTES - 512;
static_assert(fftc::FFT_LDS_BYTES <= MISC_OFF && attn::SHM_ATTN3 <= RING_BYTES, "LDS map");

typedef pg8::bf16_t bf16;
typedef unsigned u32x4t __attribute__((ext_vector_type(4)));
typedef unsigned u32x2t __attribute__((ext_vector_type(2)));
typedef float f32x2 __attribute__((ext_vector_type(2)));
__device__ __forceinline__ float wave_sum(float v) {
#pragma unroll
    for (int o = 1; o < 64; o <<= 1) v += __shfl_xor(v, o);
    return v;
}
__device__ __forceinline__ float bf_lo(unsigned w) { return __uint_as_float(w << 16); }
__device__ __forceinline__ float bf_hi(unsigned w) { return __uint_as_float(w & 0xffff0000u); }
__device__ __forceinline__ unsigned pkbf(float lo, float hi) { return pg8::cvt_pk_bf16(lo, hi); }

template <class ColMap> __device__ __forceinline__ void transpose_item(const float* W, int K, int N, bf16* WT, int ldk, LAS float* scr, int item, int nblk, int lane, const ColMap& cm) {
    const int kb = item / nblk, nb = item % nblk, k0 = 64 * kb, n0 = 32 * nb;
    const int sc = cm(n0 + (lane & 31));
#pragma unroll 8
    for (int i = 0; i < 32; ++i) { const int kk = 2 * i + (lane >> 5); scr[kk * 33 + (lane & 31)] = (sc >= 0) ? W[(size_t)(k0 + kk) * N + sc] : 0.f; }
    asm volatile("s_waitcnt lgkmcnt(0)" ::: "memory");
    const int c = lane & 7;
#pragma unroll
    for (int j = 0; j < 4; ++j) { const int n = (lane >> 3) + 8 * j; const LAS float* s = scr + (8 * c) * 33 + n;
        u32x4t o; o.x = pkbf(s[0 * 33], s[1 * 33]); o.y = pkbf(s[2 * 33], s[3 * 33]); o.z = pkbf(s[4 * 33], s[5 * 33]); o.w = pkbf(s[6 * 33], s[7 * 33]);
        *(u32x4t*)(WT + (size_t)(n0 + n) * ldk + k0 + 8 * c) = o; }
    asm volatile("s_waitcnt lgkmcnt(0)" ::: "memory");
}
struct CmIdent { __device__ __forceinline__ int operator()(int n) const { return n; } };
struct CmWin { __device__ __forceinline__ int operator()(int n) const { if (n < 640) return n; if (n >= 704) return -1; const int i = n - 640; return 640 + (i & 1) * 32 + (i >> 1); } };
struct CmWuq { __device__ __forceinline__ int operator()(int n) const { const int h = n / 192, d = n - h * 192; if (d < 128) return n; const int i = d - 128; return h * 192 + 128 + (i & 1) * 32 + (i >> 1); } };
struct CmWukv { __device__ __forceinline__ int operator()(int n) const { const int v = n >> 10, r = n & 1023, h = r >> 7, d = r & 127; return h * 256 + v * 128 + d; } };
struct CmWup { __device__ __forceinline__ int operator()(int n) const { const int pn = n >> 8, r = n & 255; return (r < 128) ? (pn * 128 + r) : (DFF + pn * 128 + (r - 128)); } };

struct Args {
    const float* in[27]; float* out; unsigned char* ws; int ph_lo, ph_hi;
};
enum { I_X = 0, I_POS, I_MLA_WIN, I_MLA_GQ, I_MLA_WUQ, I_MLA_GKV, I_MLA_WUKV, I_MLA_WO, I_HY_WIN, I_HY_WSHORT, I_HY_FW1, I_HY_FB1, I_HY_FW2, I_HY_FB2, I_HY_FW3, I_HY_FB3, I_HY_FREQ,
       I_HY_FWOUT, I_HY_DBIAS, I_HY_WO, I_FFN_WUP, I_FFN_WCONV, I_FFN_WDOWN, I_LN1G, I_LN1B, I_LN2G, I_LN2B };

__device__ __forceinline__ void ln_rows(const float* Y, float* OF, bf16* OB, const float* g, const float* b, int gw, int ngw, int lane, float omul = 1.0f) {
    f32x4 gv[4], bv[4];
#pragma unroll
    for (int j = 0; j < 4; ++j) { gv[j] = *(const f32x4*)(g + 4 * lane + 256 * j); bv[j] = *(const f32x4*)(b + 4 * lane + 256 * j); }
    for (int m = gw; m < T; m += ngw) {
        const f32x4* xr = (const f32x4*)(Y + (size_t)m * DM) + lane;
        f32x4 v[4]; float s = 0.f;
#pragma unroll
        for (int j = 0; j < 4; ++j) { v[j] = xr[64 * j]; s += (v[j].x + v[j].y) + (v[j].z + v[j].w); }
        const float mean = wave_sum(s) * (1.f / DM); float s2 = 0.f;
#pragma unroll
        for (int j = 0; j < 4; ++j) { v[j] = v[j] - mean; s2 += (v[j].x * v[j].x + v[j].y * v[j].y) + (v[j].z * v[j].z + v[j].w * v[j].w); }
        const float rstd = 1.f / sqrtf(wave_sum(s2) * (1.f / DM) + LN_EPS);
        f32x4* of = (f32x4*)(OF + (size_t)m * DM) + lane;
#pragma unroll
        for (int j = 0; j < 4; ++j) { v[j] = (v[j] * rstd * gv[j] + bv[j]) * omul;
            of[64 * j] = v[j]; }
        if (OB) { u32x2t* ob = (u32x2t*)(OB + (size_t)m * DM) + lane;
#pragma unroll
            for (int j = 0; j < 4; ++j) { u32x2t w; w.x = pkbf(v[j].x, v[j].y); w.y = pkbf(v[j].z, v[j].w); ob[64 * j] = w; } }
    }
}

__device__ __forceinline__ void mla_norm_rope(const float* H1, const float* gq, const float* gkv, const f32x2* tab, bf16* CQN, bf16* CKVN, unsigned char* Kb, int gw, int ngw, int lane) {
    float gqv[6], gkvv[4];
#pragma unroll
    for (int k = 0; k < 6; ++k) gqv[k] = gq[lane + 64 * k];
#pragma unroll
    for (int k = 0; k < 4; ++k) gkvv[k] = gkv[lane + 64 * k];
    for (int t = gw; t < T; t += ngw) {
        const float* h = H1 + (size_t)t * MLA_INP;
        float q[6], kv[4]; float sq = 0.f, sk = 0.f;
#pragma unroll
        for (int k = 0; k < 6; ++k) { q[k] = h[lane + 64 * k]; sq += q[k] * q[k]; }
#pragma unroll
        for (int k = 0; k < 4; ++k) { kv[k] = h[QLORA + lane + 64 * k]; sk += kv[k] * kv[k]; }
        const f32x2 xr = *(const f32x2*)(h + 640 + 2 * (lane & 31));
        const float rq = 1.f / sqrtf(wave_sum(sq) * (1.f / QLORA) + RMS_EPS), rk = 1.f / sqrtf(wave_sum(sk) * (1.f / KVLORA) + RMS_EPS);
#pragma unroll
        for (int k = 0; k < 6; ++k) CQN[(size_t)t * QLORA + lane + 64 * k] = (bf16)(pkbf(q[k] * rq * gqv[k], 0.f) & 0xffffu);
#pragma unroll
        for (int k = 0; k < 4; ++k) CKVN[(size_t)t * KVLORA + lane + 64 * k] = (bf16)(pkbf(kv[k] * rk * gkvv[k], 0.f) & 0xffffu);
        const f32x2 cs = tab[(size_t)t * 32 + (lane & 31)];
        const unsigned short w = (unsigned short)__builtin_amdgcn_cvt_pk_fp8_f32(xr.x * cs.x - xr.y * cs.y, xr.x * cs.y + xr.y * cs.x, 0, false);
        unsigned short* kr = (unsigned short*)(Kb + (size_t)t * 1536 + 128) + (lane & 31);
        if (lane < 32) {
#pragma unroll
            for (int hh = 0; hh < NH; ++hh) kr[hh * 96] = w; }
    }
}

__device__ __forceinline__ void ffn_conv_silu(const bf16* UH, const float* wconv  , bf16* HACT  , int gw, int ngw, int lane) {
    constexpr int RB = 32, NRB = SEQ / RB, NCC = 6;
    for (int it = gw; it < NRB * NCC; it += ngw) {
        const int rb = it / NCC, cc = it - rb * NCC, c = cc * 512 + lane * 8;
        if (c >= DFF) continue;
        const int pn = c >> 7, ucol = pn * 256 + (c & 127);
        float wa[3][8], wg[3][8];
#pragma unroll
        for (int k = 0; k < 3; ++k)
#pragma unroll
            for (int e = 0; e < 8; ++e) { wa[k][e] = wconv[k * NUP + c + e]; wg[k][e] = wconv[k * NUP + DFF + c + e]; }
        const int r0 = rb * RB;
        const bf16* up = UH + ucol;
        const u32x4t zero = {0u, 0u, 0u, 0u};
        u32x4t ra[6], rg[6];
        ra[0] = zero; rg[0] = zero;
        if (r0 > 0) { ra[0] = *(const u32x4t*)(up + (size_t)(r0 - 1) * NUP); rg[0] = *(const u32x4t*)(up + (size_t)(r0 - 1) * NUP + 128); }
        ra[1] = *(const u32x4t*)(up + (size_t)r0 * NUP); rg[1] = *(const u32x4t*)(up + (size_t)r0 * NUP + 128);
#pragma unroll 1
        for (int r = r0; r < r0 + RB; r += 4) {
#pragma unroll
            for (int j = 1; j <= 4; ++j) { const int rr = r + j; if (rr < SEQ) { ra[1 + j] = *(const u32x4t*)(up + (size_t)rr * NUP); rg[1 + j] = *(const u32x4t*)(up + (size_t)rr * NUP + 128); } else { ra[1 + j] = zero; rg[1 + j] = zero; } }
#pragma unroll
            for (int j = 0; j < 4; ++j) {
                float o[8];
#pragma unroll
                for (int e2 = 0; e2 < 4; ++e2) {
                    const float a0 = wa[0][2 * e2] * bf_lo(ra[j][e2]) + wa[1][2 * e2] * bf_lo(ra[j + 1][e2]) + wa[2][2 * e2] * bf_lo(ra[j + 2][e2]);
                    const float a1 = wa[0][2 * e2 + 1] * bf_hi(ra[j][e2]) + wa[1][2 * e2 + 1] * bf_hi(ra[j + 1][e2]) + wa[2][2 * e2 + 1] * bf_hi(ra[j + 2][e2]);
                    const float g0 = wg[0][2 * e2] * bf_lo(rg[j][e2]) + wg[1][2 * e2] * bf_lo(rg[j + 1][e2]) + wg[2][2 * e2] * bf_lo(rg[j + 2][e2]);
                    const float g1 = wg[0][2 * e2 + 1] * bf_hi(rg[j][e2]) + wg[1][2 * e2 + 1] * bf_hi(rg[j + 1][e2]) + wg[2][2 * e2 + 1] * bf_hi(rg[j + 2][e2]);
                    o[2 * e2] = a0 * g0 * __builtin_amdgcn_rcpf(1.f + __expf(-g0)); o[2 * e2 + 1] = a1 * g1 * __builtin_amdgcn_rcpf(1.f + __expf(-g1)); }
                u32x4t w; w.x = pkbf(o[0], o[1]); w.y = pkbf(o[2], o[3]); w.z = pkbf(o[4], o[5]); w.w = pkbf(o[6], o[7]);
                *(u32x4t*)(HACT + (size_t)(r + j) * DFF + c) = w;
            }
            ra[0] = ra[4]; rg[0] = rg[4]; ra[1] = ra[5]; rg[1] = rg[5];
        }
    }
}

__device__ __forceinline__ void ffn_fixup_rows(const float* halo, const float* wconv  , bf16* HACT  , int gw, int ngw, int lane) {
    constexpr int NP = T / 256, NCC = 6;
    for (int it = gw; it < NP * 2 * NCC; it += ngw) {
        const int cc = it % NCC, pe = it / NCC, e = pe & 1, pm = pe >> 1, c = cc * 512 + lane * 8;
        if (c >= DFF) continue;
        const int row = pm * 256 + (e ? 255 : 0), ucol = (c >> 7) * 256 + (c & 127);
        const float* hp = halo + (size_t)pm * 4 * NUP + ucol;
        const float* up_ = nullptr; const float* cu_; const float* dn_ = nullptr;
        if (e == 0) { cu_ = hp; dn_ = hp + NUP; if (row % SEQ != 0) up_ = hp - 4 * NUP + 3 * NUP; }
        else { up_ = hp + 2 * NUP; cu_ = hp + 3 * NUP; if (row % SEQ != SEQ - 1) dn_ = hp + 4 * NUP; }
        float o[8];
#pragma unroll
        for (int i = 0; i < 8; ++i) {
            float ha = wconv[NUP + c + i] * cu_[i], hg = wconv[NUP + DFF + c + i] * cu_[128 + i];
            if (up_) { ha += wconv[c + i] * up_[i]; hg += wconv[DFF + c + i] * up_[128 + i]; }
            if (dn_) { ha += wconv[2 * NUP + c + i] * dn_[i]; hg += wconv[2 * NUP + DFF + c + i] * dn_[128 + i]; }
            o[i] = ha * hg * __builtin_amdgcn_rcpf(1.f + __expf(-hg)); }
        u32x4t w; w.x = pkbf(o[0], o[1]); w.y = pkbf(o[2], o[3]); w.z = pkbf(o[4], o[5]); w.w = pkbf(o[6], o[7]);
        *(u32x4t*)(HACT + (size_t)row * DFF + c) = w;
    }
}

__device__ __forceinline__ void hy_conv_transpose(const bf16* U  , const float* wshort  , float* VC0, float* VC1, bf16* G1C, bf16* G2C, LAS unsigned* scr, int gw, int ngw, int lane) {
    constexpr int NTT = T / 64, NCT = 3072 / 64;
    for (int it = gw; it < NTT * NCT; it += ngw) {
        const int ct = it % NCT, tt = it / NCT, b = tt / (SEQ / 64), t0 = (tt % (SEQ / 64)) * 64, c0 = ct * 64;
        const int r8 = lane >> 3, c8 = lane & 7;
#pragma unroll
        for (int i = 0; i < 9; ++i) { const int row = r8 + 8 * i; if (row < 66) { const int tok = t0 - 1 + row; u32x4t v = {0u, 0u, 0u, 0u};
                if (tok >= 0 && tok < SEQ) v = *(const u32x4t*)(U + ((size_t)b * SEQ + tok) * 3072 + c0 + c8 * 8);
                LAS unsigned* d = scr + row * 33 + c8 * 4; d[0] = v.x; d[1] = v.y; d[2] = v.z; d[3] = v.w; } }
        asm volatile("s_waitcnt lgkmcnt(0)" ::: "memory");
        const int part = c0 >> 10, chb = c0 & 1023;
        const float wl0 = wshort[c0 + lane], wl1 = wshort[3072 + c0 + lane], wl2 = wshort[6144 + c0 + lane];
#pragma unroll
        for (int cp = 0; cp < 32; ++cp) {
            const unsigned a0 = scr[lane * 33 + cp], a1 = scr[(lane + 1) * 33 + cp], a2 = scr[(lane + 2) * 33 + cp];
            #define RL(x, i) __int_as_float(__builtin_amdgcn_readlane(__float_as_int(x), (i)))
            const float w00 = RL(wl0, 2 * cp), w10 = RL(wl1, 2 * cp), w20 = RL(wl2, 2 * cp), w01 = RL(wl0, 2 * cp + 1), w11 = RL(wl1, 2 * cp + 1), w21 = RL(wl2, 2 * cp + 1);
#undef RL
            const float v0 = w00 * bf_lo(a0) + w10 * bf_lo(a1) + w20 * bf_lo(a2), v1 = w01 * bf_hi(a0) + w11 * bf_hi(a1) + w21 * bf_hi(a2);
            const size_t o = (size_t)(chb + 2 * cp) * SEQ + t0 + lane;
            if (part == 0) { float* d = b ? VC1 : VC0; d[o] = v0; d[o + SEQ] = v1; }
            else { bf16* d = (part == 1 ? G1C : G2C) + (size_t)b * 1024 * SEQ; d[o] = (bf16)(pkbf(v0, 0.f) & 0xffffu); d[o + SEQ] = (bf16)(pkbf(v1, 0.f) & 0xffffu); }
        }
        asm volatile("s_waitcnt lgkmcnt(0)" ::: "memory");
    }
}
__device__ __forceinline__ void hy_transpose_back(const bf16* Z3C, bf16* XB, LAS unsigned* scr, int gw, int ngw, int lane) {
    constexpr int NTT = T / 64, NCT = 1024 / 64;
    for (int it = gw; it < NTT * NCT; it += ngw) {
        const int ct = it % NCT, tt = it / NCT, b = tt / (SEQ / 64), t0 = (tt % (SEQ / 64)) * 64, c0 = ct * 64;
        const bf16* src = Z3C + ((size_t)b * 1024 + c0) * SEQ + t0 + lane;
#pragma unroll 8
        for (int cp = 0; cp < 32; ++cp) { const unsigned lo = src[(size_t)(2 * cp) * SEQ], hi = src[(size_t)(2 * cp + 1) * SEQ]; scr[lane * 33 + cp] = lo | (hi << 16); }
        asm volatile("s_waitcnt lgkmcnt(0)" ::: "memory");
        const int r8 = lane >> 3, c8 = lane & 7;
#pragma unroll
        for (int i = 0; i < 8; ++i) { const int row = r8 + 8 * i; const LAS unsigned* s = scr + row * 33 + c8 * 4; u32x4t v; v.x = s[0]; v.y = s[1]; v.z = s[2]; v.w = s[3];
            *(u32x4t*)(XB + ((size_t)b * SEQ + t0 + row) * DM + c0 + c8 * 8) = v; }
        asm volatile("s_waitcnt lgkmcnt(0)" ::: "memory");
    }
}

#ifdef SELFCHECK
__device__ __forceinline__ float blk_sum(float v, LAS float* red, int tid_) {
    v = wave_sum(v); __syncthreads(); if ((tid_ & 63) == 0) red[tid_ >> 6] = v; __syncthreads();
    float t = 0.f; for (int i = 0; i < NWAVES; ++i) t += red[i]; __syncthreads(); return t;
}
__device__ __forceinline__ void chk_flag(unsigned* flag, float err2, float ref2, unsigned bit, int tid_, float tol = SELFCHECK_TOL) {
    if (tid_ == 0 && !(err2 <= tol * tol * ref2)) atomicOr(flag, bit);
}
__device__ __forceinline__ float fp8_dec(unsigned b) { const unsigned e = (b >> 3) & 15u, m = b & 7u; const float v = e ? ldexpf((float)(8u + m), (int)e - 10) : ldexpf((float)m, -9); return (b & 0x80u) ? -v : v; }
__device__ __forceinline__ float fp8_rnd(float x) { return fp8_dec((unsigned)__builtin_amdgcn_cvt_pk_fp8_f32(x, 0.f, 0, false) & 0xffu); }
__device__ __forceinline__ void selfcheck_mla(const Args& args, LAS unsigned char* ldsl, int bxx, int tid_) {
    unsigned* flag = (unsigned*)(args.ws + WS_CTL) + CW_CHK;
    const bf16* Qb_ = (const bf16*)(args.ws + WS_Q); const unsigned char* Kb_ = (const unsigned char*)(args.ws + WS_K); const bf16* Vb_ = (const bf16*)(args.ws + WS_V); const bf16* O_ = (const bf16*)(args.ws + WS_XB);
    const int* pos = (const int*)args.in[I_POS];
    LAS float* red = (LAS float*)(ldsl + 140000);
    if (bxx < 64) {
        const int t = bxx * (T / 64) + (bxx * 37) % 512;
        LAS float* h = (LAS float*)ldsl; LAS float* cq = h + 704; LAS float* ckv = cq + 384;
        const float* x = args.in[I_X] + (size_t)t * DM; const float* w_in = args.in[I_MLA_WIN];
        for (int j = tid_; j < MLA_IN; j += 512) { float a = 0.f; for (int k = 0; k < DM; ++k) a += x[k] * w_in[(size_t)k * MLA_IN + j]; h[j] = a; }
        __syncthreads();
        float sq = 0.f, sk = 0.f; for (int k = 0; k < QLORA; ++k) sq += h[k] * h[k]; for (int k = 0; k < KVLORA; ++k) sk += h[QLORA + k] * h[QLORA + k];
        const float rq = 1.f / sqrtf(sq / QLORA + RMS_EPS), rk = 1.f / sqrtf(sk / KVLORA + RMS_EPS);
        for (int k = tid_; k < QLORA; k += 512) cq[k] = h[k] * rq * args.in[I_MLA_GQ][k];
        for (int k = tid_; k < KVLORA; k += 512) ckv[k] = h[QLORA + k] * rk * args.in[I_MLA_GKV][k];
        __syncthreads();
        {
            float e2 = 0.f, r2 = 0.f; const float* w = args.in[I_MLA_WUQ];
            for (int n = tid_; n < NH * DQK; n += 512) { const int o = CmWuq()(n); float a = 0.f; for (int k = 0; k < QLORA; ++k) a += cq[k] * w[(size_t)k * (NH * DQK) + o];
                a *= QSCALE; const float g = __uint_as_float((unsigned)Qb_[(size_t)t * 1536 + n] << 16); e2 += (a - g) * (a - g); r2 += a * a; }
            e2 = blk_sum(e2, red, tid_); r2 = blk_sum(r2, red, tid_); chk_flag(flag, e2, r2, 1u, tid_);
        }
        {
            float e2 = 0.f, r2 = 0.f, e3 = 0.f, r3 = 0.f; const float* w = args.in[I_MLA_WUKV];
            for (int n = tid_; n < NH * 256; n += 512) { const int o = CmWukv()(n); float a = 0.f; for (int k = 0; k < KVLORA; ++k) a += ckv[k] * w[(size_t)k * (NH * 256) + o];
                if (n < 1024) { const float g = fp8_dec(Kb_[(size_t)t * 1536 + (n >> 7) * 192 + (n & 127)]); e2 += (a - g) * (a - g); r2 += a * a; }
                else { const float g = __uint_as_float((unsigned)Vb_[(size_t)t * 1024 + n - 1024] << 16); e3 += (a - g) * (a - g); r3 += a * a; } }
            e2 = blk_sum(e2, red, tid_); r2 = blk_sum(r2, red, tid_); chk_flag(flag, e2, r2, 2u, tid_, SELFCHECK_TOL8);
            e3 = blk_sum(e3, red, tid_); r3 = blk_sum(r3, red, tid_); chk_flag(flag, e3, r3, 8u, tid_);
        }
        {
            float e2 = 0.f, r2 = 0.f;
            if (tid_ < 256) { const int hh = tid_ >> 5, i = tid_ & 31; const float inv = powf(10000.0f, -(float)i / 32.0f); float s, c; sincosf((float)pos[t] * inv, &s, &c);
                const float x1 = h[640 + i], x2 = h[672 + i], a1 = x1 * c - x2 * s, a2 = x1 * s + x2 * c;
                const float g1 = fp8_dec(Kb_[(size_t)t * 1536 + hh * 192 + 128 + 2 * i]), g2 = fp8_dec(Kb_[(size_t)t * 1536 + hh * 192 + 129 + 2 * i]);
                e2 = (a1 - g1) * (a1 - g1) + (a2 - g2) * (a2 - g2); r2 = a1 * a1 + a2 * a2; }
            e2 = blk_sum(e2, red, tid_); r2 = blk_sum(r2, red, tid_); chk_flag(flag, e2, r2, 4u, tid_, SELFCHECK_TOL8);
        }
    } else if (bxx < 192) {
        const int sidx = bxx - 64, b = sidx & 1, hh = (sidx >> 1) & 7, row = (sidx * 509 + 13) % SEQ; const size_t t = (size_t)b * SEQ + row;
        LAS float* sc = (LAS float*)ldsl;
        LAS float* q = sc + SEQ;
        if (tid_ < DQK) { float v = __uint_as_float((unsigned)Qb_[t * 1536 + hh * DQK + tid_] << 16);
            if (tid_ >= 128) { const int i = (tid_ - 128) >> 1; const float inv = powf(10000.0f, -(float)i / 32.0f); float s, c; sincosf((float)pos[t] * inv, &s, &c);
                const float o = __uint_as_float((unsigned)Qb_[t * 1536 + hh * DQK + (tid_ ^ 1)] << 16);
                v = (tid_ & 1) ? (o * s + v * c) : (v * c - o * s); }
            q[tid_] = fp8_rnd(v); }
        __syncthreads();
        float mx = -1e30f;
        for (int k = tid_; k < SEQ; k += 512) { const unsigned char* kr = Kb_ + ((size_t)b * SEQ + k) * 1536 + hh * DQK; float a = 0.f; for (int d = 0; d < DQK; ++d) a += q[d] * fp8_dec(kr[d]); sc[k] = a; mx = fmaxf(mx, a); }
        for (int o = 1; o < 64; o <<= 1) mx = fmaxf(mx, __shfl_xor(mx, o));
        __syncthreads(); if ((tid_ & 63) == 0) red[tid_ >> 6] = mx; __syncthreads(); for (int i = 0; i < NWAVES; ++i) mx = fmaxf(mx, red[i]); __syncthreads();
        float ls = 0.f; for (int k = tid_; k < SEQ; k += 512) { const float p = exp2f(sc[k] - mx); sc[k] = p; ls += p; }
        ls = blk_sum(ls, red, tid_);
        const int d = tid_ & 127, part = tid_ >> 7; float a = 0.f;
        for (int k = part * 4096; k < (part + 1) * 4096; ++k) a += sc[k] * __uint_as_float((unsigned)Vb_[((size_t)b * SEQ + k) * 1024 + hh * DVH + d] << 16);
        LAS float* op = q + 256; op[tid_] = a; __syncthreads();
        float e2 = 0.f, r2 = 0.f;
        if (tid_ < 128) { const float o = (op[tid_] + op[tid_ + 128] + op[tid_ + 256] + op[tid_ + 384]) / ls; const float g = __uint_as_float((unsigned)O_[t * 1024 + hh * DVH + tid_] << 16); e2 = (o - g) * (o - g); r2 = o * o; }
        e2 = blk_sum(e2, red, tid_); r2 = blk_sum(r2, red, tid_); chk_flag(flag, e2, r2, 16u, tid_);
    }
}
#endif
#ifndef MK_PER_PHASE
#define MK_PER_PHASE 0
#endif
constexpr int N_PHASES = 30;
constexpr int GEMM_SP2 = true, GEMM_ALIGN = true;

__global__ void __launch_bounds__(NWAVES * 64, 2) mega_fwd(Args args) {
    extern __shared__ __attribute__((aligned(16))) unsigned char lds[];
    LAS unsigned char* ldsl = (LAS unsigned char*)lds;
    volatile LAS unsigned* MISC = (volatile LAS unsigned*)(ldsl + MISC_OFF);
    const int wave = __builtin_amdgcn_readfirstlane((int)threadIdx.x >> 6);
#define lane hw_lane()
#define tid (wave * 64 + hw_lane())
#define G ((int)gridDim.x)
#define bx ((int)blockIdx.x)
#define gw (bx * NWAVES + wave)
#define ngw (G * NWAVES)
    { const int t_ = tid; if (t_ < 128) MISC[t_] = 0u; }
    __syncthreads();
    if (!MK_PER_PHASE) (void)xcd_barrier_post((unsigned*)(args.ws + WS_CTL) + CW_BAR, MISC + 8, (unsigned)wave);
    const int lo = args.ph_lo, hi = args.ph_hi;
#ifdef ONLY_PHASE
#define IN(k) ((k) == ONLY_PHASE && lo <= (k) && (k) < hi)
#else
#define IN(k) (lo <= (k) && (k) < hi)
#endif
#define GRIDBAR() do { XcdBarrier bar_; bar_.bar = (unsigned*)(args.ws + WS_CTL) + CW_BAR; bar_.x = xb_xcc_id(); bar_.st = MISC + 8; bar_.wv = (unsigned)wave; xcd_barrier(bar_); } while (0)
#define SEAM(k) do { if (IN(k) && IN((k) + 1)) GRIDBAR(); } while (0)
#ifndef PROBE_DUP
#define PROBE_DUP (-1)
#define PROBE_REP 1
#endif
#define RUN(k, REAL, DUMMY) do { if (IN(k)) { if (PROBE_DUP == (k)) { for (int rep_ = 0; rep_ < PROBE_REP; ++rep_) { DUMMY; GRIDBAR(); } } REAL; } } while (0)

#define P_(T_, off) ((T_*)(args.ws + (off)))
#define Win_t P_(bf16, WS_WIN)
#define Wuq_t P_(bf16, WS_WUQ)
#define Wukv_t P_(bf16, WS_WUKV)
#define Wo_t P_(bf16, WS_WO)
#define Whin_t P_(bf16, WS_WHIN)
#define Who_t P_(bf16, WS_WHO)
#define Wup_t P_(bf16, WS_WUP)
#define Wdn_t P_(bf16, WS_WDN)
#define Wfo_t P_(bf16, WS_WFO)
#define H3 P_(bf16, WS_H3)
#define XB P_(bf16, WS_XB)
#define XF P_(float, WS_XF)
#define CQN P_(bf16, WS_CQN)
#define CKVN P_(bf16, WS_CKVN)
#define ROPE P_(f32x2, WS_ROPE)
#define Qb P_(bf16, WS_Q)
#define Kb P_(unsigned char, WS_K)
#define Vb P_(bf16, WS_V)
#define UH P_(bf16, WS_UH)
#define U P_(bf16, WS_U)
#define VC0 P_(float, WS_VC0)
#define VC1 P_(float, WS_VC1)
#define KT P_(float, WS_KT)
#define STASH P_(fftc::f2, WS_STASH)
#define KSPEC P_(fftc::f2, WS_KSPEC)
#define OUT (args.out)
#define H1 (args.out)
#define G1C ((bf16*)args.out)
#define G2C ((bf16*)args.out + (size_t)2 * 1024 * SEQ)
#define Z3C ((bf16*)args.out)
#define GEMM(EPI, A_, B_, M_, N_, K_, ...) do { pg8::Gemm g{(A_), (B_), (M_), (N_), (K_)}; pg8::StaticOrder S; S.init((M_), (N_), G, bx); pg8::EPI E{__VA_ARGS__}; \
        pg8::gemm_phase<pg8::EPI, pg8::StaticOrder, GEMM_ALIGN, GEMM_SP2>(ldsl, g, S, E, wave); } while (0)

    if (IN(0)) for (int prep_ = 0; prep_ < ((PROBE_DUP == 0) ? 1 + PROBE_REP : 1); ++prep_) {
        if (prep_) GRIDBAR();
        LAS float* scr = (LAS float*)(ldsl + wave * 16384);
        {
            int base = 0;
#define TR(W_, K_, N_, WT_, NP_, LDK_, CM_) do { const int nblk_ = (NP_) / 32, nit_ = ((K_) / 64) * nblk_; \
                for (int it_ = (gw + ngw - base % ngw) % ngw; it_ < nit_; it_ += ngw) transpose_item((W_), (K_), (N_), (WT_), (LDK_), scr, it_, nblk_, lane, CM_); base += nit_; } while (0)
            TR(args.in[I_MLA_WIN], DM, MLA_IN, Win_t, MLA_INP, DM, CmWin());
            TR(args.in[I_MLA_WUQ], QLORA, NH * DQK, Wuq_t, NH * DQK, QLORA, CmWuq());
            TR(args.in[I_MLA_WUKV], KVLORA, NH * 256, Wukv_t, NH * 256, KVLORA, CmWukv());
            TR(args.in[I_MLA_WO], DM, DM, Wo_t, DM, DM, CmIdent());
            TR(args.in[I_HY_WIN], DM, 3 * DM, Whin_t, 3 * DM, DM, CmIdent());
            TR(args.in[I_HY_WO], DM, DM, Who_t, DM, DM, CmIdent());
            TR(args.in[I_FFN_WUP], DM, NUP, Wup_t, NUP, DM, CmWup());
            TR(args.in[I_FFN_WUP] + (size_t)DM * NUP, DM, NUP, Wup_t + (size_t)NUP * DM, NUP, DM, CmWup());
            TR(args.in[I_FFN_WDOWN], DFF, DM, Wdn_t, DM, DFF, CmIdent());
            TR(args.in[I_FFN_WDOWN] + (size_t)DFF * DM, DFF, DM, Wdn_t + (size_t)DM * DFF, DM, DFF, CmIdent());
            TR(args.in[I_HY_FWOUT], HF, 4 * DM, Wfo_t, 4 * DM, HKP, CmIdent());
#undef TR
        }
        for (size_t i = (size_t)gw * 64 + lane; i < (size_t)4096 * 24; i += (size_t)ngw * 64) { const size_t r = i / 24, c = i % 24; *(u32x4t*)(Wfo_t + r * HKP + 64 + c * 8) = (u32x4t){0u, 0u, 0u, 0u}; }
        for (size_t i = (size_t)gw * 64 + lane; i < (size_t)SEQ * 24; i += (size_t)ngw * 64) { const size_t r = i / 24, c = i % 24; *(u32x4t*)(H3 + r * HKP + 64 + c * 8) = (u32x4t){0u, 0u, 0u, 0u}; }
        { const float* x_in = args.in[I_X];
          for (size_t i = (size_t)gw * 64 + lane; i < (size_t)T * DM / 8; i += (size_t)ngw * 64) { const f32x4 a = *(const f32x4*)(x_in + i * 8), b = *(const f32x4*)(x_in + i * 8 + 4);
            u32x4t w; w.x = pkbf(a.x, a.y); w.y = pkbf(a.z, a.w); w.z = pkbf(b.x, b.y); w.w = pkbf(b.z, b.w); *(u32x4t*)(XB + i * 8) = w; } }
        { const int* pos = (const int*)args.in[I_POS];
          for (size_t i = (size_t)gw * 64 + lane; i < (size_t)T * 32; i += (size_t)ngw * 64) { const int t = (int)(i >> 5), k = (int)(i & 31);
              const double inv = exp(-(double)k * (9.210340371976184 / 32.0)); const double ang = (double)pos[t] * inv; double s, c; sincos(ang, &s, &c); ROPE[i] = (f32x2){(float)c, (float)s}; } }
        { const float* fw1 = args.in[I_HY_FW1]; const float* fb1 = args.in[I_HY_FB1]; const float* fw2 = args.in[I_HY_FW2]; const float* fb2 = args.in[I_HY_FB2];
          const float* fw3 = args.in[I_HY_FW3]; const float* fb3 = args.in[I_HY_FB3]; const float fr = args.in[I_HY_FREQ][lane];
          for (int l = gw; l < SEQ; l += ngw) {
              const float tt = (float)l / (float)(SEQ - 1); const float w = 6.283185307179586f * (float)l / (float)SEQ;
              float z = 0.f;
              if (lane == 0) z = tt;
              else if (lane <= 16) { const float f = 1e-4f + (float)(lane - 1) * ((15.0f - 1e-4f) / 15.0f); z = cosf(f * w); }
              else if (lane <= 32) { const float f = 1e-4f + (float)(lane - 17) * ((15.0f - 1e-4f) / 15.0f); z = -sinf(f * w); }
              float a = fb1[lane];
#pragma unroll
              for (int i = 0; i < HEMB; ++i) a += __shfl(z, i) * fw1[i * HF + lane];
              float h = sinf(fr * a);
              a = fb2[lane];
#pragma unroll 8
              for (int i = 0; i < HF; ++i) a += __shfl(h, i) * fw2[i * HF + lane];
              h = sinf(fr * a);
              a = fb3[lane];
#pragma unroll 8
              for (int i = 0; i < HF; ++i) a += __shfl(h, i) * fw3[i * HF + lane];
              h = sinf(fr * a);
              H3[(size_t)l * HKP + lane] = (bf16)(pkbf(h, 0.f) & 0xffffu);
          } }
    }
    SEAM(0);
#define B1 GEMM(EpiF32, XB, Win_t, T, MLA_INP, DM, H1, MLA_INP)
    RUN(1, B1, B1);
    SEAM(1);
#define B2 mla_norm_rope(H1, args.in[I_MLA_GQ], args.in[I_MLA_GKV], ROPE, CQN, CKVN, Kb, gw, ngw, lane)
    RUN(2, B2, B2);
    SEAM(2);
#define B3 do { GEMM(EpiBf16, CQN, Wuq_t, T, NH * DQK, QLORA, Qb, NH * DQK, QSCALE); GEMM(EpiKV, CKVN, Wukv_t, T, NH * 256, KVLORA, Kb, Vb); } while (0)
    RUN(3, B3, B3);
    SEAM(3);
#define B4 do { for (int u = bx; u < BATCH * NH * (SEQ / 256); u += G) { const int qb = u & 63, h = (u >> 6) & 7, b = u >> 9; const size_t r0 = (size_t)b * SEQ + (size_t)qb * 256; \
            attn::attn_unit(Qb + r0 * 1536 + h * DQK, Kb + (size_t)b * SEQ * 1536 + h * DQK, Vb + (size_t)b * SEQ * 1024 + h * DVH, XB + r0 * 1024 + h * DVH, (const float*)(ROPE + r0 * 32), SEQ, (char*)lds, wave); } } while (0)
    RUN(4, B4, B4);
#ifdef SELFCHECK
    if (IN(4) && IN(5)) { GRIDBAR(); selfcheck_mla(args, ldsl, bx, tid); }
#endif
    SEAM(4);
#define B5 GEMM(EpiResid, XB, Wo_t, T, DM, DM, args.in[I_X], XF, DN_ALPHA)
    RUN(5, B5, B5);
    SEAM(5);
    RUN(6, ln_rows(XF, XF, XB, args.in[I_LN1G], args.in[I_LN1B], gw, ngw, lane), ln_rows(XF, OUT, XB, args.in[I_LN1G], args.in[I_LN1B], gw, ngw, lane));
    SEAM(6);
#define HACT P_(bf16, WS_S)
#define HALO P_(float, WS_S + 180 * MiB)
#define FFN_UP(layer) GEMM(EpiConvSilu, XB, Wup_t + (size_t)(layer) * NUP * DM, T, NUP, DM, HACT, args.in[I_FFN_WCONV] + (size_t)(layer) * 3 * NUP, HALO, (PG8_LAS float*)(ldsl + RING_BYTES))
#define FFN_FIX(layer) ffn_fixup_rows(HALO, args.in[I_FFN_WCONV] + (size_t)(layer) * 3 * NUP, HACT, gw, ngw, lane)
#define FFN_DN(layer, OUT_) GEMM(EpiResid, HACT, Wdn_t + (size_t)(layer) * DM * DFF, T, DM, DFF, XF, (OUT_), DN_ALPHA)
#define FFN_LAYER(p, layer) \
    RUN(p, FFN_UP(layer), FFN_UP(layer)); SEAM(p); \
    RUN((p) + 1, FFN_FIX(layer), FFN_FIX(layer)); SEAM((p) + 1); \
    RUN((p) + 2, FFN_DN(layer, XF), FFN_DN(layer, OUT)); if (IN((p) + 2) && IN((p) + 6)) GRIDBAR();
    FFN_LAYER(7, 0)
    RUN(13, ln_rows(XF, XF, XB, args.in[I_LN2G], args.in[I_LN2B], gw, ngw, lane), ln_rows(XF, P_(float, WS_S), XB, args.in[I_LN2G], args.in[I_LN2B], gw, ngw, lane));
    SEAM(13);
#define B14 GEMM(EpiBf16, XB, Whin_t, T, 3 * DM, DM, U, 3 * DM, 1.0f)
    RUN(14, B14, B14);
    SEAM(14);
#define B15 hy_conv_transpose(U, args.in[I_HY_WSHORT], VC0, VC1, G1C, G2C, (LAS unsigned*)(ldsl + wave * 16384), gw, ngw, lane)
    RUN(15, B15, B15);
    SEAM(15);
#define HY_FILT(od) GEMM(EpiFilt, H3, Wfo_t + (size_t)(od) * 2048 * HKP, SEQ, 2 * DM, HKP, KT, SEQ, -120.39728043259360f, (40.54651081081644f + 120.39728043259360f) / 1023.0f, 1.0f / (float)(SEQ - 1))
#define HY_FFT(MODE_, GC_, DB_) do { for (int c = bx; c < DM; c += G) { const size_t co = (size_t)c * SEQ; \
            fftc::hyena_channel<MODE_>((fftc::lf2*)ldsl, VC0 + co, VC1 + co, KT + co, KT + (size_t)DM * SEQ + co, (GC_) + co, (GC_) + (size_t)DM * SEQ + co, args.in[I_HY_DBIAS][(DB_) + c], \
                                       VC0 + co, VC1 + co, Z3C + co, Z3C + (size_t)DM * SEQ + co, STASH + (size_t)bx * SEQ, KSPEC + (size_t)bx * SEQ, tid); } } while (0)
    RUN(16, HY_FILT(0), HY_FILT(0)); SEAM(16);
    RUN(17, HY_FFT(0, G1C, 0), HY_FFT(2, G1C, 0)); SEAM(17);
    RUN(18, HY_FILT(1), HY_FILT(1)); SEAM(18);
    RUN(19, HY_FFT(1, G2C, DM), HY_FFT(1, G2C, DM)); SEAM(19);
#define B20 hy_transpose_back(Z3C, XB, (LAS unsigned*)(ldsl + wave * 16384), gw, ngw, lane)
    RUN(20, B20, B20);
    SEAM(20);
    RUN(21, GEMM(EpiResid, XB, Who_t, T, DM, DM, XF, XF, DN_ALPHA), GEMM(EpiResid, XB, Who_t, T, DM, DM, XF, P_(float, WS_S), DN_ALPHA));
    SEAM(21);
    RUN(22, ln_rows(XF, XF, XB, args.in[I_LN1G] + DM, args.in[I_LN1B] + DM, gw, ngw, lane), ln_rows(XF, P_(float, WS_S), XB, args.in[I_LN1G] + DM, args.in[I_LN1B] + DM, gw, ngw, lane));
    SEAM(22);
    FFN_LAYER(23, 1)
#ifdef SELFCHECK
    if (IN(29)) { const unsigned mask = __hip_atomic_load((unsigned*)(args.ws + WS_CTL) + CW_CHK, __ATOMIC_RELAXED, __HIP_MEMORY_SCOPE_AGENT);
        ln_rows(XF, OUT, nullptr, args.in[I_LN2G] + DM, args.in[I_LN2B] + DM, gw, ngw, lane, 1.0f + 0.1f * (float)mask); }
#else
    RUN(29, ln_rows(XF, OUT, nullptr, args.in[I_LN2G] + DM, args.in[I_LN2B] + DM, gw, ngw, lane), ln_rows(XF, OUT, nullptr, args.in[I_LN2G] + DM, args.in[I_LN2B] + DM, gw, ngw, lane));
#endif
#undef IN
#undef SEAM
#undef lane
#undef tid
#undef G
#undef bx
#undef gw
#undef ngw
}

extern "C" void kernel_launch(void* const* d_in, const int* in_sizes, int n_in, void* d_out, int out_size, void* d_ws, size_t ws_size, hipStream_t stream) {
    static int grid = 0;
    if (grid == 0) {
        if (n_in != 27 || in_sizes[0] != T * DM || out_size != T * DM || ws_size < WS_END) { fprintf(stderr, "kernel_launch: shape/workspace mismatch (n_in %d, in0 %d, out %d, ws %zu)\n", n_in, n_in > 0 ? in_sizes[0] : -1, out_size, ws_size); grid = -1; return; }
        int dev = 0, cus = 0, per_cu = 0;
        if (hipGetDevice(&dev) != hipSuccess || hipDeviceGetAttribute(&cus, hipDeviceAttributeMultiprocessorCount, dev) != hipSuccess) { grid = -1; return; }
        if (hipFuncSetAttribute((const void*)mega_fwd, hipFuncAttributeMaxDynamicSharedMemorySize, LDS_BYTES) != hipSuccess) { fprintf(stderr, "kernel_launch: hipFuncSetAttribute failed\n"); grid = -1; return; }
        if (hipOccupancyMaxActiveBlocksPerMultiprocessor(&per_cu, (const void*)mega_fwd, NWAVES * 64, LDS_BYTES) != hipSuccess || per_cu < 1) { fprintf(stderr, "kernel_launch: occupancy query says %d\n", per_cu); }
        (void)hipGetLastError();
        grid = cus;
    }
    if (grid < 0) return;
    if (hipMemsetAsync((char*)d_ws + WS_CTL, 0, CTL_ZERO_BYTES, stream) != hipSuccess) return;
    Args a{};
    for (int i = 0; i < 27; ++i) a.in[i] = (const float*)d_in[i];
    a.out = (float*)d_out; a.ws = (unsigned char*)d_ws;
#if MK_PER_PHASE
    for (int p = 0; p < N_PHASES; ++p) { a.ph_lo = p; a.ph_hi = p + 1; hipLaunchKernelGGL(mega_fwd, dim3(grid), dim3(NWAVES * 64), LDS_BYTES, stream, a); }
#else
    a.ph_lo = 0; a.ph_hi = N_PHASES; hipLaunchKernelGGL(mega_fwd, dim3(grid), dim3(NWAVES * 64), LDS_BYTES, stream, a);
#endif
}
```

```cpp
#include <hip/hip_runtime.h>
#include <cstdio>
#include <cstdint>
__device__ __forceinline__ int hw_lane() { int l; asm volatile("v_mbcnt_lo_u32_b32 %0, -1, 0\n\tv_mbcnt_hi_u32_b32 %0, -1, %0" : "=v"(l)); return l; }
namespace pg8 {
#define PG8_LAS __attribute__((address_space(3)))
typedef unsigned short bf16_t;
typedef short bf16x8 __attribute__((ext_vector_type(8)));
typedef float f32x4 __attribute__((ext_vector_type(4)));
typedef unsigned u32x4 __attribute__((ext_vector_type(4)));
constexpr int BM = 256, BK = 64, HALF = 128, HTB = HALF * BK * 2  , STAGE_BYTES = 8 * HTB, NXCD = 8, WGM = 8;

__host__ __device__ __forceinline__ int lds_byte(int r, int c) { const int st = (r >> 4) * 2 + (c >> 5), rr = r & 15, cc = c & 31, ob = rr * 64 + cc * 2; return st * 1024 + (ob ^ (((ob >> 9) & 1) << 5)); }
__host__ __device__ __forceinline__ void stage_rc(int b, int& R, int& C) { const int st = b / 1024, sb = b % 1024, swz = sb ^ (((sb >> 9) & 1) << 5); R = (st >> 1) * 16 + swz / 64; C = (st & 1) * 32 + (swz % 64) / 2; }
__host__ __device__ __forceinline__ int perm32(int rho) { const int n = rho >> 4, i = rho & 15; return 8 * (i >> 2) + 4 * n + (i & 3); }

struct Unit { int pm, pn; };
struct Gemm { const bf16_t* A; const bf16_t* Bt; int M, N, K; };

struct StaticOrder {
    int nM, nN, nwg, G, c;
    __host__ __device__ void init(int M, int N, int G_, int c_) { nM = M / BM; nN = N / BM; nwg = nM * nN; G = G_; c = c_; }
    __host__ __device__ bool next(int i, Unit& u) const {
        const long L = (long)i * G + c; if (L >= nwg) return false;
        int wgid = (int)L; { const int q = nwg / NXCD, r = nwg % NXCD, xcd = wgid % NXCD, off = wgid / NXCD; wgid = (xcd < r ? xcd * (q + 1) : r * (q + 1) + (xcd - r) * q) + off; }
        const int nig = WGM * nN, gid = wgid / nig, fm = gid * WGM, gsz = (nM - fm) < WGM ? (nM - fm) : WGM;
        u.pm = fm + ((wgid % nig) % gsz); u.pn = (wgid % nig) / gsz; return true;
    }
    __device__ __forceinline__ void a_ready(const Unit&) const {}
    __device__ __forceinline__ void done(const Unit&) const {}
};

__device__ __forceinline__ unsigned cvt_pk_bf16(float lo, float hi) { unsigned r; asm volatile("v_cvt_pk_bf16_f32 %0, %1, %2" : "=v"(r) : "v"(lo), "v"(hi)); return r; }
typedef float f32x2 __attribute__((ext_vector_type(2)));

struct EpiF32 {
    static constexpr bool PERM = false, AFTER_DRAIN = false;
    float* C; int ldc;
    __device__ __forceinline__ void operator()(const f32x4 (&acc)[2][2][4][2], const Unit& u_, int wr, int wc, int fr, int fq) const {
        Unit u = u_; asm volatile("" : "+s"(u.pm), "+s"(u.pn)); { const int l_ = hw_lane(); fr = l_ & 15; fq = l_ >> 4; }
        const int row0 = u.pm * BM + wr * 64 + fr, col0 = u.pn * BM + wc * 32 + 4 * fq;
#pragma unroll
        for (int ai = 0; ai < 2; ++ai)
#pragma unroll
            for (int m = 0; m < 4; ++m) { float* rowp = C + (size_t)(row0 + ai * HALF + m * 16) * ldc + col0;
#pragma unroll
                for (int bj = 0; bj < 2; ++bj)
#pragma unroll
                    for (int n = 0; n < 2; ++n) *(f32x4*)(rowp + bj * HALF + n * 16) = acc[ai][bj][m][n]; }
    }
};
struct EpiBf16 {
    static constexpr bool PERM = true, AFTER_DRAIN = false;
    bf16_t* O; int ldc; float scale;
    __device__ __forceinline__ void operator()(const f32x4 (&acc)[2][2][4][2], const Unit& u_, int wr, int wc, int fr, int fq) const {
        Unit u = u_; asm volatile("" : "+s"(u.pm), "+s"(u.pn)); { const int l_ = hw_lane(); fr = l_ & 15; fq = l_ >> 4; }
        const int row0 = u.pm * BM + wr * 64 + fr, col0 = u.pn * BM + wc * 32 + 8 * fq;
#pragma unroll
        for (int ai = 0; ai < 2; ++ai)
#pragma unroll
            for (int m = 0; m < 4; ++m) { bf16_t* rowp = O + (size_t)(row0 + ai * HALF + m * 16) * ldc + col0;
#pragma unroll
                for (int bj = 0; bj < 2; ++bj) { const f32x4 v0 = acc[ai][bj][m][0] * scale, v1 = acc[ai][bj][m][1] * scale;
                    u32x4 w; w.x = cvt_pk_bf16(v0[0], v0[1]); w.y = cvt_pk_bf16(v0[2], v0[3]); w.z = cvt_pk_bf16(v1[0], v1[1]); w.w = cvt_pk_bf16(v1[2], v1[3]);
                    *(u32x4*)(rowp + bj * HALF) = w; } }
    }
};
struct EpiResid {
    static constexpr bool PERM = false, AFTER_DRAIN = false;
    const float* base; float* out; float alpha;
    __device__ __forceinline__ void operator()(const f32x4 (&acc)[2][2][4][2], const Unit& u_, int wr, int wc, int fr, int fq) const {
        Unit u = u_; asm volatile("" : "+s"(u.pm), "+s"(u.pn)); { const int l_ = hw_lane(); fr = l_ & 15; fq = l_ >> 4; }
        const int row0 = u.pm * BM + wr * 64 + fr, col0 = u.pn * BM + wc * 32 + 4 * fq;
#pragma unroll
        for (int ai = 0; ai < 2; ++ai)
#pragma unroll
            for (int m = 0; m < 4; ++m) { const size_t off = (size_t)(row0 + ai * HALF + m * 16) * 1024 + col0;
#pragma unroll
                for (int bj = 0; bj < 2; ++bj)
#pragma unroll
                    for (int n = 0; n < 2; ++n) { const f32x4 bs = *(const f32x4*)(base + off + bj * HALF + n * 16);
                        *(f32x4*)(out + off + bj * HALF + n * 16) = bs * alpha + acc[ai][bj][m][n]; }
                if (m & 1) asm volatile("" ::: "memory"); }
    }
};
struct EpiResidB {
    static constexpr bool PERM = false, AFTER_DRAIN = false;
    const bf16_t* base; float* out; float alpha;
    __device__ __forceinline__ void operator()(const f32x4 (&acc)[2][2][4][2], const Unit& u_, int wr, int wc, int fr, int fq) const {
        Unit u = u_; asm volatile("" : "+s"(u.pm), "+s"(u.pn)); { const int l_ = hw_lane(); fr = l_ & 15; fq = l_ >> 4; }
        const int row0 = u.pm * BM + wr * 64 + fr, col0 = u.pn * BM + wc * 32 + 4 * fq;
        typedef unsigned u32x2 __attribute__((ext_vector_type(2)));
#pragma unroll
        for (int ai = 0; ai < 2; ++ai)
#pragma unroll
            for (int m = 0; m < 4; ++m) { const size_t off = (size_t)(row0 + ai * HALF + m * 16) * 1024 + col0;
#pragma unroll
                for (int bj = 0; bj < 2; ++bj)
#pragma unroll
                    for (int n = 0; n < 2; ++n) { const u32x2 b = *(const u32x2*)(base + off + bj * HALF + n * 16);
                        const f32x4 bs = {__uint_as_float(b.x << 16), __uint_as_float(b.x & 0xffff0000u), __uint_as_float(b.y << 16), __uint_as_float(b.y & 0xffff0000u)};
                        *(f32x4*)(out + off + bj * HALF + n * 16) = bs * alpha + acc[ai][bj][m][n]; }
                if (m & 1) asm volatile("" ::: "memory"); }
    }
};
struct EpiKV {
    static constexpr bool PERM = true, AFTER_DRAIN = false;
    unsigned char* Kb; bf16_t* Vb;
    __device__ __forceinline__ void operator()(const f32x4 (&acc)[2][2][4][2], const Unit& u_, int wr, int wc, int fr, int fq) const {
        Unit u = u_; asm volatile("" : "+s"(u.pm), "+s"(u.pn)); { const int l_ = hw_lane(); fr = l_ & 15; fq = l_ >> 4; }
        const int row0 = u.pm * BM + wr * 64 + fr, col0 = u.pn * BM + wc * 32 + 8 * fq;
        typedef unsigned u32x2 __attribute__((ext_vector_type(2)));
#pragma unroll
        for (int bj = 0; bj < 2; ++bj) { const int c = col0 + bj * HALF; const bool isk = c < 1024;
#pragma unroll
            for (int ai = 0; ai < 2; ++ai)
#pragma unroll
                for (int m = 0; m < 4; ++m) { const int row = row0 + ai * HALF + m * 16; const f32x4 v0 = acc[ai][bj][m][0], v1 = acc[ai][bj][m][1];
                    if (isk) { u32x2 w; int t = __builtin_amdgcn_cvt_pk_fp8_f32(v0[0], v0[1], 0, false); t = __builtin_amdgcn_cvt_pk_fp8_f32(v0[2], v0[3], t, true); w.x = (unsigned)t;
                        t = __builtin_amdgcn_cvt_pk_fp8_f32(v1[0], v1[1], 0, false); t = __builtin_amdgcn_cvt_pk_fp8_f32(v1[2], v1[3], t, true); w.y = (unsigned)t;
                        *(u32x2*)(Kb + (size_t)row * 1536 + (c >> 7) * 192 + (c & 127)) = w; }
                    else { u32x4 w; w.x = cvt_pk_bf16(v0[0], v0[1]); w.y = cvt_pk_bf16(v0[2], v0[3]); w.z = cvt_pk_bf16(v1[0], v1[1]); w.w = cvt_pk_bf16(v1[2], v1[3]);
                        *(u32x4*)(Vb + (size_t)row * 1024 + (c - 1024)) = w; } } }
    }
};
#define DPP_SHR1 0x111
#define DPP_SHL1 0x101
#define DPP_SHL15 0x10F
#define DPP_SHR15 0x11F
template <int CTRL> __device__ __forceinline__ float dpp_mov(float old, float src) { return __int_as_float(__builtin_amdgcn_update_dpp(__float_as_int(old), __float_as_int(src), CTRL, 0xF, 0xF, false)); }
struct EpiConvSilu {
    static constexpr bool PERM = true, AFTER_DRAIN = false;
    bf16_t* H; const float* wcv; float* halo; PG8_LAS float* ex;
    __device__ __forceinline__ void operator()(const f32x4 (&acc)[2][2][4][2], const Unit& u_, int wr, int wc, int fr, int fq) const {
        Unit u = u_; asm volatile("" : "+s"(u.pm), "+s"(u.pn)); { const int l_ = hw_lane(); fr = l_ & 15; fq = l_ >> 4; }
        const int hc0 = wc * 32 + 8 * fq;
#pragma unroll
        for (int ai = 0; ai < 2; ++ai)
#pragma unroll
            for (int bj = 0; bj < 2; ++bj)
#pragma unroll
                for (int n = 0; n < 2; ++n) {
                    if (fr == 0)  *(PG8_LAS f32x4*)(ex + ((ai * 2 + wr) * 2 + 0) * 256 + bj * 128 + hc0 + 4 * n) = acc[ai][bj][0][n];
                    if (fr == 15) *(PG8_LAS f32x4*)(ex + ((ai * 2 + wr) * 2 + 1) * 256 + bj * 128 + hc0 + 4 * n) = acc[ai][bj][3][n]; }
        if (wr == 0 && fr < 2) {
#pragma unroll
            for (int bj = 0; bj < 2; ++bj)
#pragma unroll
                for (int n = 0; n < 2; ++n) *(f32x4*)(halo + ((size_t)u.pm * 4 + fr) * 5632 + u.pn * 256 + bj * 128 + hc0 + 4 * n) = acc[0][bj][0][n]; }
        if (wr == 1 && fr >= 14) {
#pragma unroll
            for (int bj = 0; bj < 2; ++bj)
#pragma unroll
                for (int n = 0; n < 2; ++n) *(f32x4*)(halo + ((size_t)u.pm * 4 + 2 + (fr - 14)) * 5632 + u.pn * 256 + bj * 128 + hc0 + 4 * n) = acc[1][bj][3][n]; }
        asm volatile("s_waitcnt lgkmcnt(0)" ::: "memory"); __builtin_amdgcn_s_barrier(); asm volatile("" ::: "memory");
        float wv[2][3][8];
        { const int cg = u.pn * 128 + hc0;
#pragma unroll
          for (int bj = 0; bj < 2; ++bj)
#pragma unroll
            for (int k = 0; k < 3; ++k) { const f32x4 t0 = *(const f32x4*)(wcv + k * 5632 + bj * 2816 + cg), t1 = *(const f32x4*)(wcv + k * 5632 + bj * 2816 + cg + 4);
                wv[bj][k][0] = t0[0]; wv[bj][k][1] = t0[1]; wv[bj][k][2] = t0[2]; wv[bj][k][3] = t0[3]; wv[bj][k][4] = t1[0]; wv[bj][k][5] = t1[1]; wv[bj][k][6] = t1[2]; wv[bj][k][7] = t1[3]; } }
#pragma unroll
        for (int ai = 0; ai < 2; ++ai) {
            const int ch = ai * 2 + wr, cp = ch > 0 ? ch - 1 : 0, cn = ch < 3 ? ch + 1 : 3;
            f32x4 pe[2][2], ne[2][2];
#pragma unroll
            for (int bj = 0; bj < 2; ++bj)
#pragma unroll
                for (int n = 0; n < 2; ++n) { pe[bj][n] = *(const PG8_LAS f32x4*)(ex + (cp * 2 + 1) * 256 + bj * 128 + hc0 + 4 * n); ne[bj][n] = *(const PG8_LAS f32x4*)(ex + (cn * 2 + 0) * 256 + bj * 128 + hc0 + 4 * n); }
#pragma unroll
            for (int m = 0; m < 4; ++m) {
                float hv[2][8];
#pragma unroll
                for (int bj = 0; bj < 2; ++bj)
#pragma unroll
                    for (int n = 0; n < 2; ++n)
#pragma unroll
                        for (int j = 0; j < 4; ++j) {
                            const float cur = acc[ai][bj][m][n][j];
                            const float pin = (m > 0) ? dpp_mov<DPP_SHL15>(0.f, acc[ai][bj][m > 0 ? m - 1 : 0][n][j]) : pe[bj][n][j];
                            const float nin = (m < 3) ? dpp_mov<DPP_SHR15>(0.f, acc[ai][bj][m < 3 ? m + 1 : 3][n][j]) : ne[bj][n][j];
                            const float prv = dpp_mov<DPP_SHR1>(pin, cur), nxt = dpp_mov<DPP_SHL1>(nin, cur);
                            hv[bj][4 * n + j] = wv[bj][0][4 * n + j] * prv + wv[bj][1][4 * n + j] * cur + wv[bj][2][4 * n + j] * nxt; }
                float o[8];
#pragma unroll
                for (int i = 0; i < 8; ++i) o[i] = hv[0][i] * hv[1][i] * __builtin_amdgcn_rcpf(1.f + __expf(-hv[1][i]));
                u32x4 w; w.x = cvt_pk_bf16(o[0], o[1]); w.y = cvt_pk_bf16(o[2], o[3]); w.z = cvt_pk_bf16(o[4], o[5]); w.w = cvt_pk_bf16(o[6], o[7]);
                *(u32x4*)(H + (size_t)(u.pm * BM + ai * HALF + wr * 64 + m * 16 + fr) * 2816 + u.pn * 128 + hc0) = w;
            }
        }
        asm volatile("s_waitcnt lgkmcnt(0)" ::: "memory"); __builtin_amdgcn_s_barrier(); asm volatile("" ::: "memory");
    }
};

struct EpiFilt {
    static constexpr bool PERM = false, AFTER_DRAIN = false;
    float* KT; int L; float d0, dstep, tinv;
    __device__ __forceinline__ void operator()(const f32x4 (&acc)[2][2][4][2], const Unit& u_, int wr, int wc, int fr, int fq) const {
        Unit u = u_; asm volatile("" : "+s"(u.pm), "+s"(u.pn)); { const int l_ = hw_lane(); fr = l_ & 15; fq = l_ >> 4; }
        const int row0 = u.pm * BM + wr * 64 + fr, col0 = u.pn * BM + wc * 32 + 4 * fq;
#pragma unroll
        for (int bj = 0; bj < 2; ++bj)
#pragma unroll
            for (int n = 0; n < 2; ++n) { const int c = col0 + bj * HALF + n * 16;
#pragma unroll
                for (int j = 0; j < 4; ++j) { const int cc = c + j, ch = cc & 1023; const float nd = -__builtin_fabsf(d0 + (float)ch * dstep) * tinv; float* dst = KT + (size_t)cc * L;
#pragma unroll
                    for (int ai = 0; ai < 2; ++ai)
#pragma unroll
                        for (int m = 0; m < 4; ++m) { const int l = row0 + ai * HALF + m * 16; dst[l] = acc[ai][bj][m][n][j] * __expf(nd * (float)l); } } }
    }
};

template <class Epi, class Sched, bool ALIGN_EPI = false, bool SP2 = false>
__device__ __forceinline__ void gemm_phase(PG8_LAS unsigned char* lds, const Gemm g, const Sched& S, const Epi& E, int wid_in) {
    const int wid = wid_in, lane = hw_lane(), tid = wid * 64 + lane, wr = wid >> 2, wc = wid & 3, fr = lane & 15, fq = lane >> 4;
    const int K = g.K, nt = K / BK;
    unsigned voffA[2], voffB[2];
#pragma unroll
    for (int i = 0; i < 2; ++i) { int R, C; stage_rc(tid * 16 + i * 8192, R, C); const int Rb = Epi::PERM ? ((R & ~31) + perm32(R & 31)) : R;
        voffA[i] = (unsigned)(R * K + C) * 2u; voffB[i] = (unsigned)(Rb * K + C) * 2u; }
    const size_t kstep = (size_t)(BK * 2);
    const size_t hstep = (size_t)HALF * K * 2;
    const size_t tstep = 2 * hstep;
    const unsigned ldsw = (unsigned)wid * 1024u;
    const int aoff = lds_byte(wr * 64 + fr, fq * 8), boff = lds_byte(wc * 32 + fr, fq * 8);
#define PG8_SA(b, h) (((b) * 2 + (h)) * HTB)
#define PG8_SB(b, h) ((4 + (b) * 2 + (h)) * HTB)
#define PG8_STAGE(bufoff, gbase, voff) do { _Pragma("unroll") for (int _i = 0; _i < 2; ++_i) \
        __builtin_amdgcn_global_load_lds((const unsigned*)((const char*)(gbase) + (voff)[_i]), (PG8_LAS unsigned*)(lds + (bufoff) + ldsw + _i * 8192), 16, 0, 0); } while (0)
#define PG8_LDA(dst, b, h) do { _Pragma("unroll") for (int m = 0; m < 4; ++m) _Pragma("unroll") for (int k = 0; k < 2; ++k) dst[m][k] = *(const PG8_LAS bf16x8*)(lds + PG8_SA(b, h) + aoff + m * 2048 + k * 1024); } while (0)
#define PG8_LDB(dst, b, h) do { _Pragma("unroll") for (int n = 0; n < 2; ++n) _Pragma("unroll") for (int k = 0; k < 2; ++k) dst[n][k] = *(const PG8_LAS bf16x8*)(lds + PG8_SB(b, h) + boff + n * 2048 + k * 1024); } while (0)
#define PG8_MMA(ai, bj, At, Bt) do { __builtin_amdgcn_s_setprio(1); _Pragma("unroll") for (int m = 0; m < 4; ++m) _Pragma("unroll") for (int n = 0; n < 2; ++n) _Pragma("unroll") for (int k = 0; k < 2; ++k) \
        acc[ai][bj][m][n] = __builtin_amdgcn_mfma_f32_16x16x32_bf16(Bt[n][k], At[m][k], acc[ai][bj][m][n], 0, 0, 0); __builtin_amdgcn_s_setprio(0); } while (0)
#define PG8_WAIT_V(n) asm volatile("s_waitcnt vmcnt(" #n ")" ::: "memory")
#define PG8_WAIT_L(n) asm volatile("s_waitcnt lgkmcnt(" #n ")" ::: "memory")
#define PG8_BAR __builtin_amdgcn_s_barrier()
#define PG8_SCHED __builtin_amdgcn_sched_barrier(0)
    Unit cur, nxt; int ui = 0;
    if (!S.next(0, cur)) return;
    f32x4 acc[2][2][4][2];
#pragma unroll
    for (int a = 0; a < 2; ++a)
#pragma unroll
        for (int b = 0; b < 2; ++b)
#pragma unroll
            for (int m = 0; m < 4; ++m)
#pragma unroll
                for (int n = 0; n < 2; ++n) acc[a][b][m][n] = (f32x4){0.f, 0.f, 0.f, 0.f};
    bf16x8 At[4][2], B0[2][2], B1[2][2];
    const char* cA = (const char*)g.A + (size_t)cur.pm * tstep; const char* cB = (const char*)g.Bt + (size_t)cur.pn * tstep;
    S.a_ready(cur);
    if constexpr (SP2) {
        PG8_STAGE(PG8_SB(0, 0), cB, voffB); PG8_STAGE(PG8_SB(0, 1), cB + hstep, voffB); PG8_STAGE(PG8_SA(0, 0), cA, voffA); PG8_STAGE(PG8_SA(0, 1), cA + hstep, voffA);
        if (wr == 1) PG8_BAR;
        PG8_WAIT_V(2); PG8_BAR;
        PG8_STAGE(PG8_SB(1, 0), cB + kstep, voffB); PG8_STAGE(PG8_SA(1, 0), cA + kstep, voffA); PG8_STAGE(PG8_SB(1, 1), cB + hstep + kstep, voffB);
        PG8_WAIT_V(6); PG8_BAR;
    } else {
        PG8_STAGE(PG8_SB(0, 0), cB, voffB); PG8_STAGE(PG8_SA(0, 0), cA, voffA); PG8_STAGE(PG8_SB(0, 1), cB + hstep, voffB); PG8_STAGE(PG8_SA(0, 1), cA + hstep, voffA);
        if (wr == 1) PG8_BAR;
        PG8_WAIT_V(4); PG8_BAR;
        PG8_STAGE(PG8_SB(1, 0), cB + kstep, voffB); PG8_STAGE(PG8_SA(1, 0), cA + kstep, voffA); PG8_STAGE(PG8_SB(1, 1), cB + hstep + kstep, voffB);
        PG8_WAIT_V(6); PG8_BAR;
    }
    for (;;) {
        const bool has_next = S.next(ui + 1, nxt);
        const char* nA = has_next ? (const char*)g.A + (size_t)nxt.pm * tstep : cA; const char* nB = has_next ? (const char*)g.Bt + (size_t)nxt.pn * tstep : cB;
        for (int t = 0; t < nt; t += 2) {
            const bool last = (t == nt - 2);
            const char* a1 = cA + (size_t)(t + 1) * kstep;
            const char* a2 = last ? nA : cA + (size_t)(t + 2) * kstep; const char* b2 = last ? nB : cB + (size_t)(t + 2) * kstep;
            const char* a3 = a2 + kstep; const char* b3 = b2 + kstep;
            if (last && has_next) S.a_ready(nxt);
            if constexpr (SP2) {
            PG8_LDB(B0, 0, 0); PG8_LDB(B1, 0, 1); PG8_SCHED; PG8_LDA(At, 0, 0); PG8_STAGE(PG8_SA(1, 1), a1 + hstep, voffA);
            PG8_WAIT_V(8); PG8_WAIT_L(0); PG8_BAR; PG8_MMA(0, 0, At, B0); PG8_MMA(0, 1, At, B1); PG8_BAR; PG8_SCHED;
            PG8_LDA(At, 0, 1); PG8_STAGE(PG8_SB(0, 0), b2, voffB); PG8_STAGE(PG8_SB(0, 1), b2 + hstep, voffB); PG8_STAGE(PG8_SA(0, 0), a2, voffA);
            PG8_WAIT_V(8); PG8_WAIT_L(0); PG8_BAR; PG8_MMA(1, 0, At, B0); PG8_MMA(1, 1, At, B1); PG8_BAR; PG8_SCHED;
            PG8_LDB(B0, 1, 0); PG8_LDB(B1, 1, 1); PG8_SCHED; PG8_LDA(At, 1, 0); PG8_STAGE(PG8_SA(0, 1), a2 + hstep, voffA);
            PG8_WAIT_V(8); PG8_WAIT_L(0); PG8_BAR; PG8_MMA(0, 0, At, B0); PG8_MMA(0, 1, At, B1); PG8_BAR; PG8_SCHED;
            PG8_LDA(At, 1, 1); PG8_STAGE(PG8_SB(1, 0), b3, voffB); PG8_STAGE(PG8_SB(1, 1), b3 + hstep, voffB); PG8_STAGE(PG8_SA(1, 0), a3, voffA);
            PG8_WAIT_V(8); PG8_WAIT_L(0); PG8_BAR; PG8_MMA(1, 0, At, B0); PG8_MMA(1, 1, At, B1); PG8_BAR; PG8_SCHED;
            } else {
            PG8_LDB(B0, 0, 0); PG8_SCHED; PG8_LDA(At, 0, 0); PG8_STAGE(PG8_SA(1, 1), a1 + hstep, voffA);
            PG8_WAIT_L(8); PG8_BAR; PG8_WAIT_L(0); PG8_MMA(0, 0, At, B0); PG8_BAR; PG8_SCHED;
            PG8_LDB(B1, 0, 1); PG8_STAGE(PG8_SB(0, 0), b2, voffB);
            PG8_BAR; PG8_WAIT_L(0); PG8_MMA(0, 1, At, B1); PG8_BAR;
            PG8_LDA(At, 0, 1); PG8_STAGE(PG8_SA(0, 0), a2, voffA);
            PG8_BAR; PG8_WAIT_L(0); PG8_MMA(1, 0, At, B0); PG8_BAR; PG8_SCHED;
            PG8_STAGE(PG8_SB(0, 1), b2 + hstep, voffB);
            PG8_WAIT_V(6); PG8_BAR; PG8_MMA(1, 1, At, B1); PG8_BAR;
            PG8_LDB(B0, 1, 0); PG8_SCHED; PG8_LDA(At, 1, 0); PG8_STAGE(PG8_SA(0, 1), a2 + hstep, voffA);
            PG8_WAIT_L(8); PG8_BAR; PG8_WAIT_L(0); PG8_MMA(0, 0, At, B0); PG8_BAR; PG8_SCHED;
            PG8_LDB(B1, 1, 1); PG8_STAGE(PG8_SB(1, 0), b3, voffB);
            PG8_BAR; PG8_WAIT_L(0); PG8_MMA(0, 1, At, B1); PG8_BAR;
            PG8_LDA(At, 1, 1); PG8_STAGE(PG8_SA(1, 0), a3, voffA);
            PG8_BAR; PG8_WAIT_L(0); PG8_MMA(1, 0, At, B0); PG8_BAR; PG8_SCHED;
            PG8_STAGE(PG8_SB(1, 1), b3 + hstep, voffB);
            PG8_WAIT_V(6); PG8_BAR; PG8_MMA(1, 1, At, B1); PG8_BAR;
            }
        }
        if constexpr (ALIGN_EPI) { if (wr == 0) PG8_BAR; }
        if constexpr (!Epi::AFTER_DRAIN) { E(acc, cur, wr, wc, fr, fq); S.done(cur); }
        if (!has_next) break;
#pragma unroll
        for (int a = 0; a < 2; ++a)
#pragma unroll
            for (int b = 0; b < 2; ++b)
#pragma unroll
                for (int m = 0; m < 4; ++m)
#pragma unroll
                    for (int n = 0; n < 2; ++n) acc[a][b][m][n] = (f32x4){0.f, 0.f, 0.f, 0.f};
        cur = nxt; cA = nA; cB = nB; ++ui;
        if constexpr (ALIGN_EPI) { if (wr == 1) PG8_BAR; }
    }
    PG8_WAIT_V(0);
    if constexpr (!ALIGN_EPI) { if (wr == 0) PG8_BAR; }
    PG8_BAR;
    if constexpr (Epi::AFTER_DRAIN) { E.fused(acc, cur, wr, wc, fr, fq, lds, wid, lane); S.done(cur); }
#undef PG8_SA
#undef PG8_SB
#undef PG8_STAGE
#undef PG8_LDA
#undef PG8_LDB
#undef PG8_MMA
#undef PG8_WAIT_V
#undef PG8_WAIT_L
#undef PG8_BAR
#undef PG8_SCHED
}
}
#define GAS __attribute__((address_space(1)))
#define LAS __attribute__((address_space(3)))
typedef unsigned short bf16;
typedef unsigned v4u __attribute__((ext_vector_type(4)));
typedef float f32x4 __attribute__((ext_vector_type(4)));
typedef short bf16x8 __attribute__((ext_vector_type(8)));
typedef GAS unsigned gu32;
typedef GAS unsigned long long gu64;
#define RLX_AGENT __ATOMIC_RELAXED, __HIP_MEMORY_SCOPE_AGENT
#define LDS_WAIT() asm volatile("s_waitcnt lgkmcnt(0)" ::: "memory")
#define VM_WAIT() asm volatile("s_waitcnt vmcnt(0)" ::: "memory")
__device__ __forceinline__ unsigned long long rt() { return __builtin_amdgcn_s_memrealtime(); }
__device__ __forceinline__ unsigned f2bf(float f) { unsigned u = __builtin_bit_cast(unsigned, f); return (u + 0x7fffu + ((u >> 16) & 1u)) >> 16; }
__device__ __forceinline__ unsigned pk2(float lo, float hi) { return f2bf(lo) | (f2bf(hi) << 16); }

#define XB_TMO      128
#define XB_XCNT(j)  (256  + 64 * (j))
#define XB_XSUB(j)  (1280 + 64 * (j))
#define XB_XGEN(j)  (2304 + 64 * (j))
#define XB_TOP      3328
#define XB_TOPGEN   3392
#define XCD_BAR_WORDS 3456
#define XB_SPIN_CAP (1u << 18)

__device__ __forceinline__ unsigned xb_ld(unsigned* p)              { return __hip_atomic_load(p, __ATOMIC_RELAXED, __HIP_MEMORY_SCOPE_AGENT); }
__device__ __forceinline__ unsigned xb_add(unsigned* p, unsigned v) { return __hip_atomic_fetch_add(p, v, __ATOMIC_RELAXED, __HIP_MEMORY_SCOPE_AGENT); }
__device__ __forceinline__ unsigned xb_xcc_id() { return (unsigned)__builtin_amdgcn_s_getreg((3 << 11) | 20) & 0xFu; }
#define XB_SPIN(cond, bar) do { unsigned _sp = 0; while (cond) { __builtin_amdgcn_s_sleep(1); \
    if ((++_sp & 255u) == 0u) { if (xb_ld(&(bar)[XB_TMO])) break; if (_sp > XB_SPIN_CAP) { atomicAdd(&(bar)[XB_TMO], 1u); break; } } } } while (0)

struct XcdBarrier {
    unsigned* bar; unsigned x; unsigned wv;
    volatile LAS unsigned* st;
};

__device__ __forceinline__ XcdBarrier xcd_barrier_post(unsigned* bar, volatile LAS unsigned* st, unsigned wv) {
    XcdBarrier b; b.bar = bar; b.x = xb_xcc_id(); b.st = st; b.wv = wv;
    if (wv == 0u && hw_lane() == 0) (void)xb_add(&bar[XB_XCNT(b.x)], 1u);
    return b;
}
__device__ __forceinline__ void xcd_barrier_complete(unsigned* bar, unsigned x, unsigned& nloc, unsigned& nx) {
    const unsigned G = gridDim.x * gridDim.y * gridDim.z;
    unsigned sum, cnt, mine, sp = 0u;
    for (;;) {
        sum = 0u; cnt = 0u; mine = 0u;
#pragma unroll
        for (unsigned j = 0; j < 16; ++j) { const unsigned c = xb_ld(&bar[XB_XCNT(j)]); sum += c; cnt += (c > 0u) ? 1u : 0u; mine = (j == x) ? c : mine; }
        if (sum == G) break;
        __builtin_amdgcn_s_sleep(1);
        if ((++sp & 255u) == 0u) { if (xb_ld(&bar[XB_TMO])) break; if (sp > XB_SPIN_CAP) { atomicAdd(&bar[XB_TMO], 1u); break; } }
    }
    nloc = mine > 0u ? mine : 1u; nx = cnt > 0u ? cnt : 1u;
}

__device__ __forceinline__ void xcd_barrier(const XcdBarrier& b) {
    asm volatile("s_waitcnt vmcnt(0)" ::: "memory");
    __syncthreads();
    if (b.wv == 0u && hw_lane() == 0) {
        unsigned* bar = b.bar;
        __builtin_amdgcn_s_waitcnt(0);
        unsigned nloc = b.st[0], nx = b.st[1];
        if (nloc == 0u) { xcd_barrier_complete(bar, b.x, nloc, nx); b.st[0] = nloc; b.st[1] = nx; }
        const unsigned old = xb_add(&bar[XB_XSUB(b.x)], 1u);
        const unsigned gen = old / nloc;
        if (old + 1u == (gen + 1u) * nloc) {
            __builtin_amdgcn_fence(__ATOMIC_RELEASE, "agent");
            asm volatile("s_waitcnt vmcnt(0)" ::: "memory");
            const unsigned og = xb_add(&bar[XB_TOP], 1u);
            const unsigned tg = og / nx;
            if (og + 1u == (tg + 1u) * nx) xb_add(&bar[XB_TOPGEN], 1u);
            else XB_SPIN(xb_ld(&bar[XB_TOPGEN]) == tg, bar);
            __builtin_amdgcn_fence(__ATOMIC_ACQUIRE, "agent");
            xb_add(&bar[XB_XGEN(b.x)], 1u);
            asm volatile("s_waitcnt vmcnt(0)" ::: "memory");
        } else {
            XB_SPIN(xb_ld(&bar[XB_XGEN(b.x)]) == gen, bar);
            __builtin_amdgcn_fence(__ATOMIC_ACQUIRE, "agent");
            asm volatile("s_waitcnt vmcnt(0)" ::: "memory");
        }
    }
    __syncthreads();
}
namespace attn {
using f32x16 = __attribute__((ext_vector_type(16))) float;
using u32x4  = __attribute__((ext_vector_type(4))) unsigned;
constexpr int NW = 8, QBLK = 32, KVBLK = 64, DQ = 192, DVV = 128;
constexpr int LDQ = 1536, LDO = 1024;
constexpr float THRL = 7.0f;
#define SBAR() __builtin_amdgcn_sched_barrier(0)
__device__ __forceinline__ int crow(int r, int hi) { return (r & 3) + 8 * (r >> 2) + 4 * hi; }
typedef int v8i __attribute__((ext_vector_type(8)));
typedef int v4i __attribute__((ext_vector_type(4)));
__device__ __forceinline__ int pk8(float a, float b, float c, float d) { int t = __builtin_amdgcn_cvt_pk_fp8_f32(a, b, 0, false); return __builtin_amdgcn_cvt_pk_fp8_f32(c, d, t, true); }
__device__ __forceinline__ unsigned cvtpk(float lo, float hi) { unsigned r; asm volatile("v_cvt_pk_bf16_f32 %0, %1, %2" : "=v"(r) : "v"(lo), "v"(hi)); return r; }

__device__ __forceinline__ float softmaxPP(f32x16& p0, f32x16& p1, float& m_reg, f32x16& negm, float& l_reg, bool first, v8i& pa) {
  float a0 = fmaxf(fmaxf(p0[0], p0[1]), fmaxf(p0[2], p0[3])), a1 = fmaxf(fmaxf(p0[4], p0[5]), fmaxf(p0[6], p0[7])), a2 = fmaxf(fmaxf(p0[8], p0[9]), fmaxf(p0[10], p0[11])), a3 = fmaxf(fmaxf(p0[12], p0[13]), fmaxf(p0[14], p0[15]));
  a0 = fmaxf(a0, fmaxf(fmaxf(p1[0], p1[1]), fmaxf(p1[2], p1[3]))); a1 = fmaxf(a1, fmaxf(fmaxf(p1[4], p1[5]), fmaxf(p1[6], p1[7]))); a2 = fmaxf(a2, fmaxf(fmaxf(p1[8], p1[9]), fmaxf(p1[10], p1[11]))); a3 = fmaxf(a3, fmaxf(fmaxf(p1[12], p1[13]), fmaxf(p1[14], p1[15])));
  float pmax = fmaxf(fmaxf(a0, a1), fmaxf(a2, a3));
  { auto rr = __builtin_amdgcn_permlane32_swap(__float_as_uint(pmax), __float_as_uint(pmax), false, false); pmax = fmaxf(__uint_as_float(rr[0]), __uint_as_float(rr[1])); }
  float alpha = 1.f;
  if (__builtin_expect(first || __any(pmax > THRL), 0)) { const float dl = first ? pmax : fmaxf(pmax, 0.f); alpha = first ? 1.f : __builtin_amdgcn_exp2f(-dl); m_reg += dl;
    for (int r = 0; r < 16; ++r) { p0[r] -= dl; p1[r] -= dl; }
    for (int r = 0; r < 16; ++r) negm[r] = -m_reg; }
  for (int r = 0; r < 16; ++r) p0[r] = __builtin_amdgcn_exp2f(p0[r]);
  for (int r = 0; r < 16; ++r) p1[r] = __builtin_amdgcn_exp2f(p1[r]);
  float s0 = (p0[0] + p0[1]) + (p0[2] + p0[3]), s1 = (p0[4] + p0[5]) + (p0[6] + p0[7]), s2 = (p0[8] + p0[9]) + (p0[10] + p0[11]), s3 = (p0[12] + p0[13]) + (p0[14] + p0[15]);
  s0 += (p1[0] + p1[1]) + (p1[2] + p1[3]); s1 += (p1[4] + p1[5]) + (p1[6] + p1[7]); s2 += (p1[8] + p1[9]) + (p1[10] + p1[11]); s3 += (p1[12] + p1[13]) + (p1[14] + p1[15]);
  float ps = (s0 + s1) + (s2 + s3);
  { auto rr = __builtin_amdgcn_permlane32_swap(__float_as_uint(ps), __float_as_uint(ps), false, false); ps = __uint_as_float(rr[0]) + __uint_as_float(rr[1]); }
  l_reg = l_reg * alpha + ps;
#pragma unroll
  for (int w = 0; w < 4; ++w) { pa[w] = pk8(p0[4 * w], p0[4 * w + 1], p0[4 * w + 2], p0[4 * w + 3]); pa[4 + w] = pk8(p1[4 * w], p1[4 * w + 1], p1[4 * w + 2], p1[4 * w + 3]); }
  return alpha;
}
typedef unsigned short bf16r;
constexpr int KROWB = 192, LDKB = 1536, SHM_K3 = KVBLK * KROWB, SHM_V3 = KVBLK * DVV, NSLOT = 4;
constexpr int LDS_K3 = 0, LDS_V3 = NSLOT * SHM_K3, LDS_WS3 = LDS_V3 + NSLOT * SHM_V3, SHM_ATTN3 = LDS_WS3 + NW * 64 * 4;
__device__ __forceinline__ void glds16(const void* gsrc, unsigned lds_dst) { unsigned keep;
  asm volatile("s_mov_b32 %0, m0\n\ts_mov_b32 m0, %2\n\ts_nop 0\n\tglobal_load_lds_dwordx4 %1, off\n\ts_mov_b32 m0, %0" : "=&s"(keep) : "v"(gsrc), "s"(lds_dst) : "memory"); }
__device__ __forceinline__ float bfl(unsigned w) { return __uint_as_float(w << 16); }
__device__ __forceinline__ float bfh(unsigned w) { return __uint_as_float(w & 0xffff0000u); }
template <int AEXP> __device__ __forceinline__ void attn_unit(const bf16r* __restrict__ Qb, const unsigned char* __restrict__ Kh, const unsigned char* __restrict__ Vh, bf16r* __restrict__ Ob, const float* __restrict__ tab, int seq, char* lds, int wid) {
  const int lane = hw_lane(), r32 = lane & 31, hi = lane >> 5;
  const unsigned lds0 = (unsigned)(uintptr_t)lds;
  float* wsf = (float*)(lds + LDS_WS3) + wid * 64; float* li_l = wsf; float* al_l = wsf + 32;
  float m_reg = 0.f, l_reg = 0; f32x16 o[4] = {}; v8i qf[3]; f32x16 negm = {}; asm volatile("" : "+v"(negm));
  { const bf16r* Qw = Qb + (long)(wid * QBLK + r32) * LDQ + hi * 32;
#pragma unroll
    for (int s = 0; s < 2; ++s) { u32x4 q4[4];
#pragma unroll
      for (int i = 0; i < 4; ++i) q4[i] = *reinterpret_cast<const u32x4*>(Qw + s * 64 + i * 8);
#pragma unroll
      for (int i = 0; i < 4; ++i) { qf[s][2 * i] = pk8(bfl(q4[i][0]), bfh(q4[i][0]), bfl(q4[i][1]), bfh(q4[i][1])); qf[s][2 * i + 1] = pk8(bfl(q4[i][2]), bfh(q4[i][2]), bfl(q4[i][3]), bfh(q4[i][3])); } }
    { const float* tr = tab + (long)(wid * QBLK + r32) * 64 + hi * 32;
#pragma unroll
      for (int i = 0; i < 4; ++i) { const u32x4 qv = *reinterpret_cast<const u32x4*>(Qw + 128 + i * 8);
        const float4 t0 = *reinterpret_cast<const float4*>(tr + i * 8), t1 = *reinterpret_cast<const float4*>(tr + i * 8 + 4);
        float r_[8];
#define ROT(K_, Q_, C_, S_) do { r_[K_] = bfl(Q_) * (C_) - bfh(Q_) * (S_); r_[K_ + 1] = bfl(Q_) * (S_) + bfh(Q_) * (C_); } while (0)
        ROT(0, qv[0], t0.x, t0.y); ROT(2, qv[1], t0.z, t0.w); ROT(4, qv[2], t1.x, t1.y); ROT(6, qv[3], t1.z, t1.w);
#undef ROT
        qf[2][2 * i] = pk8(r_[0], r_[1], r_[2], r_[3]); qf[2][2 * i + 1] = pk8(r_[4], r_[5], r_[6], r_[7]); } } }
  int kof[2], vof;
#pragma unroll
  for (int i = 0; i < 2; ++i) { const int ob = (wid + 8 * i) * 1024 + 16 * lane, row = ob / KROWB, pp = (ob - row * KROWB) >> 4, sl = pp ^ ((row >> 2) & 3); kof[i] = row * LDKB + sl * 16; }
  { const int c = 16 * wid + (lane >> 2), sl = (lane & 3) ^ ((c >> 2) & 3); vof = c * seq + sl * 16; }
  const unsigned kdst = lds0 + LDS_K3 + wid * 1024, vdst = lds0 + LDS_V3 + wid * 1024;
#define DMA_KV(kt, ks, vt, vs) do { const unsigned char* kb_ = Kh + (long)(kt) * KVBLK * LDKB; const unsigned char* vb_ = Vh + (long)(vt) * KVBLK; const unsigned kd_ = (unsigned)__builtin_amdgcn_readfirstlane(kdst + (ks) * SHM_K3), vd_ = (unsigned)__builtin_amdgcn_readfirstlane(vdst + (vs) * SHM_V3); \
    glds16(kb_ + kof[0], kd_); if (wid < 4) glds16(kb_ + kof[1], kd_ + 8192); glds16(vb_ + vof, vd_); } while (0)
  int kq[2];
  { const int x = (r32 >> 2) & 3; const int kb = (int)lds0 + LDS_K3 + r32 * KROWB; kq[0] = kb + 16 * ((2 * hi) ^ x); kq[1] = kb + 16 * ((2 * hi + 1) ^ x); }
  int vq[2];
  { const int x = (r32 >> 2) & 3; const int vbb = (int)lds0 + LDS_V3 + r32 * 64; vq[0] = vbb + 16 * ((2 * hi) ^ x); vq[1] = vbb + 16 * ((2 * hi + 1) ^ x); }
#define RESC(a) do { if (__any((a) < 1.f)) { if (hi == 0) al_l[r32] = (a); asm volatile("s_waitcnt lgkmcnt(0)" ::: "memory"); \
    for (int d = 0; d < 4; ++d) for (int r = 0; r < 16; ++r) o[d][r] *= al_l[crow(r, hi)]; } } while (0)
  f32x16 p0 = {}, p1 = {}; float al; v8i pa = {}; const int NT = seq / KVBLK;
  int s0 = 0;
#define SL(d) ((s0 + (d)) & 3)
#define CLAMP(t) ((t) < NT ? (t) : NT - 1)
#define BAR() asm volatile("s_barrier" ::: "memory")
#define LGKM(n) do { asm volatile("s_waitcnt lgkmcnt(" #n ")" ::: "memory"); SBAR(); } while (0)
  DMA_KV(0, 0, 0, 0); DMA_KV(1, 1, 1, 1); DMA_KV(2, 2, 1, 1);
  asm volatile("s_waitcnt vmcnt(0)\n\ts_barrier" ::: "memory");
#ifndef ATT_HALF
#define ATT_HALF(w) ((w) >= 4)
#endif
#define KRD(F0, F1, OFF) asm volatile("ds_read_b128 %0, %4 offset:%6\n\tds_read_b128 %1, %5 offset:%6\n\tds_read_b128 %2, %4 offset:%7\n\tds_read_b128 %3, %5 offset:%7" \
    : "=&v"(F0##l), "=&v"(F0##h), "=&v"(F1##l), "=&v"(F1##h) : "v"(a0_), "v"(a1_), "i"(OFF), "i"((OFF) + 32 * KROWB) : "memory")
#define VRD8(FL, FH, CB) asm volatile("ds_read_b128 %0, %2 offset:%4\n\tds_read_b128 %1, %3 offset:%4" : "=&v"(FL), "=&v"(FH) : "v"(v0_), "v"(v1_), "i"((CB) * 2048) : "memory")
#define PV8(OD, FL, FH) do { if (AEXP == 2 || AEXP == 5) { asm volatile("" :: "v"(FL), "v"(FH)); break; } OD = __builtin_amdgcn_mfma_scale_f32_32x32x64_f8f6f4(pa, F8(FL, FH), OD, 0, 0, 0, 0, 0, 0); } while (0)
#define F8(L, H) (v8i){L[0], L[1], L[2], L[3], H[0], H[1], H[2], H[3]}
#define QK8(F0, F1, S, C0, C1) do { if (AEXP == 2 || AEXP == 5) { asm volatile("" :: "v"(F0##l), "v"(F1##h)); break; } p0 = __builtin_amdgcn_mfma_scale_f32_32x32x64_f8f6f4(F8(F0##l, F0##h), qf[S], C0, 0, 0, 0, 0, 0, 0); p1 = __builtin_amdgcn_mfma_scale_f32_32x32x64_f8f6f4(F8(F1##l, F1##h), qf[S], C1, 0, 0, 0, 0, 0, 0); } while (0)
#define MPH(PREV) do { const int ko_ = s0 * SHM_K3; const int a0_ = kq[0] + ko_, a1_ = kq[1] + ko_; const int vo_ = SL(3) * SHM_V3; const int v0_ = vq[0] + vo_, v1_ = vq[1] + vo_; \
    v4i ka0l, ka0h, ka1l, ka1h, kb0l, kb0h, kb1l, kb1h, v0l, v0h, v1l, v1h, v2l, v2h, v3l, v3h; \
    SBAR(); \
    KRD(ka0, ka1, 0); KRD(kb0, kb1, 64);                       \
    LGKM(4);  QK8(ka0, ka1, 0, negm, negm); \
    KRD(ka0, ka1, 128); VRD8(v0l, v0h, 0); VRD8(v1l, v1h, 1);   \
    LGKM(8);  QK8(kb0, kb1, 1, p0, p1); \
    VRD8(v2l, v2h, 2); VRD8(v3l, v3h, 3);                       \
    LGKM(8);  QK8(ka0, ka1, 2, p0, p1); \
    if (PREV) { LGKM(4); PV8(o[0], v0l, v0h); PV8(o[1], v1l, v1h); LGKM(0); PV8(o[2], v2l, v2h); PV8(o[3], v3l, v3h); } else { LGKM(0); } \
    } while (0)
#define WB() do { if (wid < 4) asm volatile("s_waitcnt vmcnt(3)\n\ts_barrier" ::: "memory"); else asm volatile("s_waitcnt vmcnt(2)\n\ts_barrier" ::: "memory"); } while (0)
#define VPH(j) do { if (AEXP != 3 && AEXP != 5) DMA_KV(CLAMP((j) + 3), SL(3), CLAMP((j) + 2), SL(2)); if (AEXP != 1 && AEXP != 5) { al = softmaxPP(p0, p1, m_reg, negm, l_reg, (j) == 0, pa); RESC(al); } else { asm volatile("" : "+v"(p0), "+v"(p1), "+v"(pa)); } s0 = SL(1); } while (0)
#define DRAIN() do { const int vo_ = SL(3) * SHM_V3; const int v0_ = vq[0] + vo_, v1_ = vq[1] + vo_; v4i v0l, v0h, v1l, v1h, v2l, v2h, v3l, v3h; \
    VRD8(v0l, v0h, 0); VRD8(v1l, v1h, 1); VRD8(v2l, v2h, 2); VRD8(v3l, v3h, 3); LGKM(0); PV8(o[0], v0l, v0h); PV8(o[1], v1l, v1h); PV8(o[2], v2l, v2h); PV8(o[3], v3l, v3h); } while (0)
  { const bool trail = ATT_HALF(wid);
    if (trail) BAR();
    MPH(false); if (!trail) WB();
#pragma unroll 1
    for (int j = 0; j + 1 < NT; ++j) { VPH(j); if (trail) WB(); MPH(true); if (!trail) WB(); }
    VPH(NT - 1); DRAIN(); }
  if (hi == 0) li_l[r32] = l_reg; asm volatile("s_waitcnt lgkmcnt(0)" ::: "memory");
  float rli[16];
#pragma unroll
  for (int r = 0; r < 16; ++r) rli[r] = __builtin_amdgcn_rcpf(li_l[crow(r, hi)]);
  bf16r* Ow = Ob + (long)(wid * QBLK) * LDO;
#pragma unroll
  for (int r = 0; r < 16; ++r) { const int orow = crow(r, hi);
#pragma unroll
    for (int d0 = 0; d0 < 4; ++d0) { const unsigned w = cvtpk(o[d0][r] * rli[r], 0.f); Ow[(long)orow * LDO + d0 * 32 + r32] = (bf16r)(w & 0xffffu); } }
  asm volatile("s_waitcnt vmcnt(0) lgkmcnt(0)\n\ts_barrier" ::: "memory");
#undef DMA_KV
#undef RESC
#undef SL
#undef CLAMP
#undef BAR
#undef LGKM
#undef KRD
#undef VRD8
#undef PV8
#undef F8
#undef QK8
#undef MPH
#undef WB
#undef DRAIN
#undef VPH
}
#undef SBAR
}

namespace fftc {
#define FGAS __attribute__((address_space(1)))
typedef float f2 __attribute__((ext_vector_type(2)));
typedef __attribute__((address_space(3))) f2 lf2;
constexpr int L = 16384;
constexpr int FFT_LDS_BYTES = 17920 * 8;
__device__ static const float TW64C[32] = { 1.000000000e+00f, 9.951847267e-01f, 9.807852804e-01f, 9.569403357e-01f, 9.238795325e-01f, 8.819212643e-01f, 8.314696123e-01f, 7.730104534e-01f, 7.071067812e-01f, 6.343932842e-01f, 5.555702330e-01f, 4.713967368e-01f, 3.826834324e-01f, 2.902846773e-01f, 1.950903220e-01f, 9.801714033e-02f, 0.0f, -9.801714033e-02f, -1.950903220e-01f, -2.902846773e-01f, -3.826834324e-01f, -4.713967368e-01f, -5.555702330e-01f, -6.343932842e-01f, -7.071067812e-01f, -7.730104534e-01f, -8.314696123e-01f, -8.819212643e-01f, -9.238795325e-01f, -9.569403357e-01f, -9.807852804e-01f, -9.951847267e-01f };
__device__ static const float TW64S[32] = { 0.000000000e+00f, 9.801714033e-02f, 1.950903220e-01f, 2.902846773e-01f, 3.826834324e-01f, 4.713967368e-01f, 5.555702330e-01f, 6.343932842e-01f, 7.071067812e-01f, 7.730104534e-01f, 8.314696123e-01f, 8.819212643e-01f, 9.238795325e-01f, 9.569403357e-01f, 9.807852804e-01f, 9.951847267e-01f, 1.000000000e+00f, 9.951847267e-01f, 9.807852804e-01f, 9.569403357e-01f, 9.238795325e-01f, 8.819212643e-01f, 8.314696123e-01f, 7.730104534e-01f, 7.071067812e-01f, 6.343932842e-01f, 5.555702330e-01f, 4.713967368e-01f, 3.826834324e-01f, 2.902846773e-01f, 1.950903220e-01f, 9.801714033e-02f };
__device__ __forceinline__ f2 cmul(f2 a, f2 w) { return (f2){a.x * w.x - a.y * w.y, a.x * w.y + a.y * w.x}; }
template <bool INV> __device__ __forceinline__ f2 twmul(f2 d, int tw) {
    if (tw == 0) return d;
    if (tw == 16) return INV ? (f2){-d.y, d.x} : (f2){d.y, -d.x};
    const float c = TW64C[tw], s = TW64S[tw];
    return INV ? (f2){d.x * c - d.y * s, d.y * c + d.x * s} : (f2){d.x * c + d.y * s, d.y * c - d.x * s};
}
template <int N, int S, bool INV> __device__ __forceinline__ void dif_stage(f2 (&v)[N]) {
#pragma unroll
    for (int blk = 0; blk < N; blk += 2 * S)
#pragma unroll
        for (int i = 0; i < S; ++i) { const f2 a = v[blk + i], b = v[blk + i + S]; v[blk + i] = a + b; v[blk + i + S] = twmul<INV>(a - b, i * (32 / S)); }
    if constexpr (S > 1) dif_stage<N, S / 2, INV>(v);
}
constexpr int bitrev(int k, int bits) { int r = 0; for (int b = 0; b < bits; ++b) r |= ((k >> b) & 1) << (bits - 1 - b); return r; }
template <int N, bool INV> __device__ __forceinline__ void dft(f2 (&v)[N]) {
    dif_stage<N, N / 2, INV>(v);
    constexpr int bits = (N == 32) ? 5 : 4;
    f2 t[N];
#pragma unroll
    for (int k = 0; k < N; ++k) t[k] = v[bitrev(k, bits)];
#pragma unroll
    for (int k = 0; k < N; ++k) v[k] = t[k];
}
template <bool CONJ> __device__ __forceinline__ void apply_pow32(f2 (&v)[32], f2 w) {
    if (CONJ) w.y = -w.y;
    f2 lo[8]; lo[0] = (f2){1.f, 0.f}; lo[1] = w; lo[2] = cmul(w, w); lo[3] = cmul(lo[2], w); lo[4] = cmul(lo[2], lo[2]); lo[5] = cmul(lo[4], w); lo[6] = cmul(lo[4], lo[2]); lo[7] = cmul(lo[4], lo[3]);
#pragma unroll
    for (int k = 1; k < 32; ++k) if (k & 7) v[k] = cmul(v[k], lo[k & 7]);
    const f2 p8 = cmul(lo[4], lo[4]), p16 = cmul(p8, p8), p24 = cmul(p16, p8);
#pragma unroll
    for (int k = 8; k < 16; ++k) v[k] = cmul(v[k], p8);
#pragma unroll
    for (int k = 16; k < 24; ++k) v[k] = cmul(v[k], p16);
#pragma unroll
    for (int k = 24; k < 32; ++k) v[k] = cmul(v[k], p24);
}
__device__ __forceinline__ int opaque(int x) { asm volatile("" : "+v"(x)); return x; }
__device__ __forceinline__ f2 cis_pi(float x) { float s, c; sincospif(x, &s, &c); return (f2){c, s}; }
#define FPHYS(d1, d2, d3) ((d1) * 560 + (d2) * 17 + (d3))
#define FSYNC() __syncthreads()
template <int EV> __device__ __forceinline__ void pass1_fwd(lf2* X, f2 (&v)[32], int tid) {
    tid = opaque(tid);
    if (EV != 1) { dft<32, false>(v);
    apply_pow32<false>(v, cis_pi(-(float)tid * (2.0f / L))); }
    const int base = (tid >> 4) * 17 + (tid & 15);
#pragma unroll
    for (int k = 0; k < 32; ++k) { if (EV != 2) X[base + k * 560] = v[k]; else asm volatile("" :: "v"(v[k])); }
}
template <int EV> __device__ __forceinline__ void pass1_inv(const lf2* X, f2 (&v)[32], int tid) {
    tid = opaque(tid);
    const int base = (tid >> 4) * 17 + (tid & 15);
#pragma unroll
    for (int k = 0; k < 32; ++k) { if (EV != 2) v[k] = X[base + k * 560]; else v[k] = (f2){(float)(tid + k), 2.f}; }
    if (EV != 1) { apply_pow32<true>(v, cis_pi(-(float)tid * (2.0f / L)));
    dft<32, true>(v); }
}
template <bool INV, int EV> __device__ __forceinline__ void pass2(lf2* X, int tid) {
    tid = opaque(tid);
    const int base = (tid >> 4) * 560 + (tid & 15); f2 v[32];
    if (EV == 2) { for (int k = 0; k < 32; ++k) v[k] = (f2){(float)(tid + k), 1.f}; asm volatile("" : "+v"(v[0]), "+v"(v[7]), "+v"(v[19])); }
#pragma unroll
    for (int k = 0; k < 32; ++k) if (EV != 2) v[k] = X[base + k * 17];
    const f2 w = cis_pi(-(float)(tid & 15) * (2.0f / 512.0f));
    if (EV != 1) { if (INV) { apply_pow32<true>(v, w); dft<32, true>(v); } else { dft<32, false>(v); apply_pow32<false>(v, w); } }
#pragma unroll
    for (int k = 0; k < 32; ++k) { if (EV != 2) X[base + k * 17] = v[k]; else asm volatile("" :: "v"(v[k])); }
}
template <bool KMODE, int EV> __device__ __forceinline__ void pass3(lf2* X, f2 (&KR)[2][16], int tid) {
    tid = opaque(tid);
#pragma unroll
    for (int i = 0; i < 2; ++i) { const int base = ((tid >> 5) + 16 * i) * 560 + (tid & 31) * 17; f2 u[16];
#pragma unroll
        for (int k = 0; k < 16; ++k) u[k] = X[base + k];
        if (EV != 1) dft<16, false>(u);
        if (KMODE) {
#pragma unroll
            for (int k = 0; k < 16; ++k) KR[i][k] = u[k];
        } else {
#pragma unroll
            for (int k = 0; k < 16; ++k) u[k] = cmul(u[k], KR[i][k]);
            if (EV != 1) dft<16, true>(u);
#pragma unroll
            for (int k = 0; k < 16; ++k) X[base + k] = u[k];
        } }
}
template <int EV> __device__ __forceinline__ void kernel_spectrum(lf2* X, f2 (&v)[32], f2 (&KS)[2][16], int tid) {
    pass1_fwd<EV>(X, v, tid); FSYNC(); pass2<false, EV>(X, tid); FSYNC(); pass3<true, EV>(X, KS, tid); FSYNC();
}
template <int EV> __device__ __forceinline__ void conv_roundtrip(lf2* X, f2 (&v)[32], f2 (&KS)[2][16], int tid) {
    pass1_fwd<EV>(X, v, tid); FSYNC(); pass2<false, EV>(X, tid); FSYNC(); pass3<false, EV>(X, KS, tid); FSYNC(); pass2<true, EV>(X, tid); FSYNC(); pass1_inv<EV>(X, v, tid); FSYNC();
}
__device__ __forceinline__ void modulate(f2 (&v)[32], int tid) {
    const f2 wj = cis_pi(-(float)opaque(tid) * (1.0f / L));
#pragma unroll
    for (int k = 0; k < 32; ++k) v[k] = twmul<false>(cmul(v[k], wj), k);
}
__device__ __forceinline__ void demodulate(f2 (&v)[32], int tid) {
    f2 wj = cis_pi(-(float)opaque(tid) * (1.0f / L)); wj.y = -wj.y;
#pragma unroll
    for (int k = 0; k < 32; ++k) v[k] = twmul<true>(cmul(v[k], wj), k);
}
__device__ __forceinline__ float bf2f(unsigned short u) { return __uint_as_float((unsigned)u << 16); }
__device__ __forceinline__ unsigned short f2bf_rne(float f) { unsigned u = __float_as_uint(f); return (unsigned short)((u + 0x7fffu + ((u >> 16) & 1u)) >> 16); }
template <typename T> __device__ __forceinline__ FGAS T* pstep(FGAS T* p, int n) { p += n; asm volatile("" : "+v"(p)); return p; }
template <int MODE, int EV = 0> __device__ __forceinline__ void hyena_channel(lf2* X, const float* z0, const float* z1, const float* hf, const float* hb,
                                                                        const unsigned short* g0, const unsigned short* g1, float dbias, float* zo0, float* zo1,
                                                                        unsigned short* o0, unsigned short* o1, f2* stash, f2* KSg, int tid) {
    f2 v[32]; f2 KS[2][16];
    { FGAS const float* pf = (FGAS const float*)hf + opaque(tid); FGAS const float* pb = (FGAS const float*)hb + ((L - opaque(tid)) & (L - 1));
#pragma unroll
      for (int k = 0; k < 32; ++k) { v[k] = (EV == 3) ? (f2){1.f, 0.f} : (f2){*pf + *pb, 0.f}; pf = pstep(pf, 512); pb = (k == 0) ? pstep((FGAS const float*)hb + (L - 512 - tid), 0) : pstep(pb, -512); } }
    kernel_spectrum<EV>(X, v, KS, tid);
    { FGAS const float* p0 = (FGAS const float*)z0 + opaque(tid); FGAS const float* p1 = (FGAS const float*)z1 + opaque(tid);
#pragma unroll
      for (int k = 0; k < 32; ++k) { v[k] = (EV == 3) ? (f2){1.f, 2.f} : (f2){*p0, *p1}; p0 = pstep(p0, 512); p1 = pstep(p1, 512); } }
    conv_roundtrip<EV>(X, v, KS, tid);
    { FGAS f2* ps = (FGAS f2*)stash + opaque(tid);
#pragma unroll
      for (int k = 0; k < 32; ++k) { *ps = v[k]; ps = pstep(ps, 512); } }
    { FGAS const float* pf = (FGAS const float*)hf + opaque(tid); FGAS const float* pb = (FGAS const float*)hb + ((L - opaque(tid)) & (L - 1));
#pragma unroll
      for (int k = 0; k < 32; ++k) { const float hbv = (EV == 3) ? 1.f : *pb; v[k] = (f2){*pf + ((k == 0 && tid == 0) ? hbv : -hbv), 0.f}; pf = pstep(pf, 512); pb = (k == 0) ? pstep((FGAS const float*)hb + (L - 512 - tid), 0) : pstep(pb, -512); } }
    modulate(v, tid);
    kernel_spectrum<EV>(X, v, KS, tid);
    { FGAS const float* p0 = (FGAS const float*)z0 + opaque(tid); FGAS const float* p1 = (FGAS const float*)z1 + opaque(tid);
#pragma unroll
      for (int k = 0; k < 32; ++k) { v[k] = (EV == 3) ? (f2){1.f, 2.f} : (f2){*p0, *p1}; p0 = pstep(p0, 512); p1 = pstep(p1, 512); } }
    modulate(v, tid);
    conv_roundtrip<EV>(X, v, KS, tid);
    demodulate(v, tid);
    const float sc = 1.0f / (2.0f * L);
    { FGAS const f2* ps = (FGAS const f2*)stash + opaque(tid); FGAS const float* p0 = (FGAS const float*)z0 + opaque(tid); FGAS const float* p1 = (FGAS const float*)z1 + opaque(tid); FGAS const unsigned short* q0 = (FGAS const unsigned short*)g0 + opaque(tid); FGAS const unsigned short* q1 = (FGAS const unsigned short*)g1 + opaque(tid);
      FGAS float* w0 = (FGAS float*)zo0 + opaque(tid); FGAS float* w1 = (FGAS float*)zo1 + opaque(tid); FGAS unsigned short* b0 = (FGAS unsigned short*)o0 + opaque(tid); FGAS unsigned short* b1 = (FGAS unsigned short*)o1 + opaque(tid);
#pragma unroll
      for (int k = 0; k < 32; ++k) { const f2 y = (*ps + v[k]) * sc;
          const float r0 = bf2f(*q0) * (y.x + dbias * *p0), r1 = bf2f(*q1) * (y.y + dbias * *p1);
          if (MODE == 1) { *b0 = f2bf_rne(r0); *b1 = f2bf_rne(r1); b0 = pstep(b0, 512); b1 = pstep(b1, 512); } else if (MODE == 0) { *w0 = r0; *w1 = r1; w0 = pstep(w0, 512); w1 = pstep(w1, 512); } else { asm volatile("" :: "v"(r0), "v"(r1)); }
          ps = pstep(ps, 512); p0 = pstep(p0, 512); p1 = pstep(p1, 512); q0 = pstep(q0, 512); q1 = pstep(q1, 512); } }
}
#undef FPHYS
#undef FGAS
}

constexpr int BATCH = 2, SEQ = 16384, DM = 1024, T = BATCH * SEQ;
constexpr int NH = 8, DNOPE = 128, DROPE = 64, DQK = 192, DVH = 128, QLORA = 384, KVLORA = 256, MLA_IN = 704, MLA_INP = 768;
constexpr int DFF = 2816, NUP = 2 * DFF;
constexpr int HF = 64, HEMB = 33, HKP = 256;
constexpr float LN_EPS = 1e-5f, RMS_EPS = 1e-6f;
constexpr float DN_ALPHA = 1.4142135623730951f;
constexpr float QSCALE = 0.07216878364870322f * 1.4426950408889634f;
constexpr int NWAVES = 8;

constexpr size_t MiB = 1u << 20;
constexpr size_t WS_CTL = 0, CTL_ZERO_BYTES = 64 * 1024;
constexpr size_t WS_TW1 = 256 * 1024, WS_MOD = 384 * 1024, WS_TW2 = 512 * 1024;
constexpr size_t WS_WIN = 2 * MiB, WS_WUQ = 4 * MiB, WS_WUKV = 6 * MiB, WS_WO = 7 * MiB, WS_WHIN = 9 * MiB, WS_WHO = 15 * MiB, WS_WUP = 17 * MiB, WS_WDN = 39 * MiB, WS_WFO = 50 * MiB, WS_H3 = 52 * MiB;
constexpr size_t WS_XB = 60 * MiB;
constexpr size_t WS_XF = 124 * MiB;
constexpr size_t WS_S = 252 * MiB;
constexpr size_t WS_END = 512 * MiB;
constexpr size_t WS_CQN = WS_XF, WS_CKVN = WS_XF + 24 * MiB, WS_ROPE = WS_XF + 40 * MiB;
constexpr size_t WS_Q = WS_S, WS_K = WS_S + 96 * MiB, WS_VT = WS_S + 144 * MiB, WS_V = WS_S + 192 * MiB;
constexpr size_t WS_UH = WS_S;
constexpr size_t WS_U = WS_S;
constexpr size_t WS_VC0 = WS_XB, WS_VC1 = WS_S + 192 * MiB;
constexpr size_t WS_KT = WS_S, WS_STASH = WS_S + 128 * MiB, WS_KSPEC = WS_S + 160 * MiB;
constexpr int CW_TMO = 0, CW_CODE = 1, CW_BAR = 4096, CW_CHK = 8192;

constexpr int RING_BYTES = 131072;
constexpr int LDS_BYTES = 147456;
constexpr int MISC_OFF = LDS_BYTES - 512;
static_assert(fftc::FFT_LDS_BYTES <= MISC_OFF && attn::SHM_ATTN3 <= RING_BYTES, "LDS map");

typedef pg8::bf16_t bf16;
typedef unsigned u32x4t __attribute__((ext_vector_type(4)));
typedef unsigned u32x2t __attribute__((ext_vector_type(2)));
typedef float f32x2 __attribute__((ext_vector_type(2)));
__device__ __forceinline__ float wave_sum(float v) {
#pragma unroll
    for (int o = 1; o < 64; o <<= 1) v += __shfl_xor(v, o);
    return v;
}
__device__ __forceinline__ float bf_lo(unsigned w) { return __uint_as_float(w << 16); }
__device__ __forceinline__ float bf_hi(unsigned w) { return __uint_as_float(w & 0xffff0000u); }
__device__ __forceinline__ unsigned pkbf(float lo, float hi) { return pg8::cvt_pk_bf16(lo, hi); }

template <class ColMap> __device__ __forceinline__ void transpose_item(const float* W, int K, int N, bf16* WT, int ldk, LAS float* scr, int item, int nblk, int lane, const ColMap& cm) {
    const int kb = item / nblk, nb = item % nblk, k0 = 64 * kb, n0 = 32 * nb;
    const int sc = cm(n0 + (lane & 31));
#pragma unroll 8
    for (int i = 0; i < 32; ++i) { const int kk = 2 * i + (lane >> 5); scr[kk * 33 + (lane & 31)] = (sc >= 0) ? W[(size_t)(k0 + kk) * N + sc] : 0.f; }
    asm volatile("s_waitcnt lgkmcnt(0)" ::: "memory");
    const int c = lane & 7;
#pragma unroll
    for (int j = 0; j < 4; ++j) { const int n = (lane >> 3) + 8 * j; const LAS float* s = scr + (8 * c) * 33 + n;
        u32x4t o; o.x = pkbf(s[0 * 33], s[1 * 33]); o.y = pkbf(s[2 * 33], s[3 * 33]); o.z = pkbf(s[4 * 33], s[5 * 33]); o.w = pkbf(s[6 * 33], s[7 * 33]);
        *(u32x4t*)(WT + (size_t)(n0 + n) * ldk + k0 + 8 * c) = o; }
    asm volatile("s_waitcnt lgkmcnt(0)" ::: "memory");
}
struct CmIdent { __device__ __forceinline__ int operator()(int n) const { return n; } };
struct CmWin { __device__ __forceinline__ int operator()(int n) const { if (n < 640) return n; if (n >= 704) return -1; const int i = n - 640; return 640 + (i & 1) * 32 + (i >> 1); } };
struct CmWuq { __device__ __forceinline__ int operator()(int n) const { const int h = n / 192, d = n - h * 192; if (d < 128) return n; const int i = d - 128; return h * 192 + 128 + (i & 1) * 32 + (i >> 1); } };
struct CmWukv { __device__ __forceinline__ int operator()(int n) const { const int v = n >> 10, r = n & 1023, h = r >> 7, d = r & 127; return h * 256 + v * 128 + d; } };
struct CmWup { __device__ __forceinline__ int operator()(int n) const { const int pn = n >> 8, r = n & 255; return (r < 128) ? (pn * 128 + r) : (DFF + pn * 128 + (r - 128)); } };

struct Args {
    const float* in[27]; float* out; unsigned char* ws; int ph_lo, ph_hi;
};
enum { I_X = 0, I_POS, I_MLA_WIN, I_MLA_GQ, I_MLA_WUQ, I_MLA_GKV, I_MLA_WUKV, I_MLA_WO, I_HY_WIN, I_HY_WSHORT, I_HY_FW1, I_HY_FB1, I_HY_FW2, I_HY_FB2, I_HY_FW3, I_HY_FB3, I_HY_FREQ,
       I_HY_FWOUT, I_HY_DBIAS, I_HY_WO, I_FFN_WUP, I_FFN_WCONV, I_FFN_WDOWN, I_LN1G, I_LN1B, I_LN2G, I_LN2B };

__device__ __forceinline__ void ln_rows(const float* Y, float* OF, bf16* OB, const float* g, const float* b, int gw, int ngw, int lane, float omul = 1.0f) {
    f32x4 gv[4], bv[4];
#pragma unroll
    for (int j = 0; j < 4; ++j) { gv[j] = *(const f32x4*)(g + 4 * lane + 256 * j); bv[j] = *(const f32x4*)(b + 4 * lane + 256 * j); }
    for (int m = gw; m < T; m += ngw) {
        const f32x4* xr = (const f32x4*)(Y + (size_t)m * DM) + lane;
        f32x4 v[4]; float s = 0.f;
#pragma unroll
        for (int j = 0; j < 4; ++j) { v[j] = xr[64 * j]; s += (v[j].x + v[j].y) + (v[j].z + v[j].w); }
        const float mean = wave_sum(s) * (1.f / DM); float s2 = 0.f;
#pragma unroll
        for (int j = 0; j < 4; ++j) { v[j] = v[j] - mean; s2 += (v[j].x * v[j].x + v[j].y * v[j].y) + (v[j].z * v[j].z + v[j].w * v[j].w); }
        const float rstd = 1.f / sqrtf(wave_sum(s2) * (1.f / DM) + LN_EPS);
        f32x4* of = (f32x4*)(OF + (size_t)m * DM) + lane;
#pragma unroll
        for (int j = 0; j < 4; ++j) { v[j] = (v[j] * rstd * gv[j] + bv[j]) * omul;
            if (OF) of[64 * j] = v[j]; }
        if (OB) { u32x2t* ob = (u32x2t*)(OB + (size_t)m * DM) + lane;
#pragma unroll
            for (int j = 0; j < 4; ++j) { u32x2t w; w.x = pkbf(v[j].x, v[j].y); w.y = pkbf(v[j].z, v[j].w); ob[64 * j] = w; } }
    }
}

__device__ __forceinline__ void mla_norm_rope(const float* H1, const float* gq, const float* gkv, const f32x2* tab, bf16* CQN, bf16* CKVN, unsigned char* Kb, int gw, int ngw, int lane) {
    float gqv[6], gkvv[4];
#pragma unroll
    for (int k = 0; k < 6; ++k) gqv[k] = gq[lane + 64 * k];
#pragma unroll
    for (int k = 0; k < 4; ++k) gkvv[k] = gkv[lane + 64 * k];
    for (int t = gw; t < T; t += ngw) {
        const float* h = H1 + (size_t)t * MLA_INP;
        float q[6], kv[4]; float sq = 0.f, sk = 0.f;
#pragma unroll
        for (int k = 0; k < 6; ++k) { q[k] = h[lane + 64 * k]; sq += q[k] * q[k]; }
#pragma unroll
        for (int k = 0; k < 4; ++k) { kv[k] = h[QLORA + lane + 64 * k]; sk += kv[k] * kv[k]; }
        const f32x2 xr = *(const f32x2*)(h + 640 + 2 * (lane & 31));
        const float rq = 1.f / sqrtf(wave_sum(sq) * (1.f / QLORA) + RMS_EPS), rk = 1.f / sqrtf(wave_sum(sk) * (1.f / KVLORA) + RMS_EPS);
#pragma unroll
        for (int k = 0; k < 6; ++k) CQN[(size_t)t * QLORA + lane + 64 * k] = (bf16)(pkbf(q[k] * rq * gqv[k], 0.f) & 0xffffu);
#pragma unroll
        for (int k = 0; k < 4; ++k) CKVN[(size_t)t * KVLORA + lane + 64 * k] = (bf16)(pkbf(kv[k] * rk * gkvv[k], 0.f) & 0xffffu);
        const f32x2 cs = tab[(size_t)t * 32 + (lane & 31)];
        const unsigned short w = (unsigned short)__builtin_amdgcn_cvt_pk_fp8_f32(xr.x * cs.x - xr.y * cs.y, xr.x * cs.y + xr.y * cs.x, 0, false);
        unsigned short* kr = (unsigned short*)(Kb + (size_t)t * 1536 + 128) + (lane & 31);
        if (lane < 32) {
#pragma unroll
            for (int hh = 0; hh < NH; ++hh) kr[hh * 96] = w; }
    }
}

__device__ __forceinline__ void ffn_conv_silu(const bf16* UH, const float* wconv  , bf16* HACT  , int gw, int ngw, int lane) {
    constexpr int RB = 32, NRB = SEQ / RB, NCC = 6;
    for (int it = gw; it < NRB * NCC; it += ngw) {
        const int rb = it / NCC, cc = it - rb * NCC, c = cc * 512 + lane * 8;
        if (c >= DFF) continue;
        const int pn = c >> 7, ucol = pn * 256 + (c & 127);
        float wa[3][8], wg[3][8];
#pragma unroll
        for (int k = 0; k < 3; ++k)
#pragma unroll
            for (int e = 0; e < 8; ++e) { wa[k][e] = wconv[k * NUP + c + e]; wg[k][e] = wconv[k * NUP + DFF + c + e]; }
        const int r0 = rb * RB;
        const bf16* up = UH + ucol;
        const u32x4t zero = {0u, 0u, 0u, 0u};
        u32x4t ra[6], rg[6];
        ra[0] = zero; rg[0] = zero;
        if (r0 > 0) { ra[0] = *(const u32x4t*)(up + (size_t)(r0 - 1) * NUP); rg[0] = *(const u32x4t*)(up + (size_t)(r0 - 1) * NUP + 128); }
        ra[1] = *(const u32x4t*)(up + (size_t)r0 * NUP); rg[1] = *(const u32x4t*)(up + (size_t)r0 * NUP + 128);
#pragma unroll 1
        for (int r = r0; r < r0 + RB; r += 4) {
#pragma unroll
            for (int j = 1; j <= 4; ++j) { const int rr = r + j; if (rr < SEQ) { ra[1 + j] = *(const u32x4t*)(up + (size_t)rr * NUP); rg[1 + j] = *(const u32x4t*)(up + (size_t)rr * NUP + 128); } else { ra[1 + j] = zero; rg[1 + j] = zero; } }
#pragma unroll
            for (int j = 0; j < 4; ++j) {
                float o[8];
#pragma unroll
                for (int e2 = 0; e2 < 4; ++e2) {
                    const float a0 = wa[0][2 * e2] * bf_lo(ra[j][e2]) + wa[1][2 * e2] * bf_lo(ra[j + 1][e2]) + wa[2][2 * e2] * bf_lo(ra[j + 2][e2]);
                    const float a1 = wa[0][2 * e2 + 1] * bf_hi(ra[j][e2]) + wa[1][2 * e2 + 1] * bf_hi(ra[j + 1][e2]) + wa[2][2 * e2 + 1] * bf_hi(ra[j + 2][e2]);
                    const float g0 = wg[0][2 * e2] * bf_lo(rg[j][e2]) + wg[1][2 * e2] * bf_lo(rg[j + 1][e2]) + wg[2][2 * e2] * bf_lo(rg[j + 2][e2]);
                    const float g1 = wg[0][2 * e2 + 1] * bf_hi(rg[j][e2]) + wg[1][2 * e2 + 1] * bf_hi(rg[j + 1][e2]) + wg[2][2 * e2 + 1] * bf_hi(rg[j + 2][e2]);
                    o[2 * e2] = a0 * g0 * __builtin_amdgcn_rcpf(1.f + __expf(-g0)); o[2 * e2 + 1] = a1 * g1 * __builtin_amdgcn_rcpf(1.f + __expf(-g1)); }
                u32x4t w; w.x = pkbf(o[0], o[1]); w.y = pkbf(o[2], o[3]); w.z = pkbf(o[4], o[5]); w.w = pkbf(o[6], o[7]);
                *(u32x4t*)(HACT + (size_t)(r + j) * DFF + c) = w;
            }
            ra[0] = ra[4]; rg[0] = rg[4]; ra[1] = ra[5]; rg[1] = rg[5];
        }
    }
}

__device__ __forceinline__ void v_transpose_fp8(const bf16* V, unsigned char* VT, LAS unsigned char* scr, int gw, int ngw, int lane) {
    constexpr int NKT = T / 64, NCT = 1024 / 64;
    for (int it = gw; it < NKT * NCT; it += ngw) {
        const int ct = it % NCT, kt = it / NCT, b = kt / (SEQ / 64), k0 = (kt % (SEQ / 64)) * 64, c0 = ct * 64;
        const int r8 = lane >> 3, c8 = lane & 7;
#pragma unroll
        for (int i = 0; i < 8; ++i) { const int row = r8 + 8 * i; const u32x4t v = *(const u32x4t*)(V + ((size_t)b * SEQ + k0 + row) * 1024 + c0 + c8 * 8);
            u32x2t w; w.x = (unsigned)__builtin_amdgcn_cvt_pk_fp8_f32(bf_lo(v.y), bf_hi(v.y), __builtin_amdgcn_cvt_pk_fp8_f32(bf_lo(v.x), bf_hi(v.x), 0, false), true);
            w.y = (unsigned)__builtin_amdgcn_cvt_pk_fp8_f32(bf_lo(v.w), bf_hi(v.w), __builtin_amdgcn_cvt_pk_fp8_f32(bf_lo(v.z), bf_hi(v.z), 0, false), true);
            *(LAS u32x2t*)(scr + row * 72 + c8 * 8) = w; }
        asm volatile("s_waitcnt lgkmcnt(0)" ::: "memory");
        unsigned o[16];
#pragma unroll
        for (int wd = 0; wd < 16; ++wd) { unsigned acc = 0;
#pragma unroll
            for (int bb = 0; bb < 4; ++bb) { const int pi = wd * 4 + bb, h = pi >> 5, j = pi & 31, jj = j & 15, key = (j >> 4) * 32 + (jj & 3) + 8 * (jj >> 2) + 4 * h;
                acc |= (unsigned)scr[key * 72 + lane] << (8 * bb); }
            o[wd] = acc; }
        const int hh = (c0 + lane) >> 7, cc = (c0 + lane) & 127;
        unsigned char* dst = VT + (((size_t)b * 8 + hh) * 128 + cc) * SEQ + k0;
#pragma unroll
        for (int q = 0; q < 4; ++q) *(u32x4t*)(dst + 16 * q) = (u32x4t){o[4 * q], o[4 * q + 1], o[4 * q + 2], o[4 * q + 3]};
        asm volatile("s_waitcnt lgkmcnt(0)" ::: "memory");
    }
}

__device__ __forceinline__ void ffn_fixup_rows(const float* halo, const float* wconv  , bf16* HACT  , int gw, int ngw, int lane) {
    constexpr int NP = T / 256, NCC = 6;
    for (int it = gw; it < NP * 2 * NCC; it += ngw) {
        const int cc = it % NCC, pe = it / NCC, e = pe & 1, pm = pe >> 1, c = cc * 512 + lane * 8;
        if (c >= DFF) continue;
        const int row = pm * 256 + (e ? 255 : 0), ucol = (c >> 7) * 256 + (c & 127);
        const float* hp = halo + (size_t)pm * 4 * NUP + ucol;
        const float* up_ = nullptr; const float* cu_; const float* dn_ = nullptr;
        if (e == 0) { cu_ = hp; dn_ = hp + NUP; if (row % SEQ != 0) up_ = hp - 4 * NUP + 3 * NUP; }
        else { up_ = hp + 2 * NUP; cu_ = hp + 3 * NUP; if (row % SEQ != SEQ - 1) dn_ = hp + 4 * NUP; }
        float o[8];
#pragma unroll
        for (int i = 0; i < 8; ++i) {
            float ha = wconv[NUP + c + i] * cu_[i], hg = wconv[NUP + DFF + c + i] * cu_[128 + i];
            if (up_) { ha += wconv[c + i] * up_[i]; hg += wconv[DFF + c + i] * up_[128 + i]; }
            if (dn_) { ha += wconv[2 * NUP + c + i] * dn_[i]; hg += wconv[2 * NUP + DFF + c + i] * dn_[128 + i]; }
            o[i] = ha * hg * __builtin_amdgcn_rcpf(1.f + __expf(-hg)); }
        u32x4t w; w.x = pkbf(o[0], o[1]); w.y = pkbf(o[2], o[3]); w.z = pkbf(o[4], o[5]); w.w = pkbf(o[6], o[7]);
        *(u32x4t*)(HACT + (size_t)row * DFF + c) = w;
    }
}

__device__ __forceinline__ void hy_conv_transpose(const bf16* U  , const float* wshort  , float* VC0, float* VC1, bf16* G1C, bf16* G2C, LAS unsigned* scr, int gw, int ngw, int lane) {
    constexpr int NTT = T / 64, NCT = 3072 / 64;
    const int r8 = lane >> 3, c8 = lane & 7;
    u32x4t buf[9];
#define HCT_LOAD(IT) do { const int ct_ = (IT) % NCT, tt_ = (IT) / NCT, b_ = tt_ / (SEQ / 64), t0_ = (tt_ % (SEQ / 64)) * 64, c0_ = ct_ * 64; \
        _Pragma("unroll") for (int i = 0; i < 9; ++i) { const int row = r8 + 8 * i, tok = t0_ - 1 + row; buf[i] = (u32x4t){0u, 0u, 0u, 0u}; \
            if (row < 66 && tok >= 0 && tok < SEQ) buf[i] = *(const u32x4t*)(U + ((size_t)b_ * SEQ + tok) * 3072 + c0_ + c8 * 8); } } while (0)
    if (gw < NTT * NCT) HCT_LOAD(gw);
    for (int it = gw; it < NTT * NCT; it += ngw) {
        const int ct = it % NCT, tt = it / NCT, b = tt / (SEQ / 64), t0 = (tt % (SEQ / 64)) * 64, c0 = ct * 64;
#pragma unroll
        for (int i = 0; i < 9; ++i) { const int row = r8 + 8 * i; if (row < 66) { LAS unsigned* d = scr + row * 33 + c8 * 4; d[0] = buf[i].x; d[1] = buf[i].y; d[2] = buf[i].z; d[3] = buf[i].w; } }
        if (it + ngw < NTT * NCT) HCT_LOAD(it + ngw);
        asm volatile("s_waitcnt lgkmcnt(0)" ::: "memory");
        const int part = c0 >> 10, chb = c0 & 1023;
        const float wl0 = wshort[c0 + lane], wl1 = wshort[3072 + c0 + lane], wl2 = wshort[6144 + c0 + lane];
#pragma unroll
        for (int cp = 0; cp < 32; ++cp) {
            const unsigned a0 = scr[lane * 33 + cp], a1 = scr[(lane + 1) * 33 + cp], a2 = scr[(lane + 2) * 33 + cp];
            #define RL(x, i) __int_as_float(__builtin_amdgcn_readlane(__float_as_int(x), (i)))
            const float w00 = RL(wl0, 2 * cp), w10 = RL(wl1, 2 * cp), w20 = RL(wl2, 2 * cp), w01 = RL(wl0, 2 * cp + 1), w11 = RL(wl1, 2 * cp + 1), w21 = RL(wl2, 2 * cp + 1);
#undef RL
            const float v0 = w00 * bf_lo(a0) + w10 * bf_lo(a1) + w20 * bf_lo(a2), v1 = w01 * bf_hi(a0) + w11 * bf_hi(a1) + w21 * bf_hi(a2);
            const size_t o = (size_t)(chb + 2 * cp) * SEQ + t0 + lane;
            if (part == 0) { float* d = b ? VC1 : VC0; d[o] = v0; d[o + SEQ] = v1; }
            else { bf16* d = (part == 1 ? G1C : G2C) + (size_t)b * 1024 * SEQ; d[o] = (bf16)(pkbf(v0, 0.f) & 0xffffu); d[o + SEQ] = (bf16)(pkbf(v1, 0.f) & 0xffffu); }
        }
        asm volatile("s_waitcnt lgkmcnt(0)" ::: "memory");
    }
#undef HCT_LOAD
}
__device__ __forceinline__ void hy_transpose_back(const bf16* Z3C, bf16* XB, LAS unsigned* scr, int gw, int ngw, int lane) {
    constexpr int NTT = T / 64, NCT = 1024 / 64;
    for (int it = gw; it < NTT * NCT; it += ngw) {
        const int ct = it % NCT, tt = it / NCT, b = tt / (SEQ / 64), t0 = (tt % (SEQ / 64)) * 64, c0 = ct * 64;
        const bf16* src = Z3C + ((size_t)b * 1024 + c0) * SEQ + t0 + lane;
#pragma unroll 8
        for (int cp = 0; cp < 32; ++cp) { const unsigned lo = src[(size_t)(2 * cp) * SEQ], hi = src[(size_t)(2 * cp + 1) * SEQ]; scr[lane * 33 + cp] = lo | (hi << 16); }
        asm volatile("s_waitcnt lgkmcnt(0)" ::: "memory");
        const int r8 = lane >> 3, c8 = lane & 7;
#pragma unroll
        for (int i = 0; i < 8; ++i) { const int row = r8 + 8 * i; const LAS unsigned* s = scr + row * 33 + c8 * 4; u32x4t v; v.x = s[0]; v.y = s[1]; v.z = s[2]; v.w = s[3];
            *(u32x4t*)(XB + ((size_t)b * SEQ + t0 + row) * DM + c0 + c8 * 8) = v; }
        asm volatile("s_waitcnt lgkmcnt(0)" ::: "memory");
    }
}

#ifdef SELFCHECK
__device__ __forceinline__ float blk_sum(float v, LAS float* red, int tid_) {
    v = wave_sum(v); __syncthreads(); if ((tid_ & 63) == 0) red[tid_ >> 6] = v; __syncthreads();
    float t = 0.f; for (int i = 0; i < NWAVES; ++i) t += red[i]; __syncthreads(); return t;
}
__device__ __forceinline__ void chk_flag(unsigned* flag, float err2, float ref2, unsigned bit, int tid_, float tol = SELFCHECK_TOL) {
    if (tid_ == 0 && !(err2 <= tol * tol * ref2)) atomicOr(flag, bit);
}
__device__ __forceinline__ float fp8_dec(unsigned b) { const unsigned e = (b >> 3) & 15u, m = b & 7u; const float v = e ? ldexpf((float)(8u + m), (int)e - 10) : ldexpf((float)m, -9); return (b & 0x80u) ? -v : v; }
__device__ __forceinline__ float fp8_rnd(float x) { return fp8_dec((unsigned)__builtin_amdgcn_cvt_pk_fp8_f32(x, 0.f, 0, false) & 0xffu); }
__device__ __forceinline__ void selfcheck_mla(const Args& args, LAS unsigned char* ldsl, int bxx, int tid_) {
    unsigned* flag = (unsigned*)(args.ws + WS_CTL) + CW_CHK;
    const bf16* Qb_ = (const bf16*)(args.ws + WS_Q); const unsigned char* Kb_ = (const unsigned char*)(args.ws + WS_K); const bf16* Vb_ = (const bf16*)(args.ws + WS_V); const bf16* O_ = (const bf16*)(args.ws + WS_XB);
    const int* pos = (const int*)args.in[I_POS];
    LAS float* red = (LAS float*)(ldsl + 140000);
    if (bxx < 64) {
        const int t = bxx * (T / 64) + (bxx * 37) % 512;
        LAS float* h = (LAS float*)ldsl; LAS float* cq = h + 704; LAS float* ckv = cq + 384;
        const float* x = args.in[I_X] + (size_t)t * DM; const float* w_in = args.in[I_MLA_WIN];
        for (int j = tid_; j < MLA_IN; j += 512) { float a = 0.f; for (int k = 0; k < DM; ++k) a += x[k] * w_in[(size_t)k * MLA_IN + j]; h[j] = a; }
        __syncthreads();
        float sq = 0.f, sk = 0.f; for (int k = 0; k < QLORA; ++k) sq += h[k] * h[k]; for (int k = 0; k < KVLORA; ++k) sk += h[QLORA + k] * h[QLORA + k];
        const float rq = 1.f / sqrtf(sq / QLORA + RMS_EPS), rk = 1.f / sqrtf(sk / KVLORA + RMS_EPS);
        for (int k = tid_; k < QLORA; k += 512) cq[k] = h[k] * rq * args.in[I_MLA_GQ][k];
        for (int k = tid_; k < KVLORA; k += 512) ckv[k] = h[QLORA + k] * rk * args.in[I_MLA_GKV][k];
        __syncthreads();
        {
            float e2 = 0.f, r2 = 0.f; const float* w = args.in[I_MLA_WUQ];
            for (int n = tid_; n < NH * DQK; n += 512) { const int o = CmWuq()(n); float a = 0.f; for (int k = 0; k < QLORA; ++k) a += cq[k] * w[(size_t)k * (NH * DQK) + o];
                a *= QSCALE; const float g = __uint_as_float((unsigned)Qb_[(size_t)t * 1536 + n] << 16); e2 += (a - g) * (a - g); r2 += a * a; }
            e2 = blk_sum(e2, red, tid_); r2 = blk_sum(r2, red, tid_); chk_flag(flag, e2, r2, 1u, tid_);
        }
        {
            float e2 = 0.f, r2 = 0.f, e3 = 0.f, r3 = 0.f; const float* w = args.in[I_MLA_WUKV];
            for (int n = tid_; n < NH * 256; n += 512) { const int o = CmWukv()(n); float a = 0.f; for (int k = 0; k < KVLORA; ++k) a += ckv[k] * w[(size_t)k * (NH * 256) + o];
                if (n < 1024) { const float g = fp8_dec(Kb_[(size_t)t * 1536 + (n >> 7) * 192 + (n & 127)]); e2 += (a - g) * (a - g); r2 += a * a; }
                else { const float g = __uint_as_float((unsigned)Vb_[(size_t)t * 1024 + n - 1024] << 16); e3 += (a - g) * (a - g); r3 += a * a; } }
            e2 = blk_sum(e2, red, tid_); r2 = blk_sum(r2, red, tid_); chk_flag(flag, e2, r2, 2u, tid_, SELFCHECK_TOL8);
            e3 = blk_sum(e3, red, tid_); r3 = blk_sum(r3, red, tid_); chk_flag(flag, e3, r3, 8u, tid_);
        }
        {
            float e2 = 0.f, r2 = 0.f;
            if (tid_ < 256) { const int hh = tid_ >> 5, i = tid_ & 31; const float inv = powf(10000.0f, -(float)i / 32.0f); float s, c; sincosf((float)pos[t] * inv, &s, &c);
                const float x1 = h[640 + i], x2 = h[672 + i], a1 = x1 * c - x2 * s, a2 = x1 * s + x2 * c;
                const float g1 = fp8_dec(Kb_[(size_t)t * 1536 + hh * 192 + 128 + 2 * i]), g2 = fp8_dec(Kb_[(size_t)t * 1536 + hh * 192 + 129 + 2 * i]);
                e2 = (a1 - g1) * (a1 - g1) + (a2 - g2) * (a2 - g2); r2 = a1 * a1 + a2 * a2; }
            e2 = blk_sum(e2, red, tid_); r2 = blk_sum(r2, red, tid_); chk_flag(flag, e2, r2, 4u, tid_, SELFCHECK_TOL8);
        }
    } else if (bxx < 192) {
        const int sidx = bxx - 64, b = sidx & 1, hh = (sidx >> 1) & 7, row = (sidx * 509 + 13) % SEQ; const size_t t = (size_t)b * SEQ + row;
        LAS float* sc = (LAS float*)ldsl;
        LAS float* q = sc + SEQ;
        if (tid_ < DQK) { float v = __uint_as_float((unsigned)Qb_[t * 1536 + hh * DQK + tid_] << 16);
            if (tid_ >= 128) { const int i = (tid_ - 128) >> 1; const float inv = powf(10000.0f, -(float)i / 32.0f); float s, c; sincosf((float)pos[t] * inv, &s, &c);
                const float o = __uint_as_float((unsigned)Qb_[t * 1536 + hh * DQK + (tid_ ^ 1)] << 16);
                v = (tid_ & 1) ? (o * s + v * c) : (v * c - o * s); }
            q[tid_] = fp8_rnd(v); }
        __syncthreads();
        float mx = -1e30f;
        for (int k = tid_; k < SEQ; k += 512) { const unsigned char* kr = Kb_ + ((size_t)b * SEQ + k) * 1536 + hh * DQK; float a = 0.f; for (int d = 0; d < DQK; ++d) a += q[d] * fp8_dec(kr[d]); sc[k] = a; mx = fmaxf(mx, a); }
        for (int o = 1; o < 64; o <<= 1) mx = fmaxf(mx, __shfl_xor(mx, o));
        __syncthreads(); if ((tid_ & 63) == 0) red[tid_ >> 6] = mx; __syncthreads(); for (int i = 0; i < NWAVES; ++i) mx = fmaxf(mx, red[i]); __syncthreads();
        float ls = 0.f; for (int k = tid_; k < SEQ; k += 512) { const float p = exp2f(sc[k] - mx); sc[k] = p; ls += p; }
        ls = blk_sum(ls, red, tid_);
        const int d = tid_ & 127, part = tid_ >> 7; float a = 0.f;
        for (int k = part * 4096; k < (part + 1) * 4096; ++k) a += sc[k] * fp8_rnd(__uint_as_float((unsigned)Vb_[((size_t)b * SEQ + k) * 1024 + hh * DVH + d] << 16));
        LAS float* op = q + 256; op[tid_] = a; __syncthreads();
        float e2 = 0.f, r2 = 0.f;
        if (tid_ < 128) { const float o = (op[tid_] + op[tid_ + 128] + op[tid_ + 256] + op[tid_ + 384]) / ls; const float g = __uint_as_float((unsigned)O_[t * 1024 + hh * DVH + tid_] << 16); e2 = (o - g) * (o - g); r2 = o * o; }
        e2 = blk_sum(e2, red, tid_); r2 = blk_sum(r2, red, tid_); chk_flag(flag, e2, r2, 16u, tid_, SELFCHECK_TOL8);
    }
}
#endif
#ifndef MK_PER_PHASE
#define MK_PER_PHASE 0
#endif
constexpr int N_PHASES = 30;
constexpr int GEMM_SP2 = true, GEMM_ALIGN = true;

__global__ void __launch_bounds__(NWAVES * 64, 2) mega_fwd(Args args) {
    extern __shared__ __attribute__((aligned(16))) unsigned char lds[];
    LAS unsigned char* ldsl = (LAS unsigned char*)lds;
    volatile LAS unsigned* MISC = (volatile LAS unsigned*)(ldsl + MISC_OFF);
    const int wave = __builtin_amdgcn_readfirstlane((int)threadIdx.x >> 6);
#define lane hw_lane()
#define tid (wave * 64 + hw_lane())
#define G ((int)gridDim.x)
#define bx ((int)blockIdx.x)
#define gw (bx * NWAVES + wave)
#define ngw (G * NWAVES)
    { const int t_ = tid; if (t_ < 128) MISC[t_] = 0u; }
    __syncthreads();
    if (!MK_PER_PHASE) (void)xcd_barrier_post((unsigned*)(args.ws + WS_CTL) + CW_BAR, MISC + 8, (unsigned)wave);
    const int lo = args.ph_lo, hi = args.ph_hi;
#ifdef ONLY_PHASE
#define IN(k) ((k) == ONLY_PHASE && lo <= (k) && (k) < hi)
#else
#define IN(k) (lo <= (k) && (k) < hi)
#endif
#define GRIDBAR() do { XcdBarrier bar_; bar_.bar = (unsigned*)(args.ws + WS_CTL) + CW_BAR; bar_.x = xb_xcc_id(); bar_.st = MISC + 8; bar_.wv = (unsigned)wave; xcd_barrier(bar_); } while (0)
#define SEAM(k) do { if (IN(k) && IN((k) + 1)) GRIDBAR(); } while (0)
#ifndef PROBE_DUP
#define PROBE_DUP (-1)
#define PROBE_REP 1
#endif
#define RUN(k, REAL, DUMMY) do { if (IN(k)) { if (PROBE_DUP == (k)) { for (int rep_ = 0; rep_ < PROBE_REP; ++rep_) { DUMMY; GRIDBAR(); } } REAL; } } while (0)

#define P_(T_, off) ((T_*)(args.ws + (off)))
#define Win_t P_(bf16, WS_WIN)
#define Wuq_t P_(bf16, WS_WUQ)
#define Wukv_t P_(bf16, WS_WUKV)
#define Wo_t P_(bf16, WS_WO)
#define Whin_t P_(bf16, WS_WHIN)
#define Who_t P_(bf16, WS_WHO)
#define Wup_t P_(bf16, WS_WUP)
#define Wdn_t P_(bf16, WS_WDN)
#define Wfo_t P_(bf16, WS_WFO)
#define H3 P_(bf16, WS_H3)
#define XB P_(bf16, WS_XB)
#define XF P_(float, WS_XF)
#define CQN P_(bf16, WS_CQN)
#define CKVN P_(bf16, WS_CKVN)
#define ROPE P_(f32x2, WS_ROPE)
#define Qb P_(bf16, WS_Q)
#define Kb P_(unsigned char, WS_K)
#define Vb P_(bf16, WS_V)
#define VTb P_(unsigned char, WS_VT)
#define UH P_(bf16, WS_UH)
#define U P_(bf16, WS_U)
#define VC0 P_(float, WS_VC0)
#define VC1 P_(float, WS_VC1)
#define KT P_(float, WS_KT)
#define STASH P_(fftc::f2, WS_STASH)
#define KSPEC P_(fftc::f2, WS_KSPEC)
#define FTW (fftc::Tw{P_(const fftc::f2, WS_TW1), P_(const fftc::f2, WS_TW2), P_(const fftc::f2, WS_MOD)})
#define OUT (args.out)
#define H1 (args.out)
#define G1C ((bf16*)args.out)
#define G2C ((bf16*)args.out + (size_t)2 * 1024 * SEQ)
#define Z3C ((bf16*)args.out)
#define GEMM(EPI, A_, B_, M_, N_, K_, ...) do { pg8::Gemm g{(A_), (B_), (M_), (N_), (K_)}; pg8::StaticOrder S; S.init((M_), (N_), G, bx); pg8::EPI E{__VA_ARGS__}; \
        pg8::gemm_phase<pg8::EPI, pg8::StaticOrder, GEMM_ALIGN, GEMM_SP2>(ldsl, g, S, E, wave); } while (0)

    if (IN(0)) for (int prep_ = 0; prep_ < ((PROBE_DUP == 0) ? 1 + PROBE_REP : 1); ++prep_) {
        if (prep_) GRIDBAR();
        LAS float* scr = (LAS float*)(ldsl + wave * 16384);
        {
            int base = 0;
#define TR(W_, K_, N_, WT_, NP_, LDK_, CM_) do { const int nblk_ = (NP_) / 32, nit_ = ((K_) / 64) * nblk_; \
                for (int it_ = (gw + ngw - base % ngw) % ngw; it_ < nit_; it_ += ngw) transpose_item((W_), (K_), (N_), (WT_), (LDK_), scr, it_, nblk_, lane, CM_); base += nit_; } while (0)
            TR(args.in[I_MLA_WIN], DM, MLA_IN, Win_t, MLA_INP, DM, CmWin());
            TR(args.in[I_MLA_WUQ], QLORA, NH * DQK, Wuq_t, NH * DQK, QLORA, CmWuq());
            TR(args.in[I_MLA_WUKV], KVLORA, NH * 256, Wukv_t, NH * 256, KVLORA, CmWukv());
            TR(args.in[I_MLA_WO], DM, DM, Wo_t, DM, DM, CmIdent());
            TR(args.in[I_HY_WIN], DM, 3 * DM, Whin_t, 3 * DM, DM, CmIdent());
            TR(args.in[I_HY_WO], DM, DM, Who_t, DM, DM, CmIdent());
            TR(args.in[I_FFN_WUP], DM, NUP, Wup_t, NUP, DM, CmWup());
            TR(args.in[I_FFN_WUP] + (size_t)DM * NUP, DM, NUP, Wup_t + (size_t)NUP * DM, NUP, DM, CmWup());
            TR(args.in[I_FFN_WDOWN], DFF, DM, Wdn_t, DM, DFF, CmIdent());
            TR(args.in[I_FFN_WDOWN] + (size_t)DFF * DM, DFF, DM, Wdn_t + (size_t)DM * DFF, DM, DFF, CmIdent());
            TR(args.in[I_HY_FWOUT], HF, 4 * DM, Wfo_t, 4 * DM, HKP, CmIdent());
#undef TR
        }
        for (size_t i = (size_t)gw * 64 + lane; i < (size_t)4096 * 24; i += (size_t)ngw * 64) { const size_t r = i / 24, c = i % 24; *(u32x4t*)(Wfo_t + r * HKP + 64 + c * 8) = (u32x4t){0u, 0u, 0u, 0u}; }
        for (size_t i = (size_t)gw * 64 + lane; i < (size_t)SEQ * 24; i += (size_t)ngw * 64) { const size_t r = i / 24, c = i % 24; *(u32x4t*)(H3 + r * HKP + 64 + c * 8) = (u32x4t){0u, 0u, 0u, 0u}; }
        { const float* x_in = args.in[I_X];
          for (size_t i = (size_t)gw * 64 + lane; i < (size_t)T * DM / 8; i += (size_t)ngw * 64) { const f32x4 a = *(const f32x4*)(x_in + i * 8), b = *(const f32x4*)(x_in + i * 8 + 4);
            u32x4t w; w.x = pkbf(a.x, a.y); w.y = pkbf(a.z, a.w); w.z = pkbf(b.x, b.y); w.w = pkbf(b.z, b.w); *(u32x4t*)(XB + i * 8) = w; } }
        { const int* pos = (const int*)args.in[I_POS];
          for (size_t i = (size_t)gw * 64 + lane; i < (size_t)T * 32; i += (size_t)ngw * 64) { const int t = (int)(i >> 5), k = (int)(i & 31);
              const double inv = exp(-(double)k * (9.210340371976184 / 32.0)); const double ang = (double)pos[t] * inv; double s, c; sincos(ang, &s, &c); ROPE[i] = (f32x2){(float)c, (float)s}; } }
        { const float* fw1 = args.in[I_HY_FW1]; const float* fb1 = args.in[I_HY_FB1]; const float* fw2 = args.in[I_HY_FW2]; const float* fb2 = args.in[I_HY_FB2];
          const float* fw3 = args.in[I_HY_FW3]; const float* fb3 = args.in[I_HY_FB3]; const float fr = args.in[I_HY_FREQ][lane];
          for (int l = gw; l < SEQ; l += ngw) {
              const float tt = (float)l / (float)(SEQ - 1); const float w = 6.283185307179586f * (float)l / (float)SEQ;
              float z = 0.f;
              if (lane == 0) z = tt;
              else if (lane <= 16) { const float f = 1e-4f + (float)(lane - 1) * ((15.0f - 1e-4f) / 15.0f); z = cosf(f * w); }
              else if (lane <= 32) { const float f = 1e-4f + (float)(lane - 17) * ((15.0f - 1e-4f) / 15.0f); z = -sinf(f * w); }
              float a = fb1[lane];
#pragma unroll
              for (int i = 0; i < HEMB; ++i) a += __shfl(z, i) * fw1[i * HF + lane];
              float h = sinf(fr * a);
              a = fb2[lane];
#pragma unroll 8
              for (int i = 0; i < HF; ++i) a += __shfl(h, i) * fw2[i * HF + lane];
              h = sinf(fr * a);
              a = fb3[lane];
#pragma unroll 8
              for (int i = 0; i < HF; ++i) a += __shfl(h, i) * fw3[i * HF + lane];
              h = sinf(fr * a);
              H3[(size_t)l * HKP + lane] = (bf16)(pkbf(h, 0.f) & 0xffffu);
          } }
    }
    SEAM(0);
#define B1 GEMM(EpiF32, XB, Win_t, T, MLA_INP, DM, H1, MLA_INP)
    RUN(1, B1, B1);
    SEAM(1);
#define B2 mla_norm_rope(H1, args.in[I_MLA_GQ], args.in[I_MLA_GKV], ROPE, CQN, CKVN, Kb, gw, ngw, lane)
    RUN(2, B2, B2);
    SEAM(2);
#define B3 do { GEMM(EpiBf16, CQN, Wuq_t, T, NH * DQK, QLORA, Qb, NH * DQK, QSCALE); GEMM(EpiKV, CKVN, Wukv_t, T, NH * 256, KVLORA, Kb, Vb); GRIDBAR(); v_transpose_fp8(Vb, VTb, (LAS unsigned char*)(ldsl + wave * 8192), gw, ngw, lane); } while (0)
    RUN(3, B3, B3);
    SEAM(3);
#ifndef ATT_EXP
#define ATT_EXP 0
#endif
#define B4X(EXPV) do { for (int u = bx; u < BATCH * NH * (SEQ / 256); u += G) { const int qb = u & 63, h = (u >> 6) & 7, b = u >> 9; const size_t r0 = (size_t)b * SEQ + (size_t)qb * 256; \
            attn::attn_unit<EXPV>(Qb + r0 * 1536 + h * DQK, Kb + (size_t)b * SEQ * 1536 + h * DQK, VTb + ((size_t)b * 8 + h) * 128 * SEQ, XB + r0 * 1024 + h * DVH, (const float*)(ROPE + r0 * 32), SEQ, (char*)lds, wave); } } while (0)
    RUN(4, B4X(0), B4X(ATT_EXP));
#ifdef SELFCHECK
    if (IN(4) && IN(5)) { GRIDBAR(); selfcheck_mla(args, ldsl, bx, tid); }
#endif
    SEAM(4);
#define B5 GEMM(EpiResid, XB, Wo_t, T, DM, DM, args.in[I_X], XF, DN_ALPHA)
    RUN(5, B5, B5);
    SEAM(5);
    RUN(6, ln_rows(XF, nullptr, XB, args.in[I_LN1G], args.in[I_LN1B], gw, ngw, lane), ln_rows(XF, nullptr, XB, args.in[I_LN1G], args.in[I_LN1B], gw, ngw, lane));
    SEAM(6);
#define HACT P_(bf16, WS_S)
#define HALO P_(float, WS_S + 180 * MiB)
#define FFN_UP(layer) GEMM(EpiConvSilu, XB, Wup_t + (size_t)(layer) * NUP * DM, T, NUP, DM, HACT, args.in[I_FFN_WCONV] + (size_t)(layer) * 3 * NUP, HALO, (PG8_LAS float*)(ldsl + RING_BYTES))
#define FFN_FIX(layer) ffn_fixup_rows(HALO, args.in[I_FFN_WCONV] + (size_t)(layer) * 3 * NUP, HACT, gw, ngw, lane)
#define FFN_DN(layer, OUT_) GEMM(EpiResidB, HACT, Wdn_t + (size_t)(layer) * DM * DFF, T, DM, DFF, XB, (OUT_), DN_ALPHA)
#define FFN_LAYER(p, layer) \
    RUN(p, FFN_UP(layer), FFN_UP(layer)); SEAM(p); \
    RUN((p) + 1, FFN_FIX(layer), FFN_FIX(layer)); SEAM((p) + 1); \
    RUN((p) + 2, FFN_DN(layer, XF), FFN_DN(layer, OUT)); if (IN((p) + 2) && IN((p) + 6)) GRIDBAR();
    FFN_LAYER(7, 0)
    RUN(13, ln_rows(XF, XF, XB, args.in[I_LN2G], args.in[I_LN2B], gw, ngw, lane), ln_rows(XF, P_(float, WS_S), XB, args.in[I_LN2G], args.in[I_LN2B], gw, ngw, lane));
    SEAM(13);
#define B14 GEMM(EpiBf16, XB, Whin_t, T, 3 * DM, DM, U, 3 * DM, 1.0f)
    RUN(14, B14, B14);
    SEAM(14);
#define B15 hy_conv_transpose(U, args.in[I_HY_WSHORT], VC0, VC1, G1C, G2C, (LAS unsigned*)(ldsl + wave * 16384), gw, ngw, lane)
    RUN(15, B15, B15);
    SEAM(15);
#define HY_FILT(od) GEMM(EpiFilt, H3, Wfo_t + (size_t)(od) * 2048 * HKP, SEQ, 2 * DM, HKP, KT, SEQ, -120.39728043259360f, (40.54651081081644f + 120.39728043259360f) / 1023.0f, 1.0f / (float)(SEQ - 1))
#ifndef FFT_EV
#define FFT_EV 0
#endif
#define HY_FFT(MODE_, GC_, DB_) do { for (int c = bx; c < DM; c += G) { const size_t co = (size_t)c * SEQ; \
            fftc::hyena_channel<MODE_, ((MODE_) == 2 ? FFT_EV : 0)>((fftc::lf2*)ldsl, VC0 + co, VC1 + co, KT + co, KT + (size_t)DM * SEQ + co, (GC_) + co, (GC_) + (size_t)DM * SEQ + co, args.in[I_HY_DBIAS][(DB_) + c], \
                                       VC0 + co, VC1 + co, Z3C + co, Z3C + (size_t)DM * SEQ + co, STASH + (size_t)bx * SEQ, KSPEC + (size_t)bx * SEQ, tid); } } while (0)
    RUN(16, HY_FILT(0), HY_FILT(0)); SEAM(16);
    RUN(17, HY_FFT(0, G1C, 0), HY_FFT(2, G1C, 0)); SEAM(17);
    RUN(18, HY_FILT(1), HY_FILT(1)); SEAM(18);
    RUN(19, HY_FFT(1, G2C, DM), HY_FFT(1, G2C, DM)); SEAM(19);
#define B20 hy_transpose_back(Z3C, XB, (LAS unsigned*)(ldsl + wave * 16384), gw, ngw, lane)
    RUN(20, B20, B20);
    SEAM(20);
    RUN(21, GEMM(EpiResid, XB, Who_t, T, DM, DM, XF, XF, DN_ALPHA), GEMM(EpiResid, XB, Who_t, T, DM, DM, XF, P_(float, WS_S), DN_ALPHA));
    SEAM(21);
    RUN(22, ln_rows(XF, nullptr, XB, args.in[I_LN1G] + DM, args.in[I_LN1B] + DM, gw, ngw, lane), ln_rows(XF, nullptr, XB, args.in[I_LN1G] + DM, args.in[I_LN1B] + DM, gw, ngw, lane));
    SEAM(22);
    FFN_LAYER(23, 1)
#ifdef SELFCHECK
    if (IN(29)) { const unsigned mask = __hip_atomic_load((unsigned*)(args.ws + WS_CTL) + CW_CHK, __ATOMIC_RELAXED, __HIP_MEMORY_SCOPE_AGENT);
        ln_rows(XF, OUT, nullptr, args.in[I_LN2G] + DM, args.in[I_LN2B] + DM, gw, ngw, lane, 1.0f + 0.1f * (float)mask); }
#else
    RUN(29, ln_rows(XF, OUT, nullptr, args.in[I_LN2G] + DM, args.in[I_LN2B] + DM, gw, ngw, lane), ln_rows(XF, OUT, nullptr, args.in[I_LN2G] + DM, args.in[I_LN2B] + DM, gw, ngw, lane));
#endif
#undef IN
#undef SEAM
#undef lane
#undef tid
#undef G
#undef bx
#undef gw
#undef ngw
}

extern "C" void kernel_launch(void* const* d_in, const int* in_sizes, int n_in, void* d_out, int out_size, void* d_ws, size_t ws_size, hipStream_t stream) {
    static int grid = 0;
    if (grid == 0) {
        if (n_in != 27 || in_sizes[0] != T * DM || out_size != T * DM || ws_size < WS_END) { fprintf(stderr, "kernel_launch: shape/workspace mismatch (n_in %d, in0 %d, out %d, ws %zu)\n", n_in, n_in > 0 ? in_sizes[0] : -1, out_size, ws_size); grid = -1; return; }
        int dev = 0, cus = 0, per_cu = 0;
        if (hipGetDevice(&dev) != hipSuccess || hipDeviceGetAttribute(&cus, hipDeviceAttributeMultiprocessorCount, dev) != hipSuccess) { grid = -1; return; }
        if (hipFuncSetAttribute((const void*)mega_fwd, hipFuncAttributeMaxDynamicSharedMemorySize, LDS_BYTES) != hipSuccess) { fprintf(stderr, "kernel_launch: hipFuncSetAttribute failed\n"); grid = -1; return; }
        if (hipOccupancyMaxActiveBlocksPerMultiprocessor(&per_cu, (const void*)mega_fwd, NWAVES * 64, LDS_BYTES) != hipSuccess || per_cu < 1) { fprintf(stderr, "kernel_launch: occupancy query says %d\n", per_cu); }
        (void)hipGetLastError();
        grid = cus;
    }
    if (grid < 0) return;
    if (hipMemsetAsync((char*)d_ws + WS_CTL, 0, CTL_ZERO_BYTES, stream) != hipSuccess) return;
    Args a{};
    for (int i = 0; i < 27; ++i) a.in[i] = (const float*)d_in[i];
    a.out = (float*)d_out; a.ws = (unsigned char*)d_ws;
#if MK_PER_PHASE
    for (int p = 0; p < N_PHASES; ++p) { a.ph_lo = p; a.ph_hi = p + 1; hipLaunchKernelGGL(mega_fwd, dim3(grid), dim3(NWAVES * 64), LDS_BYTES, stream, a); }
#else
    a.ph_lo = 0; a.ph_hi = N_PHASES; hipLaunchKernelGGL(mega_fwd, dim3(grid), dim3(NWAVES * 64), LDS_BYTES, stream, a);
#endif
}
```

```cpp
#include <hip/hip_runtime.h>
#include <cstdio>
#include <cstdint>
__device__ __forceinline__ int hw_lane() { int l; asm volatile("v_mbcnt_lo_u32_b32 %0, -1, 0\n\tv_mbcnt_hi_u32_b32 %0, -1, %0" : "=v"(l)); return l; }
namespace pg8 {
#define PG8_LAS __attribute__((address_space(3)))
typedef unsigned short bf16_t;
typedef short bf16x8 __attribute__((ext_vector_type(8)));
typedef float f32x4 __attribute__((ext_vector_type(4)));
typedef unsigned u32x4 __attribute__((ext_vector_type(4)));
constexpr int BM = 256, BK = 64, HALF = 128, HTB = HALF * BK * 2  , STAGE_BYTES = 8 * HTB, NXCD = 8, WGM = 8;

__host__ __device__ __forceinline__ int lds_byte(int r, int c) { const int st = (r >> 4) * 2 + (c >> 5), rr = r & 15, cc = c & 31, ob = rr * 64 + cc * 2; return st * 1024 + (ob ^ (((ob >> 9) & 1) << 5)); }
__host__ __device__ __forceinline__ void stage_rc(int b, int& R, int& C) { const int st = b / 1024, sb = b % 1024, swz = sb ^ (((sb >> 9) & 1) << 5); R = (st >> 1) * 16 + swz / 64; C = (st & 1) * 32 + (swz % 64) / 2; }
__host__ __device__ __forceinline__ int perm32(int rho) { const int n = rho >> 4, i = rho & 15; return 8 * (i >> 2) + 4 * n + (i & 3); }

struct Unit { int pm, pn; };
struct Gemm { const bf16_t* A; const bf16_t* Bt; int M, N, K; };

struct StaticOrder {
    int nM, nN, nwg, G, c;
    __host__ __device__ void init(int M, int N, int G_, int c_) { nM = M / BM; nN = N / BM; nwg = nM * nN; G = G_; c = c_; }
    __host__ __device__ bool next(int i, Unit& u) const {
        const long L = (long)i * G + c; if (L >= nwg) return false;
        int wgid = (int)L; { const int q = nwg / NXCD, r = nwg % NXCD, xcd = wgid % NXCD, off = wgid / NXCD; wgid = (xcd < r ? xcd * (q + 1) : r * (q + 1) + (xcd - r) * q) + off; }
        const int nig = WGM * nN, gid = wgid / nig, fm = gid * WGM, gsz = (nM - fm) < WGM ? (nM - fm) : WGM;
        u.pm = fm + ((wgid % nig) % gsz); u.pn = (wgid % nig) / gsz; return true;
    }
    __device__ __forceinline__ void a_ready(const Unit&) const {}
    __device__ __forceinline__ void done(const Unit&) const {}
};

__device__ __forceinline__ unsigned cvt_pk_bf16(float lo, float hi) { unsigned r; asm volatile("v_cvt_pk_bf16_f32 %0, %1, %2" : "=v"(r) : "v"(lo), "v"(hi)); return r; }
typedef float f32x2 __attribute__((ext_vector_type(2)));

struct EpiF32 {
    static constexpr bool PERM = false, AFTER_DRAIN = false;
    float* C; int ldc;
    __device__ __forceinline__ void operator()(const f32x4 (&acc)[2][2][4][2], const Unit& u_, int wr, int wc, int fr, int fq) const {
        Unit u = u_; asm volatile("" : "+s"(u.pm), "+s"(u.pn)); { const int l_ = hw_lane(); fr = l_ & 15; fq = l_ >> 4; }
        const int row0 = u.pm * BM + wr * 64 + fr, col0 = u.pn * BM + wc * 32 + 4 * fq;
#pragma unroll
        for (int ai = 0; ai < 2; ++ai)
#pragma unroll
            for (int m = 0; m < 4; ++m) { float* rowp = C + (size_t)(row0 + ai * HALF + m * 16) * ldc + col0;
#pragma unroll
                for (int bj = 0; bj < 2; ++bj)
#pragma unroll
                    for (int n = 0; n < 2; ++n) *(f32x4*)(rowp + bj * HALF + n * 16) = acc[ai][bj][m][n]; }
    }
};
struct EpiBf16 {
    static constexpr bool PERM = true, AFTER_DRAIN = false;
    bf16_t* O; int ldc; float scale;
    __device__ __forceinline__ void operator()(const f32x4 (&acc)[2][2][4][2], const Unit& u_, int wr, int wc, int fr, int fq) const {
        Unit u = u_; asm volatile("" : "+s"(u.pm), "+s"(u.pn)); { const int l_ = hw_lane(); fr = l_ & 15; fq = l_ >> 4; }
        const int row0 = u.pm * BM + wr * 64 + fr, col0 = u.pn * BM + wc * 32 + 8 * fq;
#pragma unroll
        for (int ai = 0; ai < 2; ++ai)
#pragma unroll
            for (int m = 0; m < 4; ++m) { bf16_t* rowp = O + (size_t)(row0 + ai * HALF + m * 16) * ldc + col0;
#pragma unroll
                for (int bj = 0; bj < 2; ++bj) { const f32x4 v0 = acc[ai][bj][m][0] * scale, v1 = acc[ai][bj][m][1] * scale;
                    u32x4 w; w.x = cvt_pk_bf16(v0[0], v0[1]); w.y = cvt_pk_bf16(v0[2], v0[3]); w.z = cvt_pk_bf16(v1[0], v1[1]); w.w = cvt_pk_bf16(v1[2], v1[3]);
                    *(u32x4*)(rowp + bj * HALF) = w; } }
    }
};
template <bool BASE_BF16> struct EpiRes {
    static constexpr bool PERM = true, AFTER_DRAIN = false;
    const void* base; bf16_t* out; float alpha;
    __device__ __forceinline__ void operator()(const f32x4 (&acc)[2][2][4][2], const Unit& u_, int wr, int wc, int fr, int fq) const {
        Unit u = u_; asm volatile("" : "+s"(u.pm), "+s"(u.pn)); { const int l_ = hw_lane(); fr = l_ & 15; fq = l_ >> 4; }
        const int row0 = u.pm * BM + wr * 64 + fr, col0 = u.pn * BM + wc * 32 + 8 * fq;
#pragma unroll
        for (int ai = 0; ai < 2; ++ai)
#pragma unroll
            for (int m = 0; m < 4; ++m) { const size_t off = (size_t)(row0 + ai * HALF + m * 16) * 1024 + col0;
#pragma unroll
                for (int bj = 0; bj < 2; ++bj) { f32x4 b0, b1;
                    if (BASE_BF16) { const u32x4 b = *(const u32x4*)((const bf16_t*)base + off + bj * HALF);
                        b0 = (f32x4){__uint_as_float(b.x << 16), __uint_as_float(b.x & 0xffff0000u), __uint_as_float(b.y << 16), __uint_as_float(b.y & 0xffff0000u)};
                        b1 = (f32x4){__uint_as_float(b.z << 16), __uint_as_float(b.z & 0xffff0000u), __uint_as_float(b.w << 16), __uint_as_float(b.w & 0xffff0000u)}; }
                    else { b0 = *(const f32x4*)((const float*)base + off + bj * HALF); b1 = *(const f32x4*)((const float*)base + off + bj * HALF + 4); }
                    const f32x4 v0 = b0 * alpha + acc[ai][bj][m][0], v1 = b1 * alpha + acc[ai][bj][m][1];
                    u32x4 w; w.x = cvt_pk_bf16(v0[0], v0[1]); w.y = cvt_pk_bf16(v0[2], v0[3]); w.z = cvt_pk_bf16(v1[0], v1[1]); w.w = cvt_pk_bf16(v1[2], v1[3]);
                    *(u32x4*)(out + off + bj * HALF) = w; }
                if (m & 1) asm volatile("" ::: "memory"); }
    }
};
struct EpiKV {
    static constexpr bool PERM = true, AFTER_DRAIN = false;
    unsigned char* Kb; bf16_t* Vb;
    __device__ __forceinline__ void operator()(const f32x4 (&acc)[2][2][4][2], const Unit& u_, int wr, int wc, int fr, int fq) const {
        Unit u = u_; asm volatile("" : "+s"(u.pm), "+s"(u.pn)); { const int l_ = hw_lane(); fr = l_ & 15; fq = l_ >> 4; }
        const int row0 = u.pm * BM + wr * 64 + fr, col0 = u.pn * BM + wc * 32 + 8 * fq;
        typedef unsigned u32x2 __attribute__((ext_vector_type(2)));
#pragma unroll
        for (int bj = 0; bj < 2; ++bj) { const int c = col0 + bj * HALF; const bool isk = c < 1024;
#pragma unroll
            for (int ai = 0; ai < 2; ++ai)
#pragma unroll
                for (int m = 0; m < 4; ++m) { const int row = row0 + ai * HALF + m * 16; const f32x4 v0 = acc[ai][bj][m][0], v1 = acc[ai][bj][m][1];
                    if (isk) { u32x2 w; int t = __builtin_amdgcn_cvt_pk_fp8_f32(v0[0], v0[1], 0, false); t = __builtin_amdgcn_cvt_pk_fp8_f32(v0[2], v0[3], t, true); w.x = (unsigned)t;
                        t = __builtin_amdgcn_cvt_pk_fp8_f32(v1[0], v1[1], 0, false); t = __builtin_amdgcn_cvt_pk_fp8_f32(v1[2], v1[3], t, true); w.y = (unsigned)t;
                        *(u32x2*)(Kb + (size_t)row * 1536 + (c >> 7) * 192 + (c & 127)) = w; }
                    else { u32x4 w; w.x = cvt_pk_bf16(v0[0], v0[1]); w.y = cvt_pk_bf16(v0[2], v0[3]); w.z = cvt_pk_bf16(v1[0], v1[1]); w.w = cvt_pk_bf16(v1[2], v1[3]);
                        *(u32x4*)(Vb + (size_t)row * 1024 + (c - 1024)) = w; } } }
    }
};
#define DPP_SHR1 0x111
#define DPP_SHL1 0x101
#define DPP_SHL15 0x10F
#define DPP_SHR15 0x11F
template <int CTRL> __device__ __forceinline__ float dpp_mov(float old, float src) { return __int_as_float(__builtin_amdgcn_update_dpp(__float_as_int(old), __float_as_int(src), CTRL, 0xF, 0xF, false)); }
struct EpiConvSilu {
    static constexpr bool PERM = true, AFTER_DRAIN = false;
    bf16_t* H; const float* wcv; float* halo; PG8_LAS float* ex;
    __device__ __forceinline__ void operator()(const f32x4 (&acc)[2][2][4][2], const Unit& u_, int wr, int wc, int fr, int fq) const {
        Unit u = u_; asm volatile("" : "+s"(u.pm), "+s"(u.pn)); { const int l_ = hw_lane(); fr = l_ & 15; fq = l_ >> 4; }
        const int hc0 = wc * 32 + 8 * fq;
#pragma unroll
        for (int ai = 0; ai < 2; ++ai)
#pragma unroll
            for (int bj = 0; bj < 2; ++bj)
#pragma unroll
                for (int n = 0; n < 2; ++n) {
                    if (fr == 0)  *(PG8_LAS f32x4*)(ex + ((ai * 2 + wr) * 2 + 0) * 256 + bj * 128 + hc0 + 4 * n) = acc[ai][bj][0][n];
                    if (fr == 15) *(PG8_LAS f32x4*)(ex + ((ai * 2 + wr) * 2 + 1) * 256 + bj * 128 + hc0 + 4 * n) = acc[ai][bj][3][n]; }
        if (wr == 0 && fr < 2) {
#pragma unroll
            for (int bj = 0; bj < 2; ++bj)
#pragma unroll
                for (int n = 0; n < 2; ++n) *(f32x4*)(halo + ((size_t)u.pm * 4 + fr) * 5632 + u.pn * 256 + bj * 128 + hc0 + 4 * n) = acc[0][bj][0][n]; }
        if (wr == 1 && fr >= 14) {
#pragma unroll
            for (int bj = 0; bj < 2; ++bj)
#pragma unroll
                for (int n = 0; n < 2; ++n) *(f32x4*)(halo + ((size_t)u.pm * 4 + 2 + (fr - 14)) * 5632 + u.pn * 256 + bj * 128 + hc0 + 4 * n) = acc[1][bj][3][n]; }
        asm volatile("s_waitcnt lgkmcnt(0)" ::: "memory"); __builtin_amdgcn_s_barrier(); asm volatile("" ::: "memory");
        float wv[2][3][8];
        { const int cg = u.pn * 128 + hc0;
#pragma unroll
          for (int bj = 0; bj < 2; ++bj)
#pragma unroll
            for (int k = 0; k < 3; ++k) { const f32x4 t0 = *(const f32x4*)(wcv + k * 5632 + bj * 2816 + cg), t1 = *(const f32x4*)(wcv + k * 5632 + bj * 2816 + cg + 4);
                wv[bj][k][0] = t0[0]; wv[bj][k][1] = t0[1]; wv[bj][k][2] = t0[2]; wv[bj][k][3] = t0[3]; wv[bj][k][4] = t1[0]; wv[bj][k][5] = t1[1]; wv[bj][k][6] = t1[2]; wv[bj][k][7] = t1[3]; } }
#pragma unroll
        for (int ai = 0; ai < 2; ++ai) {
            const int ch = ai * 2 + wr, cp = ch > 0 ? ch - 1 : 0, cn = ch < 3 ? ch + 1 : 3;
            f32x4 pe[2][2], ne[2][2];
#pragma unroll
            for (int bj = 0; bj < 2; ++bj)
#pragma unroll
                for (int n = 0; n < 2; ++n) { pe[bj][n] = *(const PG8_LAS f32x4*)(ex + (cp * 2 + 1) * 256 + bj * 128 + hc0 + 4 * n); ne[bj][n] = *(const PG8_LAS f32x4*)(ex + (cn * 2 + 0) * 256 + bj * 128 + hc0 + 4 * n); }
#pragma unroll
            for (int m = 0; m < 4; ++m) {
                float hv[2][8];
#pragma unroll
                for (int bj = 0; bj < 2; ++bj)
#pragma unroll
                    for (int n = 0; n < 2; ++n)
#pragma unroll
                        for (int j = 0; j < 4; ++j) {
                            const float cur = acc[ai][bj][m][n][j];
                            const float pin = (m > 0) ? dpp_mov<DPP_SHL15>(0.f, acc[ai][bj][m > 0 ? m - 1 : 0][n][j]) : pe[bj][n][j];
                            const float nin = (m < 3) ? dpp_mov<DPP_SHR15>(0.f, acc[ai][bj][m < 3 ? m + 1 : 3][n][j]) : ne[bj][n][j];
                            const float prv = dpp_mov<DPP_SHR1>(pin, cur), nxt = dpp_mov<DPP_SHL1>(nin, cur);
                            hv[bj][4 * n + j] = wv[bj][0][4 * n + j] * prv + wv[bj][1][4 * n + j] * cur + wv[bj][2][4 * n + j] * nxt; }
                float o[8];
#pragma unroll
                for (int i = 0; i < 8; ++i) o[i] = hv[0][i] * hv[1][i] * __builtin_amdgcn_rcpf(1.f + __expf(-hv[1][i]));
                u32x4 w; w.x = cvt_pk_bf16(o[0], o[1]); w.y = cvt_pk_bf16(o[2], o[3]); w.z = cvt_pk_bf16(o[4], o[5]); w.w = cvt_pk_bf16(o[6], o[7]);
                *(u32x4*)(H + (size_t)(u.pm * BM + ai * HALF + wr * 64 + m * 16 + fr) * 2816 + u.pn * 128 + hc0) = w;
            }
        }
        asm volatile("s_waitcnt lgkmcnt(0)" ::: "memory"); __builtin_amdgcn_s_barrier(); asm volatile("" ::: "memory");
    }
};

struct EpiFilt {
    static constexpr bool PERM = false, AFTER_DRAIN = false;
    float* KT; int L; float d0, dstep, tinv;
    __device__ __forceinline__ void operator()(const f32x4 (&acc)[2][2][4][2], const Unit& u_, int wr, int wc, int fr, int fq) const {
        Unit u = u_; asm volatile("" : "+s"(u.pm), "+s"(u.pn)); { const int l_ = hw_lane(); fr = l_ & 15; fq = l_ >> 4; }
        const int row0 = u.pm * BM + wr * 64 + fr, col0 = u.pn * BM + wc * 32 + 4 * fq;
#pragma unroll
        for (int bj = 0; bj < 2; ++bj)
#pragma unroll
            for (int n = 0; n < 2; ++n) { const int c = col0 + bj * HALF + n * 16;
#pragma unroll
                for (int j = 0; j < 4; ++j) { const int cc = c + j, ch = cc & 1023; const float nd = -__builtin_fabsf(d0 + (float)ch * dstep) * tinv; float* dst = KT + (size_t)cc * L;
#pragma unroll
                    for (int ai = 0; ai < 2; ++ai)
#pragma unroll
                        for (int m = 0; m < 4; ++m) { const int l = row0 + ai * HALF + m * 16; dst[l] = acc[ai][bj][m][n][j] * __expf(nd * (float)l); } } }
    }
};

template <class Epi, class Sched, bool ALIGN_EPI = false, bool SP2 = false>
__device__ __forceinline__ void gemm_phase(PG8_LAS unsigned char* lds, const Gemm g, const Sched& S, const Epi& E, int wid_in) {
    const int wid = wid_in, lane = hw_lane(), tid = wid * 64 + lane, wr = wid >> 2, wc = wid & 3, fr = lane & 15, fq = lane >> 4;
    const int K = g.K, nt = K / BK;
    unsigned voffA[2], voffB[2];
#pragma unroll
    for (int i = 0; i < 2; ++i) { int R, C; stage_rc(tid * 16 + i * 8192, R, C); const int Rb = Epi::PERM ? ((R & ~31) + perm32(R & 31)) : R;
        voffA[i] = (unsigned)(R * K + C) * 2u; voffB[i] = (unsigned)(Rb * K + C) * 2u; }
    const size_t kstep = (size_t)(BK * 2);
    const size_t hstep = (size_t)HALF * K * 2;
    const size_t tstep = 2 * hstep;
    const unsigned ldsw = (unsigned)wid * 1024u;
    const int aoff = lds_byte(wr * 64 + fr, fq * 8), boff = lds_byte(wc * 32 + fr, fq * 8);
#define PG8_SA(b, h) (((b) * 2 + (h)) * HTB)
#define PG8_SB(b, h) ((4 + (b) * 2 + (h)) * HTB)
#define PG8_STAGE(bufoff, gbase, voff) do { _Pragma("unroll") for (int _i = 0; _i < 2; ++_i) \
        __builtin_amdgcn_global_load_lds((const unsigned*)((const char*)(gbase) + (voff)[_i]), (PG8_LAS unsigned*)(lds + (bufoff) + ldsw + _i * 8192), 16, 0, 0); } while (0)
#define PG8_LDA(dst, b, h) do { _Pragma("unroll") for (int m = 0; m < 4; ++m) _Pragma("unroll") for (int k = 0; k < 2; ++k) dst[m][k] = *(const PG8_LAS bf16x8*)(lds + PG8_SA(b, h) + aoff + m * 2048 + k * 1024); } while (0)
#define PG8_LDB(dst, b, h) do { _Pragma("unroll") for (int n = 0; n < 2; ++n) _Pragma("unroll") for (int k = 0; k < 2; ++k) dst[n][k] = *(const PG8_LAS bf16x8*)(lds + PG8_SB(b, h) + boff + n * 2048 + k * 1024); } while (0)
#define PG8_MMA(ai, bj, At, Bt) do { __builtin_amdgcn_s_setprio(1); _Pragma("unroll") for (int m = 0; m < 4; ++m) _Pragma("unroll") for (int n = 0; n < 2; ++n) _Pragma("unroll") for (int k = 0; k < 2; ++k) \
        acc[ai][bj][m][n] = __builtin_amdgcn_mfma_f32_16x16x32_bf16(Bt[n][k], At[m][k], acc[ai][bj][m][n], 0, 0, 0); __builtin_amdgcn_s_setprio(0); } while (0)
#define PG8_WAIT_V(n) asm volatile("s_waitcnt vmcnt(" #n ")" ::: "memory")
#define PG8_WAIT_L(n) asm volatile("s_waitcnt lgkmcnt(" #n ")" ::: "memory")
#define PG8_BAR __builtin_amdgcn_s_barrier()
#define PG8_SCHED __builtin_amdgcn_sched_barrier(0)
    Unit cur, nxt; int ui = 0;
    if (!S.next(0, cur)) return;
    f32x4 acc[2][2][4][2];
#pragma unroll
    for (int a = 0; a < 2; ++a)
#pragma unroll
        for (int b = 0; b < 2; ++b)
#pragma unroll
            for (int m = 0; m < 4; ++m)
#pragma unroll
                for (int n = 0; n < 2; ++n) acc[a][b][m][n] = (f32x4){0.f, 0.f, 0.f, 0.f};
    bf16x8 At[4][2], B0[2][2], B1[2][2];
    const char* cA = (const char*)g.A + (size_t)cur.pm * tstep; const char* cB = (const char*)g.Bt + (size_t)cur.pn * tstep;
    S.a_ready(cur);
    if constexpr (SP2) {
        PG8_STAGE(PG8_SB(0, 0), cB, voffB); PG8_STAGE(PG8_SB(0, 1), cB + hstep, voffB); PG8_STAGE(PG8_SA(0, 0), cA, voffA); PG8_STAGE(PG8_SA(0, 1), cA + hstep, voffA);
        if (wr == 1) PG8_BAR;
        PG8_WAIT_V(2); PG8_BAR;
        PG8_STAGE(PG8_SB(1, 0), cB + kstep, voffB); PG8_STAGE(PG8_SA(1, 0), cA + kstep, voffA); PG8_STAGE(PG8_SB(1, 1), cB + hstep + kstep, voffB);
        PG8_WAIT_V(6); PG8_BAR;
    } else {
        PG8_STAGE(PG8_SB(0, 0), cB, voffB); PG8_STAGE(PG8_SA(0, 0), cA, voffA); PG8_STAGE(PG8_SB(0, 1), cB + hstep, voffB); PG8_STAGE(PG8_SA(0, 1), cA + hstep, voffA);
        if (wr == 1) PG8_BAR;
        PG8_WAIT_V(4); PG8_BAR;
        PG8_STAGE(PG8_SB(1, 0), cB + kstep, voffB); PG8_STAGE(PG8_SA(1, 0), cA + kstep, voffA); PG8_STAGE(PG8_SB(1, 1), cB + hstep + kstep, voffB);
        PG8_WAIT_V(6); PG8_BAR;
    }
    for (;;) {
        const bool has_next = S.next(ui + 1, nxt);
        const char* nA = has_next ? (const char*)g.A + (size_t)nxt.pm * tstep : cA; const char* nB = has_next ? (const char*)g.Bt + (size_t)nxt.pn * tstep : cB;
        for (int t = 0; t < nt; t += 2) {
            const bool last = (t == nt - 2);
            const char* a1 = cA + (size_t)(t + 1) * kstep;
            const char* a2 = last ? nA : cA + (size_t)(t + 2) * kstep; const char* b2 = last ? nB : cB + (size_t)(t + 2) * kstep;
            const char* a3 = a2 + kstep; const char* b3 = b2 + kstep;
            if (last && has_next) S.a_ready(nxt);
            if constexpr (SP2) {
            PG8_LDB(B0, 0, 0); PG8_LDB(B1, 0, 1); PG8_SCHED; PG8_LDA(At, 0, 0); PG8_STAGE(PG8_SA(1, 1), a1 + hstep, voffA);
            PG8_WAIT_V(8); PG8_WAIT_L(0); PG8_BAR; PG8_MMA(0, 0, At, B0); PG8_MMA(0, 1, At, B1); PG8_BAR; PG8_SCHED;
            PG8_LDA(At, 0, 1); PG8_STAGE(PG8_SB(0, 0), b2, voffB); PG8_STAGE(PG8_SB(0, 1), b2 + hstep, voffB); PG8_STAGE(PG8_SA(0, 0), a2, voffA);
            PG8_WAIT_V(8); PG8_WAIT_L(0); PG8_BAR; PG8_MMA(1, 0, At, B0); PG8_MMA(1, 1, At, B1); PG8_BAR; PG8_SCHED;
            PG8_LDB(B0, 1, 0); PG8_LDB(B1, 1, 1); PG8_SCHED; PG8_LDA(At, 1, 0); PG8_STAGE(PG8_SA(0, 1), a2 + hstep, voffA);
            PG8_WAIT_V(8); PG8_WAIT_L(0); PG8_BAR; PG8_MMA(0, 0, At, B0); PG8_MMA(0, 1, At, B1); PG8_BAR; PG8_SCHED;
            PG8_LDA(At, 1, 1); PG8_STAGE(PG8_SB(1, 0), b3, voffB); PG8_STAGE(PG8_SB(1, 1), b3 + hstep, voffB); PG8_STAGE(PG8_SA(1, 0), a3, voffA);
            PG8_WAIT_V(8); PG8_WAIT_L(0); PG8_BAR; PG8_MMA(1, 0, At, B0); PG8_MMA(1, 1, At, B1); PG8_BAR; PG8_SCHED;
            } else {
            PG8_LDB(B0, 0, 0); PG8_SCHED; PG8_LDA(At, 0, 0); PG8_STAGE(PG8_SA(1, 1), a1 + hstep, voffA);
            PG8_WAIT_L(8); PG8_BAR; PG8_WAIT_L(0); PG8_MMA(0, 0, At, B0); PG8_BAR; PG8_SCHED;
            PG8_LDB(B1, 0, 1); PG8_STAGE(PG8_SB(0, 0), b2, voffB);
            PG8_BAR; PG8_WAIT_L(0); PG8_MMA(0, 1, At, B1); PG8_BAR;
            PG8_LDA(At, 0, 1); PG8_STAGE(PG8_SA(0, 0), a2, voffA);
            PG8_BAR; PG8_WAIT_L(0); PG8_MMA(1, 0, At, B0); PG8_BAR; PG8_SCHED;
            PG8_STAGE(PG8_SB(0, 1), b2 + hstep, voffB);
            PG8_WAIT_V(6); PG8_BAR; PG8_MMA(1, 1, At, B1); PG8_BAR;
            PG8_LDB(B0, 1, 0); PG8_SCHED; PG8_LDA(At, 1, 0); PG8_STAGE(PG8_SA(0, 1), a2 + hstep, voffA);
            PG8_WAIT_L(8); PG8_BAR; PG8_WAIT_L(0); PG8_MMA(0, 0, At, B0); PG8_BAR; PG8_SCHED;
            PG8_LDB(B1, 1, 1); PG8_STAGE(PG8_SB(1, 0), b3, voffB);
            PG8_BAR; PG8_WAIT_L(0); PG8_MMA(0, 1, At, B1); PG8_BAR;
            PG8_LDA(At, 1, 1); PG8_STAGE(PG8_SA(1, 0), a3, voffA);
            PG8_BAR; PG8_WAIT_L(0); PG8_MMA(1, 0, At, B0); PG8_BAR; PG8_SCHED;
            PG8_STAGE(PG8_SB(1, 1), b3 + hstep, voffB);
            PG8_WAIT_V(6); PG8_BAR; PG8_MMA(1, 1, At, B1); PG8_BAR;
            }
        }
        if constexpr (ALIGN_EPI) { if (wr == 0) PG8_BAR; }
        if constexpr (!Epi::AFTER_DRAIN) { E(acc, cur, wr, wc, fr, fq); S.done(cur); }
        if (!has_next) break;
#pragma unroll
        for (int a = 0; a < 2; ++a)
#pragma unroll
            for (int b = 0; b < 2; ++b)
#pragma unroll
                for (int m = 0; m < 4; ++m)
#pragma unroll
                    for (int n = 0; n < 2; ++n) acc[a][b][m][n] = (f32x4){0.f, 0.f, 0.f, 0.f};
        cur = nxt; cA = nA; cB = nB; ++ui;
        if constexpr (ALIGN_EPI) { if (wr == 1) PG8_BAR; }
    }
    PG8_WAIT_V(0);
    if constexpr (!ALIGN_EPI) { if (wr == 0) PG8_BAR; }
    PG8_BAR;
    if constexpr (Epi::AFTER_DRAIN) { E.fused(acc, cur, wr, wc, fr, fq, lds, wid, lane); S.done(cur); }
#undef PG8_SA
#undef PG8_SB
#undef PG8_STAGE
#undef PG8_LDA
#undef PG8_LDB
#undef PG8_MMA
#undef PG8_WAIT_V
#undef PG8_WAIT_L
#undef PG8_BAR
#undef PG8_SCHED
}
}
#define GAS __attribute__((address_space(1)))
#define LAS __attribute__((address_space(3)))
typedef unsigned short bf16;
typedef unsigned v4u __attribute__((ext_vector_type(4)));
typedef float f32x4 __attribute__((ext_vector_type(4)));
typedef short bf16x8 __attribute__((ext_vector_type(8)));
typedef GAS unsigned gu32;
typedef GAS unsigned long long gu64;
#define RLX_AGENT __ATOMIC_RELAXED, __HIP_MEMORY_SCOPE_AGENT
#define LDS_WAIT() asm volatile("s_waitcnt lgkmcnt(0)" ::: "memory")
#define VM_WAIT() asm volatile("s_waitcnt vmcnt(0)" ::: "memory")
__device__ __forceinline__ unsigned long long rt() { return __builtin_amdgcn_s_memrealtime(); }
__device__ __forceinline__ unsigned f2bf(float f) { unsigned u = __builtin_bit_cast(unsigned, f); return (u + 0x7fffu + ((u >> 16) & 1u)) >> 16; }
__device__ __forceinline__ unsigned pk2(float lo, float hi) { return f2bf(lo) | (f2bf(hi) << 16); }

#define XB_TMO      128
#define XB_XCNT(j)  (256  + 64 * (j))
#define XB_XSUB(j)  (1280 + 64 * (j))
#define XB_XGEN(j)  (2304 + 64 * (j))
#define XB_TOP      3328
#define XB_TOPGEN   3392
#define XCD_BAR_WORDS 3456
#define XB_SPIN_CAP (1u << 18)

__device__ __forceinline__ unsigned xb_ld(unsigned* p)              { return __hip_atomic_load(p, __ATOMIC_RELAXED, __HIP_MEMORY_SCOPE_AGENT); }
__device__ __forceinline__ unsigned xb_add(unsigned* p, unsigned v) { return __hip_atomic_fetch_add(p, v, __ATOMIC_RELAXED, __HIP_MEMORY_SCOPE_AGENT); }
__device__ __forceinline__ unsigned xb_xcc_id() { return (unsigned)__builtin_amdgcn_s_getreg((3 << 11) | 20) & 0xFu; }
#define XB_SPIN(cond, bar) do { unsigned _sp = 0; while (cond) { __builtin_amdgcn_s_sleep(1); \
    if ((++_sp & 255u) == 0u) { if (xb_ld(&(bar)[XB_TMO])) break; if (_sp > XB_SPIN_CAP) { atomicAdd(&(bar)[XB_TMO], 1u); break; } } } } while (0)

struct XcdBarrier {
    unsigned* bar; unsigned x; unsigned wv;
    volatile LAS unsigned* st;
};

__device__ __forceinline__ XcdBarrier xcd_barrier_post(unsigned* bar, volatile LAS unsigned* st, unsigned wv) {
    XcdBarrier b; b.bar = bar; b.x = xb_xcc_id(); b.st = st; b.wv = wv;
    if (wv == 0u && hw_lane() == 0) (void)xb_add(&bar[XB_XCNT(b.x)], 1u);
    return b;
}
__device__ __forceinline__ void xcd_barrier_complete(unsigned* bar, unsigned x, unsigned& nloc, unsigned& nx) {
    const unsigned G = gridDim.x * gridDim.y * gridDim.z;
    unsigned sum, cnt, mine, sp = 0u;
    for (;;) {
        sum = 0u; cnt = 0u; mine = 0u;
#pragma unroll
        for (unsigned j = 0; j < 16; ++j) { const unsigned c = xb_ld(&bar[XB_XCNT(j)]); sum += c; cnt += (c > 0u) ? 1u : 0u; mine = (j == x) ? c : mine; }
        if (sum == G) break;
        __builtin_amdgcn_s_sleep(1);
        if ((++sp & 255u) == 0u) { if (xb_ld(&bar[XB_TMO])) break; if (sp > XB_SPIN_CAP) { atomicAdd(&bar[XB_TMO], 1u); break; } }
    }
    nloc = mine > 0u ? mine : 1u; nx = cnt > 0u ? cnt : 1u;
}

__device__ __forceinline__ void xcd_barrier(const XcdBarrier& b) {
    asm volatile("s_waitcnt vmcnt(0)" ::: "memory");
    __syncthreads();
    if (b.wv == 0u && hw_lane() == 0) {
        unsigned* bar = b.bar;
        __builtin_amdgcn_s_waitcnt(0);
        unsigned nloc = b.st[0], nx = b.st[1];
        if (nloc == 0u) { xcd_barrier_complete(bar, b.x, nloc, nx); b.st[0] = nloc; b.st[1] = nx; }
        const unsigned old = xb_add(&bar[XB_XSUB(b.x)], 1u);
        const unsigned gen = old / nloc;
        if (old + 1u == (gen + 1u) * nloc) {
            __builtin_amdgcn_fence(__ATOMIC_RELEASE, "agent");
            asm volatile("s_waitcnt vmcnt(0)" ::: "memory");
            const unsigned og = xb_add(&bar[XB_TOP], 1u);
            const unsigned tg = og / nx;
            if (og + 1u == (tg + 1u) * nx) xb_add(&bar[XB_TOPGEN], 1u);
            else XB_SPIN(xb_ld(&bar[XB_TOPGEN]) == tg, bar);
            __builtin_amdgcn_fence(__ATOMIC_ACQUIRE, "agent");
            xb_add(&bar[XB_XGEN(b.x)], 1u);
            asm volatile("s_waitcnt vmcnt(0)" ::: "memory");
        } else {
            XB_SPIN(xb_ld(&bar[XB_XGEN(b.x)]) == gen, bar);
            __builtin_amdgcn_fence(__ATOMIC_ACQUIRE, "agent");
            asm volatile("s_waitcnt vmcnt(0)" ::: "memory");
        }
    }
    __syncthreads();
}
namespace attn {
using f32x16 = __attribute__((ext_vector_type(16))) float;
using u32x4  = __attribute__((ext_vector_type(4))) unsigned;
constexpr int NW = 8, QBLK = 32, KVBLK = 64, DQ = 192, DVV = 128;
constexpr int LDQ = 1536, LDO = 1024;
constexpr float THRL = 7.0f;
#define SBAR() __builtin_amdgcn_sched_barrier(0)
__device__ __forceinline__ int crow(int r, int hi) { return (r & 3) + 8 * (r >> 2) + 4 * hi; }
typedef int v8i __attribute__((ext_vector_type(8)));
typedef int v4i __attribute__((ext_vector_type(4)));
__device__ __forceinline__ int pk8(float a, float b, float c, float d) { int t = __builtin_amdgcn_cvt_pk_fp8_f32(a, b, 0, false); return __builtin_amdgcn_cvt_pk_fp8_f32(c, d, t, true); }
__device__ __forceinline__ unsigned cvtpk(float lo, float hi) { unsigned r; asm volatile("v_cvt_pk_bf16_f32 %0, %1, %2" : "=v"(r) : "v"(lo), "v"(hi)); return r; }

__device__ __forceinline__ float softmaxPP(f32x16& p0, f32x16& p1, float& m_reg, f32x16& negm, float& l_reg, bool first, v8i& pa) {
  float a0 = fmaxf(fmaxf(p0[0], p0[1]), fmaxf(p0[2], p0[3])), a1 = fmaxf(fmaxf(p0[4], p0[5]), fmaxf(p0[6], p0[7])), a2 = fmaxf(fmaxf(p0[8], p0[9]), fmaxf(p0[10], p0[11])), a3 = fmaxf(fmaxf(p0[12], p0[13]), fmaxf(p0[14], p0[15]));
  a0 = fmaxf(a0, fmaxf(fmaxf(p1[0], p1[1]), fmaxf(p1[2], p1[3]))); a1 = fmaxf(a1, fmaxf(fmaxf(p1[4], p1[5]), fmaxf(p1[6], p1[7]))); a2 = fmaxf(a2, fmaxf(fmaxf(p1[8], p1[9]), fmaxf(p1[10], p1[11]))); a3 = fmaxf(a3, fmaxf(fmaxf(p1[12], p1[13]), fmaxf(p1[14], p1[15])));
  float pmax = fmaxf(fmaxf(a0, a1), fmaxf(a2, a3));
  { auto rr = __builtin_amdgcn_permlane32_swap(__float_as_uint(pmax), __float_as_uint(pmax), false, false); pmax = fmaxf(__uint_as_float(rr[0]), __uint_as_float(rr[1])); }
  float alpha = 1.f;
  if (__builtin_expect(first || __any(pmax > THRL), 0)) { const float dl = first ? pmax : fmaxf(pmax, 0.f); alpha = first ? 1.f : __builtin_amdgcn_exp2f(-dl); m_reg += dl;
    for (int r = 0; r < 16; ++r) { p0[r] -= dl; p1[r] -= dl; }
    for (int r = 0; r < 16; ++r) negm[r] = -m_reg; }
  for (int r = 0; r < 16; ++r) p0[r] = __builtin_amdgcn_exp2f(p0[r]);
  for (int r = 0; r < 16; ++r) p1[r] = __builtin_amdgcn_exp2f(p1[r]);
  float s0 = (p0[0] + p0[1]) + (p0[2] + p0[3]), s1 = (p0[4] + p0[5]) + (p0[6] + p0[7]), s2 = (p0[8] + p0[9]) + (p0[10] + p0[11]), s3 = (p0[12] + p0[13]) + (p0[14] + p0[15]);
  s0 += (p1[0] + p1[1]) + (p1[2] + p1[3]); s1 += (p1[4] + p1[5]) + (p1[6] + p1[7]); s2 += (p1[8] + p1[9]) + (p1[10] + p1[11]); s3 += (p1[12] + p1[13]) + (p1[14] + p1[15]);
  float ps = (s0 + s1) + (s2 + s3);
  { auto rr = __builtin_amdgcn_permlane32_swap(__float_as_uint(ps), __float_as_uint(ps), false, false); ps = __uint_as_float(rr[0]) + __uint_as_float(rr[1]); }
  l_reg = l_reg * alpha + ps;
#pragma unroll
  for (int w = 0; w < 4; ++w) { pa[w] = pk8(p0[4 * w], p0[4 * w + 1], p0[4 * w + 2], p0[4 * w + 3]); pa[4 + w] = pk8(p1[4 * w], p1[4 * w + 1], p1[4 * w + 2], p1[4 * w + 3]); }
  return alpha;
}
typedef unsigned short bf16r;
constexpr int KROWB = 192, LDKB = 1536, SHM_K3 = KVBLK * KROWB, SHM_V3 = KVBLK * DVV, NSLOT = 4;
constexpr int LDS_K3 = 0, LDS_V3 = NSLOT * SHM_K3, LDS_WS3 = LDS_V3 + NSLOT * SHM_V3, SHM_ATTN3 = LDS_WS3 + NW * 64 * 4;
__device__ __forceinline__ void glds16(const void* gsrc, unsigned lds_dst) { unsigned keep;
  asm volatile("s_mov_b32 %0, m0\n\ts_mov_b32 m0, %2\n\ts_nop 0\n\tglobal_load_lds_dwordx4 %1, off\n\ts_mov_b32 m0, %0" : "=&s"(keep) : "v"(gsrc), "s"(lds_dst) : "memory"); }
__device__ __forceinline__ float bfl(unsigned w) { return __uint_as_float(w << 16); }
__device__ __forceinline__ float bfh(unsigned w) { return __uint_as_float(w & 0xffff0000u); }
template <int AEXP> __device__ __forceinline__ void attn_unit(const bf16r* __restrict__ Qb, const unsigned char* __restrict__ Kh, const unsigned char* __restrict__ Vh, bf16r* __restrict__ Ob, const float* __restrict__ tab, int seq, char* lds, int wid) {
  const int lane = hw_lane(), r32 = lane & 31, hi = lane >> 5;
  const unsigned lds0 = (unsigned)(uintptr_t)lds;
  float* wsf = (float*)(lds + LDS_WS3) + wid * 64; float* li_l = wsf; float* al_l = wsf + 32;
  float m_reg = 0.f, l_reg = 0; f32x16 o[4] = {}; v8i qf[3]; f32x16 negm = {}; asm volatile("" : "+v"(negm));
  { const bf16r* Qw = Qb + (long)(wid * QBLK + r32) * LDQ + hi * 32;
#pragma unroll
    for (int s = 0; s < 2; ++s) { u32x4 q4[4];
#pragma unroll
      for (int i = 0; i < 4; ++i) q4[i] = *reinterpret_cast<const u32x4*>(Qw + s * 64 + i * 8);
#pragma unroll
      for (int i = 0; i < 4; ++i) { qf[s][2 * i] = pk8(bfl(q4[i][0]), bfh(q4[i][0]), bfl(q4[i][1]), bfh(q4[i][1])); qf[s][2 * i + 1] = pk8(bfl(q4[i][2]), bfh(q4[i][2]), bfl(q4[i][3]), bfh(q4[i][3])); } }
    { const float* tr = tab + (long)(wid * QBLK + r32) * 64 + hi * 32;
#pragma unroll
      for (int i = 0; i < 4; ++i) { const u32x4 qv = *reinterpret_cast<const u32x4*>(Qw + 128 + i * 8);
        const float4 t0 = *reinterpret_cast<const float4*>(tr + i * 8), t1 = *reinterpret_cast<const float4*>(tr + i * 8 + 4);
        float r_[8];
#define ROT(K_, Q_, C_, S_) do { r_[K_] = bfl(Q_) * (C_) - bfh(Q_) * (S_); r_[K_ + 1] = bfl(Q_) * (S_) + bfh(Q_) * (C_); } while (0)
        ROT(0, qv[0], t0.x, t0.y); ROT(2, qv[1], t0.z, t0.w); ROT(4, qv[2], t1.x, t1.y); ROT(6, qv[3], t1.z, t1.w);
#undef ROT
        qf[2][2 * i] = pk8(r_[0], r_[1], r_[2], r_[3]); qf[2][2 * i + 1] = pk8(r_[4], r_[5], r_[6], r_[7]); } } }
  int kof[2], vof;
#pragma unroll
  for (int i = 0; i < 2; ++i) { const int ob = (wid + 8 * i) * 1024 + 16 * lane, row = ob / KROWB, pp = (ob - row * KROWB) >> 4, sl = pp ^ ((row >> 2) & 3); kof[i] = row * LDKB + sl * 16; }
  { const int c = 16 * wid + (lane >> 2), sl = (lane & 3) ^ ((c >> 2) & 3); vof = c * seq + sl * 16; }
  const unsigned kdst = lds0 + LDS_K3 + wid * 1024, vdst = lds0 + LDS_V3 + wid * 1024;
#define DMA_KV(kt, ks, vt, vs) do { const unsigned char* kb_ = Kh + (long)(kt) * KVBLK * LDKB; const unsigned char* vb_ = Vh + (long)(vt) * KVBLK; const unsigned kd_ = (unsigned)__builtin_amdgcn_readfirstlane(kdst + (ks) * SHM_K3), vd_ = (unsigned)__builtin_amdgcn_readfirstlane(vdst + (vs) * SHM_V3); \
    glds16(kb_ + kof[0], kd_); if (wid < 4) glds16(kb_ + kof[1], kd_ + 8192); glds16(vb_ + vof, vd_); } while (0)
  int kq[2];
  { const int x = (r32 >> 2) & 3; const int kb = (int)lds0 + LDS_K3 + r32 * KROWB; kq[0] = kb + 16 * ((2 * hi) ^ x); kq[1] = kb + 16 * ((2 * hi + 1) ^ x); }
  int vq[2];
  { const int x = (r32 >> 2) & 3; const int vbb = (int)lds0 + LDS_V3 + r32 * 64; vq[0] = vbb + 16 * ((2 * hi) ^ x); vq[1] = vbb + 16 * ((2 * hi + 1) ^ x); }
#define RESC(a) do { if (__any((a) < 1.f)) { if (hi == 0) al_l[r32] = (a); asm volatile("s_waitcnt lgkmcnt(0)" ::: "memory"); \
    for (int d = 0; d < 4; ++d) for (int r = 0; r < 16; ++r) o[d][r] *= al_l[crow(r, hi)]; } } while (0)
  f32x16 p0 = {}, p1 = {}; float al; v8i pa = {}; const int NT = seq / KVBLK;
  int s0 = 0;
#define SL(d) ((s0 + (d)) & 3)
#define CLAMP(t) ((t) < NT ? (t) : NT - 1)
#define BAR() asm volatile("s_barrier" ::: "memory")
#define LGKM(n) do { asm volatile("s_waitcnt lgkmcnt(" #n ")" ::: "memory"); SBAR(); } while (0)
  DMA_KV(0, 0, 0, 0); DMA_KV(1, 1, 1, 1); DMA_KV(2, 2, 1, 1);
  asm volatile("s_waitcnt vmcnt(0)\n\ts_barrier" ::: "memory");
#ifndef ATT_HALF
#define ATT_HALF(w) ((w) >= 4)
#endif
#define KRD(F0, F1, OFF) asm volatile("ds_read_b128 %0, %4 offset:%6\n\tds_read_b128 %1, %5 offset:%6\n\tds_read_b128 %2, %4 offset:%7\n\tds_read_b128 %3, %5 offset:%7" \
    : "=&v"(F0##l), "=&v"(F0##h), "=&v"(F1##l), "=&v"(F1##h) : "v"(a0_), "v"(a1_), "i"(OFF), "i"((OFF) + 32 * KROWB) : "memory")
#define VRD8(FL, FH, CB) asm volatile("ds_read_b128 %0, %2 offset:%4\n\tds_read_b128 %1, %3 offset:%4" : "=&v"(FL), "=&v"(FH) : "v"(v0_), "v"(v1_), "i"((CB) * 2048) : "memory")
#define PV8(OD, FL, FH) do { if (AEXP == 2 || AEXP == 5) { asm volatile("" :: "v"(FL), "v"(FH)); break; } OD = __builtin_amdgcn_mfma_scale_f32_32x32x64_f8f6f4(pa, F8(FL, FH), OD, 0, 0, 0, 0, 0, 0); } while (0)
#define F8(L, H) (v8i){L[0], L[1], L[2], L[3], H[0], H[1], H[2], H[3]}
#define QK8(F0, F1, S, C0, C1) do { if (AEXP == 2 || AEXP == 5) { asm volatile("" :: "v"(F0##l), "v"(F1##h)); break; } p0 = __builtin_amdgcn_mfma_scale_f32_32x32x64_f8f6f4(F8(F0##l, F0##h), qf[S], C0, 0, 0, 0, 0, 0, 0); p1 = __builtin_amdgcn_mfma_scale_f32_32x32x64_f8f6f4(F8(F1##l, F1##h), qf[S], C1, 0, 0, 0, 0, 0, 0); } while (0)
#define MPH(PREV) do { const int ko_ = s0 * SHM_K3; const int a0_ = kq[0] + ko_, a1_ = kq[1] + ko_; const int vo_ = SL(3) * SHM_V3; const int v0_ = vq[0] + vo_, v1_ = vq[1] + vo_; \
    v4i ka0l, ka0h, ka1l, ka1h, kb0l, kb0h, kb1l, kb1h, v0l, v0h, v1l, v1h, v2l, v2h, v3l, v3h; \
    SBAR(); \
    KRD(ka0, ka1, 0); KRD(kb0, kb1, 64);                       \
    LGKM(4);  QK8(ka0, ka1, 0, negm, negm); \
    KRD(ka0, ka1, 128); VRD8(v0l, v0h, 0); VRD8(v1l, v1h, 1);   \
    LGKM(8);  QK8(kb0, kb1, 1, p0, p1); \
    VRD8(v2l, v2h, 2); VRD8(v3l, v3h, 3);                       \
    LGKM(8);  QK8(ka0, ka1, 2, p0, p1); \
    if (PREV) { LGKM(4); PV8(o[0], v0l, v0h); PV8(o[1], v1l, v1h); LGKM(0); PV8(o[2], v2l, v2h); PV8(o[3], v3l, v3h); } else { LGKM(0); } \
    } while (0)
#define WB() do { if (wid < 4) asm volatile("s_waitcnt vmcnt(3)\n\ts_barrier" ::: "memory"); else asm volatile("s_waitcnt vmcnt(2)\n\ts_barrier" ::: "memory"); } while (0)
#define VPH(j) do { if (AEXP != 3 && AEXP != 5) DMA_KV(CLAMP((j) + 3), SL(3), CLAMP((j) + 2), SL(2)); if (AEXP != 1 && AEXP != 5) { al = softmaxPP(p0, p1, m_reg, negm, l_reg, (j) == 0, pa); RESC(al); } else { asm volatile("" : "+v"(p0), "+v"(p1), "+v"(pa)); } s0 = SL(1); } while (0)
#define DRAIN() do { const int vo_ = SL(3) * SHM_V3; const int v0_ = vq[0] + vo_, v1_ = vq[1] + vo_; v4i v0l, v0h, v1l, v1h, v2l, v2h, v3l, v3h; \
    VRD8(v0l, v0h, 0); VRD8(v1l, v1h, 1); VRD8(v2l, v2h, 2); VRD8(v3l, v3h, 3); LGKM(0); PV8(o[0], v0l, v0h); PV8(o[1], v1l, v1h); PV8(o[2], v2l, v2h); PV8(o[3], v3l, v3h); } while (0)
  { const bool trail = ATT_HALF(wid);
    if (trail) BAR();
    MPH(false); if (!trail) WB();
#pragma unroll 1
    for (int j = 0; j + 1 < NT; ++j) { VPH(j); if (trail) WB(); MPH(true); if (!trail) WB(); }
    VPH(NT - 1); DRAIN(); }
  if (hi == 0) li_l[r32] = l_reg; asm volatile("s_waitcnt lgkmcnt(0)" ::: "memory");
  float rli[16];
#pragma unroll
  for (int r = 0; r < 16; ++r) rli[r] = __builtin_amdgcn_rcpf(li_l[crow(r, hi)]);
  bf16r* Ow = Ob + (long)(wid * QBLK) * LDO;
#pragma unroll
  for (int r = 0; r < 16; ++r) { const int orow = crow(r, hi);
#pragma unroll
    for (int d0 = 0; d0 < 4; ++d0) { const unsigned w = cvtpk(o[d0][r] * rli[r], 0.f); Ow[(long)orow * LDO + d0 * 32 + r32] = (bf16r)(w & 0xffffu); } }
  asm volatile("s_waitcnt vmcnt(0) lgkmcnt(0)\n\ts_barrier" ::: "memory");
#undef DMA_KV
#undef RESC
#undef SL
#undef CLAMP
#undef BAR
#undef LGKM
#undef KRD
#undef VRD8
#undef PV8
#undef F8
#undef QK8
#undef MPH
#undef WB
#undef DRAIN
#undef VPH
}
#undef SBAR
}

namespace fftc {
#define FGAS __attribute__((address_space(1)))
typedef float f2 __attribute__((ext_vector_type(2)));
typedef __attribute__((address_space(3))) f2 lf2;
constexpr int L = 16384;
constexpr int FFT_LDS_BYTES = 17920 * 8;
__device__ static const float TW64C[32] = { 1.000000000e+00f, 9.951847267e-01f, 9.807852804e-01f, 9.569403357e-01f, 9.238795325e-01f, 8.819212643e-01f, 8.314696123e-01f, 7.730104534e-01f, 7.071067812e-01f, 6.343932842e-01f, 5.555702330e-01f, 4.713967368e-01f, 3.826834324e-01f, 2.902846773e-01f, 1.950903220e-01f, 9.801714033e-02f, 0.0f, -9.801714033e-02f, -1.950903220e-01f, -2.902846773e-01f, -3.826834324e-01f, -4.713967368e-01f, -5.555702330e-01f, -6.343932842e-01f, -7.071067812e-01f, -7.730104534e-01f, -8.314696123e-01f, -8.819212643e-01f, -9.238795325e-01f, -9.569403357e-01f, -9.807852804e-01f, -9.951847267e-01f };
__device__ static const float TW64S[32] = { 0.000000000e+00f, 9.801714033e-02f, 1.950903220e-01f, 2.902846773e-01f, 3.826834324e-01f, 4.713967368e-01f, 5.555702330e-01f, 6.343932842e-01f, 7.071067812e-01f, 7.730104534e-01f, 8.314696123e-01f, 8.819212643e-01f, 9.238795325e-01f, 9.569403357e-01f, 9.807852804e-01f, 9.951847267e-01f, 1.000000000e+00f, 9.951847267e-01f, 9.807852804e-01f, 9.569403357e-01f, 9.238795325e-01f, 8.819212643e-01f, 8.314696123e-01f, 7.730104534e-01f, 7.071067812e-01f, 6.343932842e-01f, 5.555702330e-01f, 4.713967368e-01f, 3.826834324e-01f, 2.902846773e-01f, 1.950903220e-01f, 9.801714033e-02f };
__device__ __forceinline__ f2 cmul(f2 a, f2 w) { return (f2){a.x * w.x - a.y * w.y, a.x * w.y + a.y * w.x}; }
template <bool INV> __device__ __forceinline__ f2 twmul(f2 d, int tw) {
    if (tw == 0) return d;
    if (tw == 16) return INV ? (f2){-d.y, d.x} : (f2){d.y, -d.x};
    const float c = TW64C[tw], s = TW64S[tw];
    return INV ? (f2){d.x * c - d.y * s, d.y * c + d.x * s} : (f2){d.x * c + d.y * s, d.y * c - d.x * s};
}
template <int N, int S, bool INV> __device__ __forceinline__ void dif_stage(f2 (&v)[N]) {
#pragma unroll
    for (int blk = 0; blk < N; blk += 2 * S)
#pragma unroll
        for (int i = 0; i < S; ++i) { const f2 a = v[blk + i], b = v[blk + i + S]; v[blk + i] = a + b; v[blk + i + S] = twmul<INV>(a - b, i * (32 / S)); }
    if constexpr (S > 1) dif_stage<N, S / 2, INV>(v);
}
constexpr int bitrev(int k, int bits) { int r = 0; for (int b = 0; b < bits; ++b) r |= ((k >> b) & 1) << (bits - 1 - b); return r; }
template <int N, bool INV> __device__ __forceinline__ void dft(f2 (&v)[N]) {
    dif_stage<N, N / 2, INV>(v);
    constexpr int bits = (N == 32) ? 5 : 4;
    f2 t[N];
#pragma unroll
    for (int k = 0; k < N; ++k) t[k] = v[bitrev(k, bits)];
#pragma unroll
    for (int k = 0; k < N; ++k) v[k] = t[k];
}
template <bool CONJ> __device__ __forceinline__ void apply_pow32(f2 (&v)[32], f2 w) {
    if (CONJ) w.y = -w.y;
    f2 lo[8]; lo[0] = (f2){1.f, 0.f}; lo[1] = w; lo[2] = cmul(w, w); lo[3] = cmul(lo[2], w); lo[4] = cmul(lo[2], lo[2]); lo[5] = cmul(lo[4], w); lo[6] = cmul(lo[4], lo[2]); lo[7] = cmul(lo[4], lo[3]);
#pragma unroll
    for (int k = 1; k < 32; ++k) if (k & 7) v[k] = cmul(v[k], lo[k & 7]);
    const f2 p8 = cmul(lo[4], lo[4]), p16 = cmul(p8, p8), p24 = cmul(p16, p8);
#pragma unroll
    for (int k = 8; k < 16; ++k) v[k] = cmul(v[k], p8);
#pragma unroll
    for (int k = 16; k < 24; ++k) v[k] = cmul(v[k], p16);
#pragma unroll
    for (int k = 24; k < 32; ++k) v[k] = cmul(v[k], p24);
}
__device__ __forceinline__ int opaque(int x) { asm volatile("" : "+v"(x)); return x; }
__device__ __forceinline__ f2 cis_pi(float x) { float s, c; sincospif(x, &s, &c); return (f2){c, s}; }
#define FPHYS(d1, d2, d3) ((d1) * 560 + (d2) * 17 + (d3))
#define FSYNC() __syncthreads()
template <int EV> __device__ __forceinline__ void pass1_fwd(lf2* X, f2 (&v)[32], int tid) {
    tid = opaque(tid);
    if (EV != 1) { dft<32, false>(v);
    apply_pow32<false>(v, cis_pi(-(float)tid * (2.0f / L))); }
    const int base = (tid >> 4) * 17 + (tid & 15);
#pragma unroll
    for (int k = 0; k < 32; ++k) { if (EV != 2) X[base + k * 560] = v[k]; else asm volatile("" :: "v"(v[k])); }
}
template <int EV> __device__ __forceinline__ void pass1_inv(const lf2* X, f2 (&v)[32], int tid) {
    tid = opaque(tid);
    const int base = (tid >> 4) * 17 + (tid & 15);
#pragma unroll
    for (int k = 0; k < 32; ++k) { if (EV != 2) v[k] = X[base + k * 560]; else v[k] = (f2){(float)(tid + k), 2.f}; }
    if (EV != 1) { apply_pow32<true>(v, cis_pi(-(float)tid * (2.0f / L)));
    dft<32, true>(v); }
}
template <bool INV, int EV> __device__ __forceinline__ void pass2(lf2* X, int tid) {
    tid = opaque(tid);
    const int base = (tid >> 4) * 560 + (tid & 15); f2 v[32];
    if (EV == 2) { for (int k = 0; k < 32; ++k) v[k] = (f2){(float)(tid + k), 1.f}; asm volatile("" : "+v"(v[0]), "+v"(v[7]), "+v"(v[19])); }
#pragma unroll
    for (int k = 0; k < 32; ++k) if (EV != 2) v[k] = X[base + k * 17];
    const f2 w = cis_pi(-(float)(tid & 15) * (2.0f / 512.0f));
    if (EV != 1) { if (INV) { apply_pow32<true>(v, w); dft<32, true>(v); } else { dft<32, false>(v); apply_pow32<false>(v, w); } }
#pragma unroll
    for (int k = 0; k < 32; ++k) { if (EV != 2) X[base + k * 17] = v[k]; else asm volatile("" :: "v"(v[k])); }
}
template <bool KMODE, int EV> __device__ __forceinline__ void pass3(lf2* X, f2 (&KR)[2][16], int tid) {
    tid = opaque(tid);
#pragma unroll
    for (int i = 0; i < 2; ++i) { const int base = ((tid >> 5) + 16 * i) * 560 + (tid & 31) * 17; f2 u[16];
#pragma unroll
        for (int k = 0; k < 16; ++k) u[k] = X[base + k];
        if (EV != 1) dft<16, false>(u);
        if (KMODE) {
#pragma unroll
            for (int k = 0; k < 16; ++k) KR[i][k] = u[k];
        } else {
#pragma unroll
            for (int k = 0; k < 16; ++k) u[k] = cmul(u[k], KR[i][k]);
            if (EV != 1) dft<16, true>(u);
#pragma unroll
            for (int k = 0; k < 16; ++k) X[base + k] = u[k];
        } }
}
template <int EV> __device__ __forceinline__ void kernel_spectrum(lf2* X, f2 (&v)[32], f2 (&KS)[2][16], int tid) {
    pass1_fwd<EV>(X, v, tid); FSYNC(); pass2<false, EV>(X, tid); FSYNC(); pass3<true, EV>(X, KS, tid); FSYNC();
}
template <int EV> __device__ __forceinline__ void conv_roundtrip(lf2* X, f2 (&v)[32], f2 (&KS)[2][16], int tid) {
    pass1_fwd<EV>(X, v, tid); FSYNC(); pass2<false, EV>(X, tid); FSYNC(); pass3<false, EV>(X, KS, tid); FSYNC(); pass2<true, EV>(X, tid); FSYNC(); pass1_inv<EV>(X, v, tid); FSYNC();
}
__device__ __forceinline__ void modulate(f2 (&v)[32], int tid) {
    const f2 wj = cis_pi(-(float)opaque(tid) * (1.0f / L));
#pragma unroll
    for (int k = 0; k < 32; ++k) v[k] = twmul<false>(cmul(v[k], wj), k);
}
__device__ __forceinline__ void demodulate(f2 (&v)[32], int tid) {
    f2 wj = cis_pi(-(float)opaque(tid) * (1.0f / L)); wj.y = -wj.y;
#pragma unroll
    for (int k = 0; k < 32; ++k) v[k] = twmul<true>(cmul(v[k], wj), k);
}
__device__ __forceinline__ float bf2f(unsigned short u) { return __uint_as_float((unsigned)u << 16); }
__device__ __forceinline__ unsigned short f2bf_rne(float f) { unsigned u = __float_as_uint(f); return (unsigned short)((u + 0x7fffu + ((u >> 16) & 1u)) >> 16); }
template <typename T> __device__ __forceinline__ FGAS T* pstep(FGAS T* p, int n) { p += n; asm volatile("" : "+v"(p)); return p; }
template <int MODE, int EV = 0> __device__ __forceinline__ void hyena_channel(lf2* X, const float* z0, const float* z1, const float* hf, const float* hb,
                                                                        const unsigned short* g0, const unsigned short* g1, float dbias, float* zo0, float* zo1,
                                                                        unsigned short* o0, unsigned short* o1, f2* stash, f2* KSg, int tid) {
    f2 v[32]; f2 KS[2][16];
    { FGAS const float* pf = (FGAS const float*)hf + opaque(tid); FGAS const float* pb = (FGAS const float*)hb + ((L - opaque(tid)) & (L - 1));
#pragma unroll
      for (int k = 0; k < 32; ++k) { v[k] = (EV == 3) ? (f2){1.f, 0.f} : (f2){*pf + *pb, 0.f}; pf = pstep(pf, 512); pb = (k == 0) ? pstep((FGAS const float*)hb + (L - 512 - tid), 0) : pstep(pb, -512); } }
    kernel_spectrum<EV>(X, v, KS, tid);
    { FGAS const float* p0 = (FGAS const float*)z0 + opaque(tid); FGAS const float* p1 = (FGAS const float*)z1 + opaque(tid);
#pragma unroll
      for (int k = 0; k < 32; ++k) { v[k] = (EV == 3) ? (f2){1.f, 2.f} : (f2){*p0, *p1}; p0 = pstep(p0, 512); p1 = pstep(p1, 512); } }
    conv_roundtrip<EV>(X, v, KS, tid);
    { FGAS f2* ps = (FGAS f2*)stash + opaque(tid);
#pragma unroll
      for (int k = 0; k < 32; ++k) { *ps = v[k]; ps = pstep(ps, 512); } }
    { FGAS const float* pf = (FGAS const float*)hf + opaque(tid); FGAS const float* pb = (FGAS const float*)hb + ((L - opaque(tid)) & (L - 1));
#pragma unroll
      for (int k = 0; k < 32; ++k) { const float hbv = (EV == 3) ? 1.f : *pb; v[k] = (f2){*pf + ((k == 0 && tid == 0) ? hbv : -hbv), 0.f}; pf = pstep(pf, 512); pb = (k == 0) ? pstep((FGAS const float*)hb + (L - 512 - tid), 0) : pstep(pb, -512); } }
    modulate(v, tid);
    kernel_spectrum<EV>(X, v, KS, tid);
    { FGAS const float* p0 = (FGAS const float*)z0 + opaque(tid); FGAS const float* p1 = (FGAS const float*)z1 + opaque(tid);
#pragma unroll
      for (int k = 0; k < 32; ++k) { v[k] = (EV == 3) ? (f2){1.f, 2.f} : (f2){*p0, *p1}; p0 = pstep(p0, 512); p1 = pstep(p1, 512); } }
    modulate(v, tid);
    conv_roundtrip<EV>(X, v, KS, tid);
    demodulate(v, tid);
    const float sc = 1.0f / (2.0f * L);
    { FGAS const f2* ps = (FGAS const f2*)stash + opaque(tid); FGAS const float* p0 = (FGAS const float*)z0 + opaque(tid); FGAS const float* p1 = (FGAS const float*)z1 + opaque(tid); FGAS const unsigned short* q0 = (FGAS const unsigned short*)g0 + opaque(tid); FGAS const unsigned short* q1 = (FGAS const unsigned short*)g1 + opaque(tid);
      FGAS float* w0 = (FGAS float*)zo0 + opaque(tid); FGAS float* w1 = (FGAS float*)zo1 + opaque(tid); FGAS unsigned short* b0 = (FGAS unsigned short*)o0 + opaque(tid); FGAS unsigned short* b1 = (FGAS unsigned short*)o1 + opaque(tid);
#pragma unroll
      for (int k = 0; k < 32; ++k) { const f2 y = (*ps + v[k]) * sc;
          const float r0 = bf2f(*q0) * (y.x + dbias * *p0), r1 = bf2f(*q1) * (y.y + dbias * *p1);
          if (MODE == 1) { *b0 = f2bf_rne(r0); *b1 = f2bf_rne(r1); b0 = pstep(b0, 512); b1 = pstep(b1, 512); } else if (MODE == 0) { *w0 = r0; *w1 = r1; w0 = pstep(w0, 512); w1 = pstep(w1, 512); } else { asm volatile("" :: "v"(r0), "v"(r1)); }
          ps = pstep(ps, 512); p0 = pstep(p0, 512); p1 = pstep(p1, 512); q0 = pstep(q0, 512); q1 = pstep(q1, 512); } }
}
#undef FPHYS
#undef FGAS
}

constexpr int BATCH = 2, SEQ = 16384, DM = 1024, T = BATCH * SEQ;
constexpr int NH = 8, DNOPE = 128, DROPE = 64, DQK = 192, DVH = 128, QLORA = 384, KVLORA = 256, MLA_IN = 704, MLA_INP = 768;
constexpr int DFF = 2816, NUP = 2 * DFF;
constexpr int HF = 64, HEMB = 33, HKP = 256;
constexpr float LN_EPS = 1e-5f, RMS_EPS = 1e-6f;
constexpr float DN_ALPHA = 1.4142135623730951f;
constexpr float QSCALE = 0.07216878364870322f * 1.4426950408889634f;
constexpr int NWAVES = 8;

constexpr size_t MiB = 1u << 20;
constexpr size_t WS_CTL = 0, CTL_ZERO_BYTES = 64 * 1024;
constexpr size_t WS_TW1 = 256 * 1024, WS_MOD = 384 * 1024, WS_TW2 = 512 * 1024;
constexpr size_t WS_WIN = 2 * MiB, WS_WUQ = 4 * MiB, WS_WUKV = 6 * MiB, WS_WO = 7 * MiB, WS_WHIN = 9 * MiB, WS_WHO = 15 * MiB, WS_WUP = 17 * MiB, WS_WDN = 39 * MiB, WS_WFO = 50 * MiB, WS_H3 = 52 * MiB;
constexpr size_t WS_XB = 60 * MiB;
constexpr size_t WS_XF = 124 * MiB;
constexpr size_t WS_S = 252 * MiB;
constexpr size_t WS_END = 512 * MiB;
constexpr size_t WS_CQN = WS_XF, WS_CKVN = WS_XF + 24 * MiB, WS_ROPE = WS_XF + 40 * MiB;
constexpr size_t WS_Q = WS_S, WS_K = WS_S + 96 * MiB, WS_VT = WS_S + 144 * MiB, WS_V = WS_S + 192 * MiB;
constexpr size_t WS_UH = WS_S;
constexpr size_t WS_U = WS_S;
constexpr size_t WS_VC0 = WS_XB, WS_VC1 = WS_S + 192 * MiB;
constexpr size_t WS_KT = WS_S, WS_STASH = WS_S + 128 * MiB, WS_KSPEC = WS_S + 160 * MiB;
constexpr int CW_TMO = 0, CW_CODE = 1, CW_BAR = 4096, CW_CHK = 8192;

constexpr int RING_BYTES = 131072;
constexpr int LDS_BYTES = 147456;
constexpr int MISC_OFF = LDS_BYTES - 512;
static_assert(fftc::FFT_LDS_BYTES <= MISC_OFF && attn::SHM_ATTN3 <= RING_BYTES, "LDS map");

typedef pg8::bf16_t bf16;
typedef unsigned u32x4t __attribute__((ext_vector_type(4)));
typedef unsigned u32x2t __attribute__((ext_vector_type(2)));
typedef float f32x2 __attribute__((ext_vector_type(2)));
__device__ __forceinline__ float wave_sum(float v) {
#pragma unroll
    for (int o = 1; o < 64; o <<= 1) v += __shfl_xor(v, o);
    return v;
}
__device__ __forceinline__ float bf_lo(unsigned w) { return __uint_as_float(w << 16); }
__device__ __forceinline__ float bf_hi(unsigned w) { return __uint_as_float(w & 0xffff0000u); }
__device__ __forceinline__ unsigned pkbf(float lo, float hi) { return pg8::cvt_pk_bf16(lo, hi); }

template <class ColMap> __device__ __forceinline__ void transpose_item(const float* W, int K, int N, bf16* WT, int ldk, LAS float* scr, int item, int nblk, int lane, const ColMap& cm) {
    const int kb = item / nblk, nb = item % nblk, k0 = 64 * kb, n0 = 32 * nb;
    const int q4 = 4 * (lane & 7), s0 = cm(n0 + q4), s1 = cm(n0 + q4 + 1), s2 = cm(n0 + q4 + 2), s3 = cm(n0 + q4 + 3);
    const bool vec = (s0 >= 0) && (s1 == s0 + 1) && (s2 == s0 + 2) && (s3 == s0 + 3) && ((s0 & 3) == 0) && ((N & 3) == 0);
#pragma unroll
    for (int i = 0; i < 8; ++i) { const int kk = (lane >> 3) + 8 * i; const float* wr = W + (size_t)(k0 + kk) * N; f32x4 v;
        if (vec) v = *(const f32x4*)(wr + s0);
        else { v.x = s0 >= 0 ? wr[s0] : 0.f; v.y = s1 >= 0 ? wr[s1] : 0.f; v.z = s2 >= 0 ? wr[s2] : 0.f; v.w = s3 >= 0 ? wr[s3] : 0.f; }
        LAS float* d = scr + kk * 33 + q4; d[0] = v.x; d[1] = v.y; d[2] = v.z; d[3] = v.w; }
    asm volatile("s_waitcnt lgkmcnt(0)" ::: "memory");
    const int c = lane & 7;
#pragma unroll
    for (int j = 0; j < 4; ++j) { const int n = (lane >> 3) + 8 * j; const LAS float* s = scr + (8 * c) * 33 + n;
        u32x4t o; o.x = pkbf(s[0 * 33], s[1 * 33]); o.y = pkbf(s[2 * 33], s[3 * 33]); o.z = pkbf(s[4 * 33], s[5 * 33]); o.w = pkbf(s[6 * 33], s[7 * 33]);
        *(u32x4t*)(WT + (size_t)(n0 + n) * ldk + k0 + 8 * c) = o; }
    asm volatile("s_waitcnt lgkmcnt(0)" ::: "memory");
}
struct CmIdent { __device__ __forceinline__ int operator()(int n) const { return n; } };
struct CmWin { __device__ __forceinline__ int operator()(int n) const { if (n < 640) return n; if (n >= 704) return -1; const int i = n - 640; return 640 + (i & 1) * 32 + (i >> 1); } };
struct CmWuq { __device__ __forceinline__ int operator()(int n) const { const int h = n / 192, d = n - h * 192; if (d < 128) return n; const int i = d - 128; return h * 192 + 128 + (i & 1) * 32 + (i >> 1); } };
struct CmWukv { __device__ __forceinline__ int operator()(int n) const { const int v = n >> 10, r = n & 1023, h = r >> 7, d = r & 127; return h * 256 + v * 128 + d; } };
struct CmWup { __device__ __forceinline__ int operator()(int n) const { const int pn = n >> 8, r = n & 255; return (r < 128) ? (pn * 128 + r) : (DFF + pn * 128 + (r - 128)); } };

struct Args {
    const float* in[27]; float* out; unsigned char* ws; int ph_lo, ph_hi;
};
enum { I_X = 0, I_POS, I_MLA_WIN, I_MLA_GQ, I_MLA_WUQ, I_MLA_GKV, I_MLA_WUKV, I_MLA_WO, I_HY_WIN, I_HY_WSHORT, I_HY_FW1, I_HY_FB1, I_HY_FW2, I_HY_FB2, I_HY_FW3, I_HY_FB3, I_HY_FREQ,
       I_HY_FWOUT, I_HY_DBIAS, I_HY_WO, I_FFN_WUP, I_FFN_WCONV, I_FFN_WDOWN, I_LN1G, I_LN1B, I_LN2G, I_LN2B };

__device__ __forceinline__ void ln_rows(const bf16* Y, float* OF, bf16* OB, const float* g, const float* b, int gw, int ngw, int lane, float omul = 1.0f) {
    f32x4 gv[4], bv[4];
#pragma unroll
    for (int j = 0; j < 4; ++j) { gv[j] = *(const f32x4*)(g + 4 * lane + 256 * j); bv[j] = *(const f32x4*)(b + 4 * lane + 256 * j); }
    for (int m0 = gw; m0 < T; m0 += 4 * ngw) {
        u32x2t w[4][4];
#pragma unroll
        for (int q = 0; q < 4; ++q) { const int m = m0 + q * ngw; if (m < T) { const u32x2t* xr = (const u32x2t*)(Y + (size_t)m * DM) + lane;
#pragma unroll
                for (int j = 0; j < 4; ++j) w[q][j] = xr[64 * j]; } }
#pragma unroll
        for (int q = 0; q < 4; ++q) { const int m = m0 + q * ngw; if (m < T) {
            f32x4 v[4]; float s = 0.f;
#pragma unroll
            for (int j = 0; j < 4; ++j) { v[j] = (f32x4){bf_lo(w[q][j].x), bf_hi(w[q][j].x), bf_lo(w[q][j].y), bf_hi(w[q][j].y)}; s += (v[j].x + v[j].y) + (v[j].z + v[j].w); }
            const float mean = wave_sum(s) * (1.f / DM); float s2 = 0.f;
#pragma unroll
            for (int j = 0; j < 4; ++j) { v[j] = v[j] - mean; s2 += (v[j].x * v[j].x + v[j].y * v[j].y) + (v[j].z * v[j].z + v[j].w * v[j].w); }
            const float rstd = 1.f / sqrtf(wave_sum(s2) * (1.f / DM) + LN_EPS);
            f32x4* of = (f32x4*)(OF + (size_t)m * DM) + lane;
#pragma unroll
            for (int j = 0; j < 4; ++j) { v[j] = (v[j] * rstd * gv[j] + bv[j]) * omul;
                if (OF) of[64 * j] = v[j]; }
            if (OB) { u32x2t* ob = (u32x2t*)(OB + (size_t)m * DM) + lane;
#pragma unroll
                for (int j = 0; j < 4; ++j) { u32x2t ww; ww.x = pkbf(v[j].x, v[j].y); ww.y = pkbf(v[j].z, v[j].w); ob[64 * j] = ww; } } } }
    }
}

__device__ __forceinline__ void mla_norm_rope(const float* H1, const float* gq, const float* gkv, const f32x2* tab, bf16* CQN, bf16* CKVN, unsigned char* Kb, int gw, int ngw, int lane) {
    float gqv[6], gkvv[4];
#pragma unroll
    for (int k = 0; k < 6; ++k) gqv[k] = gq[lane + 64 * k];
#pragma unroll
    for (int k = 0; k < 4; ++k) gkvv[k] = gkv[lane + 64 * k];
    for (int t0 = gw; t0 < T; t0 += 2 * ngw) {
        float q[2][6], kv[2][4]; f32x2 xr[2], cs[2];
#pragma unroll
        for (int u = 0; u < 2; ++u) { const int t = t0 + u * ngw; if (t < T) { const float* h = H1 + (size_t)t * MLA_INP;
#pragma unroll
            for (int k = 0; k < 6; ++k) q[u][k] = h[lane + 64 * k];
#pragma unroll
            for (int k = 0; k < 4; ++k) kv[u][k] = h[QLORA + lane + 64 * k];
            xr[u] = *(const f32x2*)(h + 640 + 2 * (lane & 31)); cs[u] = tab[(size_t)t * 32 + (lane & 31)]; } }
#pragma unroll
        for (int u = 0; u < 2; ++u) { const int t = t0 + u * ngw; if (t < T) {
            float sq = 0.f, sk = 0.f;
#pragma unroll
            for (int k = 0; k < 6; ++k) sq += q[u][k] * q[u][k];
#pragma unroll
            for (int k = 0; k < 4; ++k) sk += kv[u][k] * kv[u][k];
            const float rq = 1.f / sqrtf(wave_sum(sq) * (1.f / QLORA) + RMS_EPS), rk = 1.f / sqrtf(wave_sum(sk) * (1.f / KVLORA) + RMS_EPS);
#pragma unroll
            for (int k = 0; k < 6; ++k) CQN[(size_t)t * QLORA + lane + 64 * k] = (bf16)(pkbf(q[u][k] * rq * gqv[k], 0.f) & 0xffffu);
#pragma unroll
            for (int k = 0; k < 4; ++k) CKVN[(size_t)t * KVLORA + lane + 64 * k] = (bf16)(pkbf(kv[u][k] * rk * gkvv[k], 0.f) & 0xffffu);
            const unsigned short w = (unsigned short)__builtin_amdgcn_cvt_pk_fp8_f32(xr[u].x * cs[u].x - xr[u].y * cs[u].y, xr[u].x * cs[u].y + xr[u].y * cs[u].x, 0, false);
            unsigned short* kr = (unsigned short*)(Kb + (size_t)t * 1536 + 128) + (lane & 31);
            if (lane < 32) {
#pragma unroll
                for (int hh = 0; hh < NH; ++hh) kr[hh * 96] = w; } } }
    }
}

__device__ __forceinline__ void ffn_conv_silu(const bf16* UH, const float* wconv  , bf16* HACT  , int gw, int ngw, int lane) {
    constexpr int RB = 32, NRB = SEQ / RB, NCC = 6;
    for (int it = gw; it < NRB * NCC; it += ngw) {
        const int rb = it / NCC, cc = it - rb * NCC, c = cc * 512 + lane * 8;
        if (c >= DFF) continue;
        const int pn = c >> 7, ucol = pn * 256 + (c & 127);
        float wa[3][8], wg[3][8];
#pragma unroll
        for (int k = 0; k < 3; ++k)
#pragma unroll
            for (int e = 0; e < 8; ++e) { wa[k][e] = wconv[k * NUP + c + e]; wg[k][e] = wconv[k * NUP + DFF + c + e]; }
        const int r0 = rb * RB;
        const bf16* up = UH + ucol;
        const u32x4t zero = {0u, 0u, 0u, 0u};
        u32x4t ra[6], rg[6];
        ra[0] = zero; rg[0] = zero;
        if (r0 > 0) { ra[0] = *(const u32x4t*)(up + (size_t)(r0 - 1) * NUP); rg[0] = *(const u32x4t*)(up + (size_t)(r0 - 1) * NUP + 128); }
        ra[1] = *(const u32x4t*)(up + (size_t)r0 * NUP); rg[1] = *(const u32x4t*)(up + (size_t)r0 * NUP + 128);
#pragma unroll 1
        for (int r = r0; r < r0 + RB; r += 4) {
#pragma unroll
            for (int j = 1; j <= 4; ++j) { const int rr = r + j; if (rr < SEQ) { ra[1 + j] = *(const u32x4t*)(up + (size_t)rr * NUP); rg[1 + j] = *(const u32x4t*)(up + (size_t)rr * NUP + 128); } else { ra[1 + j] = zero; rg[1 + j] = zero; } }
#pragma unroll
            for (int j = 0; j < 4; ++j) {
                float o[8];
#pragma unroll
                for (int e2 = 0; e2 < 4; ++e2) {
                    const float a0 = wa[0][2 * e2] * bf_lo(ra[j][e2]) + wa[1][2 * e2] * bf_lo(ra[j + 1][e2]) + wa[2][2 * e2] * bf_lo(ra[j + 2][e2]);
                    const float a1 = wa[0][2 * e2 + 1] * bf_hi(ra[j][e2]) + wa[1][2 * e2 + 1] * bf_hi(ra[j + 1][e2]) + wa[2][2 * e2 + 1] * bf_hi(ra[j + 2][e2]);
                    const float g0 = wg[0][2 * e2] * bf_lo(rg[j][e2]) + wg[1][2 * e2] * bf_lo(rg[j + 1][e2]) + wg[2][2 * e2] * bf_lo(rg[j + 2][e2]);
                    const float g1 = wg[0][2 * e2 + 1] * bf_hi(rg[j][e2]) + wg[1][2 * e2 + 1] * bf_hi(rg[j + 1][e2]) + wg[2][2 * e2 + 1] * bf_hi(rg[j + 2][e2]);
                    o[2 * e2] = a0 * g0 * __builtin_amdgcn_rcpf(1.f + __expf(-g0)); o[2 * e2 + 1] = a1 * g1 * __builtin_amdgcn_rcpf(1.f + __expf(-g1)); }
                u32x4t w; w.x = pkbf(o[0], o[1]); w.y = pkbf(o[2], o[3]); w.z = pkbf(o[4], o[5]); w.w = pkbf(o[6], o[7]);
                *(u32x4t*)(HACT + (size_t)(r + j) * DFF + c) = w;
            }
            ra[0] = ra[4]; rg[0] = rg[4]; ra[1] = ra[5]; rg[1] = rg[5];
        }
    }
}

__device__ __forceinline__ void v_transpose_fp8(const bf16* V, unsigned char* VT, LAS unsigned char* scr, int gw, int ngw, int lane) {
    constexpr int NKT = T / 64, NCT = 1024 / 64;
    for (int it = gw; it < NKT * NCT; it += ngw) {
        const int ct = it % NCT, kt = it / NCT, b = kt / (SEQ / 64), k0 = (kt % (SEQ / 64)) * 64, c0 = ct * 64;
        const int r8 = lane >> 3, c8 = lane & 7;
#pragma unroll
        for (int i = 0; i < 8; ++i) { const int row = r8 + 8 * i; const u32x4t v = *(const u32x4t*)(V + ((size_t)b * SEQ + k0 + row) * 1024 + c0 + c8 * 8);
            u32x2t w; w.x = (unsigned)__builtin_amdgcn_cvt_pk_fp8_f32(bf_lo(v.y), bf_hi(v.y), __builtin_amdgcn_cvt_pk_fp8_f32(bf_lo(v.x), bf_hi(v.x), 0, false), true);
            w.y = (unsigned)__builtin_amdgcn_cvt_pk_fp8_f32(bf_lo(v.w), bf_hi(v.w), __builtin_amdgcn_cvt_pk_fp8_f32(bf_lo(v.z), bf_hi(v.z), 0, false), true);
            *(LAS u32x2t*)(scr + row * 72 + c8 * 8) = w; }
        asm volatile("s_waitcnt lgkmcnt(0)" ::: "memory");
        unsigned o[16];
#pragma unroll
        for (int wd = 0; wd < 16; ++wd) { unsigned acc = 0;
#pragma unroll
            for (int bb = 0; bb < 4; ++bb) { const int pi = wd * 4 + bb, h = pi >> 5, j = pi & 31, jj = j & 15, key = (j >> 4) * 32 + (jj & 3) + 8 * (jj >> 2) + 4 * h;
                acc |= (unsigned)scr[key * 72 + lane] << (8 * bb); }
            o[wd] = acc; }
        const int hh = (c0 + lane) >> 7, cc = (c0 + lane) & 127;
        unsigned char* dst = VT + (((size_t)b * 8 + hh) * 128 + cc) * SEQ + k0;
#pragma unroll
        for (int q = 0; q < 4; ++q) *(u32x4t*)(dst + 16 * q) = (u32x4t){o[4 * q], o[4 * q + 1], o[4 * q + 2], o[4 * q + 3]};
        asm volatile("s_waitcnt lgkmcnt(0)" ::: "memory");
    }
}

__device__ __forceinline__ void ffn_fixup_rows(const float* halo, const float* wconv  , bf16* HACT  , int gw, int ngw, int lane) {
    constexpr int NP = T / 256, NCC = 6;
    for (int it = gw; it < NP * 2 * NCC; it += ngw) {
        const int cc = it % NCC, pe = it / NCC, e = pe & 1, pm = pe >> 1, c = cc * 512 + lane * 8;
        if (c >= DFF) continue;
        const int row = pm * 256 + (e ? 255 : 0), ucol = (c >> 7) * 256 + (c & 127);
        const float* hp = halo + (size_t)pm * 4 * NUP + ucol;
        const float* up_ = nullptr; const float* cu_; const float* dn_ = nullptr;
        if (e == 0) { cu_ = hp; dn_ = hp + NUP; if (row % SEQ != 0) up_ = hp - 4 * NUP + 3 * NUP; }
        else { up_ = hp + 2 * NUP; cu_ = hp + 3 * NUP; if (row % SEQ != SEQ - 1) dn_ = hp + 4 * NUP; }
        float o[8];
#pragma unroll
        for (int i = 0; i < 8; ++i) {
            float ha = wconv[NUP + c + i] * cu_[i], hg = wconv[NUP + DFF + c + i] * cu_[128 + i];
            if (up_) { ha += wconv[c + i] * up_[i]; hg += wconv[DFF + c + i] * up_[128 + i]; }
            if (dn_) { ha += wconv[2 * NUP + c + i] * dn_[i]; hg += wconv[2 * NUP + DFF + c + i] * dn_[128 + i]; }
            o[i] = ha * hg * __builtin_amdgcn_rcpf(1.f + __expf(-hg)); }
        u32x4t w; w.x = pkbf(o[0], o[1]); w.y = pkbf(o[2], o[3]); w.z = pkbf(o[4], o[5]); w.w = pkbf(o[6], o[7]);
        *(u32x4t*)(HACT + (size_t)row * DFF + c) = w;
    }
}

__device__ __forceinline__ void hy_conv_transpose(const bf16* U  , const float* wshort  , float* VC0, float* VC1, bf16* G1C, bf16* G2C, LAS unsigned* scr, int gw, int ngw, int lane) {
    constexpr int NTT = T / 64, NCT = 3072 / 64;
    const int r8 = lane >> 3, c8 = lane & 7;
    u32x4t buf[9];
#define HCT_LOAD(IT) do { const int ct_ = (IT) % NCT, tt_ = (IT) / NCT, b_ = tt_ / (SEQ / 64), t0_ = (tt_ % (SEQ / 64)) * 64, c0_ = ct_ * 64; \
        _Pragma("unroll") for (int i = 0; i < 9; ++i) { const int row = r8 + 8 * i, tok = t0_ - 1 + row; buf[i] = (u32x4t){0u, 0u, 0u, 0u}; \
            if (row < 66 && tok >= 0 && tok < SEQ) buf[i] = *(const u32x4t*)(U + ((size_t)b_ * SEQ + tok) * 3072 + c0_ + c8 * 8); } } while (0)
    if (gw < NTT * NCT) HCT_LOAD(gw);
    for (int it = gw; it < NTT * NCT; it += ngw) {
        const int ct = it % NCT, tt = it / NCT, b = tt / (SEQ / 64), t0 = (tt % (SEQ / 64)) * 64, c0 = ct * 64;
#pragma unroll
        for (int i = 0; i < 9; ++i) { const int row = r8 + 8 * i; if (row < 66) { LAS unsigned* d = scr + row * 33 + c8 * 4; d[0] = buf[i].x; d[1] = buf[i].y; d[2] = buf[i].z; d[3] = buf[i].w; } }
        if (it + ngw < NTT * NCT) HCT_LOAD(it + ngw);
        asm volatile("s_waitcnt lgkmcnt(0)" ::: "memory");
        const int part = c0 >> 10, chb = c0 & 1023;
        const float wl0 = wshort[c0 + lane], wl1 = wshort[3072 + c0 + lane], wl2 = wshort[6144 + c0 + lane];
#pragma unroll
        for (int cp = 0; cp < 32; ++cp) {
            const unsigned a0 = scr[lane * 33 + cp], a1 = scr[(lane + 1) * 33 + cp], a2 = scr[(lane + 2) * 33 + cp];
            #define RL(x, i) __int_as_float(__builtin_amdgcn_readlane(__float_as_int(x), (i)))
            const float w00 = RL(wl0, 2 * cp), w10 = RL(wl1, 2 * cp), w20 = RL(wl2, 2 * cp), w01 = RL(wl0, 2 * cp + 1), w11 = RL(wl1, 2 * cp + 1), w21 = RL(wl2, 2 * cp + 1);
#undef RL
            const float v0 = w00 * bf_lo(a0) + w10 * bf_lo(a1) + w20 * bf_lo(a2), v1 = w01 * bf_hi(a0) + w11 * bf_hi(a1) + w21 * bf_hi(a2);
            const size_t o = (size_t)(chb + 2 * cp) * SEQ + t0 + lane;
            if (part == 0) { float* d = b ? VC1 : VC0; d[o] = v0; d[o + SEQ] = v1; }
            else { bf16* d = (part == 1 ? G1C : G2C) + (size_t)b * 1024 * SEQ; d[o] = (bf16)(pkbf(v0, 0.f) & 0xffffu); d[o + SEQ] = (bf16)(pkbf(v1, 0.f) & 0xffffu); }
        }
        asm volatile("s_waitcnt lgkmcnt(0)" ::: "memory");
    }
#undef HCT_LOAD
}
__device__ __forceinline__ void hy_transpose_back(const bf16* Z3C, bf16* XB, LAS unsigned* scr, int gw, int ngw, int lane) {
    constexpr int NTT = T / 64, NCT = 1024 / 64;
    for (int it = gw; it < NTT * NCT; it += ngw) {
        const int ct = it % NCT, tt = it / NCT, b = tt / (SEQ / 64), t0 = (tt % (SEQ / 64)) * 64, c0 = ct * 64;
        const bf16* src = Z3C + ((size_t)b * 1024 + c0) * SEQ + t0 + lane;
#pragma unroll 8
        for (int cp = 0; cp < 32; ++cp) { const unsigned lo = src[(size_t)(2 * cp) * SEQ], hi = src[(size_t)(2 * cp + 1) * SEQ]; scr[lane * 33 + cp] = lo | (hi << 16); }
        asm volatile("s_waitcnt lgkmcnt(0)" ::: "memory");
        const int r8 = lane >> 3, c8 = lane & 7;
#pragma unroll
        for (int i = 0; i < 8; ++i) { const int row = r8 + 8 * i; const LAS unsigned* s = scr + row * 33 + c8 * 4; u32x4t v; v.x = s[0]; v.y = s[1]; v.z = s[2]; v.w = s[3];
            *(u32x4t*)(XB + ((size_t)b * SEQ + t0 + row) * DM + c0 + c8 * 8) = v; }
        asm volatile("s_waitcnt lgkmcnt(0)" ::: "memory");
    }
}

#ifdef SELFCHECK
__device__ __forceinline__ float blk_sum(float v, LAS float* red, int tid_) {
    v = wave_sum(v); __syncthreads(); if ((tid_ & 63) == 0) red[tid_ >> 6] = v; __syncthreads();
    float t = 0.f; for (int i = 0; i < NWAVES; ++i) t += red[i]; __syncthreads(); return t;
}
__device__ __forceinline__ void chk_flag(unsigned* flag, float err2, float ref2, unsigned bit, int tid_, float tol = SELFCHECK_TOL) {
    if (tid_ == 0 && !(err2 <= tol * tol * ref2)) atomicOr(flag, bit);
}
__device__ __forceinline__ float fp8_dec(unsigned b) { const unsigned e = (b >> 3) & 15u, m = b & 7u; const float v = e ? ldexpf((float)(8u + m), (int)e - 10) : ldexpf((float)m, -9); return (b & 0x80u) ? -v : v; }
__device__ __forceinline__ float fp8_rnd(float x) { return fp8_dec((unsigned)__builtin_amdgcn_cvt_pk_fp8_f32(x, 0.f, 0, false) & 0xffu); }
__device__ __forceinline__ void selfcheck_mla(const Args& args, LAS unsigned char* ldsl, int bxx, int tid_) {
    unsigned* flag = (unsigned*)(args.ws + WS_CTL) + CW_CHK;
    const bf16* Qb_ = (const bf16*)(args.ws + WS_Q); const unsigned char* Kb_ = (const unsigned char*)(args.ws + WS_K); const bf16* Vb_ = (const bf16*)(args.ws + WS_V); const bf16* O_ = (const bf16*)(args.ws + WS_XB);
    const int* pos = (const int*)args.in[I_POS];
    LAS float* red = (LAS float*)(ldsl + 140000);
    if (bxx < 64) {
        const int t = bxx * (T / 64) + (bxx * 37) % 512;
        LAS float* h = (LAS float*)ldsl; LAS float* cq = h + 704; LAS float* ckv = cq + 384;
        const float* x = args.in[I_X] + (size_t)t * DM; const float* w_in = args.in[I_MLA_WIN];
        for (int j = tid_; j < MLA_IN; j += 512) { float a = 0.f; for (int k = 0; k < DM; ++k) a += x[k] * w_in[(size_t)k * MLA_IN + j]; h[j] = a; }
        __syncthreads();
        float sq = 0.f, sk = 0.f; for (int k = 0; k < QLORA; ++k) sq += h[k] * h[k]; for (int k = 0; k < KVLORA; ++k) sk += h[QLORA + k] * h[QLORA + k];
        const float rq = 1.f / sqrtf(sq / QLORA + RMS_EPS), rk = 1.f / sqrtf(sk / KVLORA + RMS_EPS);
        for (int k = tid_; k < QLORA; k += 512) cq[k] = h[k] * rq * args.in[I_MLA_GQ][k];
        for (int k = tid_; k < KVLORA; k += 512) ckv[k] = h[QLORA + k] * rk * args.in[I_MLA_GKV][k];
        __syncthreads();
        {
            float e2 = 0.f, r2 = 0.f; const float* w = args.in[I_MLA_WUQ];
            for (int n = tid_; n < NH * DQK; n += 512) { const int o = CmWuq()(n); float a = 0.f; for (int k = 0; k < QLORA; ++k) a += cq[k] * w[(size_t)k * (NH * DQK) + o];
                a *= QSCALE; const float g = __uint_as_float((unsigned)Qb_[(size_t)t * 1536 + n] << 16); e2 += (a - g) * (a - g); r2 += a * a; }
            e2 = blk_sum(e2, red, tid_); r2 = blk_sum(r2, red, tid_); chk_flag(flag, e2, r2, 1u, tid_);
        }
        {
            float e2 = 0.f, r2 = 0.f, e3 = 0.f, r3 = 0.f; const float* w = args.in[I_MLA_WUKV];
            for (int n = tid_; n < NH * 256; n += 512) { const int o = CmWukv()(n); float a = 0.f; for (int k = 0; k < KVLORA; ++k) a += ckv[k] * w[(size_t)k * (NH * 256) + o];
                if (n < 1024) { const float g = fp8_dec(Kb_[(size_t)t * 1536 + (n >> 7) * 192 + (n & 127)]); e2 += (a - g) * (a - g); r2 += a * a; }
                else { const float g = __uint_as_float((unsigned)Vb_[(size_t)t * 1024 + n - 1024] << 16); e3 += (a - g) * (a - g); r3 += a * a; } }
            e2 = blk_sum(e2, red, tid_); r2 = blk_sum(r2, red, tid_); chk_flag(flag, e2, r2, 2u, tid_, SELFCHECK_TOL8);
            e3 = blk_sum(e3, red, tid_); r3 = blk_sum(r3, red, tid_); chk_flag(flag, e3, r3, 8u, tid_);
        }
        {
            float e2 = 0.f, r2 = 0.f;
            if (tid_ < 256) { const int hh = tid_ >> 5, i = tid_ & 31; const float inv = powf(10000.0f, -(float)i / 32.0f); float s, c; sincosf((float)pos[t] * inv, &s, &c);
                const float x1 = h[640 + i], x2 = h[672 + i], a1 = x1 * c - x2 * s, a2 = x1 * s + x2 * c;
                const float g1 = fp8_dec(Kb_[(size_t)t * 1536 + hh * 192 + 128 + 2 * i]), g2 = fp8_dec(Kb_[(size_t)t * 1536 + hh * 192 + 129 + 2 * i]);
                e2 = (a1 - g1) * (a1 - g1) + (a2 - g2) * (a2 - g2); r2 = a1 * a1 + a2 * a2; }
            e2 = blk_sum(e2, red, tid_); r2 = blk_sum(r2, red, tid_); chk_flag(flag, e2, r2, 4u, tid_, SELFCHECK_TOL8);
        }
    } else if (bxx < 192) {
        const int sidx = bxx - 64, b = sidx & 1, hh = (sidx >> 1) & 7, row = (sidx * 509 + 13) % SEQ; const size_t t = (size_t)b * SEQ + row;
        LAS float* sc = (LAS float*)ldsl;
        LAS float* q = sc + SEQ;
        if (tid_ < DQK) { float v = __uint_as_float((unsigned)Qb_[t * 1536 + hh * DQK + tid_] << 16);
            if (tid_ >= 128) { const int i = (tid_ - 128) >> 1; const float inv = powf(10000.0f, -(float)i / 32.0f); float s, c; sincosf((float)pos[t] * inv, &s, &c);
                const float o = __uint_as_float((unsigned)Qb_[t * 1536 + hh * DQK + (tid_ ^ 1)] << 16);
                v = (tid_ & 1) ? (o * s + v * c) : (v * c - o * s); }
            q[tid_] = fp8_rnd(v); }
        __syncthreads();
        float mx = -1e30f;
        for (int k = tid_; k < SEQ; k += 512) { const unsigned char* kr = Kb_ + ((size_t)b * SEQ + k) * 1536 + hh * DQK; float a = 0.f; for (int d = 0; d < DQK; ++d) a += q[d] * fp8_dec(kr[d]); sc[k] = a; mx = fmaxf(mx, a); }
        for (int o = 1; o < 64; o <<= 1) mx = fmaxf(mx, __shfl_xor(mx, o));
        __syncthreads(); if ((tid_ & 63) == 0) red[tid_ >> 6] = mx; __syncthreads(); for (int i = 0; i < NWAVES; ++i) mx = fmaxf(mx, red[i]); __syncthreads();
        float ls = 0.f; for (int k = tid_; k < SEQ; k += 512) { const float p = exp2f(sc[k] - mx); sc[k] = p; ls += p; }
        ls = blk_sum(ls, red, tid_);
        const int d = tid_ & 127, part = tid_ >> 7; float a = 0.f;
        for (int k = part * 4096; k < (part + 1) * 4096; ++k) a += sc[k] * fp8_rnd(__uint_as_float((unsigned)Vb_[((size_t)b * SEQ + k) * 1024 + hh * DVH + d] << 16));
        LAS float* op = q + 256; op[tid_] = a; __syncthreads();
        float e2 = 0.f, r2 = 0.f;
        if (tid_ < 128) { const float o = (op[tid_] + op[tid_ + 128] + op[tid_ + 256] + op[tid_ + 384]) / ls; const float g = __uint_as_float((unsigned)O_[t * 1024 + hh * DVH + tid_] << 16); e2 = (o - g) * (o - g); r2 = o * o; }
        e2 = blk_sum(e2, red, tid_); r2 = blk_sum(r2, red, tid_); chk_flag(flag, e2, r2, 16u, tid_, SELFCHECK_TOL8);
    }
}
#endif
#ifndef MK_PER_PHASE
#define MK_PER_PHASE 0
#endif
constexpr int N_PHASES = 30;
constexpr int GEMM_SP2 = true, GEMM_ALIGN = true;

__global__ void __launch_bounds__(NWAVES * 64, 2) mega_fwd(Args args) {
    extern __shared__ __attribute__((aligned(16))) unsigned char lds[];
    LAS unsigned char* ldsl = (LAS unsigned char*)lds;
    volatile LAS unsigned* MISC = (volatile LAS unsigned*)(ldsl + MISC_OFF);
    const int wave = __builtin_amdgcn_readfirstlane((int)threadIdx.x >> 6);
#define lane hw_lane()
#define tid (wave * 64 + hw_lane())
#define G ((int)gridDim.x)
#define bx ((int)blockIdx.x)
#define gw (bx * NWAVES + wave)
#define ngw (G * NWAVES)
    { const int t_ = tid; if (t_ < 128) MISC[t_] = 0u; }
    __syncthreads();
    if (!MK_PER_PHASE) (void)xcd_barrier_post((unsigned*)(args.ws + WS_CTL) + CW_BAR, MISC + 8, (unsigned)wave);
    const int lo = args.ph_lo, hi = args.ph_hi;
#ifdef ONLY_PHASE
#define IN(k) ((k) == ONLY_PHASE && lo <= (k) && (k) < hi)
#else
#define IN(k) (lo <= (k) && (k) < hi)
#endif
#define GRIDBAR() do { XcdBarrier bar_; bar_.bar = (unsigned*)(args.ws + WS_CTL) + CW_BAR; bar_.x = xb_xcc_id(); bar_.st = MISC + 8; bar_.wv = (unsigned)wave; xcd_barrier(bar_); } while (0)
#define SEAM(k) do { if (IN(k) && IN((k) + 1)) GRIDBAR(); } while (0)
#ifndef PROBE_DUP
#define PROBE_DUP (-1)
#define PROBE_REP 1
#endif
#define RUN(k, REAL, DUMMY) do { if (IN(k)) { if (PROBE_DUP == (k)) { for (int rep_ = 0; rep_ < PROBE_REP; ++rep_) { DUMMY; GRIDBAR(); } } REAL; } } while (0)

#define P_(T_, off) ((T_*)(args.ws + (off)))
#define Win_t P_(bf16, WS_WIN)
#define Wuq_t P_(bf16, WS_WUQ)
#define Wukv_t P_(bf16, WS_WUKV)
#define Wo_t P_(bf16, WS_WO)
#define Whin_t P_(bf16, WS_WHIN)
#define Who_t P_(bf16, WS_WHO)
#define Wup_t P_(bf16, WS_WUP)
#define Wdn_t P_(bf16, WS_WDN)
#define Wfo_t P_(bf16, WS_WFO)
#define H3 P_(bf16, WS_H3)
#define XB P_(bf16, WS_XB)
#define XF P_(float, WS_XF)
#define CQN P_(bf16, WS_CQN)
#define CKVN P_(bf16, WS_CKVN)
#define ROPE P_(f32x2, WS_ROPE)
#define Qb P_(bf16, WS_Q)
#define Kb P_(unsigned char, WS_K)
#define Vb P_(bf16, WS_V)
#define VTb P_(unsigned char, WS_VT)
#define UH P_(bf16, WS_UH)
#define U P_(bf16, WS_U)
#define VC0 P_(float, WS_VC0)
#define VC1 P_(float, WS_VC1)
#define KT P_(float, WS_KT)
#define STASH P_(fftc::f2, WS_STASH)
#define KSPEC P_(fftc::f2, WS_KSPEC)
#define FTW (fftc::Tw{P_(const fftc::f2, WS_TW1), P_(const fftc::f2, WS_TW2), P_(const fftc::f2, WS_MOD)})
#define OUT (args.out)
#define H1 (args.out)
#define G1C ((bf16*)args.out)
#define G2C ((bf16*)args.out + (size_t)2 * 1024 * SEQ)
#define Z3C ((bf16*)args.out)
#define GEMM(EPI, A_, B_, M_, N_, K_, ...) do { pg8::Gemm g{(A_), (B_), (M_), (N_), (K_)}; pg8::StaticOrder S; S.init((M_), (N_), G, bx); typedef pg8::EPI Epi_; Epi_ E{__VA_ARGS__}; \
        pg8::gemm_phase<Epi_, pg8::StaticOrder, GEMM_ALIGN, GEMM_SP2>(ldsl, g, S, E, wave); } while (0)
#define YB_A P_(bf16, WS_XF)
#define YB_B P_(bf16, WS_S + 192 * MiB)
#define YB_C P_(bf16, WS_S)

    if (IN(0)) for (int prep_ = 0; prep_ < ((PROBE_DUP == 0) ? 1 + PROBE_REP : 1); ++prep_) {
        if (prep_) GRIDBAR();
        LAS float* scr = (LAS float*)(ldsl + wave * 16384);
        {
            int base = 0;
#define TR(W_, K_, N_, WT_, NP_, LDK_, CM_) do { const int nblk_ = (NP_) / 32, nit_ = ((K_) / 64) * nblk_; \
                for (int it_ = (gw + ngw - base % ngw) % ngw; it_ < nit_; it_ += ngw) transpose_item((W_), (K_), (N_), (WT_), (LDK_), scr, it_, nblk_, lane, CM_); base += nit_; } while (0)
            TR(args.in[I_MLA_WIN], DM, MLA_IN, Win_t, MLA_INP, DM, CmWin());
            TR(args.in[I_MLA_WUQ], QLORA, NH * DQK, Wuq_t, NH * DQK, QLORA, CmWuq());
            TR(args.in[I_MLA_WUKV], KVLORA, NH * 256, Wukv_t, NH * 256, KVLORA, CmWukv());
            TR(args.in[I_MLA_WO], DM, DM, Wo_t, DM, DM, CmIdent());
            TR(args.in[I_HY_WIN], DM, 3 * DM, Whin_t, 3 * DM, DM, CmIdent());
            TR(args.in[I_HY_WO], DM, DM, Who_t, DM, DM, CmIdent());
            TR(args.in[I_FFN_WUP], DM, NUP, Wup_t, NUP, DM, CmWup());
            TR(args.in[I_FFN_WUP] + (size_t)DM * NUP, DM, NUP, Wup_t + (size_t)NUP * DM, NUP, DM, CmWup());
            TR(args.in[I_FFN_WDOWN], DFF, DM, Wdn_t, DM, DFF, CmIdent());
            TR(args.in[I_FFN_WDOWN] + (size_t)DFF * DM, DFF, DM, Wdn_t + (size_t)DM * DFF, DM, DFF, CmIdent());
            TR(args.in[I_HY_FWOUT], HF, 4 * DM, Wfo_t, 4 * DM, HKP, CmIdent());
#undef TR
        }
        for (size_t i = (size_t)gw * 64 + lane; i < (size_t)4096 * 24; i += (size_t)ngw * 64) { const size_t r = i / 24, c = i % 24; *(u32x4t*)(Wfo_t + r * HKP + 64 + c * 8) = (u32x4t){0u, 0u, 0u, 0u}; }
        for (size_t i = (size_t)gw * 64 + lane; i < (size_t)SEQ * 24; i += (size_t)ngw * 64) { const size_t r = i / 24, c = i % 24; *(u32x4t*)(H3 + r * HKP + 64 + c * 8) = (u32x4t){0u, 0u, 0u, 0u}; }
        { const float* x_in = args.in[I_X];
          const size_t n8 = (size_t)T * DM / 8, st = (size_t)ngw * 64;
          for (size_t i = (size_t)gw * 64 + lane; i < n8; i += 4 * st) { f32x4 a[4], b[4];
#pragma unroll
            for (int q = 0; q < 4; ++q) { const size_t ii = i + q * st; if (ii < n8) { a[q] = *(const f32x4*)(x_in + ii * 8); b[q] = *(const f32x4*)(x_in + ii * 8 + 4); } }
#pragma unroll
            for (int q = 0; q < 4; ++q) { const size_t ii = i + q * st; if (ii < n8) { u32x4t w; w.x = pkbf(a[q].x, a[q].y); w.y = pkbf(a[q].z, a[q].w); w.z = pkbf(b[q].x, b[q].y); w.w = pkbf(b[q].z, b[q].w); *(u32x4t*)(XB + ii * 8) = w; } } } }
        { const int* pos = (const int*)args.in[I_POS]; const double inv = exp(-(double)(lane & 31) * (9.210340371976184 / 32.0));
          for (size_t i = (size_t)gw * 64 + lane; i < (size_t)T * 32; i += (size_t)ngw * 64) { const int t = (int)(i >> 5);
              const double ang = (double)pos[t] * inv; double s, c; sincos(ang, &s, &c); ROPE[i] = (f32x2){(float)c, (float)s}; } }
        { const float* fw1 = args.in[I_HY_FW1]; const float* fb1 = args.in[I_HY_FB1]; const float* fw2 = args.in[I_HY_FW2]; const float* fb2 = args.in[I_HY_FB2];
          const float* fw3 = args.in[I_HY_FW3]; const float* fb3 = args.in[I_HY_FB3]; const float fr = args.in[I_HY_FREQ][lane];
          for (int l0 = gw; l0 < SEQ; l0 += 4 * ngw) {
              float z[4], a[4], h[4];
#pragma unroll
              for (int u = 0; u < 4; ++u) { const int l = l0 + u * ngw < SEQ ? l0 + u * ngw : SEQ - 1;
                  const float tt = (float)l / (float)(SEQ - 1); const float w = 6.283185307179586f * (float)l / (float)SEQ;
                  z[u] = 0.f;
                  if (lane == 0) z[u] = tt;
                  else if (lane <= 16) { const float f = 1e-4f + (float)(lane - 1) * ((15.0f - 1e-4f) / 15.0f); z[u] = cosf(f * w); }
                  else if (lane <= 32) { const float f = 1e-4f + (float)(lane - 17) * ((15.0f - 1e-4f) / 15.0f); z[u] = -sinf(f * w); }
                  a[u] = fb1[lane]; }
#pragma unroll
              for (int i = 0; i < HEMB; ++i) { const float wv = fw1[i * HF + lane];
#pragma unroll
                  for (int u = 0; u < 4; ++u) a[u] += __shfl(z[u], i) * wv; }
#pragma unroll
              for (int u = 0; u < 4; ++u) { h[u] = sinf(fr * a[u]); a[u] = fb2[lane]; }
#pragma unroll 8
              for (int i = 0; i < HF; ++i) { const float wv = fw2[i * HF + lane];
#pragma unroll
                  for (int u = 0; u < 4; ++u) a[u] += __shfl(h[u], i) * wv; }
#pragma unroll
              for (int u = 0; u < 4; ++u) { h[u] = sinf(fr * a[u]); a[u] = fb3[lane]; }
#pragma unroll 8
              for (int i = 0; i < HF; ++i) { const float wv = fw3[i * HF + lane];
#pragma unroll
                  for (int u = 0; u < 4; ++u) a[u] += __shfl(h[u], i) * wv; }
#pragma unroll
              for (int u = 0; u < 4; ++u) { const int l = l0 + u * ngw; if (l < SEQ) H3[(size_t)l * HKP + lane] = (bf16)(pkbf(sinf(fr * a[u]), 0.f) & 0xffffu); }
          } }
    }
    SEAM(0);
#define B1 GEMM(EpiF32, XB, Win_t, T, MLA_INP, DM, H1, MLA_INP)
    RUN(1, B1, B1);
    SEAM(1);
#define B2 mla_norm_rope(H1, args.in[I_MLA_GQ], args.in[I_MLA_GKV], ROPE, CQN, CKVN, Kb, gw, ngw, lane)
    RUN(2, B2, B2);
    SEAM(2);
#define B3 do { GEMM(EpiBf16, CQN, Wuq_t, T, NH * DQK, QLORA, Qb, NH * DQK, QSCALE); GEMM(EpiKV, CKVN, Wukv_t, T, NH * 256, KVLORA, Kb, Vb); GRIDBAR(); v_transpose_fp8(Vb, VTb, (LAS unsigned char*)(ldsl + wave * 8192), gw, ngw, lane); } while (0)
    RUN(3, B3, B3);
    SEAM(3);
#ifndef ATT_EXP
#define ATT_EXP 0
#endif
#define B4X(EXPV) do { for (int u = bx; u < BATCH * NH * (SEQ / 256); u += G) { const int qb = u & 63, h = (u >> 6) & 7, b = u >> 9; const size_t r0 = (size_t)b * SEQ + (size_t)qb * 256; \
            attn::attn_unit<EXPV>(Qb + r0 * 1536 + h * DQK, Kb + (size_t)b * SEQ * 1536 + h * DQK, VTb + ((size_t)b * 8 + h) * 128 * SEQ, XB + r0 * 1024 + h * DVH, (const float*)(ROPE + r0 * 32), SEQ, (char*)lds, wave); } } while (0)
    RUN(4, B4X(0), B4X(ATT_EXP));
#ifdef SELFCHECK
    if (IN(4) && IN(5)) { GRIDBAR(); selfcheck_mla(args, ldsl, bx, tid); }
#endif
    SEAM(4);
#define B5 GEMM(EpiRes<false>, XB, Wo_t, T, DM, DM, args.in[I_X], YB_A, DN_ALPHA)
    RUN(5, B5, B5);
    SEAM(5);
#define B6 ln_rows(YB_A, nullptr, XB, args.in[I_LN1G], args.in[I_LN1B], gw, ngw, lane)
    RUN(6, B6, B6);
    SEAM(6);
#define HACT P_(bf16, WS_S)
#define HALO P_(float, WS_S + 180 * MiB)
#define FFN_UP(layer) GEMM(EpiConvSilu, XB, Wup_t + (size_t)(layer) * NUP * DM, T, NUP, DM, HACT, args.in[I_FFN_WCONV] + (size_t)(layer) * 3 * NUP, HALO, (PG8_LAS float*)(ldsl + RING_BYTES))
#define FFN_FIX(layer) ffn_fixup_rows(HALO, args.in[I_FFN_WCONV] + (size_t)(layer) * 3 * NUP, HACT, gw, ngw, lane)
#define FFN_DN(layer, OUT_) GEMM(EpiRes<true>, HACT, Wdn_t + (size_t)(layer) * DM * DFF, T, DM, DFF, XB, (OUT_), DN_ALPHA)
#define FFN_LAYER(p, layer) \
    RUN(p, FFN_UP(layer), FFN_UP(layer)); SEAM(p); \
    RUN((p) + 1, FFN_FIX(layer), FFN_FIX(layer)); SEAM((p) + 1); \
    RUN((p) + 2, FFN_DN(layer, (layer) ? YB_A : YB_B), FFN_DN(layer, (layer) ? YB_A : YB_B)); if (IN((p) + 2) && IN((p) + 6)) GRIDBAR();
    FFN_LAYER(7, 0)
#define B13 ln_rows(YB_B, XF, XB, args.in[I_LN2G], args.in[I_LN2B], gw, ngw, lane)
    RUN(13, B13, B13);
    SEAM(13);
#define B14 GEMM(EpiBf16, XB, Whin_t, T, 3 * DM, DM, U, 3 * DM, 1.0f)
    RUN(14, B14, B14);
    SEAM(14);
#define B15 hy_conv_transpose(U, args.in[I_HY_WSHORT], VC0, VC1, G1C, G2C, (LAS unsigned*)(ldsl + wave * 16384), gw, ngw, lane)
    RUN(15, B15, B15);
    SEAM(15);
#define HY_FILT(od) GEMM(EpiFilt, H3, Wfo_t + (size_t)(od) * 2048 * HKP, SEQ, 2 * DM, HKP, KT, SEQ, -120.39728043259360f, (40.54651081081644f + 120.39728043259360f) / 1023.0f, 1.0f / (float)(SEQ - 1))
#ifndef FFT_EV
#define FFT_EV 0
#endif
#define HY_FFT(MODE_, GC_, DB_) do { for (int c = bx; c < DM; c += G) { const size_t co = (size_t)c * SEQ; \
            fftc::hyena_channel<MODE_, ((MODE_) == 2 ? FFT_EV : 0)>((fftc::lf2*)ldsl, VC0 + co, VC1 + co, KT + co, KT + (size_t)DM * SEQ + co, (GC_) + co, (GC_) + (size_t)DM * SEQ + co, args.in[I_HY_DBIAS][(DB_) + c], \
                                       VC0 + co, VC1 + co, Z3C + co, Z3C + (size_t)DM * SEQ + co, STASH + (size_t)bx * SEQ, KSPEC + (size_t)bx * SEQ, tid); } } while (0)
    RUN(16, HY_FILT(0), HY_FILT(0)); SEAM(16);
    RUN(17, HY_FFT(0, G1C, 0), HY_FFT(2, G1C, 0)); SEAM(17);
    RUN(18, HY_FILT(1), HY_FILT(1)); SEAM(18);
    RUN(19, HY_FFT(1, G2C, DM), HY_FFT(1, G2C, DM)); SEAM(19);
#define B20 hy_transpose_back(Z3C, XB, (LAS unsigned*)(ldsl + wave * 16384), gw, ngw, lane)
    RUN(20, B20, B20);
    SEAM(20);
#define B21 GEMM(EpiRes<false>, XB, Who_t, T, DM, DM, XF, YB_C, DN_ALPHA)
    RUN(21, B21, B21);
    SEAM(21);
#define B22 ln_rows(YB_C, nullptr, XB, args.in[I_LN1G] + DM, args.in[I_LN1B] + DM, gw, ngw, lane)
    RUN(22, B22, B22);
    SEAM(22);
    FFN_LAYER(23, 1)
#ifdef SELFCHECK
    if (IN(29)) { const unsigned mask = __hip_atomic_load((unsigned*)(args.ws + WS_CTL) + CW_CHK, __ATOMIC_RELAXED, __HIP_MEMORY_SCOPE_AGENT);
        ln_rows(YB_A, OUT, nullptr, args.in[I_LN2G] + DM, args.in[I_LN2B] + DM, gw, ngw, lane, 1.0f + 0.1f * (float)mask); }
#else
    RUN(29, ln_rows(YB_A, OUT, nullptr, args.in[I_LN2G] + DM, args.in[I_LN2B] + DM, gw, ngw, lane), ln_rows(YB_A, OUT, nullptr, args.in[I_LN2G] + DM, args.in[I_LN2B] + DM, gw, ngw, lane));
#endif
#undef IN
#undef SEAM
#undef lane
#undef tid
#undef G
#undef bx
#undef gw
#undef ngw
}

extern "C" void kernel_launch(void* const* d_in, const int* in_sizes, int n_in, void* d_out, int out_size, void* d_ws, size_t ws_size, hipStream_t stream) {
    static int grid = 0;
    if (grid == 0) {
        if (n_in != 27 || in_sizes[0] != T * DM || out_size != T * DM || ws_size < WS_END) { fprintf(stderr, "kernel_launch: shape/workspace mismatch (n_in %d, in0 %d, out %d, ws %zu)\n", n_in, n_in > 0 ? in_sizes[0] : -1, out_size, ws_size); grid = -1; return; }
        int dev = 0, cus = 0, per_cu = 0;
        if (hipGetDevice(&dev) != hipSuccess || hipDeviceGetAttribute(&cus, hipDeviceAttributeMultiprocessorCount, dev) != hipSuccess) { grid = -1; return; }
        if (hipFuncSetAttribute((const void*)mega_fwd, hipFuncAttributeMaxDynamicSharedMemorySize, LDS_BYTES) != hipSuccess) { fprintf(stderr, "kernel_launch: hipFuncSetAttribute failed\n"); grid = -1; return; }
        if (hipOccupancyMaxActiveBlocksPerMultiprocessor(&per_cu, (const void*)mega_fwd, NWAVES * 64, LDS_BYTES) != hipSuccess || per_cu < 1) { fprintf(stderr, "kernel_launch: occupancy query says %d\n", per_cu); }
        (void)hipGetLastError();
        grid = cus;
    }
    if (grid < 0) return;
    if (hipMemsetAsync((char*)d_ws + WS_CTL, 0, CTL_ZERO_BYTES, stream) != hipSuccess) return;
    Args a{};
    for (int i = 0; i < 27; ++i) a.in[i] = (const float*)d_in[i];
    a.out = (float*)d_out; a.ws = (unsigned char*)d_ws;
#if MK_PER_PHASE
    for (int p = 0; p < N_PHASES; ++p) { a.ph_lo = p; a.ph_hi = p + 1; hipLaunchKernelGGL(mega_fwd, dim3(grid), dim3(NWAVES * 64), LDS_BYTES, stream, a); }
#else
    a.ph_lo = 0; a.ph_hi = N_PHASES; hipLaunchKernelGGL(mega_fwd, dim3(grid), dim3(NWAVES * 64), LDS_BYTES, stream, a);
#endif
}
```

```cpp
#include <hip/hip_runtime.h>
#include <cstdio>
#include <cstdint>
__device__ __forceinline__ int hw_lane() { int l; asm volatile("v_mbcnt_lo_u32_b32 %0, -1, 0\n\tv_mbcnt_hi_u32_b32 %0, -1, %0" : "=v"(l)); return l; }
namespace pg8 {
#define PG8_LAS __attribute__((address_space(3)))
typedef unsigned short bf16_t;
typedef short bf16x8 __attribute__((ext_vector_type(8)));
typedef float f32x4 __attribute__((ext_vector_type(4)));
typedef unsigned u32x4 __attribute__((ext_vector_type(4)));
constexpr int BM = 256, BK = 64, HALF = 128, HTB = HALF * BK * 2  , STAGE_BYTES = 8 * HTB, NXCD = 8, WGM = 8;

__host__ __device__ __forceinline__ int lds_byte(int r, int c) { const int st = (r >> 4) * 2 + (c >> 5), rr = r & 15, cc = c & 31, ob = rr * 64 + cc * 2; return st * 1024 + (ob ^ (((ob >> 9) & 1) << 5)); }
__host__ __device__ __forceinline__ void stage_rc(int b, int& R, int& C) { const int st = b / 1024, sb = b % 1024, swz = sb ^ (((sb >> 9) & 1) << 5); R = (st >> 1) * 16 + swz / 64; C = (st & 1) * 32 + (swz % 64) / 2; }
__host__ __device__ __forceinline__ int perm32(int rho) { const int n = rho >> 4, i = rho & 15; return 8 * (i >> 2) + 4 * n + (i & 3); }

struct Unit { int pm, pn; };
struct Gemm { const bf16_t* A; const bf16_t* Bt; int M, N, K; };

struct StaticOrder {
    int nM, nN, nwg, G, c;
    __host__ __device__ void init(int M, int N, int G_, int c_) { nM = M / BM; nN = N / BM; nwg = nM * nN; G = G_; c = c_; }
    __host__ __device__ bool next(int i, Unit& u) const {
        const long L = (long)i * G + c; if (L >= nwg) return false;
        int wgid = (int)L; { const int q = nwg / NXCD, r = nwg % NXCD, xcd = wgid % NXCD, off = wgid / NXCD; wgid = (xcd < r ? xcd * (q + 1) : r * (q + 1) + (xcd - r) * q) + off; }
        const int nig = WGM * nN, gid = wgid / nig, fm = gid * WGM, gsz = (nM - fm) < WGM ? (nM - fm) : WGM;
        u.pm = fm + ((wgid % nig) % gsz); u.pn = (wgid % nig) / gsz; return true;
    }
    __device__ __forceinline__ void a_ready(const Unit&) const {}
    __device__ __forceinline__ void done(const Unit&) const {}
};

__device__ __forceinline__ unsigned cvt_pk_bf16(float lo, float hi) { unsigned r; asm volatile("v_cvt_pk_bf16_f32 %0, %1, %2" : "=v"(r) : "v"(lo), "v"(hi)); return r; }
typedef float f32x2 __attribute__((ext_vector_type(2)));

struct EpiF32 {
    static constexpr bool PERM = false, AFTER_DRAIN = false;
    float* C; int ldc;
    __device__ __forceinline__ void operator()(const f32x4 (&acc)[2][2][4][2], const Unit& u_, int wr, int wc, int fr, int fq) const {
        Unit u = u_; asm volatile("" : "+s"(u.pm), "+s"(u.pn)); { const int l_ = hw_lane(); fr = l_ & 15; fq = l_ >> 4; }
        const int row0 = u.pm * BM + wr * 64 + fr, col0 = u.pn * BM + wc * 32 + 4 * fq;
#pragma unroll
        for (int ai = 0; ai < 2; ++ai)
#pragma unroll
            for (int m = 0; m < 4; ++m) { float* rowp = C + (size_t)(row0 + ai * HALF + m * 16) * ldc + col0;
#pragma unroll
                for (int bj = 0; bj < 2; ++bj)
#pragma unroll
                    for (int n = 0; n < 2; ++n) *(f32x4*)(rowp + bj * HALF + n * 16) = acc[ai][bj][m][n]; }
    }
};
struct EpiBf16 {
    static constexpr bool PERM = true, AFTER_DRAIN = false;
    bf16_t* O; int ldc; float scale;
    __device__ __forceinline__ void operator()(const f32x4 (&acc)[2][2][4][2], const Unit& u_, int wr, int wc, int fr, int fq) const {
        Unit u = u_; asm volatile("" : "+s"(u.pm), "+s"(u.pn)); { const int l_ = hw_lane(); fr = l_ & 15; fq = l_ >> 4; }
        const int row0 = u.pm * BM + wr * 64 + fr, col0 = u.pn * BM + wc * 32 + 8 * fq;
#pragma unroll
        for (int ai = 0; ai < 2; ++ai)
#pragma unroll
            for (int m = 0; m < 4; ++m) { bf16_t* rowp = O + (size_t)(row0 + ai * HALF + m * 16) * ldc + col0;
#pragma unroll
                for (int bj = 0; bj < 2; ++bj) { const f32x4 v0 = acc[ai][bj][m][0] * scale, v1 = acc[ai][bj][m][1] * scale;
                    u32x4 w; w.x = cvt_pk_bf16(v0[0], v0[1]); w.y = cvt_pk_bf16(v0[2], v0[3]); w.z = cvt_pk_bf16(v1[0], v1[1]); w.w = cvt_pk_bf16(v1[2], v1[3]);
                    *(u32x4*)(rowp + bj * HALF) = w; } }
    }
};
template <bool BASE_BF16> struct EpiRes {
    static constexpr bool PERM = true, AFTER_DRAIN = false;
    const void* base; bf16_t* out; float alpha;
    __device__ __forceinline__ void operator()(const f32x4 (&acc)[2][2][4][2], const Unit& u_, int wr, int wc, int fr, int fq) const {
        Unit u = u_; asm volatile("" : "+s"(u.pm), "+s"(u.pn)); { const int l_ = hw_lane(); fr = l_ & 15; fq = l_ >> 4; }
        const int row0 = u.pm * BM + wr * 64 + fr, col0 = u.pn * BM + wc * 32 + 8 * fq;
#pragma unroll
        for (int ai = 0; ai < 2; ++ai)
#pragma unroll
            for (int m = 0; m < 4; ++m) { const size_t off = (size_t)(row0 + ai * HALF + m * 16) * 1024 + col0;
#pragma unroll
                for (int bj = 0; bj < 2; ++bj) { f32x4 b0, b1;
                    if (BASE_BF16) { const u32x4 b = *(const u32x4*)((const bf16_t*)base + off + bj * HALF);
                        b0 = (f32x4){__uint_as_float(b.x << 16), __uint_as_float(b.x & 0xffff0000u), __uint_as_float(b.y << 16), __uint_as_float(b.y & 0xffff0000u)};
                        b1 = (f32x4){__uint_as_float(b.z << 16), __uint_as_float(b.z & 0xffff0000u), __uint_as_float(b.w << 16), __uint_as_float(b.w & 0xffff0000u)}; }
                    else { b0 = *(const f32x4*)((const float*)base + off + bj * HALF); b1 = *(const f32x4*)((const float*)base + off + bj * HALF + 4); }
                    const f32x4 v0 = b0 * alpha + acc[ai][bj][m][0], v1 = b1 * alpha + acc[ai][bj][m][1];
                    u32x4 w; w.x = cvt_pk_bf16(v0[0], v0[1]); w.y = cvt_pk_bf16(v0[2], v0[3]); w.z = cvt_pk_bf16(v1[0], v1[1]); w.w = cvt_pk_bf16(v1[2], v1[3]);
                    *(u32x4*)(out + off + bj * HALF) = w; }
                if (m & 1) asm volatile("" ::: "memory"); }
    }
};
struct EpiKV {
    static constexpr bool PERM = true, AFTER_DRAIN = false;
    unsigned char* Kb; bf16_t* Vb;
    __device__ __forceinline__ void operator()(const f32x4 (&acc)[2][2][4][2], const Unit& u_, int wr, int wc, int fr, int fq) const {
        Unit u = u_; asm volatile("" : "+s"(u.pm), "+s"(u.pn)); { const int l_ = hw_lane(); fr = l_ & 15; fq = l_ >> 4; }
        const int row0 = u.pm * BM + wr * 64 + fr, col0 = u.pn * BM + wc * 32 + 8 * fq;
        typedef unsigned u32x2 __attribute__((ext_vector_type(2)));
#pragma unroll
        for (int bj = 0; bj < 2; ++bj) { const int c = col0 + bj * HALF; const bool isk = c < 1024;
#pragma unroll
            for (int ai = 0; ai < 2; ++ai)
#pragma unroll
                for (int m = 0; m < 4; ++m) { const int row = row0 + ai * HALF + m * 16; const f32x4 v0 = acc[ai][bj][m][0], v1 = acc[ai][bj][m][1];
                    if (isk) { u32x2 w; int t = __builtin_amdgcn_cvt_pk_fp8_f32(v0[0], v0[1], 0, false); t = __builtin_amdgcn_cvt_pk_fp8_f32(v0[2], v0[3], t, true); w.x = (unsigned)t;
                        t = __builtin_amdgcn_cvt_pk_fp8_f32(v1[0], v1[1], 0, false); t = __builtin_amdgcn_cvt_pk_fp8_f32(v1[2], v1[3], t, true); w.y = (unsigned)t;
                        *(u32x2*)(Kb + (size_t)row * 1536 + (c >> 7) * 192 + (c & 127)) = w; }
                    else { u32x4 w; w.x = cvt_pk_bf16(v0[0], v0[1]); w.y = cvt_pk_bf16(v0[2], v0[3]); w.z = cvt_pk_bf16(v1[0], v1[1]); w.w = cvt_pk_bf16(v1[2], v1[3]);
                        *(u32x4*)(Vb + (size_t)row * 1024 + (c - 1024)) = w; } } }
    }
};
#define DPP_SHR1 0x111
#define DPP_SHL1 0x101
#define DPP_SHL15 0x10F
#define DPP_SHR15 0x11F
template <int CTRL> __device__ __forceinline__ float dpp_mov(float old, float src) { return __int_as_float(__builtin_amdgcn_update_dpp(__float_as_int(old), __float_as_int(src), CTRL, 0xF, 0xF, false)); }
struct EpiConvSilu {
    static constexpr bool PERM = true, AFTER_DRAIN = false;
    bf16_t* H; const float* wcv; float* halo; PG8_LAS float* ex;
    __device__ __forceinline__ void operator()(const f32x4 (&acc)[2][2][4][2], const Unit& u_, int wr, int wc, int fr, int fq) const {
        Unit u = u_; asm volatile("" : "+s"(u.pm), "+s"(u.pn)); { const int l_ = hw_lane(); fr = l_ & 15; fq = l_ >> 4; }
        const int hc0 = wc * 32 + 8 * fq;
#pragma unroll
        for (int ai = 0; ai < 2; ++ai)
#pragma unroll
            for (int bj = 0; bj < 2; ++bj)
#pragma unroll
                for (int n = 0; n < 2; ++n) {
                    if (fr == 0)  *(PG8_LAS f32x4*)(ex + ((ai * 2 + wr) * 2 + 0) * 256 + bj * 128 + hc0 + 4 * n) = acc[ai][bj][0][n];
                    if (fr == 15) *(PG8_LAS f32x4*)(ex + ((ai * 2 + wr) * 2 + 1) * 256 + bj * 128 + hc0 + 4 * n) = acc[ai][bj][3][n]; }
        if (wr == 0 && fr < 2) {
#pragma unroll
            for (int bj = 0; bj < 2; ++bj)
#pragma unroll
                for (int n = 0; n < 2; ++n) *(f32x4*)(halo + ((size_t)u.pm * 4 + fr) * 5632 + u.pn * 256 + bj * 128 + hc0 + 4 * n) = acc[0][bj][0][n]; }
        if (wr == 1 && fr >= 14) {
#pragma unroll
            for (int bj = 0; bj < 2; ++bj)
#pragma unroll
                for (int n = 0; n < 2; ++n) *(f32x4*)(halo + ((size_t)u.pm * 4 + 2 + (fr - 14)) * 5632 + u.pn * 256 + bj * 128 + hc0 + 4 * n) = acc[1][bj][3][n]; }
        asm volatile("s_waitcnt lgkmcnt(0)" ::: "memory"); __builtin_amdgcn_s_barrier(); asm volatile("" ::: "memory");
        float wv[2][3][8];
        { const int cg = u.pn * 128 + hc0;
#pragma unroll
          for (int bj = 0; bj < 2; ++bj)
#pragma unroll
            for (int k = 0; k < 3; ++k) { const f32x4 t0 = *(const f32x4*)(wcv + k * 5632 + bj * 2816 + cg), t1 = *(const f32x4*)(wcv + k * 5632 + bj * 2816 + cg + 4);
                wv[bj][k][0] = t0[0]; wv[bj][k][1] = t0[1]; wv[bj][k][2] = t0[2]; wv[bj][k][3] = t0[3]; wv[bj][k][4] = t1[0]; wv[bj][k][5] = t1[1]; wv[bj][k][6] = t1[2]; wv[bj][k][7] = t1[3]; } }
#pragma unroll
        for (int ai = 0; ai < 2; ++ai) {
            const int ch = ai * 2 + wr, cp = ch > 0 ? ch - 1 : 0, cn = ch < 3 ? ch + 1 : 3;
            f32x4 pe[2][2], ne[2][2];
#pragma unroll
            for (int bj = 0; bj < 2; ++bj)
#pragma unroll
                for (int n = 0; n < 2; ++n) { pe[bj][n] = *(const PG8_LAS f32x4*)(ex + (cp * 2 + 1) * 256 + bj * 128 + hc0 + 4 * n); ne[bj][n] = *(const PG8_LAS f32x4*)(ex + (cn * 2 + 0) * 256 + bj * 128 + hc0 + 4 * n); }
#pragma unroll
            for (int m = 0; m < 4; ++m) {
                float hv[2][8];
#pragma unroll
                for (int bj = 0; bj < 2; ++bj)
#pragma unroll
                    for (int n = 0; n < 2; ++n)
#pragma unroll
                        for (int j = 0; j < 4; ++j) {
                            const float cur = acc[ai][bj][m][n][j];
                            const float pin = (m > 0) ? dpp_mov<DPP_SHL15>(0.f, acc[ai][bj][m > 0 ? m - 1 : 0][n][j]) : pe[bj][n][j];
                            const float nin = (m < 3) ? dpp_mov<DPP_SHR15>(0.f, acc[ai][bj][m < 3 ? m + 1 : 3][n][j]) : ne[bj][n][j];
                            const float prv = dpp_mov<DPP_SHR1>(pin, cur), nxt = dpp_mov<DPP_SHL1>(nin, cur);
                            hv[bj][4 * n + j] = wv[bj][0][4 * n + j] * prv + wv[bj][1][4 * n + j] * cur + wv[bj][2][4 * n + j] * nxt; }
                float o[8];
#pragma unroll
                for (int i = 0; i < 8; ++i) o[i] = hv[0][i] * hv[1][i] * __builtin_amdgcn_rcpf(1.f + __expf(-hv[1][i]));
                u32x4 w; w.x = cvt_pk_bf16(o[0], o[1]); w.y = cvt_pk_bf16(o[2], o[3]); w.z = cvt_pk_bf16(o[4], o[5]); w.w = cvt_pk_bf16(o[6], o[7]);
                *(u32x4*)(H + (size_t)(u.pm * BM + ai * HALF + wr * 64 + m * 16 + fr) * 2816 + u.pn * 128 + hc0) = w;
            }
        }
        asm volatile("s_waitcnt lgkmcnt(0)" ::: "memory"); __builtin_amdgcn_s_barrier(); asm volatile("" ::: "memory");
    }
};

struct EpiFilt {
    static constexpr bool PERM = false, AFTER_DRAIN = false;
    float* KT; int L; float d0, dstep, tinv;
    __device__ __forceinline__ void operator()(const f32x4 (&acc)[2][2][4][2], const Unit& u_, int wr, int wc, int fr, int fq) const {
        Unit u = u_; asm volatile("" : "+s"(u.pm), "+s"(u.pn)); { const int l_ = hw_lane(); fr = l_ & 15; fq = l_ >> 4; }
        const int row0 = u.pm * BM + wr * 64 + fr, col0 = u.pn * BM + wc * 32 + 4 * fq;
#pragma unroll
        for (int bj = 0; bj < 2; ++bj)
#pragma unroll
            for (int n = 0; n < 2; ++n) { const int c = col0 + bj * HALF + n * 16;
#pragma unroll
                for (int j = 0; j < 4; ++j) { const int cc = c + j, ch = cc & 1023; const float nd = -__builtin_fabsf(d0 + (float)ch * dstep) * tinv; float* dst = KT + (size_t)cc * L;
#pragma unroll
                    for (int ai = 0; ai < 2; ++ai)
#pragma unroll
                        for (int m = 0; m < 4; ++m) { const int l = row0 + ai * HALF + m * 16; dst[l] = acc[ai][bj][m][n][j] * __expf(nd * (float)l); } } }
    }
};

template <class Epi, class Sched, bool ALIGN_EPI = false, bool SP2 = false>
__device__ __forceinline__ void gemm_phase(PG8_LAS unsigned char* lds, const Gemm g, const Sched& S, const Epi& E, int wid_in) {
    const int wid = wid_in, lane = hw_lane(), tid = wid * 64 + lane, wr = wid >> 2, wc = wid & 3, fr = lane & 15, fq = lane >> 4;
    const int K = g.K, nt = K / BK;
    unsigned voffA[2], voffB[2];
#pragma unroll
    for (int i = 0; i < 2; ++i) { int R, C; stage_rc(tid * 16 + i * 8192, R, C); const int Rb = Epi::PERM ? ((R & ~31) + perm32(R & 31)) : R;
        voffA[i] = (unsigned)(R * K + C) * 2u; voffB[i] = (unsigned)(Rb * K + C) * 2u; }
    const size_t kstep = (size_t)(BK * 2);
    const size_t hstep = (size_t)HALF * K * 2;
    const size_t tstep = 2 * hstep;
    const unsigned ldsw = (unsigned)wid * 1024u;
    const int aoff = lds_byte(wr * 64 + fr, fq * 8), boff = lds_byte(wc * 32 + fr, fq * 8);
#define PG8_SA(b, h) (((b) * 2 + (h)) * HTB)
#define PG8_SB(b, h) ((4 + (b) * 2 + (h)) * HTB)
#define PG8_STAGE(bufoff, gbase, voff) do { _Pragma("unroll") for (int _i = 0; _i < 2; ++_i) \
        __builtin_amdgcn_global_load_lds((const unsigned*)((const char*)(gbase) + (voff)[_i]), (PG8_LAS unsigned*)(lds + (bufoff) + ldsw + _i * 8192), 16, 0, 0); } while (0)
#define PG8_LDA(dst, b, h) do { _Pragma("unroll") for (int m = 0; m < 4; ++m) _Pragma("unroll") for (int k = 0; k < 2; ++k) dst[m][k] = *(const PG8_LAS bf16x8*)(lds + PG8_SA(b, h) + aoff + m * 2048 + k * 1024); } while (0)
#define PG8_LDB(dst, b, h) do { _Pragma("unroll") for (int n = 0; n < 2; ++n) _Pragma("unroll") for (int k = 0; k < 2; ++k) dst[n][k] = *(const PG8_LAS bf16x8*)(lds + PG8_SB(b, h) + boff + n * 2048 + k * 1024); } while (0)
#define PG8_MMA(ai, bj, At, Bt) do { __builtin_amdgcn_s_setprio(1); _Pragma("unroll") for (int m = 0; m < 4; ++m) _Pragma("unroll") for (int n = 0; n < 2; ++n) _Pragma("unroll") for (int k = 0; k < 2; ++k) \
        acc[ai][bj][m][n] = __builtin_amdgcn_mfma_f32_16x16x32_bf16(Bt[n][k], At[m][k], acc[ai][bj][m][n], 0, 0, 0); __builtin_amdgcn_s_setprio(0); } while (0)
#define PG8_WAIT_V(n) asm volatile("s_waitcnt vmcnt(" #n ")" ::: "memory")
#define PG8_WAIT_L(n) asm volatile("s_waitcnt lgkmcnt(" #n ")" ::: "memory")
#define PG8_BAR __builtin_amdgcn_s_barrier()
#define PG8_SCHED __builtin_amdgcn_sched_barrier(0)
    Unit cur, nxt; int ui = 0;
    if (!S.next(0, cur)) return;
    f32x4 acc[2][2][4][2];
#pragma unroll
    for (int a = 0; a < 2; ++a)
#pragma unroll
        for (int b = 0; b < 2; ++b)
#pragma unroll
            for (int m = 0; m < 4; ++m)
#pragma unroll
                for (int n = 0; n < 2; ++n) acc[a][b][m][n] = (f32x4){0.f, 0.f, 0.f, 0.f};
    bf16x8 At[4][2], B0[2][2], B1[2][2];
    const char* cA = (const char*)g.A + (size_t)cur.pm * tstep; const char* cB = (const char*)g.Bt + (size_t)cur.pn * tstep;
    S.a_ready(cur);
    if constexpr (SP2) {
        PG8_STAGE(PG8_SB(0, 0), cB, voffB); PG8_STAGE(PG8_SB(0, 1), cB + hstep, voffB); PG8_STAGE(PG8_SA(0, 0), cA, voffA); PG8_STAGE(PG8_SA(0, 1), cA + hstep, voffA);
        if (wr == 1) PG8_BAR;
        PG8_WAIT_V(2); PG8_BAR;
        PG8_STAGE(PG8_SB(1, 0), cB + kstep, voffB); PG8_STAGE(PG8_SA(1, 0), cA + kstep, voffA); PG8_STAGE(PG8_SB(1, 1), cB + hstep + kstep, voffB);
        PG8_WAIT_V(6); PG8_BAR;
    } else {
        PG8_STAGE(PG8_SB(0, 0), cB, voffB); PG8_STAGE(PG8_SA(0, 0), cA, voffA); PG8_STAGE(PG8_SB(0, 1), cB + hstep, voffB); PG8_STAGE(PG8_SA(0, 1), cA + hstep, voffA);
        if (wr == 1) PG8_BAR;
        PG8_WAIT_V(4); PG8_BAR;
        PG8_STAGE(PG8_SB(1, 0), cB + kstep, voffB); PG8_STAGE(PG8_SA(1, 0), cA + kstep, voffA); PG8_STAGE(PG8_SB(1, 1), cB + hstep + kstep, voffB);
        PG8_WAIT_V(6); PG8_BAR;
    }
    for (;;) {
        const bool has_next = S.next(ui + 1, nxt);
        const char* nA = has_next ? (const char*)g.A + (size_t)nxt.pm * tstep : cA; const char* nB = has_next ? (const char*)g.Bt + (size_t)nxt.pn * tstep : cB;
        for (int t = 0; t < nt; t += 2) {
            const bool last = (t == nt - 2);
            const char* a1 = cA + (size_t)(t + 1) * kstep;
            const char* a2 = last ? nA : cA + (size_t)(t + 2) * kstep; const char* b2 = last ? nB : cB + (size_t)(t + 2) * kstep;
            const char* a3 = a2 + kstep; const char* b3 = b2 + kstep;
            if (last && has_next) S.a_ready(nxt);
            if constexpr (SP2) {
            PG8_LDB(B0, 0, 0); PG8_LDB(B1, 0, 1); PG8_SCHED; PG8_LDA(At, 0, 0); PG8_STAGE(PG8_SA(1, 1), a1 + hstep, voffA);
            PG8_WAIT_V(8); PG8_WAIT_L(0); PG8_BAR; PG8_MMA(0, 0, At, B0); PG8_MMA(0, 1, At, B1); PG8_BAR; PG8_SCHED;
            PG8_LDA(At, 0, 1); PG8_STAGE(PG8_SB(0, 0), b2, voffB); PG8_STAGE(PG8_SB(0, 1), b2 + hstep, voffB); PG8_STAGE(PG8_SA(0, 0), a2, voffA);
            PG8_WAIT_V(8); PG8_WAIT_L(0); PG8_BAR; PG8_MMA(1, 0, At, B0); PG8_MMA(1, 1, At, B1); PG8_BAR; PG8_SCHED;
            PG8_LDB(B0, 1, 0); PG8_LDB(B1, 1, 1); PG8_SCHED; PG8_LDA(At, 1, 0); PG8_STAGE(PG8_SA(0, 1), a2 + hstep, voffA);
            PG8_WAIT_V(8); PG8_WAIT_L(0); PG8_BAR; PG8_MMA(0, 0, At, B0); PG8_MMA(0, 1, At, B1); PG8_BAR; PG8_SCHED;
            PG8_LDA(At, 1, 1); PG8_STAGE(PG8_SB(1, 0), b3, voffB); PG8_STAGE(PG8_SB(1, 1), b3 + hstep, voffB); PG8_STAGE(PG8_SA(1, 0), a3, voffA);
            PG8_WAIT_V(8); PG8_WAIT_L(0); PG8_BAR; PG8_MMA(1, 0, At, B0); PG8_MMA(1, 1, At, B1); PG8_BAR; PG8_SCHED;
            } else {
            PG8_LDB(B0, 0, 0); PG8_SCHED; PG8_LDA(At, 0, 0); PG8_STAGE(PG8_SA(1, 1), a1 + hstep, voffA);
            PG8_WAIT_L(8); PG8_BAR; PG8_WAIT_L(0); PG8_MMA(0, 0, At, B0); PG8_BAR; PG8_SCHED;
            PG8_LDB(B1, 0, 1); PG8_STAGE(PG8_SB(0, 0), b2, voffB);
            PG8_BAR; PG8_WAIT_L(0); PG8_MMA(0, 1, At, B1); PG8_BAR;
            PG8_LDA(At, 0, 1); PG8_STAGE(PG8_SA(0, 0), a2, voffA);
            PG8_BAR; PG8_WAIT_L(0); PG8_MMA(1, 0, At, B0); PG8_BAR; PG8_SCHED;
            PG8_STAGE(PG8_SB(0, 1), b2 + hstep, voffB);
            PG8_WAIT_V(6); PG8_BAR; PG8_MMA(1, 1, At, B1); PG8_BAR;
            PG8_LDB(B0, 1, 0); PG8_SCHED; PG8_LDA(At, 1, 0); PG8_STAGE(PG8_SA(0, 1), a2 + hstep, voffA);
            PG8_WAIT_L(8); PG8_BAR; PG8_WAIT_L(0); PG8_MMA(0, 0, At, B0); PG8_BAR; PG8_SCHED;
            PG8_LDB(B1, 1, 1); PG8_STAGE(PG8_SB(1, 0), b3, voffB);
            PG8_BAR; PG8_WAIT_L(0); PG8_MMA(0, 1, At, B1); PG8_BAR;
            PG8_LDA(At, 1, 1); PG8_STAGE(PG8_SA(1, 0), a3, voffA);
            PG8_BAR; PG8_WAIT_L(0); PG8_MMA(1, 0, At, B0); PG8_BAR; PG8_SCHED;
            PG8_STAGE(PG8_SB(1, 1), b3 + hstep, voffB);
            PG8_WAIT_V(6); PG8_BAR; PG8_MMA(1, 1, At, B1); PG8_BAR;
            }
        }
        if constexpr (ALIGN_EPI) { if (wr == 0) PG8_BAR; }
        if constexpr (!Epi::AFTER_DRAIN) { E(acc, cur, wr, wc, fr, fq); S.done(cur); }
        if (!has_next) break;
#pragma unroll
        for (int a = 0; a < 2; ++a)
#pragma unroll
            for (int b = 0; b < 2; ++b)
#pragma unroll
                for (int m = 0; m < 4; ++m)
#pragma unroll
                    for (int n = 0; n < 2; ++n) acc[a][b][m][n] = (f32x4){0.f, 0.f, 0.f, 0.f};
        cur = nxt; cA = nA; cB = nB; ++ui;
        if constexpr (ALIGN_EPI) { if (wr == 1) PG8_BAR; }
    }
    PG8_WAIT_V(0);
    if constexpr (!ALIGN_EPI) { if (wr == 0) PG8_BAR; }
    PG8_BAR;
    if constexpr (Epi::AFTER_DRAIN) { E.fused(acc, cur, wr, wc, fr, fq, lds, wid, lane); S.done(cur); }
#undef PG8_SA
#undef PG8_SB
#undef PG8_STAGE
#undef PG8_LDA
#undef PG8_LDB
#undef PG8_MMA
#undef PG8_WAIT_V
#undef PG8_WAIT_L
#undef PG8_BAR
#undef PG8_SCHED
}
}
#define GAS __attribute__((address_space(1)))
#define LAS __attribute__((address_space(3)))
typedef unsigned short bf16;
typedef unsigned v4u __attribute__((ext_vector_type(4)));
typedef float f32x4 __attribute__((ext_vector_type(4)));
typedef short bf16x8 __attribute__((ext_vector_type(8)));
typedef GAS unsigned gu32;
typedef GAS unsigned long long gu64;
#define RLX_AGENT __ATOMIC_RELAXED, __HIP_MEMORY_SCOPE_AGENT
#define LDS_WAIT() asm volatile("s_waitcnt lgkmcnt(0)" ::: "memory")
#define VM_WAIT() asm volatile("s_waitcnt vmcnt(0)" ::: "memory")
__device__ __forceinline__ unsigned long long rt() { return __builtin_amdgcn_s_memrealtime(); }
__device__ __forceinline__ unsigned f2bf(float f) { unsigned u = __builtin_bit_cast(unsigned, f); return (u + 0x7fffu + ((u >> 16) & 1u)) >> 16; }
__device__ __forceinline__ unsigned pk2(float lo, float hi) { return f2bf(lo) | (f2bf(hi) << 16); }

#define XB_TMO      128
#define XB_XCNT(j)  (256  + 64 * (j))
#define XB_XSUB(j)  (1280 + 64 * (j))
#define XB_XGEN(j)  (2304 + 64 * (j))
#define XB_TOP      3328
#define XB_TOPGEN   3392
#define XCD_BAR_WORDS 3456
#define XB_SPIN_CAP (1u << 18)

__device__ __forceinline__ unsigned xb_ld(unsigned* p)              { return __hip_atomic_load(p, __ATOMIC_RELAXED, __HIP_MEMORY_SCOPE_AGENT); }
__device__ __forceinline__ unsigned xb_add(unsigned* p, unsigned v) { return __hip_atomic_fetch_add(p, v, __ATOMIC_RELAXED, __HIP_MEMORY_SCOPE_AGENT); }
__device__ __forceinline__ unsigned xb_xcc_id() { return (unsigned)__builtin_amdgcn_s_getreg((3 << 11) | 20) & 0xFu; }
#define XB_SPIN(cond, bar) do { unsigned _sp = 0; while (cond) { __builtin_amdgcn_s_sleep(1); \
    if ((++_sp & 255u) == 0u) { if (xb_ld(&(bar)[XB_TMO])) break; if (_sp > XB_SPIN_CAP) { atomicAdd(&(bar)[XB_TMO], 1u); break; } } } } while (0)

struct XcdBarrier {
    unsigned* bar; unsigned x; unsigned wv;
    volatile LAS unsigned* st;
};

__device__ __forceinline__ XcdBarrier xcd_barrier_post(unsigned* bar, volatile LAS unsigned* st, unsigned wv) {
    XcdBarrier b; b.bar = bar; b.x = xb_xcc_id(); b.st = st; b.wv = wv;
    if (wv == 0u && hw_lane() == 0) (void)xb_add(&bar[XB_XCNT(b.x)], 1u);
    return b;
}
__device__ __forceinline__ void xcd_barrier_complete(unsigned* bar, unsigned x, unsigned& nloc, unsigned& nx) {
    const unsigned G = gridDim.x * gridDim.y * gridDim.z;
    unsigned sum, cnt, mine, sp = 0u;
    for (;;) {
        sum = 0u; cnt = 0u; mine = 0u;
#pragma unroll
        for (unsigned j = 0; j < 16; ++j) { const unsigned c = xb_ld(&bar[XB_XCNT(j)]); sum += c; cnt += (c > 0u) ? 1u : 0u; mine = (j == x) ? c : mine; }
        if (sum == G) break;
        __builtin_amdgcn_s_sleep(1);
        if ((++sp & 255u) == 0u) { if (xb_ld(&bar[XB_TMO])) break; if (sp > XB_SPIN_CAP) { atomicAdd(&bar[XB_TMO], 1u); break; } }
    }
    nloc = mine > 0u ? mine : 1u; nx = cnt > 0u ? cnt : 1u;
}

__device__ __forceinline__ void xcd_barrier(const XcdBarrier& b) {
    asm volatile("s_waitcnt vmcnt(0)" ::: "memory");
    __syncthreads();
    if (b.wv == 0u && hw_lane() == 0) {
        unsigned* bar = b.bar;
        __builtin_amdgcn_s_waitcnt(0);
        unsigned nloc = b.st[0], nx = b.st[1];
        if (nloc == 0u) { xcd_barrier_complete(bar, b.x, nloc, nx); b.st[0] = nloc; b.st[1] = nx; }
        const unsigned old = xb_add(&bar[XB_XSUB(b.x)], 1u);
        const unsigned gen = old / nloc;
        if (old + 1u == (gen + 1u) * nloc) {
            __builtin_amdgcn_fence(__ATOMIC_RELEASE, "agent");
            asm volatile("s_waitcnt vmcnt(0)" ::: "memory");
            const unsigned og = xb_add(&bar[XB_TOP], 1u);
            const unsigned tg = og / nx;
            if (og + 1u == (tg + 1u) * nx) xb_add(&bar[XB_TOPGEN], 1u);
            else XB_SPIN(xb_ld(&bar[XB_TOPGEN]) == tg, bar);
            __builtin_amdgcn_fence(__ATOMIC_ACQUIRE, "agent");
            xb_add(&bar[XB_XGEN(b.x)], 1u);
            asm volatile("s_waitcnt vmcnt(0)" ::: "memory");
        } else {
            XB_SPIN(xb_ld(&bar[XB_XGEN(b.x)]) == gen, bar);
            __builtin_amdgcn_fence(__ATOMIC_ACQUIRE, "agent");
            asm volatile("s_waitcnt vmcnt(0)" ::: "memory");
        }
    }
    __syncthreads();
}
namespace attn {
using f32x16 = __attribute__((ext_vector_type(16))) float;
using u32x4  = __attribute__((ext_vector_type(4))) unsigned;
constexpr int NW = 8, QBLK = 32, KVBLK = 64, DQ = 192, DVV = 128;
constexpr int LDQ = 1536, LDO = 1024;
constexpr float THRL = 7.0f;
#define SBAR() __builtin_amdgcn_sched_barrier(0)
__device__ __forceinline__ int crow(int r, int hi) { return (r & 3) + 8 * (r >> 2) + 4 * hi; }
typedef int v8i __attribute__((ext_vector_type(8)));
typedef int v4i __attribute__((ext_vector_type(4)));
__device__ __forceinline__ int pk8(float a, float b, float c, float d) { int t = __builtin_amdgcn_cvt_pk_fp8_f32(a, b, 0, false); return __builtin_amdgcn_cvt_pk_fp8_f32(c, d, t, true); }
__device__ __forceinline__ unsigned cvtpk(float lo, float hi) { unsigned r; asm volatile("v_cvt_pk_bf16_f32 %0, %1, %2" : "=v"(r) : "v"(lo), "v"(hi)); return r; }

__device__ __forceinline__ float vmax3(float a, float b, float c) { float r; asm("v_max3_f32 %0, %1, %2, %3" : "=v"(r) : "v"(a), "v"(b), "v"(c)); return r; }
__device__ __forceinline__ float vmax2(float a, float b) { float r; asm("v_max_f32 %0, %1, %2" : "=v"(r) : "v"(a), "v"(b)); return r; }
__device__ __forceinline__ float softmaxPP(f32x16& p0, f32x16& p1, float& m_reg, f32x16& negm, float& l_reg, bool first, v8i& pa) {
  const float a0 = vmax3(p0[0], p0[1], p0[2]), a1 = vmax3(p0[3], p0[4], p0[5]), a2 = vmax3(p0[6], p0[7], p0[8]), a3 = vmax3(p0[9], p0[10], p0[11]), a4 = vmax3(p0[12], p0[13], p0[14]);
  const float a5 = vmax3(p1[0], p1[1], p1[2]), a6 = vmax3(p1[3], p1[4], p1[5]), a7 = vmax3(p1[6], p1[7], p1[8]), a8 = vmax3(p1[9], p1[10], p1[11]), a9 = vmax3(p1[12], p1[13], p1[14]);
  const float b0 = vmax3(a0, a1, a2), b1 = vmax3(a3, a4, a5), b2 = vmax3(a6, a7, a8), b3 = vmax3(a9, p0[15], p1[15]);
  float pmax = vmax2(vmax3(b0, b1, b2), b3);
  { auto rr = __builtin_amdgcn_permlane32_swap(__float_as_uint(pmax), __float_as_uint(pmax), false, false); pmax = vmax2(__uint_as_float(rr[0]), __uint_as_float(rr[1])); }
  float alpha = 1.f;
  if (__builtin_expect(first || __any(pmax > THRL), 0)) { const float dl = first ? pmax : vmax2(pmax, 0.f); alpha = first ? 1.f : __builtin_amdgcn_exp2f(-dl); m_reg += dl;
    for (int r = 0; r < 16; ++r) { p0[r] -= dl; p1[r] -= dl; }
    for (int r = 0; r < 16; ++r) negm[r] = -m_reg; }
  for (int r = 0; r < 16; ++r) p0[r] = __builtin_amdgcn_exp2f(p0[r]);
  for (int r = 0; r < 16; ++r) p1[r] = __builtin_amdgcn_exp2f(p1[r]);
  float s0 = (p0[0] + p0[1]) + (p0[2] + p0[3]), s1 = (p0[4] + p0[5]) + (p0[6] + p0[7]), s2 = (p0[8] + p0[9]) + (p0[10] + p0[11]), s3 = (p0[12] + p0[13]) + (p0[14] + p0[15]);
  s0 += (p1[0] + p1[1]) + (p1[2] + p1[3]); s1 += (p1[4] + p1[5]) + (p1[6] + p1[7]); s2 += (p1[8] + p1[9]) + (p1[10] + p1[11]); s3 += (p1[12] + p1[13]) + (p1[14] + p1[15]);
  float ps = (s0 + s1) + (s2 + s3);
  { auto rr = __builtin_amdgcn_permlane32_swap(__float_as_uint(ps), __float_as_uint(ps), false, false); ps = __uint_as_float(rr[0]) + __uint_as_float(rr[1]); }
  l_reg = l_reg * alpha + ps;
#pragma unroll
  for (int w = 0; w < 4; ++w) {
    pa[w] = __builtin_amdgcn_cvt_pk_fp8_f32(p0[4 * w], p0[4 * w + 1], pa[w], false); pa[w] = __builtin_amdgcn_cvt_pk_fp8_f32(p0[4 * w + 2], p0[4 * w + 3], pa[w], true);
    pa[4 + w] = __builtin_amdgcn_cvt_pk_fp8_f32(p1[4 * w], p1[4 * w + 1], pa[4 + w], false); pa[4 + w] = __builtin_amdgcn_cvt_pk_fp8_f32(p1[4 * w + 2], p1[4 * w + 3], pa[4 + w], true); }
  return alpha;
}
typedef unsigned short bf16r;
constexpr int KROWB = 192, LDKB = 1536, SHM_K3 = KVBLK * KROWB, SHM_V3 = KVBLK * DVV, NSLOT = 4;
constexpr int LDS_K3 = 0, LDS_V3 = NSLOT * SHM_K3, LDS_WS3 = LDS_V3 + NSLOT * SHM_V3, SHM_ATTN3 = LDS_WS3 + NW * 64 * 4;
__device__ __forceinline__ void glds16(const void* gsrc, unsigned lds_dst) { unsigned keep;
  asm volatile("s_mov_b32 %0, m0\n\ts_mov_b32 m0, %2\n\ts_nop 0\n\tglobal_load_lds_dwordx4 %1, off\n\ts_mov_b32 m0, %0" : "=&s"(keep) : "v"(gsrc), "s"(lds_dst) : "memory"); }
__device__ __forceinline__ float bfl(unsigned w) { return __uint_as_float(w << 16); }
__device__ __forceinline__ float bfh(unsigned w) { return __uint_as_float(w & 0xffff0000u); }
template <int AEXP> __device__ __forceinline__ void attn_unit(const bf16r* __restrict__ Qb, const unsigned char* __restrict__ Kh, const unsigned char* __restrict__ Vh, bf16r* __restrict__ Ob, const float* __restrict__ tab, int seq, char* lds, int wid) {
  const int lane = hw_lane(), r32 = lane & 31, hi = lane >> 5;
  const unsigned lds0 = (unsigned)(uintptr_t)lds;
  float* wsf = (float*)(lds + LDS_WS3) + wid * 64; float* li_l = wsf; float* al_l = wsf + 32;
  float m_reg = 0.f, l_reg = 0; f32x16 o[4] = {}; v8i qf[3]; f32x16 negm = {}; asm volatile("" : "+v"(negm));
  { const bf16r* Qw = Qb + (long)(wid * QBLK + r32) * LDQ + hi * 32;
#pragma unroll
    for (int s = 0; s < 2; ++s) { u32x4 q4[4];
#pragma unroll
      for (int i = 0; i < 4; ++i) q4[i] = *reinterpret_cast<const u32x4*>(Qw + s * 64 + i * 8);
#pragma unroll
      for (int i = 0; i < 4; ++i) { qf[s][2 * i] = pk8(bfl(q4[i][0]), bfh(q4[i][0]), bfl(q4[i][1]), bfh(q4[i][1])); qf[s][2 * i + 1] = pk8(bfl(q4[i][2]), bfh(q4[i][2]), bfl(q4[i][3]), bfh(q4[i][3])); } }
    { const float* tr = tab + (long)(wid * QBLK + r32) * 64 + hi * 32;
#pragma unroll
      for (int i = 0; i < 4; ++i) { const u32x4 qv = *reinterpret_cast<const u32x4*>(Qw + 128 + i * 8);
        const float4 t0 = *reinterpret_cast<const float4*>(tr + i * 8), t1 = *reinterpret_cast<const float4*>(tr + i * 8 + 4);
        float r_[8];
#define ROT(K_, Q_, C_, S_) do { r_[K_] = bfl(Q_) * (C_) - bfh(Q_) * (S_); r_[K_ + 1] = bfl(Q_) * (S_) + bfh(Q_) * (C_); } while (0)
        ROT(0, qv[0], t0.x, t0.y); ROT(2, qv[1], t0.z, t0.w); ROT(4, qv[2], t1.x, t1.y); ROT(6, qv[3], t1.z, t1.w);
#undef ROT
        qf[2][2 * i] = pk8(r_[0], r_[1], r_[2], r_[3]); qf[2][2 * i + 1] = pk8(r_[4], r_[5], r_[6], r_[7]); } } }
  int kof[2], vof;
#pragma unroll
  for (int i = 0; i < 2; ++i) { const int ob = (wid + 8 * i) * 1024 + 16 * lane, row = ob / KROWB, pp = (ob - row * KROWB) >> 4, sl = pp ^ ((row >> 2) & 3); kof[i] = row * LDKB + sl * 16; }
  { const int c = 16 * wid + (lane >> 2), sl = (lane & 3) ^ ((c >> 2) & 3); vof = c * seq + sl * 16; }
  const unsigned kdst = lds0 + LDS_K3 + wid * 1024, vdst = lds0 + LDS_V3 + wid * 1024;
#define DMA_KV(kt, ks, vt, vs) do { const unsigned char* kb_ = Kh + (long)(kt) * KVBLK * LDKB; const unsigned char* vb_ = Vh + (long)(vt) * KVBLK; const unsigned kd_ = (unsigned)__builtin_amdgcn_readfirstlane(kdst + (ks) * SHM_K3), vd_ = (unsigned)__builtin_amdgcn_readfirstlane(vdst + (vs) * SHM_V3); \
    glds16(kb_ + kof[0], kd_); if (wid < 4) glds16(kb_ + kof[1], kd_ + 8192); glds16(vb_ + vof, vd_); } while (0)
  int kq[2];
  { const int x = (r32 >> 2) & 3; const int kb = (int)lds0 + LDS_K3 + r32 * KROWB; kq[0] = kb + 16 * ((2 * hi) ^ x); kq[1] = kb + 16 * ((2 * hi + 1) ^ x); }
  int vq[2];
  { const int x = (r32 >> 2) & 3; const int vbb = (int)lds0 + LDS_V3 + r32 * 64; vq[0] = vbb + 16 * ((2 * hi) ^ x); vq[1] = vbb + 16 * ((2 * hi + 1) ^ x); }
#define RESC(a) do { if (__any((a) < 1.f)) { if (hi == 0) al_l[r32] = (a); asm volatile("s_waitcnt lgkmcnt(0)" ::: "memory"); \
    for (int d = 0; d < 4; ++d) for (int r = 0; r < 16; ++r) o[d][r] *= al_l[crow(r, hi)]; } } while (0)
  f32x16 p0 = {}, p1 = {}; float al; v8i pa = {}; const int NT = seq / KVBLK;
  int s0 = 0;
#define SL(d) ((s0 + (d)) & 3)
#define CLAMP(t) ((t) < NT ? (t) : NT - 1)
#define BAR() asm volatile("s_barrier" ::: "memory")
#define LGKM(n) do { asm volatile("s_waitcnt lgkmcnt(" #n ")" ::: "memory"); SBAR(); } while (0)
  DMA_KV(0, 0, 0, 0); DMA_KV(1, 1, 1, 1); DMA_KV(2, 2, 1, 1);
  asm volatile("s_waitcnt vmcnt(0)\n\ts_barrier" ::: "memory");
#ifndef ATT_PRIO
#define ATT_PRIO 0
#endif
#ifndef ATT_HALF
#define ATT_HALF(w) ((w) >= 4)
#endif
#define KRD(F0, F1, OFF) asm volatile("ds_read_b128 %0, %4 offset:%6\n\tds_read_b128 %1, %5 offset:%6\n\tds_read_b128 %2, %4 offset:%7\n\tds_read_b128 %3, %5 offset:%7" \
    : "=&v"(F0##l), "=&v"(F0##h), "=&v"(F1##l), "=&v"(F1##h) : "v"(a0_), "v"(a1_), "i"(OFF), "i"((OFF) + 32 * KROWB) : "memory")
#define VRD8(FL, FH, CB) asm volatile("ds_read_b128 %0, %2 offset:%4\n\tds_read_b128 %1, %3 offset:%4" : "=&v"(FL), "=&v"(FH) : "v"(v0_), "v"(v1_), "i"((CB) * 2048) : "memory")
#define PV8(OD, FL, FH) do { if (AEXP == 2 || AEXP == 5) { asm volatile("" :: "v"(FL), "v"(FH)); break; } OD = __builtin_amdgcn_mfma_scale_f32_32x32x64_f8f6f4(pa, F8(FL, FH), OD, 0, 0, 0, 0, 0, 0); } while (0)
#define F8(L, H) (v8i){L[0], L[1], L[2], L[3], H[0], H[1], H[2], H[3]}
#define QK8(F0, F1, S, C0, C1) do { if (AEXP == 2 || AEXP == 5) { asm volatile("" :: "v"(F0##l), "v"(F1##h)); break; } p0 = __builtin_amdgcn_mfma_scale_f32_32x32x64_f8f6f4(F8(F0##l, F0##h), qf[S], C0, 0, 0, 0, 0, 0, 0); p1 = __builtin_amdgcn_mfma_scale_f32_32x32x64_f8f6f4(F8(F1##l, F1##h), qf[S], C1, 0, 0, 0, 0, 0, 0); } while (0)
#define MPH(PREV) do { const int ko_ = s0 * SHM_K3; const int a0_ = kq[0] + ko_, a1_ = kq[1] + ko_; const int vo_ = SL(3) * SHM_V3; const int v0_ = vq[0] + vo_, v1_ = vq[1] + vo_; \
    v4i ka0l, ka0h, ka1l, ka1h, kb0l, kb0h, kb1l, kb1h, v0l, v0h, v1l, v1h, v2l, v2h, v3l, v3h; \
    SBAR(); \
    KRD(ka0, ka1, 0); KRD(kb0, kb1, 64);                       \
    LGKM(4);  QK8(ka0, ka1, 0, negm, negm); \
    KRD(ka0, ka1, 128); VRD8(v0l, v0h, 0); VRD8(v1l, v1h, 1);   \
    LGKM(8);  QK8(kb0, kb1, 1, p0, p1); \
    VRD8(v2l, v2h, 2); VRD8(v3l, v3h, 3);                       \
    LGKM(8);  QK8(ka0, ka1, 2, p0, p1); \
    if (PREV) { LGKM(4); PV8(o[0], v0l, v0h); PV8(o[1], v1l, v1h); LGKM(0); PV8(o[2], v2l, v2h); PV8(o[3], v3l, v3h); } else { LGKM(0); } \
    } while (0)
#define WB() do { if (wid < 4) asm volatile("s_waitcnt vmcnt(3)\n\ts_barrier" ::: "memory"); else asm volatile("s_waitcnt vmcnt(2)\n\ts_barrier" ::: "memory"); } while (0)
#define VPH(j) do { if (AEXP != 3 && AEXP != 5) DMA_KV(CLAMP((j) + 3), SL(3), CLAMP((j) + 2), SL(2)); if (AEXP != 1 && AEXP != 5) { al = softmaxPP(p0, p1, m_reg, negm, l_reg, (j) == 0, pa); RESC(al); } else { asm volatile("" : "+v"(p0), "+v"(p1), "+v"(pa)); } s0 = SL(1); } while (0)
#define DRAIN() do { const int vo_ = SL(3) * SHM_V3; const int v0_ = vq[0] + vo_, v1_ = vq[1] + vo_; v4i v0l, v0h, v1l, v1h, v2l, v2h, v3l, v3h; \
    VRD8(v0l, v0h, 0); VRD8(v1l, v1h, 1); VRD8(v2l, v2h, 2); VRD8(v3l, v3h, 3); LGKM(0); PV8(o[0], v0l, v0h); PV8(o[1], v1l, v1h); PV8(o[2], v2l, v2h); PV8(o[3], v3l, v3h); } while (0)
  { const bool trail = ATT_HALF(wid);
    if (AEXP == 6 && trail) {
      BAR();
#pragma unroll 1
      for (int j = 0; j + 1 < NT; ++j) { DMA_KV(CLAMP((j) + 3), SL(3), CLAMP((j) + 2), SL(2)); s0 = SL(1); WB(); }
    } else {
    if (trail) BAR();
    if (ATT_PRIO == 1) __builtin_amdgcn_s_setprio(1);
    MPH(false); if (ATT_PRIO == 1) __builtin_amdgcn_s_setprio(0); if (!trail) WB();
#pragma unroll 1
    for (int j = 0; j + 1 < NT; ++j) { if (ATT_PRIO == 2) __builtin_amdgcn_s_setprio(1); VPH(j); if (ATT_PRIO == 2) __builtin_amdgcn_s_setprio(0); if (trail) WB(); if (ATT_PRIO == 1) __builtin_amdgcn_s_setprio(1); MPH(true); if (ATT_PRIO == 1) __builtin_amdgcn_s_setprio(0); if (!trail) WB(); }
    VPH(NT - 1); DRAIN(); } }
  if (hi == 0) li_l[r32] = l_reg; asm volatile("s_waitcnt lgkmcnt(0)" ::: "memory");
  float rli[16];
#pragma unroll
  for (int r = 0; r < 16; ++r) rli[r] = __builtin_amdgcn_rcpf(li_l[crow(r, hi)]);
  bf16r* Ow = Ob + (long)(wid * QBLK) * LDO;
#pragma unroll
  for (int r = 0; r < 16; ++r) { const int orow = crow(r, hi);
#pragma unroll
    for (int d0 = 0; d0 < 4; ++d0) { const unsigned w = cvtpk(o[d0][r] * rli[r], 0.f); Ow[(long)orow * LDO + d0 * 32 + r32] = (bf16r)(w & 0xffffu); } }
  asm volatile("s_waitcnt vmcnt(0) lgkmcnt(0)\n\ts_barrier" ::: "memory");
#undef DMA_KV
#undef RESC
#undef SL
#undef CLAMP
#undef BAR
#undef LGKM
#undef KRD
#undef VRD8
#undef PV8
#undef F8
#undef QK8
#undef MPH
#undef WB
#undef DRAIN
#undef VPH
}
#undef SBAR
}

namespace fftc {
#define FGAS __attribute__((address_space(1)))
typedef float f2 __attribute__((ext_vector_type(2)));
typedef __attribute__((address_space(3))) f2 lf2;
constexpr int L = 16384;
constexpr int FFT_LDS_BYTES = 17920 * 8;
__device__ static const float TW64C[32] = { 1.000000000e+00f, 9.951847267e-01f, 9.807852804e-01f, 9.569403357e-01f, 9.238795325e-01f, 8.819212643e-01f, 8.314696123e-01f, 7.730104534e-01f, 7.071067812e-01f, 6.343932842e-01f, 5.555702330e-01f, 4.713967368e-01f, 3.826834324e-01f, 2.902846773e-01f, 1.950903220e-01f, 9.801714033e-02f, 0.0f, -9.801714033e-02f, -1.950903220e-01f, -2.902846773e-01f, -3.826834324e-01f, -4.713967368e-01f, -5.555702330e-01f, -6.343932842e-01f, -7.071067812e-01f, -7.730104534e-01f, -8.314696123e-01f, -8.819212643e-01f, -9.238795325e-01f, -9.569403357e-01f, -9.807852804e-01f, -9.951847267e-01f };
__device__ static const float TW64S[32] = { 0.000000000e+00f, 9.801714033e-02f, 1.950903220e-01f, 2.902846773e-01f, 3.826834324e-01f, 4.713967368e-01f, 5.555702330e-01f, 6.343932842e-01f, 7.071067812e-01f, 7.730104534e-01f, 8.314696123e-01f, 8.819212643e-01f, 9.238795325e-01f, 9.569403357e-01f, 9.807852804e-01f, 9.951847267e-01f, 1.000000000e+00f, 9.951847267e-01f, 9.807852804e-01f, 9.569403357e-01f, 9.238795325e-01f, 8.819212643e-01f, 8.314696123e-01f, 7.730104534e-01f, 7.071067812e-01f, 6.343932842e-01f, 5.555702330e-01f, 4.713967368e-01f, 3.826834324e-01f, 2.902846773e-01f, 1.950903220e-01f, 9.801714033e-02f };
__device__ __forceinline__ f2 cmul(f2 a, f2 w) { return (f2){a.x * w.x - a.y * w.y, a.x * w.y + a.y * w.x}; }
template <bool INV> __device__ __forceinline__ f2 twmul(f2 d, int tw) {
    if (tw == 0) return d;
    if (tw == 16) return INV ? (f2){-d.y, d.x} : (f2){d.y, -d.x};
    const float c = TW64C[tw], s = TW64S[tw];
    return INV ? (f2){d.x * c - d.y * s, d.y * c + d.x * s} : (f2){d.x * c + d.y * s, d.y * c - d.x * s};
}
template <int N, int S, bool INV> __device__ __forceinline__ void dif_stage(f2 (&v)[N]) {
#pragma unroll
    for (int blk = 0; blk < N; blk += 2 * S)
#pragma unroll
        for (int i = 0; i < S; ++i) { const f2 a = v[blk + i], b = v[blk + i + S]; v[blk + i] = a + b; v[blk + i + S] = twmul<INV>(a - b, i * (32 / S)); }
    if constexpr (S > 1) dif_stage<N, S / 2, INV>(v);
}
constexpr int bitrev(int k, int bits) { int r = 0; for (int b = 0; b < bits; ++b) r |= ((k >> b) & 1) << (bits - 1 - b); return r; }
template <int N, bool INV> __device__ __forceinline__ void dft(f2 (&v)[N]) {
    dif_stage<N, N / 2, INV>(v);
    constexpr int bits = (N == 32) ? 5 : 4;
    f2 t[N];
#pragma unroll
    for (int k = 0; k < N; ++k) t[k] = v[bitrev(k, bits)];
#pragma unroll
    for (int k = 0; k < N; ++k) v[k] = t[k];
}
template <bool CONJ> __device__ __forceinline__ void apply_pow32(f2 (&v)[32], f2 w) {
    if (CONJ) w.y = -w.y;
    f2 lo[8]; lo[0] = (f2){1.f, 0.f}; lo[1] = w; lo[2] = cmul(w, w); lo[3] = cmul(lo[2], w); lo[4] = cmul(lo[2], lo[2]); lo[5] = cmul(lo[4], w); lo[6] = cmul(lo[4], lo[2]); lo[7] = cmul(lo[4], lo[3]);
#pragma unroll
    for (int k = 1; k < 32; ++k) if (k & 7) v[k] = cmul(v[k], lo[k & 7]);
    const f2 p8 = cmul(lo[4], lo[4]), p16 = cmul(p8, p8), p24 = cmul(p16, p8);
#pragma unroll
    for (int k = 8; k < 16; ++k) v[k] = cmul(v[k], p8);
#pragma unroll
    for (int k = 16; k < 24; ++k) v[k] = cmul(v[k], p16);
#pragma unroll
    for (int k = 24; k < 32; ++k) v[k] = cmul(v[k], p24);
}
__device__ __forceinline__ int opaque(int x) { asm volatile("" : "+v"(x)); return x; }
__device__ __forceinline__ f2 cis_pi(float x) { float s, c; sincospif(x, &s, &c); return (f2){c, s}; }
#define FPHYS(d1, d2, d3) ((d1) * 560 + (d2) * 17 + (d3))
#define FSYNC() __syncthreads()
template <int EV> __device__ __forceinline__ void pass1_fwd(lf2* X, f2 (&v)[32], int tid) {
    tid = opaque(tid);
    if (EV != 1) { dft<32, false>(v);
    apply_pow32<false>(v, cis_pi(-(float)tid * (2.0f / L))); }
    const int base = (tid >> 4) * 17 + (tid & 15);
#pragma unroll
    for (int k = 0; k < 32; ++k) { if (EV != 2) X[base + k * 560] = v[k]; else asm volatile("" :: "v"(v[k])); }
}
template <int EV> __device__ __forceinline__ void pass1_inv(const lf2* X, f2 (&v)[32], int tid) {
    tid = opaque(tid);
    const int base = (tid >> 4) * 17 + (tid & 15);
#pragma unroll
    for (int k = 0; k < 32; ++k) { if (EV != 2) v[k] = X[base + k * 560]; else v[k] = (f2){(float)(tid + k), 2.f}; }
    if (EV != 1) { apply_pow32<true>(v, cis_pi(-(float)tid * (2.0f / L)));
    dft<32, true>(v); }
}
template <bool INV, int EV> __device__ __forceinline__ void pass2(lf2* X, int tid) {
    tid = opaque(tid);
    const int base = (tid >> 4) * 560 + (tid & 15); f2 v[32];
    if (EV == 2) { for (int k = 0; k < 32; ++k) v[k] = (f2){(float)(tid + k), 1.f}; asm volatile("" : "+v"(v[0]), "+v"(v[7]), "+v"(v[19])); }
#pragma unroll
    for (int k = 0; k < 32; ++k) if (EV != 2) v[k] = X[base + k * 17];
    const f2 w = cis_pi(-(float)(tid & 15) * (2.0f / 512.0f));
    if (EV != 1) { if (INV) { apply_pow32<true>(v, w); dft<32, true>(v); } else { dft<32, false>(v); apply_pow32<false>(v, w); } }
#pragma unroll
    for (int k = 0; k < 32; ++k) { if (EV != 2) X[base + k * 17] = v[k]; else asm volatile("" :: "v"(v[k])); }
}
template <bool KMODE, int EV> __device__ __forceinline__ void pass3(lf2* X, f2 (&KR)[2][16], int tid) {
    tid = opaque(tid);
#pragma unroll
    for (int i = 0; i < 2; ++i) { const int base = ((tid >> 5) + 16 * i) * 560 + (tid & 31) * 17; f2 u[16];
#pragma unroll
        for (int k = 0; k < 16; ++k) u[k] = X[base + k];
        if (EV != 1) dft<16, false>(u);
        if (KMODE) {
#pragma unroll
            for (int k = 0; k < 16; ++k) KR[i][k] = u[k];
        } else {
#pragma unroll
            for (int k = 0; k < 16; ++k) u[k] = cmul(u[k], KR[i][k]);
            if (EV != 1) dft<16, true>(u);
#pragma unroll
            for (int k = 0; k < 16; ++k) X[base + k] = u[k];
        } }
}
template <int EV> __device__ __forceinline__ void kernel_spectrum(lf2* X, f2 (&v)[32], f2 (&KS)[2][16], int tid) {
    pass1_fwd<EV>(X, v, tid); FSYNC(); pass2<false, EV>(X, tid); FSYNC(); pass3<true, EV>(X, KS, tid); FSYNC();
}
template <int EV> __device__ __forceinline__ void conv_roundtrip(lf2* X, f2 (&v)[32], f2 (&KS)[2][16], int tid) {
    pass1_fwd<EV>(X, v, tid); FSYNC(); pass2<false, EV>(X, tid); FSYNC(); pass3<false, EV>(X, KS, tid); FSYNC(); pass2<true, EV>(X, tid); FSYNC(); pass1_inv<EV>(X, v, tid); FSYNC();
}
__device__ __forceinline__ void modulate(f2 (&v)[32], int tid) {
    const f2 wj = cis_pi(-(float)opaque(tid) * (1.0f / L));
#pragma unroll
    for (int k = 0; k < 32; ++k) v[k] = twmul<false>(cmul(v[k], wj), k);
}
__device__ __forceinline__ void demodulate(f2 (&v)[32], int tid) {
    f2 wj = cis_pi(-(float)opaque(tid) * (1.0f / L)); wj.y = -wj.y;
#pragma unroll
    for (int k = 0; k < 32; ++k) v[k] = twmul<true>(cmul(v[k], wj), k);
}
__device__ __forceinline__ float bf2f(unsigned short u) { return __uint_as_float((unsigned)u << 16); }
__device__ __forceinline__ unsigned short f2bf_rne(float f) { unsigned u = __float_as_uint(f); return (unsigned short)((u + 0x7fffu + ((u >> 16) & 1u)) >> 16); }
template <typename T> __device__ __forceinline__ FGAS T* pstep(FGAS T* p, int n) { p += n; asm volatile("" : "+v"(p)); return p; }
template <int MODE, int EV = 0> __device__ __forceinline__ void hyena_channel(lf2* X, const float* z0, const float* z1, const float* hf, const float* hb,
                                                                        const unsigned short* g0, const unsigned short* g1, float dbias, float* zo0, float* zo1,
                                                                        unsigned short* o0, unsigned short* o1, f2* stash, f2* KSg, int tid) {
    f2 v[32]; f2 KS[2][16];
    { FGAS const float* pf = (FGAS const float*)hf + opaque(tid); FGAS const float* pb = (FGAS const float*)hb + ((L - opaque(tid)) & (L - 1));
#pragma unroll
      for (int k = 0; k < 32; ++k) { v[k] = (EV == 3) ? (f2){1.f, 0.f} : (f2){*pf + *pb, 0.f}; pf = pstep(pf, 512); pb = (k == 0) ? pstep((FGAS const float*)hb + (L - 512 - tid), 0) : pstep(pb, -512); } }
    kernel_spectrum<EV>(X, v, KS, tid);
    { FGAS const float* p0 = (FGAS const float*)z0 + opaque(tid); FGAS const float* p1 = (FGAS const float*)z1 + opaque(tid);
#pragma unroll
      for (int k = 0; k < 32; ++k) { v[k] = (EV == 3) ? (f2){1.f, 2.f} : (f2){*p0, *p1}; p0 = pstep(p0, 512); p1 = pstep(p1, 512); } }
    conv_roundtrip<EV>(X, v, KS, tid);
    { FGAS f2* ps = (FGAS f2*)stash + opaque(tid);
#pragma unroll
      for (int k = 0; k < 32; ++k) { *ps = v[k]; ps = pstep(ps, 512); } }
    { FGAS const float* pf = (FGAS const float*)hf + opaque(tid); FGAS const float* pb = (FGAS const float*)hb + ((L - opaque(tid)) & (L - 1));
#pragma unroll
      for (int k = 0; k < 32; ++k) { const float hbv = (EV == 3) ? 1.f : *pb; v[k] = (f2){*pf + ((k == 0 && tid == 0) ? hbv : -hbv), 0.f}; pf = pstep(pf, 512); pb = (k == 0) ? pstep((FGAS const float*)hb + (L - 512 - tid), 0) : pstep(pb, -512); } }
    modulate(v, tid);
    kernel_spectrum<EV>(X, v, KS, tid);
    { FGAS const float* p0 = (FGAS const float*)z0 + opaque(tid); FGAS const float* p1 = (FGAS const float*)z1 + opaque(tid);
#pragma unroll
      for (int k = 0; k < 32; ++k) { v[k] = (EV == 3) ? (f2){1.f, 2.f} : (f2){*p0, *p1}; p0 = pstep(p0, 512); p1 = pstep(p1, 512); } }
    modulate(v, tid);
    conv_roundtrip<EV>(X, v, KS, tid);
    demodulate(v, tid);
    const float sc = 1.0f / (2.0f * L);
    { FGAS const f2* ps = (FGAS const f2*)stash + opaque(tid); FGAS const float* p0 = (FGAS const float*)z0 + opaque(tid); FGAS const float* p1 = (FGAS const float*)z1 + opaque(tid); FGAS const unsigned short* q0 = (FGAS const unsigned short*)g0 + opaque(tid); FGAS const unsigned short* q1 = (FGAS const unsigned short*)g1 + opaque(tid);
      FGAS float* w0 = (FGAS float*)zo0 + opaque(tid); FGAS float* w1 = (FGAS float*)zo1 + opaque(tid); FGAS unsigned short* b0 = (FGAS unsigned short*)o0 + opaque(tid); FGAS unsigned short* b1 = (FGAS unsigned short*)o1 + opaque(tid);
#pragma unroll
      for (int k = 0; k < 32; ++k) { const f2 y = (*ps + v[k]) * sc;
          const float r0 = bf2f(*q0) * (y.x + dbias * *p0), r1 = bf2f(*q1) * (y.y + dbias * *p1);
          if (MODE == 1) { *b0 = f2bf_rne(r0); *b1 = f2bf_rne(r1); b0 = pstep(b0, 512); b1 = pstep(b1, 512); } else if (MODE == 0) { *w0 = r0; *w1 = r1; w0 = pstep(w0, 512); w1 = pstep(w1, 512); } else { asm volatile("" :: "v"(r0), "v"(r1)); }
          ps = pstep(ps, 512); p0 = pstep(p0, 512); p1 = pstep(p1, 512); q0 = pstep(q0, 512); q1 = pstep(q1, 512); } }
}
#undef FPHYS
#undef FGAS
}

constexpr int BATCH = 2, SEQ = 16384, DM = 1024, T = BATCH * SEQ;
constexpr int NH = 8, DNOPE = 128, DROPE = 64, DQK = 192, DVH = 128, QLORA = 384, KVLORA = 256, MLA_IN = 704, MLA_INP = 768;
constexpr int DFF = 2816, NUP = 2 * DFF;
constexpr int HF = 64, HEMB = 33, HKP = 256;
constexpr float LN_EPS = 1e-5f, RMS_EPS = 1e-6f;
constexpr float DN_ALPHA = 1.4142135623730951f;
constexpr float QSCALE = 0.07216878364870322f * 1.4426950408889634f;
constexpr int NWAVES = 8;

constexpr size_t MiB = 1u << 20;
constexpr size_t WS_CTL = 0, CTL_ZERO_BYTES = 64 * 1024;
constexpr size_t WS_TW1 = 256 * 1024, WS_MOD = 384 * 1024, WS_TW2 = 512 * 1024;
constexpr size_t WS_WIN = 2 * MiB, WS_WUQ = 4 * MiB, WS_WUKV = 6 * MiB, WS_WO = 7 * MiB, WS_WHIN = 9 * MiB, WS_WHO = 15 * MiB, WS_WUP = 17 * MiB, WS_WDN = 39 * MiB, WS_WFO = 50 * MiB, WS_H3 = 52 * MiB;
constexpr size_t WS_XB = 60 * MiB;
constexpr size_t WS_XF = 124 * MiB;
constexpr size_t WS_S = 252 * MiB;
constexpr size_t WS_END = 512 * MiB;
constexpr size_t WS_CQN = WS_XF, WS_CKVN = WS_XF + 24 * MiB, WS_ROPE = WS_XF + 40 * MiB;
constexpr size_t WS_Q = WS_S, WS_K = WS_S + 96 * MiB, WS_VT = WS_S + 144 * MiB, WS_V = WS_S + 192 * MiB;
constexpr size_t WS_UH = WS_S;
constexpr size_t WS_U = WS_S;
constexpr size_t WS_VC0 = WS_XB, WS_VC1 = WS_S + 192 * MiB;
constexpr size_t WS_KT = WS_S, WS_STASH = WS_S + 128 * MiB, WS_KSPEC = WS_S + 160 * MiB;
constexpr int CW_TMO = 0, CW_CODE = 1, CW_BAR = 4096, CW_CHK = 8192;

constexpr int RING_BYTES = 131072;
constexpr int LDS_BYTES = 147456;
constexpr int MISC_OFF = LDS_BYTES - 512;
static_assert(fftc::FFT_LDS_BYTES <= MISC_OFF && attn::SHM_ATTN3 <= RING_BYTES, "LDS map");

typedef pg8::bf16_t bf16;
typedef unsigned u32x4t __attribute__((ext_vector_type(4)));
typedef unsigned u32x2t __attribute__((ext_vector_type(2)));
typedef float f32x2 __attribute__((ext_vector_type(2)));
__device__ __forceinline__ float wave_sum(float v) {
#pragma unroll
    for (int o = 1; o < 64; o <<= 1) v += __shfl_xor(v, o);
    return v;
}
__device__ __forceinline__ float bf_lo(unsigned w) { return __uint_as_float(w << 16); }
__device__ __forceinline__ float bf_hi(unsigned w) { return __uint_as_float(w & 0xffff0000u); }
__device__ __forceinline__ unsigned pkbf(float lo, float hi) { return pg8::cvt_pk_bf16(lo, hi); }

template <class ColMap> __device__ __forceinline__ void transpose_item(const float* W, int K, int N, bf16* WT, int ldk, LAS float* scr, int item, int nblk, int lane, const ColMap& cm) {
    const int kb = item / nblk, nb = item % nblk, k0 = 64 * kb, n0 = 32 * nb;
    const int q4 = 4 * (lane & 7), s0 = cm(n0 + q4), s1 = cm(n0 + q4 + 1), s2 = cm(n0 + q4 + 2), s3 = cm(n0 + q4 + 3);
    const bool vec = (s0 >= 0) && (s1 == s0 + 1) && (s2 == s0 + 2) && (s3 == s0 + 3) && ((s0 & 3) == 0) && ((N & 3) == 0);
#pragma unroll
    for (int i = 0; i < 8; ++i) { const int kk = (lane >> 3) + 8 * i; const float* wr = W + (size_t)(k0 + kk) * N; f32x4 v;
        if (vec) v = *(const f32x4*)(wr + s0);
        else { v.x = s0 >= 0 ? wr[s0] : 0.f; v.y = s1 >= 0 ? wr[s1] : 0.f; v.z = s2 >= 0 ? wr[s2] : 0.f; v.w = s3 >= 0 ? wr[s3] : 0.f; }
        LAS float* d = scr + kk * 33 + q4; d[0] = v.x; d[1] = v.y; d[2] = v.z; d[3] = v.w; }
    asm volatile("s_waitcnt lgkmcnt(0)" ::: "memory");
    const int c = lane & 7;
#pragma unroll
    for (int j = 0; j < 4; ++j) { const int n = (lane >> 3) + 8 * j; const LAS float* s = scr + (8 * c) * 33 + n;
        u32x4t o; o.x = pkbf(s[0 * 33], s[1 * 33]); o.y = pkbf(s[2 * 33], s[3 * 33]); o.z = pkbf(s[4 * 33], s[5 * 33]); o.w = pkbf(s[6 * 33], s[7 * 33]);
        *(u32x4t*)(WT + (size_t)(n0 + n) * ldk + k0 + 8 * c) = o; }
    asm volatile("s_waitcnt lgkmcnt(0)" ::: "memory");
}
struct CmIdent { __device__ __forceinline__ int operator()(int n) const { return n; } };
struct CmWin { __device__ __forceinline__ int operator()(int n) const { if (n < 640) return n; if (n >= 704) return -1; const int i = n - 640; return 640 + (i & 1) * 32 + (i >> 1); } };
struct CmWuq { __device__ __forceinline__ int operator()(int n) const { const int h = n / 192, d = n - h * 192; if (d < 128) return n; const int i = d - 128; return h * 192 + 128 + (i & 1) * 32 + (i >> 1); } };
struct CmWukv { __device__ __forceinline__ int operator()(int n) const { const int v = n >> 10, r = n & 1023, h = r >> 7, d = r & 127; return h * 256 + v * 128 + d; } };
struct CmWup { __device__ __forceinline__ int operator()(int n) const { const int pn = n >> 8, r = n & 255; return (r < 128) ? (pn * 128 + r) : (DFF + pn * 128 + (r - 128)); } };

struct Args {
    const float* in[27]; float* out; unsigned char* ws; int ph_lo, ph_hi;
};
enum { I_X = 0, I_POS, I_MLA_WIN, I_MLA_GQ, I_MLA_WUQ, I_MLA_GKV, I_MLA_WUKV, I_MLA_WO, I_HY_WIN, I_HY_WSHORT, I_HY_FW1, I_HY_FB1, I_HY_FW2, I_HY_FB2, I_HY_FW3, I_HY_FB3, I_HY_FREQ,
       I_HY_FWOUT, I_HY_DBIAS, I_HY_WO, I_FFN_WUP, I_FFN_WCONV, I_FFN_WDOWN, I_LN1G, I_LN1B, I_LN2G, I_LN2B };

__device__ __forceinline__ void ln_rows(const bf16* Y, float* OF, bf16* OB, const float* g, const float* b, int gw, int ngw, int lane, float omul = 1.0f) {
    f32x4 gv[4], bv[4];
#pragma unroll
    for (int j = 0; j < 4; ++j) { gv[j] = *(const f32x4*)(g + 4 * lane + 256 * j); bv[j] = *(const f32x4*)(b + 4 * lane + 256 * j); }
    for (int m0 = gw; m0 < T; m0 += 4 * ngw) {
        u32x2t w[4][4];
#pragma unroll
        for (int q = 0; q < 4; ++q) { const int m = m0 + q * ngw; if (m < T) { const u32x2t* xr = (const u32x2t*)(Y + (size_t)m * DM) + lane;
#pragma unroll
                for (int j = 0; j < 4; ++j) w[q][j] = xr[64 * j]; } }
#pragma unroll
        for (int q = 0; q < 4; ++q) { const int m = m0 + q * ngw; if (m < T) {
            f32x4 v[4]; float s = 0.f;
#pragma unroll
            for (int j = 0; j < 4; ++j) { v[j] = (f32x4){bf_lo(w[q][j].x), bf_hi(w[q][j].x), bf_lo(w[q][j].y), bf_hi(w[q][j].y)}; s += (v[j].x + v[j].y) + (v[j].z + v[j].w); }
            const float mean = wave_sum(s) * (1.f / DM); float s2 = 0.f;
#pragma unroll
            for (int j = 0; j < 4; ++j) { v[j] = v[j] - mean; s2 += (v[j].x * v[j].x + v[j].y * v[j].y) + (v[j].z * v[j].z + v[j].w * v[j].w); }
            const float rstd = 1.f / sqrtf(wave_sum(s2) * (1.f / DM) + LN_EPS);
            f32x4* of = (f32x4*)(OF + (size_t)m * DM) + lane;
#pragma unroll
            for (int j = 0; j < 4; ++j) { v[j] = (v[j] * rstd * gv[j] + bv[j]) * omul;
                if (OF) of[64 * j] = v[j]; }
            if (OB) { u32x2t* ob = (u32x2t*)(OB + (size_t)m * DM) + lane;
#pragma unroll
                for (int j = 0; j < 4; ++j) { u32x2t ww; ww.x = pkbf(v[j].x, v[j].y); ww.y = pkbf(v[j].z, v[j].w); ob[64 * j] = ww; } } } }
    }
}

__device__ __forceinline__ void mla_norm_rope(const float* H1, const float* gq, const float* gkv, const f32x2* tab, bf16* CQN, bf16* CKVN, unsigned char* Kb, int gw, int ngw, int lane) {
    float gqv[6], gkvv[4];
#pragma unroll
    for (int k = 0; k < 6; ++k) gqv[k] = gq[lane + 64 * k];
#pragma unroll
    for (int k = 0; k < 4; ++k) gkvv[k] = gkv[lane + 64 * k];
    for (int t0 = gw; t0 < T; t0 += 2 * ngw) {
        float q[2][6], kv[2][4]; f32x2 xr[2], cs[2];
#pragma unroll
        for (int u = 0; u < 2; ++u) { const int t = t0 + u * ngw; if (t < T) { const float* h = H1 + (size_t)t * MLA_INP;
#pragma unroll
            for (int k = 0; k < 6; ++k) q[u][k] = h[lane + 64 * k];
#pragma unroll
            for (int k = 0; k < 4; ++k) kv[u][k] = h[QLORA + lane + 64 * k];
            xr[u] = *(const f32x2*)(h + 640 + 2 * (lane & 31)); cs[u] = tab[(size_t)t * 32 + (lane & 31)]; } }
#pragma unroll
        for (int u = 0; u < 2; ++u) { const int t = t0 + u * ngw; if (t < T) {
            float sq = 0.f, sk = 0.f;
#pragma unroll
            for (int k = 0; k < 6; ++k) sq += q[u][k] * q[u][k];
#pragma unroll
            for (int k = 0; k < 4; ++k) sk += kv[u][k] * kv[u][k];
            const float rq = 1.f / sqrtf(wave_sum(sq) * (1.f / QLORA) + RMS_EPS), rk = 1.f / sqrtf(wave_sum(sk) * (1.f / KVLORA) + RMS_EPS);
#pragma unroll
            for (int k = 0; k < 6; ++k) CQN[(size_t)t * QLORA + lane + 64 * k] = (bf16)(pkbf(q[u][k] * rq * gqv[k], 0.f) & 0xffffu);
#pragma unroll
            for (int k = 0; k < 4; ++k) CKVN[(size_t)t * KVLORA + lane + 64 * k] = (bf16)(pkbf(kv[u][k] * rk * gkvv[k], 0.f) & 0xffffu);
            const unsigned short w = (unsigned short)__builtin_amdgcn_cvt_pk_fp8_f32(xr[u].x * cs[u].x - xr[u].y * cs[u].y, xr[u].x * cs[u].y + xr[u].y * cs[u].x, 0, false);
            unsigned short* kr = (unsigned short*)(Kb + (size_t)t * 1536 + 128) + (lane & 31);
            if (lane < 32) {
#pragma unroll
                for (int hh = 0; hh < NH; ++hh) kr[hh * 96] = w; } } }
    }
}

__device__ __forceinline__ void ffn_conv_silu(const bf16* UH, const float* wconv  , bf16* HACT  , int gw, int ngw, int lane) {
    constexpr int RB = 32, NRB = SEQ / RB, NCC = 6;
    for (int it = gw; it < NRB * NCC; it += ngw) {
        const int rb = it / NCC, cc = it - rb * NCC, c = cc * 512 + lane * 8;
        if (c >= DFF) continue;
        const int pn = c >> 7, ucol = pn * 256 + (c & 127);
        float wa[3][8], wg[3][8];
#pragma unroll
        for (int k = 0; k < 3; ++k)
#pragma unroll
            for (int e = 0; e < 8; ++e) { wa[k][e] = wconv[k * NUP + c + e]; wg[k][e] = wconv[k * NUP + DFF + c + e]; }
        const int r0 = rb * RB;
        const bf16* up = UH + ucol;
        const u32x4t zero = {0u, 0u, 0u, 0u};
        u32x4t ra[6], rg[6];
        ra[0] = zero; rg[0] = zero;
        if (r0 > 0) { ra[0] = *(const u32x4t*)(up + (size_t)(r0 - 1) * NUP); rg[0] = *(const u32x4t*)(up + (size_t)(r0 - 1) * NUP + 128); }
        ra[1] = *(const u32x4t*)(up + (size_t)r0 * NUP); rg[1] = *(const u32x4t*)(up + (size_t)r0 * NUP + 128);
#pragma unroll 1
        for (int r = r0; r < r0 + RB; r += 4) {
#pragma unroll
            for (int j = 1; j <= 4; ++j) { const int rr = r + j; if (rr < SEQ) { ra[1 + j] = *(const u32x4t*)(up + (size_t)rr * NUP); rg[1 + j] = *(const u32x4t*)(up + (size_t)rr * NUP + 128); } else { ra[1 + j] = zero; rg[1 + j] = zero; } }
#pragma unroll
            for (int j = 0; j < 4; ++j) {
                float o[8];
#pragma unroll
                for (int e2 = 0; e2 < 4; ++e2) {
                    const float a0 = wa[0][2 * e2] * bf_lo(ra[j][e2]) + wa[1][2 * e2] * bf_lo(ra[j + 1][e2]) + wa[2][2 * e2] * bf_lo(ra[j + 2][e2]);
                    const float a1 = wa[0][2 * e2 + 1] * bf_hi(ra[j][e2]) + wa[1][2 * e2 + 1] * bf_hi(ra[j + 1][e2]) + wa[2][2 * e2 + 1] * bf_hi(ra[j + 2][e2]);
                    const float g0 = wg[0][2 * e2] * bf_lo(rg[j][e2]) + wg[1][2 * e2] * bf_lo(rg[j + 1][e2]) + wg[2][2 * e2] * bf_lo(rg[j + 2][e2]);
                    const float g1 = wg[0][2 * e2 + 1] * bf_hi(rg[j][e2]) + wg[1][2 * e2 + 1] * bf_hi(rg[j + 1][e2]) + wg[2][2 * e2 + 1] * bf_hi(rg[j + 2][e2]);
                    o[2 * e2] = a0 * g0 * __builtin_amdgcn_rcpf(1.f + __expf(-g0)); o[2 * e2 + 1] = a1 * g1 * __builtin_amdgcn_rcpf(1.f + __expf(-g1)); }
                u32x4t w; w.x = pkbf(o[0], o[1]); w.y = pkbf(o[2], o[3]); w.z = pkbf(o[4], o[5]); w.w = pkbf(o[6], o[7]);
                *(u32x4t*)(HACT + (size_t)(r + j) * DFF + c) = w;
            }
            ra[0] = ra[4]; rg[0] = rg[4]; ra[1] = ra[5]; rg[1] = rg[5];
        }
    }
}

__device__ __forceinline__ void v_transpose_fp8(const bf16* V, unsigned char* VT, LAS unsigned char* scr, int gw, int ngw, int lane) {
    constexpr int NKT = T / 64, NCT = 1024 / 64;
    for (int it = gw; it < NKT * NCT; it += ngw) {
        const int ct = it % NCT, kt = it / NCT, b = kt / (SEQ / 64), k0 = (kt % (SEQ / 64)) * 64, c0 = ct * 64;
        const int r8 = lane >> 3, c8 = lane & 7;
#pragma unroll
        for (int i = 0; i < 8; ++i) { const int row = r8 + 8 * i; const u32x4t v = *(const u32x4t*)(V + ((size_t)b * SEQ + k0 + row) * 1024 + c0 + c8 * 8);
            u32x2t w; w.x = (unsigned)__builtin_amdgcn_cvt_pk_fp8_f32(bf_lo(v.y), bf_hi(v.y), __builtin_amdgcn_cvt_pk_fp8_f32(bf_lo(v.x), bf_hi(v.x), 0, false), true);
            w.y = (unsigned)__builtin_amdgcn_cvt_pk_fp8_f32(bf_lo(v.w), bf_hi(v.w), __builtin_amdgcn_cvt_pk_fp8_f32(bf_lo(v.z), bf_hi(v.z), 0, false), true);
            *(LAS u32x2t*)(scr + row * 72 + c8 * 8) = w; }
        asm volatile("s_waitcnt lgkmcnt(0)" ::: "memory");
        unsigned o[16];
#pragma unroll
        for (int wd = 0; wd < 16; ++wd) { unsigned acc = 0;
#pragma unroll
            for (int bb = 0; bb < 4; ++bb) { const int pi = wd * 4 + bb, h = pi >> 5, j = pi & 31, jj = j & 15, key = (j >> 4) * 32 + (jj & 3) + 8 * (jj >> 2) + 4 * h;
                acc |= (unsigned)scr[key * 72 + lane] << (8 * bb); }
            o[wd] = acc; }
        const int hh = (c0 + lane) >> 7, cc = (c0 + lane) & 127;
        unsigned char* dst = VT + (((size_t)b * 8 + hh) * 128 + cc) * SEQ + k0;
#pragma unroll
        for (int q = 0; q < 4; ++q) *(u32x4t*)(dst + 16 * q) = (u32x4t){o[4 * q], o[4 * q + 1], o[4 * q + 2], o[4 * q + 3]};
        asm volatile("s_waitcnt lgkmcnt(0)" ::: "memory");
    }
}

__device__ __forceinline__ void ffn_fixup_rows(const float* halo, const float* wconv  , bf16* HACT  , int gw, int ngw, int lane) {
    constexpr int NP = T / 256, NCC = 6;
    for (int it = gw; it < NP * 2 * NCC; it += ngw) {
        const int cc = it % NCC, pe = it / NCC, e = pe & 1, pm = pe >> 1, c = cc * 512 + lane * 8;
        if (c >= DFF) continue;
        const int row = pm * 256 + (e ? 255 : 0), ucol = (c >> 7) * 256 + (c & 127);
        const float* hp = halo + (size_t)pm * 4 * NUP + ucol;
        const float* up_ = nullptr; const float* cu_; const float* dn_ = nullptr;
        if (e == 0) { cu_ = hp; dn_ = hp + NUP; if (row % SEQ != 0) up_ = hp - 4 * NUP + 3 * NUP; }
        else { up_ = hp + 2 * NUP; cu_ = hp + 3 * NUP; if (row % SEQ != SEQ - 1) dn_ = hp + 4 * NUP; }
        float o[8];
#pragma unroll
        for (int i = 0; i < 8; ++i) {
            float ha = wconv[NUP + c + i] * cu_[i], hg = wconv[NUP + DFF + c + i] * cu_[128 + i];
            if (up_) { ha += wconv[c + i] * up_[i]; hg += wconv[DFF + c + i] * up_[128 + i]; }
            if (dn_) { ha += wconv[2 * NUP + c + i] * dn_[i]; hg += wconv[2 * NUP + DFF + c + i] * dn_[128 + i]; }
            o[i] = ha * hg * __builtin_amdgcn_rcpf(1.f + __expf(-hg)); }
        u32x4t w; w.x = pkbf(o[0], o[1]); w.y = pkbf(o[2], o[3]); w.z = pkbf(o[4], o[5]); w.w = pkbf(o[6], o[7]);
        *(u32x4t*)(HACT + (size_t)row * DFF + c) = w;
    }
}

__device__ __forceinline__ void hy_conv_transpose(const bf16* U  , const float* wshort  , float* VC0, float* VC1, bf16* G1C, bf16* G2C, LAS unsigned* scr, int gw, int ngw, int lane) {
    constexpr int NTT = T / 64, NCT = 3072 / 64;
    const int r8 = lane >> 3, c8 = lane & 7;
    u32x4t buf[9];
#define HCT_LOAD(IT) do { const int ct_ = (IT) % NCT, tt_ = (IT) / NCT, b_ = tt_ / (SEQ / 64), t0_ = (tt_ % (SEQ / 64)) * 64, c0_ = ct_ * 64; \
        _Pragma("unroll") for (int i = 0; i < 9; ++i) { const int row = r8 + 8 * i, tok = t0_ - 1 + row; buf[i] = (u32x4t){0u, 0u, 0u, 0u}; \
            if (row < 66 && tok >= 0 && tok < SEQ) buf[i] = *(const u32x4t*)(U + ((size_t)b_ * SEQ + tok) * 3072 + c0_ + c8 * 8); } } while (0)
    if (gw < NTT * NCT) HCT_LOAD(gw);
    for (int it = gw; it < NTT * NCT; it += ngw) {
        const int ct = it % NCT, tt = it / NCT, b = tt / (SEQ / 64), t0 = (tt % (SEQ / 64)) * 64, c0 = ct * 64;
#pragma unroll
        for (int i = 0; i < 9; ++i) { const int row = r8 + 8 * i; if (row < 66) { LAS unsigned* d = scr + row * 33 + c8 * 4; d[0] = buf[i].x; d[1] = buf[i].y; d[2] = buf[i].z; d[3] = buf[i].w; } }
        if (it + ngw < NTT * NCT) HCT_LOAD(it + ngw);
        asm volatile("s_waitcnt lgkmcnt(0)" ::: "memory");
        const int part = c0 >> 10, chb = c0 & 1023;
        const float wl0 = wshort[c0 + lane], wl1 = wshort[3072 + c0 + lane], wl2 = wshort[6144 + c0 + lane];
#pragma unroll
        for (int cp = 0; cp < 32; ++cp) {
            const unsigned a0 = scr[lane * 33 + cp], a1 = scr[(lane + 1) * 33 + cp], a2 = scr[(lane + 2) * 33 + cp];
            #define RL(x, i) __int_as_float(__builtin_amdgcn_readlane(__float_as_int(x), (i)))
            const float w00 = RL(wl0, 2 * cp), w10 = RL(wl1, 2 * cp), w20 = RL(wl2, 2 * cp), w01 = RL(wl0, 2 * cp + 1), w11 = RL(wl1, 2 * cp + 1), w21 = RL(wl2, 2 * cp + 1);
#undef RL
            const float v0 = w00 * bf_lo(a0) + w10 * bf_lo(a1) + w20 * bf_lo(a2), v1 = w01 * bf_hi(a0) + w11 * bf_hi(a1) + w21 * bf_hi(a2);
            const size_t o = (size_t)(chb + 2 * cp) * SEQ + t0 + lane;
            if (part == 0) { float* d = b ? VC1 : VC0; d[o] = v0; d[o + SEQ] = v1; }
            else { bf16* d = (part == 1 ? G1C : G2C) + (size_t)b * 1024 * SEQ; d[o] = (bf16)(pkbf(v0, 0.f) & 0xffffu); d[o + SEQ] = (bf16)(pkbf(v1, 0.f) & 0xffffu); }
        }
        asm volatile("s_waitcnt lgkmcnt(0)" ::: "memory");
    }
#undef HCT_LOAD
}
__device__ __forceinline__ void hy_transpose_back(const bf16* Z3C, bf16* XB, LAS unsigned* scr, int gw, int ngw, int lane) {
    constexpr int NTT = T / 64, NCT = 1024 / 64;
    for (int it = gw; it < NTT * NCT; it += ngw) {
        const int ct = it % NCT, tt = it / NCT, b = tt / (SEQ / 64), t0 = (tt % (SEQ / 64)) * 64, c0 = ct * 64;
        const bf16* src = Z3C + ((size_t)b * 1024 + c0) * SEQ + t0 + lane;
#pragma unroll 8
        for (int cp = 0; cp < 32; ++cp) { const unsigned lo = src[(size_t)(2 * cp) * SEQ], hi = src[(size_t)(2 * cp + 1) * SEQ]; scr[lane * 33 + cp] = lo | (hi << 16); }
        asm volatile("s_waitcnt lgkmcnt(0)" ::: "memory");
        const int r8 = lane >> 3, c8 = lane & 7;
#pragma unroll
        for (int i = 0; i < 8; ++i) { const int row = r8 + 8 * i; const LAS unsigned* s = scr + row * 33 + c8 * 4; u32x4t v; v.x = s[0]; v.y = s[1]; v.z = s[2]; v.w = s[3];
            *(u32x4t*)(XB + ((size_t)b * SEQ + t0 + row) * DM + c0 + c8 * 8) = v; }
        asm volatile("s_waitcnt lgkmcnt(0)" ::: "memory");
    }
}

#ifdef SELFCHECK
__device__ __forceinline__ float blk_sum(float v, LAS float* red, int tid_) {
    v = wave_sum(v); __syncthreads(); if ((tid_ & 63) == 0) red[tid_ >> 6] = v; __syncthreads();
    float t = 0.f; for (int i = 0; i < NWAVES; ++i) t += red[i]; __syncthreads(); return t;
}
__device__ __forceinline__ void chk_flag(unsigned* flag, float err2, float ref2, unsigned bit, int tid_, float tol = SELFCHECK_TOL) {
    if (tid_ == 0 && !(err2 <= tol * tol * ref2)) atomicOr(flag, bit);
}
__device__ __forceinline__ float fp8_dec(unsigned b) { const unsigned e = (b >> 3) & 15u, m = b & 7u; const float v = e ? ldexpf((float)(8u + m), (int)e - 10) : ldexpf((float)m, -9); return (b & 0x80u) ? -v : v; }
__device__ __forceinline__ float fp8_rnd(float x) { return fp8_dec((unsigned)__builtin_amdgcn_cvt_pk_fp8_f32(x, 0.f, 0, false) & 0xffu); }
__device__ __forceinline__ void selfcheck_mla(const Args& args, LAS unsigned char* ldsl, int bxx, int tid_) {
    unsigned* flag = (unsigned*)(args.ws + WS_CTL) + CW_CHK;
    const bf16* Qb_ = (const bf16*)(args.ws + WS_Q); const unsigned char* Kb_ = (const unsigned char*)(args.ws + WS_K); const bf16* Vb_ = (const bf16*)(args.ws + WS_V); const bf16* O_ = (const bf16*)(args.ws + WS_XB);
    const int* pos = (const int*)args.in[I_POS];
    LAS float* red = (LAS float*)(ldsl + 140000);
    if (bxx < 64) {
        const int t = bxx * (T / 64) + (bxx * 37) % 512;
        LAS float* h = (LAS float*)ldsl; LAS float* cq = h + 704; LAS float* ckv = cq + 384;
        const float* x = args.in[I_X] + (size_t)t * DM; const float* w_in = args.in[I_MLA_WIN];
        for (int j = tid_; j < MLA_IN; j += 512) { float a = 0.f; for (int k = 0; k < DM; ++k) a += x[k] * w_in[(size_t)k * MLA_IN + j]; h[j] = a; }
        __syncthreads();
        float sq = 0.f, sk = 0.f; for (int k = 0; k < QLORA; ++k) sq += h[k] * h[k]; for (int k = 0; k < KVLORA; ++k) sk += h[QLORA + k] * h[QLORA + k];
        const float rq = 1.f / sqrtf(sq / QLORA + RMS_EPS), rk = 1.f / sqrtf(sk / KVLORA + RMS_EPS);
        for (int k = tid_; k < QLORA; k += 512) cq[k] = h[k] * rq * args.in[I_MLA_GQ][k];
        for (int k = tid_; k < KVLORA; k += 512) ckv[k] = h[QLORA + k] * rk * args.in[I_MLA_GKV][k];
        __syncthreads();
        {
            float e2 = 0.f, r2 = 0.f; const float* w = args.in[I_MLA_WUQ];
            for (int n = tid_; n < NH * DQK; n += 512) { const int o = CmWuq()(n); float a = 0.f; for (int k = 0; k < QLORA; ++k) a += cq[k] * w[(size_t)k * (NH * DQK) + o];
                a *= QSCALE; const float g = __uint_as_float((unsigned)Qb_[(size_t)t * 1536 + n] << 16); e2 += (a - g) * (a - g); r2 += a * a; }
            e2 = blk_sum(e2, red, tid_); r2 = blk_sum(r2, red, tid_); chk_flag(flag, e2, r2, 1u, tid_);
        }
        {
            float e2 = 0.f, r2 = 0.f, e3 = 0.f, r3 = 0.f; const float* w = args.in[I_MLA_WUKV];
            for (int n = tid_; n < NH * 256; n += 512) { const int o = CmWukv()(n); float a = 0.f; for (int k = 0; k < KVLORA; ++k) a += ckv[k] * w[(size_t)k * (NH * 256) + o];
                if (n < 1024) { const float g = fp8_dec(Kb_[(size_t)t * 1536 + (n >> 7) * 192 + (n & 127)]); e2 += (a - g) * (a - g); r2 += a * a; }
                else { const float g = __uint_as_float((unsigned)Vb_[(size_t)t * 1024 + n - 1024] << 16); e3 += (a - g) * (a - g); r3 += a * a; } }
            e2 = blk_sum(e2, red, tid_); r2 = blk_sum(r2, red, tid_); chk_flag(flag, e2, r2, 2u, tid_, SELFCHECK_TOL8);
            e3 = blk_sum(e3, red, tid_); r3 = blk_sum(r3, red, tid_); chk_flag(flag, e3, r3, 8u, tid_);
        }
        {
            float e2 = 0.f, r2 = 0.f;
            if (tid_ < 256) { const int hh = tid_ >> 5, i = tid_ & 31; const float inv = powf(10000.0f, -(float)i / 32.0f); float s, c; sincosf((float)pos[t] * inv, &s, &c);
                const float x1 = h[640 + i], x2 = h[672 + i], a1 = x1 * c - x2 * s, a2 = x1 * s + x2 * c;
                const float g1 = fp8_dec(Kb_[(size_t)t * 1536 + hh * 192 + 128 + 2 * i]), g2 = fp8_dec(Kb_[(size_t)t * 1536 + hh * 192 + 129 + 2 * i]);
                e2 = (a1 - g1) * (a1 - g1) + (a2 - g2) * (a2 - g2); r2 = a1 * a1 + a2 * a2; }
            e2 = blk_sum(e2, red, tid_); r2 = blk_sum(r2, red, tid_); chk_flag(flag, e2, r2, 4u, tid_, SELFCHECK_TOL8);
        }
    } else if (bxx < 192) {
        const int sidx = bxx - 64, b = sidx & 1, hh = (sidx >> 1) & 7, row = (sidx * 509 + 13) % SEQ; const size_t t = (size_t)b * SEQ + row;
        LAS float* sc = (LAS float*)ldsl;
        LAS float* q = sc + SEQ;
        if (tid_ < DQK) { float v = __uint_as_float((unsigned)Qb_[t * 1536 + hh * DQK + tid_] << 16);
            if (tid_ >= 128) { const int i = (tid_ - 128) >> 1; const float inv = powf(10000.0f, -(float)i / 32.0f); float s, c; sincosf((float)pos[t] * inv, &s, &c);
                const float o = __uint_as_float((unsigned)Qb_[t * 1536 + hh * DQK + (tid_ ^ 1)] << 16);
                v = (tid_ & 1) ? (o * s + v * c) : (v * c - o * s); }
            q[tid_] = fp8_rnd(v); }
        __syncthreads();
        float mx = -1e30f;
        for (int k = tid_; k < SEQ; k += 512) { const unsigned char* kr = Kb_ + ((size_t)b * SEQ + k) * 1536 + hh * DQK; float a = 0.f; for (int d = 0; d < DQK; ++d) a += q[d] * fp8_dec(kr[d]); sc[k] = a; mx = fmaxf(mx, a); }
        for (int o = 1; o < 64; o <<= 1) mx = fmaxf(mx, __shfl_xor(mx, o));
        __syncthreads(); if ((tid_ & 63) == 0) red[tid_ >> 6] = mx; __syncthreads(); for (int i = 0; i < NWAVES; ++i) mx = fmaxf(mx, red[i]); __syncthreads();
        float ls = 0.f; for (int k = tid_; k < SEQ; k += 512) { const float p = exp2f(sc[k] - mx); sc[k] = p; ls += p; }
        ls = blk_sum(ls, red, tid_);
        const int d = tid_ & 127, part = tid_ >> 7; float a = 0.f;
        for (int k = part * 4096; k < (part + 1) * 4096; ++k) a += sc[k] * fp8_rnd(__uint_as_float((unsigned)Vb_[((size_t)b * SEQ + k) * 1024 + hh * DVH + d] << 16));
        LAS float* op = q + 256; op[tid_] = a; __syncthreads();
        float e2 = 0.f, r2 = 0.f;
        if (tid_ < 128) { const float o = (op[tid_] + op[tid_ + 128] + op[tid_ + 256] + op[tid_ + 384]) / ls; const float g = __uint_as_float((unsigned)O_[t * 1024 + hh * DVH + tid_] << 16); e2 = (o - g) * (o - g); r2 = o * o; }
        e2 = blk_sum(e2, red, tid_); r2 = blk_sum(r2, red, tid_); chk_flag(flag, e2, r2, 16u, tid_, SELFCHECK_TOL8);
    }
}
#endif
#ifndef MK_PER_PHASE
#define MK_PER_PHASE 0
#endif
constexpr int N_PHASES = 30;
constexpr int GEMM_SP2 = true, GEMM_ALIGN = true;

__global__ void __launch_bounds__(NWAVES * 64, 2) mega_fwd(Args args) {
    extern __shared__ __attribute__((aligned(16))) unsigned char lds[];
    LAS unsigned char* ldsl = (LAS unsigned char*)lds;
    volatile LAS unsigned* MISC = (volatile LAS unsigned*)(ldsl + MISC_OFF);
    const int wave = __builtin_amdgcn_readfirstlane((int)threadIdx.x >> 6);
#define lane hw_lane()
#define tid (wave * 64 + hw_lane())
#define G ((int)gridDim.x)
#define bx ((int)blockIdx.x)
#define gw (bx * NWAVES + wave)
#define ngw (G * NWAVES)
    { const int t_ = tid; if (t_ < 128) MISC[t_] = 0u; }
    __syncthreads();
    if (!MK_PER_PHASE) (void)xcd_barrier_post((unsigned*)(args.ws + WS_CTL) + CW_BAR, MISC + 8, (unsigned)wave);
    const int lo = args.ph_lo, hi = args.ph_hi;
#ifdef ONLY_PHASE
#define IN(k) ((k) == ONLY_PHASE && lo <= (k) && (k) < hi)
#else
#define IN(k) (lo <= (k) && (k) < hi)
#endif
#define GRIDBAR() do { XcdBarrier bar_; bar_.bar = (unsigned*)(args.ws + WS_CTL) + CW_BAR; bar_.x = xb_xcc_id(); bar_.st = MISC + 8; bar_.wv = (unsigned)wave; xcd_barrier(bar_); } while (0)
#define SEAM(k) do { if (IN(k) && IN((k) + 1)) GRIDBAR(); } while (0)
#ifndef PROBE_DUP
#define PROBE_DUP (-1)
#define PROBE_REP 1
#endif
#define RUN(k, REAL, DUMMY) do { if (IN(k)) { if (PROBE_DUP == (k)) { for (int rep_ = 0; rep_ < PROBE_REP; ++rep_) { DUMMY; GRIDBAR(); } } REAL; } } while (0)

#define P_(T_, off) ((T_*)(args.ws + (off)))
#define Win_t P_(bf16, WS_WIN)
#define Wuq_t P_(bf16, WS_WUQ)
#define Wukv_t P_(bf16, WS_WUKV)
#define Wo_t P_(bf16, WS_WO)
#define Whin_t P_(bf16, WS_WHIN)
#define Who_t P_(bf16, WS_WHO)
#define Wup_t P_(bf16, WS_WUP)
#define Wdn_t P_(bf16, WS_WDN)
#define Wfo_t P_(bf16, WS_WFO)
#define H3 P_(bf16, WS_H3)
#define XB P_(bf16, WS_XB)
#define XF P_(float, WS_XF)
#define CQN P_(bf16, WS_CQN)
#define CKVN P_(bf16, WS_CKVN)
#define ROPE P_(f32x2, WS_ROPE)
#define Qb P_(bf16, WS_Q)
#define Kb P_(unsigned char, WS_K)
#define Vb P_(bf16, WS_V)
#define VTb P_(unsigned char, WS_VT)
#define UH P_(bf16, WS_UH)
#define U P_(bf16, WS_U)
#define VC0 P_(float, WS_VC0)
#define VC1 P_(float, WS_VC1)
#define KT P_(float, WS_KT)
#define STASH P_(fftc::f2, WS_STASH)
#define KSPEC P_(fftc::f2, WS_KSPEC)
#define FTW (fftc::Tw{P_(const fftc::f2, WS_TW1), P_(const fftc::f2, WS_TW2), P_(const fftc::f2, WS_MOD)})
#define OUT (args.out)
#define H1 (args.out)
#define G1C ((bf16*)args.out)
#define G2C ((bf16*)args.out + (size_t)2 * 1024 * SEQ)
#define Z3C ((bf16*)args.out)
#define GEMM(EPI, A_, B_, M_, N_, K_, ...) do { pg8::Gemm g{(A_), (B_), (M_), (N_), (K_)}; pg8::StaticOrder S; S.init((M_), (N_), G, bx); typedef pg8::EPI Epi_; Epi_ E{__VA_ARGS__}; \
        pg8::gemm_phase<Epi_, pg8::StaticOrder, GEMM_ALIGN, GEMM_SP2>(ldsl, g, S, E, wave); } while (0)
#define YB_A P_(bf16, WS_XF)
#define YB_B P_(bf16, WS_S + 192 * MiB)
#define YB_C P_(bf16, WS_S)

    if (IN(0)) for (int prep_ = 0; prep_ < ((PROBE_DUP == 0) ? 1 + PROBE_REP : 1); ++prep_) {
        if (prep_) GRIDBAR();
        LAS float* scr = (LAS float*)(ldsl + wave * 16384);
        {
            int base = 0;
#define TR(W_, K_, N_, WT_, NP_, LDK_, CM_) do { const int nblk_ = (NP_) / 32, nit_ = ((K_) / 64) * nblk_; \
                for (int it_ = (gw + ngw - base % ngw) % ngw; it_ < nit_; it_ += ngw) transpose_item((W_), (K_), (N_), (WT_), (LDK_), scr, it_, nblk_, lane, CM_); base += nit_; } while (0)
            TR(args.in[I_MLA_WIN], DM, MLA_IN, Win_t, MLA_INP, DM, CmWin());
            TR(args.in[I_MLA_WUQ], QLORA, NH * DQK, Wuq_t, NH * DQK, QLORA, CmWuq());
            TR(args.in[I_MLA_WUKV], KVLORA, NH * 256, Wukv_t, NH * 256, KVLORA, CmWukv());
            TR(args.in[I_MLA_WO], DM, DM, Wo_t, DM, DM, CmIdent());
            TR(args.in[I_HY_WIN], DM, 3 * DM, Whin_t, 3 * DM, DM, CmIdent());
            TR(args.in[I_HY_WO], DM, DM, Who_t, DM, DM, CmIdent());
            TR(args.in[I_FFN_WUP], DM, NUP, Wup_t, NUP, DM, CmWup());
            TR(args.in[I_FFN_WUP] + (size_t)DM * NUP, DM, NUP, Wup_t + (size_t)NUP * DM, NUP, DM, CmWup());
            TR(args.in[I_FFN_WDOWN], DFF, DM, Wdn_t, DM, DFF, CmIdent());
            TR(args.in[I_FFN_WDOWN] + (size_t)DFF * DM, DFF, DM, Wdn_t + (size_t)DM * DFF, DM, DFF, CmIdent());
            TR(args.in[I_HY_FWOUT], HF, 4 * DM, Wfo_t, 4 * DM, HKP, CmIdent());
#undef TR
        }
        for (size_t i = (size_t)gw * 64 + lane; i < (size_t)4096 * 24; i += (size_t)ngw * 64) { const size_t r = i / 24, c = i % 24; *(u32x4t*)(Wfo_t + r * HKP + 64 + c * 8) = (u32x4t){0u, 0u, 0u, 0u}; }
        for (size_t i = (size_t)gw * 64 + lane; i < (size_t)SEQ * 24; i += (size_t)ngw * 64) { const size_t r = i / 24, c = i % 24; *(u32x4t*)(H3 + r * HKP + 64 + c * 8) = (u32x4t){0u, 0u, 0u, 0u}; }
        { const float* x_in = args.in[I_X];
          const size_t n8 = (size_t)T * DM / 8, st = (size_t)ngw * 64;
          for (size_t i = (size_t)gw * 64 + lane; i < n8; i += 4 * st) { f32x4 a[4], b[4];
#pragma unroll
            for (int q = 0; q < 4; ++q) { const size_t ii = i + q * st; if (ii < n8) { a[q] = *(const f32x4*)(x_in + ii * 8); b[q] = *(const f32x4*)(x_in + ii * 8 + 4); } }
#pragma unroll
            for (int q = 0; q < 4; ++q) { const size_t ii = i + q * st; if (ii < n8) { u32x4t w; w.x = pkbf(a[q].x, a[q].y); w.y = pkbf(a[q].z, a[q].w); w.z = pkbf(b[q].x, b[q].y); w.w = pkbf(b[q].z, b[q].w); *(u32x4t*)(XB + ii * 8) = w; } } } }
        { const int* pos = (const int*)args.in[I_POS]; const double inv = exp(-(double)(lane & 31) * (9.210340371976184 / 32.0));
          for (size_t i = (size_t)gw * 64 + lane; i < (size_t)T * 32; i += (size_t)ngw * 64) { const int t = (int)(i >> 5);
              const double ang = (double)pos[t] * inv; double s, c; sincos(ang, &s, &c); ROPE[i] = (f32x2){(float)c, (float)s}; } }
        { const float* fw1 = args.in[I_HY_FW1]; const float* fb1 = args.in[I_HY_FB1]; const float* fw2 = args.in[I_HY_FW2]; const float* fb2 = args.in[I_HY_FB2];
          const float* fw3 = args.in[I_HY_FW3]; const float* fb3 = args.in[I_HY_FB3]; const float fr = args.in[I_HY_FREQ][lane];
          for (int l0 = gw; l0 < SEQ; l0 += 4 * ngw) {
              float z[4], a[4], h[4];
#pragma unroll
              for (int u = 0; u < 4; ++u) { const int l = l0 + u * ngw < SEQ ? l0 + u * ngw : SEQ - 1;
                  const float tt = (float)l / (float)(SEQ - 1); const float w = 6.283185307179586f * (float)l / (float)SEQ;
                  z[u] = 0.f;
                  if (lane == 0) z[u] = tt;
                  else if (lane <= 16) { const float f = 1e-4f + (float)(lane - 1) * ((15.0f - 1e-4f) / 15.0f); z[u] = cosf(f * w); }
                  else if (lane <= 32) { const float f = 1e-4f + (float)(lane - 17) * ((15.0f - 1e-4f) / 15.0f); z[u] = -sinf(f * w); }
                  a[u] = fb1[lane]; }
#pragma unroll
              for (int i = 0; i < HEMB; ++i) { const float wv = fw1[i * HF + lane];
#pragma unroll
                  for (int u = 0; u < 4; ++u) a[u] += __shfl(z[u], i) * wv; }
#pragma unroll
              for (int u = 0; u < 4; ++u) { h[u] = sinf(fr * a[u]); a[u] = fb2[lane]; }
#pragma unroll 8
              for (int i = 0; i < HF; ++i) { const float wv = fw2[i * HF + lane];
#pragma unroll
                  for (int u = 0; u < 4; ++u) a[u] += __shfl(h[u], i) * wv; }
#pragma unroll
              for (int u = 0; u < 4; ++u) { h[u] = sinf(fr * a[u]); a[u] = fb3[lane]; }
#pragma unroll 8
              for (int i = 0; i < HF; ++i) { const float wv = fw3[i * HF + lane];
#pragma unroll
                  for (int u = 0; u < 4; ++u) a[u] += __shfl(h[u], i) * wv; }
#pragma unroll
              for (int u = 0; u < 4; ++u) { const int l = l0 + u * ngw; if (l < SEQ) H3[(size_t)l * HKP + lane] = (bf16)(pkbf(sinf(fr * a[u]), 0.f) & 0xffffu); }
          } }
    }
    SEAM(0);
#define B1 GEMM(EpiF32, XB, Win_t, T, MLA_INP, DM, H1, MLA_INP)
    RUN(1, B1, B1);
    SEAM(1);
#define B2 mla_norm_rope(H1, args.in[I_MLA_GQ], args.in[I_MLA_GKV], ROPE, CQN, CKVN, Kb, gw, ngw, lane)
    RUN(2, B2, B2);
    SEAM(2);
#define B3 do { GEMM(EpiBf16, CQN, Wuq_t, T, NH * DQK, QLORA, Qb, NH * DQK, QSCALE); GEMM(EpiKV, CKVN, Wukv_t, T, NH * 256, KVLORA, Kb, Vb); GRIDBAR(); v_transpose_fp8(Vb, VTb, (LAS unsigned char*)(ldsl + wave * 8192), gw, ngw, lane); } while (0)
    RUN(3, B3, B3);
    SEAM(3);
#ifndef ATT_EXP
#define ATT_EXP 0
#endif
#define B4X(EXPV) do { for (int u = bx; u < BATCH * NH * (SEQ / 256); u += G) { const int qb = u & 63, h = (u >> 6) & 7, b = u >> 9; const size_t r0 = (size_t)b * SEQ + (size_t)qb * 256; \
            attn::attn_unit<EXPV>(Qb + r0 * 1536 + h * DQK, Kb + (size_t)b * SEQ * 1536 + h * DQK, VTb + ((size_t)b * 8 + h) * 128 * SEQ, XB + r0 * 1024 + h * DVH, (const float*)(ROPE + r0 * 32), SEQ, (char*)lds, wave); } } while (0)
    RUN(4, B4X(0), B4X(ATT_EXP));
#ifdef SELFCHECK
    if (IN(4) && IN(5)) { GRIDBAR(); selfcheck_mla(args, ldsl, bx, tid); }
#endif
    SEAM(4);
#define B5 GEMM(EpiRes<false>, XB, Wo_t, T, DM, DM, args.in[I_X], YB_A, DN_ALPHA)
    RUN(5, B5, B5);
    SEAM(5);
#define B6 ln_rows(YB_A, nullptr, XB, args.in[I_LN1G], args.in[I_LN1B], gw, ngw, lane)
    RUN(6, B6, B6);
    SEAM(6);
#define HACT P_(bf16, WS_S)
#define HALO P_(float, WS_S + 180 * MiB)
#define FFN_UP(layer) GEMM(EpiConvSilu, XB, Wup_t + (size_t)(layer) * NUP * DM, T, NUP, DM, HACT, args.in[I_FFN_WCONV] + (size_t)(layer) * 3 * NUP, HALO, (PG8_LAS float*)(ldsl + RING_BYTES))
#define FFN_FIX(layer) ffn_fixup_rows(HALO, args.in[I_FFN_WCONV] + (size_t)(layer) * 3 * NUP, HACT, gw, ngw, lane)
#define FFN_DN(layer, OUT_) GEMM(EpiRes<true>, HACT, Wdn_t + (size_t)(layer) * DM * DFF, T, DM, DFF, XB, (OUT_), DN_ALPHA)
#define FFN_LAYER(p, layer) \
    RUN(p, FFN_UP(layer), FFN_UP(layer)); SEAM(p); \
    RUN((p) + 1, FFN_FIX(layer), FFN_FIX(layer)); SEAM((p) + 1); \
    RUN((p) + 2, FFN_DN(layer, (layer) ? YB_A : YB_B), FFN_DN(layer, (layer) ? YB_A : YB_B)); if (IN((p) + 2) && IN((p) + 6)) GRIDBAR();
    FFN_LAYER(7, 0)
#define B13 ln_rows(YB_B, XF, XB, args.in[I_LN2G], args.in[I_LN2B], gw, ngw, lane)
    RUN(13, B13, B13);
    SEAM(13);
#define B14 GEMM(EpiBf16, XB, Whin_t, T, 3 * DM, DM, U, 3 * DM, 1.0f)
    RUN(14, B14, B14);
    SEAM(14);
#define B15 hy_conv_transpose(U, args.in[I_HY_WSHORT], VC0, VC1, G1C, G2C, (LAS unsigned*)(ldsl + wave * 16384), gw, ngw, lane)
    RUN(15, B15, B15);
    SEAM(15);
#define HY_FILT(od) GEMM(EpiFilt, H3, Wfo_t + (size_t)(od) * 2048 * HKP, SEQ, 2 * DM, HKP, KT, SEQ, -120.39728043259360f, (40.54651081081644f + 120.39728043259360f) / 1023.0f, 1.0f / (float)(SEQ - 1))
#ifndef FFT_EV
#define FFT_EV 0
#endif
#define HY_FFT(MODE_, GC_, DB_) do { for (int c = bx; c < DM; c += G) { const size_t co = (size_t)c * SEQ; \
            fftc::hyena_channel<MODE_, ((MODE_) == 2 ? FFT_EV : 0)>((fftc::lf2*)ldsl, VC0 + co, VC1 + co, KT + co, KT + (size_t)DM * SEQ + co, (GC_) + co, (GC_) + (size_t)DM * SEQ + co, args.in[I_HY_DBIAS][(DB_) + c], \
                                       VC0 + co, VC1 + co, Z3C + co, Z3C + (size_t)DM * SEQ + co, STASH + (size_t)bx * SEQ, KSPEC + (size_t)bx * SEQ, tid); } } while (0)
    RUN(16, HY_FILT(0), HY_FILT(0)); SEAM(16);
    RUN(17, HY_FFT(0, G1C, 0), HY_FFT(2, G1C, 0)); SEAM(17);
    RUN(18, HY_FILT(1), HY_FILT(1)); SEAM(18);
    RUN(19, HY_FFT(1, G2C, DM), HY_FFT(1, G2C, DM)); SEAM(19);
#define B20 hy_transpose_back(Z3C, XB, (LAS unsigned*)(ldsl + wave * 16384), gw, ngw, lane)
    RUN(20, B20, B20);
    SEAM(20);
#define B21 GEMM(EpiRes<false>, XB, Who_t, T, DM, DM, XF, YB_C, DN_ALPHA)
    RUN(21, B21, B21);
    SEAM(21);
#define B22 ln_rows(YB_C, nullptr, XB, args.in[I_LN1G] + DM, args.in[I_LN1B] + DM, gw, ngw, lane)
    RUN(22, B22, B22);
    SEAM(22);
    FFN_LAYER(23, 1)
#ifdef SELFCHECK
    if (IN(29)) { const unsigned mask = __hip_atomic_load((unsigned*)(args.ws + WS_CTL) + CW_CHK, __ATOMIC_RELAXED, __HIP_MEMORY_SCOPE_AGENT);
        ln_rows(YB_A, OUT, nullptr, args.in[I_LN2G] + DM, args.in[I_LN2B] + DM, gw, ngw, lane, 1.0f + 0.1f * (float)mask); }
#else
    RUN(29, ln_rows(YB_A, OUT, nullptr, args.in[I_LN2G] + DM, args.in[I_LN2B] + DM, gw, ngw, lane), ln_rows(YB_A, OUT, nullptr, args.in[I_LN2G] + DM, args.in[I_LN2B] + DM, gw, ngw, lane));
#endif
#undef IN
#undef SEAM
#undef lane
#undef tid
#undef G
#undef bx
#undef gw
#undef ngw
}

extern "C" void kernel_launch(void* const* d_in, const int* in_sizes, int n_in, void* d_out, int out_size, void* d_ws, size_t ws_size, hipStream_t stream) {
    static int grid = 0;
    if (grid == 0) {
        if (n_in != 27 || in_sizes[0] != T * DM || out_size != T * DM || ws_size < WS_END) { fprintf(stderr, "kernel_launch: shape/workspace mismatch (n_in %d, in0 %d, out %d, ws %zu)\n", n_in, n_in > 0 ? in_sizes[0] : -1, out_size, ws_size); grid = -1; return; }
        int dev = 0, cus = 0, per_cu = 0;
        if (hipGetDevice(&dev) != hipSuccess || hipDeviceGetAttribute(&cus, hipDeviceAttributeMultiprocessorCount, dev) != hipSuccess) { grid = -1; return; }
        if (hipFuncSetAttribute((const void*)mega_fwd, hipFuncAttributeMaxDynamicSharedMemorySize, LDS_BYTES) != hipSuccess) { fprintf(stderr, "kernel_launch: hipFuncSetAttribute failed\n"); grid = -1; return; }
        if (hipOccupancyMaxActiveBlocksPerMultiprocessor(&per_cu, (const void*)mega_fwd, NWAVES * 64, LDS_BYTES) != hipSuccess || per_cu < 1) { fprintf(stderr, "kernel_launch: occupancy query says %d\n", per_cu); }
        (void)hipGetLastError();
        grid = cus;
    }
    if (grid < 0) return;
    if (hipMemsetAsync((char*)d_ws + WS_CTL, 0, CTL_ZERO_BYTES, stream) != hipSuccess) return;
    Args a{};
    for (int i = 0; i < 27; ++i) a.in[i] = (const float*)d_in[i];
    a.out = (float*)d_out; a.ws = (unsigned char*)d_ws;
#if MK_PER_PHASE
    for (int p = 0; p < N_PHASES; ++p) { a.ph_lo = p; a.ph_hi = p + 1; hipLaunchKernelGGL(mega_fwd, dim3(grid), dim3(NWAVES * 64), LDS_BYTES, stream, a); }
#else
    a.ph_lo = 0; a.ph_hi = N_PHASES; hipLaunchKernelGGL(mega_fwd, dim3(grid), dim3(NWAVES * 64), LDS_BYTES, stream, a);
#endif
}
```

```cpp
#include <hip/hip_runtime.h>
#include <cstdio>
#include <cstdint>
__device__ __forceinline__ int hw_lane() { int l; asm volatile("v_mbcnt_lo_u32_b32 %0, -1, 0\n\tv_mbcnt_hi_u32_b32 %0, -1, %0" : "=v"(l)); return l; }
namespace pg8 {
#define PG8_LAS __attribute__((address_space(3)))
typedef unsigned short bf16_t;
typedef short bf16x8 __attribute__((ext_vector_type(8)));
typedef float f32x4 __attribute__((ext_vector_type(4)));
typedef unsigned u32x4 __attribute__((ext_vector_type(4)));
constexpr int BM = 256, BK = 64, HALF = 128, HTB = HALF * BK * 2  , STAGE_BYTES = 8 * HTB, NXCD = 8, WGM = 8;

__host__ __device__ __forceinline__ int lds_byte(int r, int c) { const int st = (r >> 4) * 2 + (c >> 5), rr = r & 15, cc = c & 31, ob = rr * 64 + cc * 2; return st * 1024 + (ob ^ (((ob >> 9) & 1) << 5)); }
__host__ __device__ __forceinline__ void stage_rc(int b, int& R, int& C) { const int st = b / 1024, sb = b % 1024, swz = sb ^ (((sb >> 9) & 1) << 5); R = (st >> 1) * 16 + swz / 64; C = (st & 1) * 32 + (swz % 64) / 2; }
__host__ __device__ __forceinline__ int perm32(int rho) { const int n = rho >> 4, i = rho & 15; return 8 * (i >> 2) + 4 * n + (i & 3); }

struct Unit { int pm, pn; };
struct Gemm { const bf16_t* A; const bf16_t* Bt; int M, N, K; };

struct StaticOrder {
    int nM, nN, nwg, G, c;
    __host__ __device__ void init(int M, int N, int G_, int c_) { nM = M / BM; nN = N / BM; nwg = nM * nN; G = G_; c = c_; }
    __host__ __device__ bool next(int i, Unit& u) const {
        const long L = (long)i * G + c; if (L >= nwg) return false;
        int wgid = (int)L; { const int q = nwg / NXCD, r = nwg % NXCD, xcd = wgid % NXCD, off = wgid / NXCD; wgid = (xcd < r ? xcd * (q + 1) : r * (q + 1) + (xcd - r) * q) + off; }
        const int nig = WGM * nN, gid = wgid / nig, fm = gid * WGM, gsz = (nM - fm) < WGM ? (nM - fm) : WGM;
        u.pm = fm + ((wgid % nig) % gsz); u.pn = (wgid % nig) / gsz; return true;
    }
    __device__ __forceinline__ void a_ready(const Unit&) const {}
    __device__ __forceinline__ void done(const Unit&) const {}
};

__device__ __forceinline__ unsigned cvt_pk_bf16(float lo, float hi) { unsigned r; asm volatile("v_cvt_pk_bf16_f32 %0, %1, %2" : "=v"(r) : "v"(lo), "v"(hi)); return r; }
typedef float f32x2 __attribute__((ext_vector_type(2)));

struct EpiF32 {
    static constexpr bool PERM = false, AFTER_DRAIN = false;
    float* C; int ldc;
    __device__ __forceinline__ void operator()(const f32x4 (&acc)[2][2][4][2], const Unit& u_, int wr, int wc, int fr, int fq) const {
        Unit u = u_; asm volatile("" : "+s"(u.pm), "+s"(u.pn)); { const int l_ = hw_lane(); fr = l_ & 15; fq = l_ >> 4; }
        const int row0 = u.pm * BM + wr * 64 + fr, col0 = u.pn * BM + wc * 32 + 4 * fq;
#pragma unroll
        for (int ai = 0; ai < 2; ++ai)
#pragma unroll
            for (int m = 0; m < 4; ++m) { float* rowp = C + (size_t)(row0 + ai * HALF + m * 16) * ldc + col0;
#pragma unroll
                for (int bj = 0; bj < 2; ++bj)
#pragma unroll
                    for (int n = 0; n < 2; ++n) *(f32x4*)(rowp + bj * HALF + n * 16) = acc[ai][bj][m][n]; }
    }
};
struct EpiBf16 {
    static constexpr bool PERM = true, AFTER_DRAIN = false;
    bf16_t* O; int ldc; float scale;
    __device__ __forceinline__ void operator()(const f32x4 (&acc)[2][2][4][2], const Unit& u_, int wr, int wc, int fr, int fq) const {
        Unit u = u_; asm volatile("" : "+s"(u.pm), "+s"(u.pn)); { const int l_ = hw_lane(); fr = l_ & 15; fq = l_ >> 4; }
        const int row0 = u.pm * BM + wr * 64 + fr, col0 = u.pn * BM + wc * 32 + 8 * fq;
#pragma unroll
        for (int ai = 0; ai < 2; ++ai)
#pragma unroll
            for (int m = 0; m < 4; ++m) { bf16_t* rowp = O + (size_t)(row0 + ai * HALF + m * 16) * ldc + col0;
#pragma unroll
                for (int bj = 0; bj < 2; ++bj) { const f32x4 v0 = acc[ai][bj][m][0] * scale, v1 = acc[ai][bj][m][1] * scale;
                    u32x4 w; w.x = cvt_pk_bf16(v0[0], v0[1]); w.y = cvt_pk_bf16(v0[2], v0[3]); w.z = cvt_pk_bf16(v1[0], v1[1]); w.w = cvt_pk_bf16(v1[2], v1[3]);
                    *(u32x4*)(rowp + bj * HALF) = w; } }
    }
};
template <bool BASE_BF16> struct EpiRes {
    static constexpr bool PERM = true, AFTER_DRAIN = false;
    const void* base; bf16_t* out; float alpha;
    __device__ __forceinline__ void operator()(const f32x4 (&acc)[2][2][4][2], const Unit& u_, int wr, int wc, int fr, int fq) const {
        Unit u = u_; asm volatile("" : "+s"(u.pm), "+s"(u.pn)); { const int l_ = hw_lane(); fr = l_ & 15; fq = l_ >> 4; }
        const int row0 = u.pm * BM + wr * 64 + fr, col0 = u.pn * BM + wc * 32 + 8 * fq;
#pragma unroll
        for (int ai = 0; ai < 2; ++ai)
#pragma unroll
            for (int m = 0; m < 4; ++m) { const size_t off = (size_t)(row0 + ai * HALF + m * 16) * 1024 + col0;
#pragma unroll
                for (int bj = 0; bj < 2; ++bj) { f32x4 b0, b1;
                    if (BASE_BF16) { const u32x4 b = *(const u32x4*)((const bf16_t*)base + off + bj * HALF);
                        b0 = (f32x4){__uint_as_float(b.x << 16), __uint_as_float(b.x & 0xffff0000u), __uint_as_float(b.y << 16), __uint_as_float(b.y & 0xffff0000u)};
                        b1 = (f32x4){__uint_as_float(b.z << 16), __uint_as_float(b.z & 0xffff0000u), __uint_as_float(b.w << 16), __uint_as_float(b.w & 0xffff0000u)}; }
                    else { b0 = *(const f32x4*)((const float*)base + off + bj * HALF); b1 = *(const f32x4*)((const float*)base + off + bj * HALF + 4); }
                    const f32x4 v0 = b0 * alpha + acc[ai][bj][m][0], v1 = b1 * alpha + acc[ai][bj][m][1];
                    u32x4 w; w.x = cvt_pk_bf16(v0[0], v0[1]); w.y = cvt_pk_bf16(v0[2], v0[3]); w.z = cvt_pk_bf16(v1[0], v1[1]); w.w = cvt_pk_bf16(v1[2], v1[3]);
                    *(u32x4*)(out + off + bj * HALF) = w; }
                if (m & 1) asm volatile("" ::: "memory"); }
    }
};
struct EpiKV {
    static constexpr bool PERM = true, AFTER_DRAIN = false;
    unsigned char* Kb; bf16_t* Vb;
    __device__ __forceinline__ void operator()(const f32x4 (&acc)[2][2][4][2], const Unit& u_, int wr, int wc, int fr, int fq) const {
        Unit u = u_; asm volatile("" : "+s"(u.pm), "+s"(u.pn)); { const int l_ = hw_lane(); fr = l_ & 15; fq = l_ >> 4; }
        const int row0 = u.pm * BM + wr * 64 + fr, col0 = u.pn * BM + wc * 32 + 8 * fq;
        typedef unsigned u32x2 __attribute__((ext_vector_type(2)));
#pragma unroll
        for (int bj = 0; bj < 2; ++bj) { const int c = col0 + bj * HALF; const bool isk = c < 1024;
#pragma unroll
            for (int ai = 0; ai < 2; ++ai)
#pragma unroll
                for (int m = 0; m < 4; ++m) { const int row = row0 + ai * HALF + m * 16; const f32x4 v0 = acc[ai][bj][m][0], v1 = acc[ai][bj][m][1];
                    if (isk) { u32x2 w; int t = __builtin_amdgcn_cvt_pk_fp8_f32(v0[0], v0[1], 0, false); t = __builtin_amdgcn_cvt_pk_fp8_f32(v0[2], v0[3], t, true); w.x = (unsigned)t;
                        t = __builtin_amdgcn_cvt_pk_fp8_f32(v1[0], v1[1], 0, false); t = __builtin_amdgcn_cvt_pk_fp8_f32(v1[2], v1[3], t, true); w.y = (unsigned)t;
                        *(u32x2*)(Kb + (size_t)row * 1536 + (c >> 7) * 192 + (c & 127)) = w; }
                    else { u32x4 w; w.x = cvt_pk_bf16(v0[0], v0[1]); w.y = cvt_pk_bf16(v0[2], v0[3]); w.z = cvt_pk_bf16(v1[0], v1[1]); w.w = cvt_pk_bf16(v1[2], v1[3]);
                        *(u32x4*)(Vb + (size_t)row * 1024 + (c - 1024)) = w; } } }
    }
};
#define DPP_SHR1 0x111
#define DPP_SHL1 0x101
#define DPP_SHL15 0x10F
#define DPP_SHR15 0x11F
template <int CTRL> __device__ __forceinline__ float dpp_mov(float old, float src) { return __int_as_float(__builtin_amdgcn_update_dpp(__float_as_int(old), __float_as_int(src), CTRL, 0xF, 0xF, false)); }
struct EpiConvSilu {
    static constexpr bool PERM = true, AFTER_DRAIN = false;
    bf16_t* H; const float* wcv; float* halo; PG8_LAS float* ex;
    __device__ __forceinline__ void operator()(const f32x4 (&acc)[2][2][4][2], const Unit& u_, int wr, int wc, int fr, int fq) const {
        Unit u = u_; asm volatile("" : "+s"(u.pm), "+s"(u.pn)); { const int l_ = hw_lane(); fr = l_ & 15; fq = l_ >> 4; }
        const int hc0 = wc * 32 + 8 * fq;
#pragma unroll
        for (int ai = 0; ai < 2; ++ai)
#pragma unroll
            for (int bj = 0; bj < 2; ++bj)
#pragma unroll
                for (int n = 0; n < 2; ++n) {
                    if (fr == 0)  *(PG8_LAS f32x4*)(ex + ((ai * 2 + wr) * 2 + 0) * 256 + bj * 128 + hc0 + 4 * n) = acc[ai][bj][0][n];
                    if (fr == 15) *(PG8_LAS f32x4*)(ex + ((ai * 2 + wr) * 2 + 1) * 256 + bj * 128 + hc0 + 4 * n) = acc[ai][bj][3][n]; }
        if (wr == 0 && fr < 2) {
#pragma unroll
            for (int bj = 0; bj < 2; ++bj)
#pragma unroll
                for (int n = 0; n < 2; ++n) *(f32x4*)(halo + ((size_t)u.pm * 4 + fr) * 5632 + u.pn * 256 + bj * 128 + hc0 + 4 * n) = acc[0][bj][0][n]; }
        if (wr == 1 && fr >= 14) {
#pragma unroll
            for (int bj = 0; bj < 2; ++bj)
#pragma unroll
                for (int n = 0; n < 2; ++n) *(f32x4*)(halo + ((size_t)u.pm * 4 + 2 + (fr - 14)) * 5632 + u.pn * 256 + bj * 128 + hc0 + 4 * n) = acc[1][bj][3][n]; }
        asm volatile("s_waitcnt lgkmcnt(0)" ::: "memory"); __builtin_amdgcn_s_barrier(); asm volatile("" ::: "memory");
        float wv[2][3][8];
        { const int cg = u.pn * 128 + hc0;
#pragma unroll
          for (int bj = 0; bj < 2; ++bj)
#pragma unroll
            for (int k = 0; k < 3; ++k) { const f32x4 t0 = *(const f32x4*)(wcv + k * 5632 + bj * 2816 + cg), t1 = *(const f32x4*)(wcv + k * 5632 + bj * 2816 + cg + 4);
                wv[bj][k][0] = t0[0]; wv[bj][k][1] = t0[1]; wv[bj][k][2] = t0[2]; wv[bj][k][3] = t0[3]; wv[bj][k][4] = t1[0]; wv[bj][k][5] = t1[1]; wv[bj][k][6] = t1[2]; wv[bj][k][7] = t1[3]; } }
#pragma unroll
        for (int ai = 0; ai < 2; ++ai) {
            const int ch = ai * 2 + wr, cp = ch > 0 ? ch - 1 : 0, cn = ch < 3 ? ch + 1 : 3;
            f32x4 pe[2][2], ne[2][2];
#pragma unroll
            for (int bj = 0; bj < 2; ++bj)
#pragma unroll
                for (int n = 0; n < 2; ++n) { pe[bj][n] = *(const PG8_LAS f32x4*)(ex + (cp * 2 + 1) * 256 + bj * 128 + hc0 + 4 * n); ne[bj][n] = *(const PG8_LAS f32x4*)(ex + (cn * 2 + 0) * 256 + bj * 128 + hc0 + 4 * n); }
#pragma unroll
            for (int m = 0; m < 4; ++m) {
                float hv[2][8];
#pragma unroll
                for (int bj = 0; bj < 2; ++bj)
#pragma unroll
                    for (int n = 0; n < 2; ++n)
#pragma unroll
                        for (int j = 0; j < 4; ++j) {
                            const float cur = acc[ai][bj][m][n][j];
                            const float pin = (m > 0) ? dpp_mov<DPP_SHL15>(0.f, acc[ai][bj][m > 0 ? m - 1 : 0][n][j]) : pe[bj][n][j];
                            const float nin = (m < 3) ? dpp_mov<DPP_SHR15>(0.f, acc[ai][bj][m < 3 ? m + 1 : 3][n][j]) : ne[bj][n][j];
                            const float prv = dpp_mov<DPP_SHR1>(pin, cur), nxt = dpp_mov<DPP_SHL1>(nin, cur);
                            hv[bj][4 * n + j] = wv[bj][0][4 * n + j] * prv + wv[bj][1][4 * n + j] * cur + wv[bj][2][4 * n + j] * nxt; }
                float o[8];
#pragma unroll
                for (int i = 0; i < 8; ++i) o[i] = hv[0][i] * hv[1][i] * __builtin_amdgcn_rcpf(1.f + __expf(-hv[1][i]));
                u32x4 w; w.x = cvt_pk_bf16(o[0], o[1]); w.y = cvt_pk_bf16(o[2], o[3]); w.z = cvt_pk_bf16(o[4], o[5]); w.w = cvt_pk_bf16(o[6], o[7]);
                *(u32x4*)(H + (size_t)(u.pm * BM + ai * HALF + wr * 64 + m * 16 + fr) * 2816 + u.pn * 128 + hc0) = w;
            }
        }
        asm volatile("s_waitcnt lgkmcnt(0)" ::: "memory"); __builtin_amdgcn_s_barrier(); asm volatile("" ::: "memory");
    }
};

struct EpiFilt {
    static constexpr bool PERM = false, AFTER_DRAIN = false;
    float* KT; int L; float d0, dstep, tinv;
    __device__ __forceinline__ void operator()(const f32x4 (&acc)[2][2][4][2], const Unit& u_, int wr, int wc, int fr, int fq) const {
        Unit u = u_; asm volatile("" : "+s"(u.pm), "+s"(u.pn)); { const int l_ = hw_lane(); fr = l_ & 15; fq = l_ >> 4; }
        const int row0 = u.pm * BM + wr * 64 + fr, col0 = u.pn * BM + wc * 32 + 4 * fq;
#pragma unroll
        for (int bj = 0; bj < 2; ++bj)
#pragma unroll
            for (int n = 0; n < 2; ++n) { const int c = col0 + bj * HALF + n * 16;
#pragma unroll
                for (int j = 0; j < 4; ++j) { const int cc = c + j, ch = cc & 1023; const float nd = -__builtin_fabsf(d0 + (float)ch * dstep) * tinv; float* dst = KT + (size_t)cc * L;
#pragma unroll
                    for (int ai = 0; ai < 2; ++ai)
#pragma unroll
                        for (int m = 0; m < 4; ++m) { const int l = row0 + ai * HALF + m * 16; dst[l] = acc[ai][bj][m][n][j] * __expf(nd * (float)l); } } }
    }
};

template <class Epi, class Sched, bool ALIGN_EPI = false, bool SP2 = false>
__device__ __forceinline__ void gemm_phase(PG8_LAS unsigned char* lds, const Gemm g, const Sched& S, const Epi& E, int wid_in) {
    const int wid = wid_in, lane = hw_lane(), tid = wid * 64 + lane, wr = wid >> 2, wc = wid & 3, fr = lane & 15, fq = lane >> 4;
    const int K = g.K, nt = K / BK;
    unsigned voffA[2], voffB[2];
#pragma unroll
    for (int i = 0; i < 2; ++i) { int R, C; stage_rc(tid * 16 + i * 8192, R, C); const int Rb = Epi::PERM ? ((R & ~31) + perm32(R & 31)) : R;
        voffA[i] = (unsigned)(R * K + C) * 2u; voffB[i] = (unsigned)(Rb * K + C) * 2u; }
    const size_t kstep = (size_t)(BK * 2);
    const size_t hstep = (size_t)HALF * K * 2;
    const size_t tstep = 2 * hstep;
    const unsigned ldsw = (unsigned)wid * 1024u;
    const int aoff = lds_byte(wr * 64 + fr, fq * 8), boff = lds_byte(wc * 32 + fr, fq * 8);
#define PG8_SA(b, h) (((b) * 2 + (h)) * HTB)
#define PG8_SB(b, h) ((4 + (b) * 2 + (h)) * HTB)
#define PG8_STAGE(bufoff, gbase, voff) do { _Pragma("unroll") for (int _i = 0; _i < 2; ++_i) \
        __builtin_amdgcn_global_load_lds((const unsigned*)((const char*)(gbase) + (voff)[_i]), (PG8_LAS unsigned*)(lds + (bufoff) + ldsw + _i * 8192), 16, 0, 0); } while (0)
#define PG8_LDA(dst, b, h) do { _Pragma("unroll") for (int m = 0; m < 4; ++m) _Pragma("unroll") for (int k = 0; k < 2; ++k) dst[m][k] = *(const PG8_LAS bf16x8*)(lds + PG8_SA(b, h) + aoff + m * 2048 + k * 1024); } while (0)
#define PG8_LDB(dst, b, h) do { _Pragma("unroll") for (int n = 0; n < 2; ++n) _Pragma("unroll") for (int k = 0; k < 2; ++k) dst[n][k] = *(const PG8_LAS bf16x8*)(lds + PG8_SB(b, h) + boff + n * 2048 + k * 1024); } while (0)
#define PG8_MMA(ai, bj, At, Bt) do { __builtin_amdgcn_s_setprio(1); _Pragma("unroll") for (int m = 0; m < 4; ++m) _Pragma("unroll") for (int n = 0; n < 2; ++n) _Pragma("unroll") for (int k = 0; k < 2; ++k) \
        acc[ai][bj][m][n] = __builtin_amdgcn_mfma_f32_16x16x32_bf16(Bt[n][k], At[m][k], acc[ai][bj][m][n], 0, 0, 0); __builtin_amdgcn_s_setprio(0); } while (0)
#define PG8_WAIT_V(n) asm volatile("s_waitcnt vmcnt(" #n ")" ::: "memory")
#define PG8_WAIT_L(n) asm volatile("s_waitcnt lgkmcnt(" #n ")" ::: "memory")
#define PG8_BAR __builtin_amdgcn_s_barrier()
#define PG8_SCHED __builtin_amdgcn_sched_barrier(0)
    Unit cur, nxt; int ui = 0;
    if (!S.next(0, cur)) return;
    f32x4 acc[2][2][4][2];
#pragma unroll
    for (int a = 0; a < 2; ++a)
#pragma unroll
        for (int b = 0; b < 2; ++b)
#pragma unroll
            for (int m = 0; m < 4; ++m)
#pragma unroll
                for (int n = 0; n < 2; ++n) acc[a][b][m][n] = (f32x4){0.f, 0.f, 0.f, 0.f};
    bf16x8 At[4][2], B0[2][2], B1[2][2];
    const char* cA = (const char*)g.A + (size_t)cur.pm * tstep; const char* cB = (const char*)g.Bt + (size_t)cur.pn * tstep;
    S.a_ready(cur);
    if constexpr (SP2) {
        PG8_STAGE(PG8_SB(0, 0), cB, voffB); PG8_STAGE(PG8_SB(0, 1), cB + hstep, voffB); PG8_STAGE(PG8_SA(0, 0), cA, voffA); PG8_STAGE(PG8_SA(0, 1), cA + hstep, voffA);
        if (wr == 1) PG8_BAR;
        PG8_WAIT_V(2); PG8_BAR;
        PG8_STAGE(PG8_SB(1, 0), cB + kstep, voffB); PG8_STAGE(PG8_SA(1, 0), cA + kstep, voffA); PG8_STAGE(PG8_SB(1, 1), cB + hstep + kstep, voffB);
        PG8_WAIT_V(6); PG8_BAR;
    } else {
        PG8_STAGE(PG8_SB(0, 0), cB, voffB); PG8_STAGE(PG8_SA(0, 0), cA, voffA); PG8_STAGE(PG8_SB(0, 1), cB + hstep, voffB); PG8_STAGE(PG8_SA(0, 1), cA + hstep, voffA);
        if (wr == 1) PG8_BAR;
        PG8_WAIT_V(4); PG8_BAR;
        PG8_STAGE(PG8_SB(1, 0), cB + kstep, voffB); PG8_STAGE(PG8_SA(1, 0), cA + kstep, voffA); PG8_STAGE(PG8_SB(1, 1), cB + hstep + kstep, voffB);
        PG8_WAIT_V(6); PG8_BAR;
    }
    for (;;) {
        const bool has_next = S.next(ui + 1, nxt);
        const char* nA = has_next ? (const char*)g.A + (size_t)nxt.pm * tstep : cA; const char* nB = has_next ? (const char*)g.Bt + (size_t)nxt.pn * tstep : cB;
        for (int t = 0; t < nt; t += 2) {
            const bool last = (t == nt - 2);
            const char* a1 = cA + (size_t)(t + 1) * kstep;
            const char* a2 = last ? nA : cA + (size_t)(t + 2) * kstep; const char* b2 = last ? nB : cB + (size_t)(t + 2) * kstep;
            const char* a3 = a2 + kstep; const char* b3 = b2 + kstep;
            if (last && has_next) S.a_ready(nxt);
            if constexpr (SP2) {
            PG8_LDB(B0, 0, 0); PG8_LDB(B1, 0, 1); PG8_SCHED; PG8_LDA(At, 0, 0); PG8_STAGE(PG8_SA(1, 1), a1 + hstep, voffA);
            PG8_WAIT_V(8); PG8_WAIT_L(0); PG8_BAR; PG8_MMA(0, 0, At, B0); PG8_MMA(0, 1, At, B1); PG8_BAR; PG8_SCHED;
            PG8_LDA(At, 0, 1); PG8_STAGE(PG8_SB(0, 0), b2, voffB); PG8_STAGE(PG8_SB(0, 1), b2 + hstep, voffB); PG8_STAGE(PG8_SA(0, 0), a2, voffA);
            PG8_WAIT_V(8); PG8_WAIT_L(0); PG8_BAR; PG8_MMA(1, 0, At, B0); PG8_MMA(1, 1, At, B1); PG8_BAR; PG8_SCHED;
            PG8_LDB(B0, 1, 0); PG8_LDB(B1, 1, 1); PG8_SCHED; PG8_LDA(At, 1, 0); PG8_STAGE(PG8_SA(0, 1), a2 + hstep, voffA);
            PG8_WAIT_V(8); PG8_WAIT_L(0); PG8_BAR; PG8_MMA(0, 0, At, B0); PG8_MMA(0, 1, At, B1); PG8_BAR; PG8_SCHED;
            PG8_LDA(At, 1, 1); PG8_STAGE(PG8_SB(1, 0), b3, voffB); PG8_STAGE(PG8_SB(1, 1), b3 + hstep, voffB); PG8_STAGE(PG8_SA(1, 0), a3, voffA);
            PG8_WAIT_V(8); PG8_WAIT_L(0); PG8_BAR; PG8_MMA(1, 0, At, B0); PG8_MMA(1, 1, At, B1); PG8_BAR; PG8_SCHED;
            } else {
            PG8_LDB(B0, 0, 0); PG8_SCHED; PG8_LDA(At, 0, 0); PG8_STAGE(PG8_SA(1, 1), a1 + hstep, voffA);
            PG8_WAIT_L(8); PG8_BAR; PG8_WAIT_L(0); PG8_MMA(0, 0, At, B0); PG8_BAR; PG8_SCHED;
            PG8_LDB(B1, 0, 1); PG8_STAGE(PG8_SB(0, 0), b2, voffB);
            PG8_BAR; PG8_WAIT_L(0); PG8_MMA(0, 1, At, B1); PG8_BAR;
            PG8_LDA(At, 0, 1); PG8_STAGE(PG8_SA(0, 0), a2, voffA);
            PG8_BAR; PG8_WAIT_L(0); PG8_MMA(1, 0, At, B0); PG8_BAR; PG8_SCHED;
            PG8_STAGE(PG8_SB(0, 1), b2 + hstep, voffB);
            PG8_WAIT_V(6); PG8_BAR; PG8_MMA(1, 1, At, B1); PG8_BAR;
            PG8_LDB(B0, 1, 0); PG8_SCHED; PG8_LDA(At, 1, 0); PG8_STAGE(PG8_SA(0, 1), a2 + hstep, voffA);
            PG8_WAIT_L(8); PG8_BAR; PG8_WAIT_L(0); PG8_MMA(0, 0, At, B0); PG8_BAR; PG8_SCHED;
            PG8_LDB(B1, 1, 1); PG8_STAGE(PG8_SB(1, 0), b3, voffB);
            PG8_BAR; PG8_WAIT_L(0); PG8_MMA(0, 1, At, B1); PG8_BAR;
            PG8_LDA(At, 1, 1); PG8_STAGE(PG8_SA(1, 0), a3, voffA);
            PG8_BAR; PG8_WAIT_L(0); PG8_MMA(1, 0, At, B0); PG8_BAR; PG8_SCHED;
            PG8_STAGE(PG8_SB(1, 1), b3 + hstep, voffB);
            PG8_WAIT_V(6); PG8_BAR; PG8_MMA(1, 1, At, B1); PG8_BAR;
            }
        }
        if constexpr (ALIGN_EPI) { if (wr == 0) PG8_BAR; }
        if constexpr (!Epi::AFTER_DRAIN) { E(acc, cur, wr, wc, fr, fq); S.done(cur); }
        if (!has_next) break;
#pragma unroll
        for (int a = 0; a < 2; ++a)
#pragma unroll
            for (int b = 0; b < 2; ++b)
#pragma unroll
                for (int m = 0; m < 4; ++m)
#pragma unroll
                    for (int n = 0; n < 2; ++n) acc[a][b][m][n] = (f32x4){0.f, 0.f, 0.f, 0.f};
        cur = nxt; cA = nA; cB = nB; ++ui;
        if constexpr (ALIGN_EPI) { if (wr == 1) PG8_BAR; }
    }
    PG8_WAIT_V(0);
    if constexpr (!ALIGN_EPI) { if (wr == 0) PG8_BAR; }
    PG8_BAR;
    if constexpr (Epi::AFTER_DRAIN) { E.fused(acc, cur, wr, wc, fr, fq, lds, wid, lane); S.done(cur); }
#undef PG8_SA
#undef PG8_SB
#undef PG8_STAGE
#undef PG8_LDA
#undef PG8_LDB
#undef PG8_MMA
#undef PG8_WAIT_V
#undef PG8_WAIT_L
#undef PG8_BAR
#undef PG8_SCHED
}
}
#define GAS __attribute__((address_space(1)))
#define LAS __attribute__((address_space(3)))
typedef unsigned short bf16;
typedef unsigned v4u __attribute__((ext_vector_type(4)));
typedef float f32x4 __attribute__((ext_vector_type(4)));
typedef short bf16x8 __attribute__((ext_vector_type(8)));
typedef GAS unsigned gu32;
typedef GAS unsigned long long gu64;
#define RLX_AGENT __ATOMIC_RELAXED, __HIP_MEMORY_SCOPE_AGENT
#define LDS_WAIT() asm volatile("s_waitcnt lgkmcnt(0)" ::: "memory")
#define VM_WAIT() asm volatile("s_waitcnt vmcnt(0)" ::: "memory")
__device__ __forceinline__ unsigned long long rt() { return __builtin_amdgcn_s_memrealtime(); }
__device__ __forceinline__ unsigned f2bf(float f) { unsigned u = __builtin_bit_cast(unsigned, f); return (u + 0x7fffu + ((u >> 16) & 1u)) >> 16; }
__device__ __forceinline__ unsigned pk2(float lo, float hi) { return f2bf(lo) | (f2bf(hi) << 16); }

#define XB_TMO      128
#define XB_XCNT(j)  (256  + 64 * (j))
#define XB_XSUB(j)  (1280 + 64 * (j))
#define XB_XGEN(j)  (2304 + 64 * (j))
#define XB_TOP      3328
#define XB_TOPGEN   3392
#define XCD_BAR_WORDS 3456
#define XB_SPIN_CAP (1u << 18)

__device__ __forceinline__ unsigned xb_ld(unsigned* p)              { return __hip_atomic_load(p, __ATOMIC_RELAXED, __HIP_MEMORY_SCOPE_AGENT); }
__device__ __forceinline__ unsigned xb_add(unsigned* p, unsigned v) { return __hip_atomic_fetch_add(p, v, __ATOMIC_RELAXED, __HIP_MEMORY_SCOPE_AGENT); }
__device__ __forceinline__ unsigned xb_xcc_id() { return (unsigned)__builtin_amdgcn_s_getreg((3 << 11) | 20) & 0xFu; }
#define XB_SPIN(cond, bar) do { unsigned _sp = 0; while (cond) { __builtin_amdgcn_s_sleep(1); \
    if ((++_sp & 255u) == 0u) { if (xb_ld(&(bar)[XB_TMO])) break; if (_sp > XB_SPIN_CAP) { atomicAdd(&(bar)[XB_TMO], 1u); break; } } } } while (0)

struct XcdBarrier {
    unsigned* bar; unsigned x; unsigned wv;
    volatile LAS unsigned* st;
};

__device__ __forceinline__ XcdBarrier xcd_barrier_post(unsigned* bar, volatile LAS unsigned* st, unsigned wv) {
    XcdBarrier b; b.bar = bar; b.x = xb_xcc_id(); b.st = st; b.wv = wv;
    if (wv == 0u && hw_lane() == 0) (void)xb_add(&bar[XB_XCNT(b.x)], 1u);
    return b;
}
__device__ __forceinline__ void xcd_barrier_complete(unsigned* bar, unsigned x, unsigned& nloc, unsigned& nx) {
    const unsigned G = gridDim.x * gridDim.y * gridDim.z;
    unsigned sum, cnt, mine, sp = 0u;
    for (;;) {
        sum = 0u; cnt = 0u; mine = 0u;
#pragma unroll
        for (unsigned j = 0; j < 16; ++j) { const unsigned c = xb_ld(&bar[XB_XCNT(j)]); sum += c; cnt += (c > 0u) ? 1u : 0u; mine = (j == x) ? c : mine; }
        if (sum == G) break;
        __builtin_amdgcn_s_sleep(1);
        if ((++sp & 255u) == 0u) { if (xb_ld(&bar[XB_TMO])) break; if (sp > XB_SPIN_CAP) { atomicAdd(&bar[XB_TMO], 1u); break; } }
    }
    nloc = mine > 0u ? mine : 1u; nx = cnt > 0u ? cnt : 1u;
}

__device__ __forceinline__ void xcd_barrier(const XcdBarrier& b) {
    asm volatile("s_waitcnt vmcnt(0)" ::: "memory");
    __syncthreads();
    if (b.wv == 0u && hw_lane() == 0) {
        unsigned* bar = b.bar;
        __builtin_amdgcn_s_waitcnt(0);
        unsigned nloc = b.st[0], nx = b.st[1];
        if (nloc == 0u) { xcd_barrier_complete(bar, b.x, nloc, nx); b.st[0] = nloc; b.st[1] = nx; }
        const unsigned old = xb_add(&bar[XB_XSUB(b.x)], 1u);
        const unsigned gen = old / nloc;
        if (old + 1u == (gen + 1u) * nloc) {
            __builtin_amdgcn_fence(__ATOMIC_RELEASE, "agent");
            asm volatile("s_waitcnt vmcnt(0)" ::: "memory");
            const unsigned og = xb_add(&bar[XB_TOP], 1u);
            const unsigned tg = og / nx;
            if (og + 1u == (tg + 1u) * nx) xb_add(&bar[XB_TOPGEN], 1u);
            else XB_SPIN(xb_ld(&bar[XB_TOPGEN]) == tg, bar);
            __builtin_amdgcn_fence(__ATOMIC_ACQUIRE, "agent");
            xb_add(&bar[XB_XGEN(b.x)], 1u);
            asm volatile("s_waitcnt vmcnt(0)" ::: "memory");
        } else {
            XB_SPIN(xb_ld(&bar[XB_XGEN(b.x)]) == gen, bar);
            __builtin_amdgcn_fence(__ATOMIC_ACQUIRE, "agent");
            asm volatile("s_waitcnt vmcnt(0)" ::: "memory");
        }
    }
    __syncthreads();
}
namespace attn {
using f32x16 = __attribute__((ext_vector_type(16))) float;
using u32x4  = __attribute__((ext_vector_type(4))) unsigned;
constexpr int NW = 8, QBLK = 32, KVBLK = 64, DQ = 192, DVV = 128;
constexpr int LDQ = 1536, LDO = 1024;
constexpr float THRL = 7.0f;
#define SBAR() __builtin_amdgcn_sched_barrier(0)
__device__ __forceinline__ int crow(int r, int hi) { return (r & 3) + 8 * (r >> 2) + 4 * hi; }
typedef int v8i __attribute__((ext_vector_type(8)));
typedef int v4i __attribute__((ext_vector_type(4)));
__device__ __forceinline__ int pk8(float a, float b, float c, float d) { int t = __builtin_amdgcn_cvt_pk_fp8_f32(a, b, 0, false); return __builtin_amdgcn_cvt_pk_fp8_f32(c, d, t, true); }
__device__ __forceinline__ unsigned cvtpk(float lo, float hi) { unsigned r; asm volatile("v_cvt_pk_bf16_f32 %0, %1, %2" : "=v"(r) : "v"(lo), "v"(hi)); return r; }

__device__ __forceinline__ float vmax3(float a, float b, float c) { float r; asm("v_max3_f32 %0, %1, %2, %3" : "=v"(r) : "v"(a), "v"(b), "v"(c)); return r; }
__device__ __forceinline__ float vmax2(float a, float b) { float r; asm("v_max_f32 %0, %1, %2" : "=v"(r) : "v"(a), "v"(b)); return r; }
__device__ __forceinline__ float softmaxPP(f32x16& p0, f32x16& p1, float& m_reg, f32x16& negm, float& l_reg, bool first, v8i& pa) {
  const float a0 = vmax3(p0[0], p0[1], p0[2]), a1 = vmax3(p0[3], p0[4], p0[5]), a2 = vmax3(p0[6], p0[7], p0[8]), a3 = vmax3(p0[9], p0[10], p0[11]), a4 = vmax3(p0[12], p0[13], p0[14]);
  const float a5 = vmax3(p1[0], p1[1], p1[2]), a6 = vmax3(p1[3], p1[4], p1[5]), a7 = vmax3(p1[6], p1[7], p1[8]), a8 = vmax3(p1[9], p1[10], p1[11]), a9 = vmax3(p1[12], p1[13], p1[14]);
  const float b0 = vmax3(a0, a1, a2), b1 = vmax3(a3, a4, a5), b2 = vmax3(a6, a7, a8), b3 = vmax3(a9, p0[15], p1[15]);
  float pmax = vmax2(vmax3(b0, b1, b2), b3);
  { auto rr = __builtin_amdgcn_permlane32_swap(__float_as_uint(pmax), __float_as_uint(pmax), false, false); pmax = vmax2(__uint_as_float(rr[0]), __uint_as_float(rr[1])); }
  float alpha = 1.f;
  if (__builtin_expect(first || __any(pmax > THRL), 0)) { const float dl = first ? pmax : vmax2(pmax, 0.f); alpha = first ? 1.f : __builtin_amdgcn_exp2f(-dl); m_reg += dl;
    for (int r = 0; r < 16; ++r) { p0[r] -= dl; p1[r] -= dl; }
    for (int r = 0; r < 16; ++r) negm[r] = -m_reg; }
  for (int r = 0; r < 16; ++r) p0[r] = __builtin_amdgcn_exp2f(p0[r]);
  for (int r = 0; r < 16; ++r) p1[r] = __builtin_amdgcn_exp2f(p1[r]);
  float s0 = (p0[0] + p0[1]) + (p0[2] + p0[3]), s1 = (p0[4] + p0[5]) + (p0[6] + p0[7]), s2 = (p0[8] + p0[9]) + (p0[10] + p0[11]), s3 = (p0[12] + p0[13]) + (p0[14] + p0[15]);
  s0 += (p1[0] + p1[1]) + (p1[2] + p1[3]); s1 += (p1[4] + p1[5]) + (p1[6] + p1[7]); s2 += (p1[8] + p1[9]) + (p1[10] + p1[11]); s3 += (p1[12] + p1[13]) + (p1[14] + p1[15]);
  float ps = (s0 + s1) + (s2 + s3);
  { auto rr = __builtin_amdgcn_permlane32_swap(__float_as_uint(ps), __float_as_uint(ps), false, false); ps = __uint_as_float(rr[0]) + __uint_as_float(rr[1]); }
  l_reg = l_reg * alpha + ps;
#pragma unroll
  for (int w = 0; w < 4; ++w) {
    pa[w] = __builtin_amdgcn_cvt_pk_fp8_f32(p0[4 * w], p0[4 * w + 1], pa[w], false); pa[w] = __builtin_amdgcn_cvt_pk_fp8_f32(p0[4 * w + 2], p0[4 * w + 3], pa[w], true);
    pa[4 + w] = __builtin_amdgcn_cvt_pk_fp8_f32(p1[4 * w], p1[4 * w + 1], pa[4 + w], false); pa[4 + w] = __builtin_amdgcn_cvt_pk_fp8_f32(p1[4 * w + 2], p1[4 * w + 3], pa[4 + w], true); }
  return alpha;
}
typedef unsigned short bf16r;
constexpr int KROWB = 192, LDKB = 1536, SHM_K3 = KVBLK * KROWB, SHM_V3 = KVBLK * DVV, NSLOT = 4;
constexpr int LDS_K3 = 0, LDS_V3 = NSLOT * SHM_K3, LDS_WS3 = LDS_V3 + NSLOT * SHM_V3, SHM_ATTN3 = LDS_WS3 + NW * 64 * 4;
__device__ __forceinline__ void glds16(const void* gsrc, unsigned lds_dst) { unsigned keep;
  asm volatile("s_mov_b32 %0, m0\n\ts_mov_b32 m0, %2\n\ts_nop 0\n\tglobal_load_lds_dwordx4 %1, off\n\ts_mov_b32 m0, %0" : "=&s"(keep) : "v"(gsrc), "s"(lds_dst) : "memory"); }
__device__ __forceinline__ float bfl(unsigned w) { return __uint_as_float(w << 16); }
__device__ __forceinline__ float bfh(unsigned w) { return __uint_as_float(w & 0xffff0000u); }
template <int AEXP> __device__ __forceinline__ void attn_unit(const bf16r* __restrict__ Qb, const unsigned char* __restrict__ Kh, const unsigned char* __restrict__ Vh, bf16r* __restrict__ Ob, const float* __restrict__ tab, int seq, char* lds, int wid) {
  const int lane = hw_lane(), r32 = lane & 31, hi = lane >> 5;
  const unsigned lds0 = (unsigned)(uintptr_t)lds;
  float* wsf = (float*)(lds + LDS_WS3) + wid * 64; float* li_l = wsf; float* al_l = wsf + 32;
  float m_reg = 0.f, l_reg = 0; f32x16 o[4] = {}; v8i qf[3]; f32x16 negm = {}; asm volatile("" : "+v"(negm));
  { const bf16r* Qw = Qb + (long)(wid * QBLK + r32) * LDQ + hi * 32;
#pragma unroll
    for (int s = 0; s < 2; ++s) { u32x4 q4[4];
#pragma unroll
      for (int i = 0; i < 4; ++i) q4[i] = *reinterpret_cast<const u32x4*>(Qw + s * 64 + i * 8);
#pragma unroll
      for (int i = 0; i < 4; ++i) { qf[s][2 * i] = pk8(bfl(q4[i][0]), bfh(q4[i][0]), bfl(q4[i][1]), bfh(q4[i][1])); qf[s][2 * i + 1] = pk8(bfl(q4[i][2]), bfh(q4[i][2]), bfl(q4[i][3]), bfh(q4[i][3])); } }
    { const float* tr = tab + (long)(wid * QBLK + r32) * 64 + hi * 32;
#pragma unroll
      for (int i = 0; i < 4; ++i) { const u32x4 qv = *reinterpret_cast<const u32x4*>(Qw + 128 + i * 8);
        const float4 t0 = *reinterpret_cast<const float4*>(tr + i * 8), t1 = *reinterpret_cast<const float4*>(tr + i * 8 + 4);
        float r_[8];
#define ROT(K_, Q_, C_, S_) do { r_[K_] = bfl(Q_) * (C_) - bfh(Q_) * (S_); r_[K_ + 1] = bfl(Q_) * (S_) + bfh(Q_) * (C_); } while (0)
        ROT(0, qv[0], t0.x, t0.y); ROT(2, qv[1], t0.z, t0.w); ROT(4, qv[2], t1.x, t1.y); ROT(6, qv[3], t1.z, t1.w);
#undef ROT
        qf[2][2 * i] = pk8(r_[0], r_[1], r_[2], r_[3]); qf[2][2 * i + 1] = pk8(r_[4], r_[5], r_[6], r_[7]); } } }
  int kof[2], vof;
#pragma unroll
  for (int i = 0; i < 2; ++i) { const int ob = (wid + 8 * i) * 1024 + 16 * lane, row = ob / KROWB, pp = (ob - row * KROWB) >> 4, sl = pp ^ ((row >> 2) & 3); kof[i] = row * LDKB + sl * 16; }
  { const int c = 16 * wid + (lane >> 2), sl = (lane & 3) ^ ((c >> 2) & 3); vof = c * seq + sl * 16; }
  const unsigned kdst = lds0 + LDS_K3 + wid * 1024, vdst = lds0 + LDS_V3 + wid * 1024;
#define DMA_KV(kt, ks, vt, vs) do { const unsigned char* kb_ = Kh + (long)(kt) * KVBLK * LDKB; const unsigned char* vb_ = Vh + (long)(vt) * KVBLK; const unsigned kd_ = (unsigned)__builtin_amdgcn_readfirstlane(kdst + (ks) * SHM_K3), vd_ = (unsigned)__builtin_amdgcn_readfirstlane(vdst + (vs) * SHM_V3); \
    glds16(kb_ + kof[0], kd_); if (wid < 4) glds16(kb_ + kof[1], kd_ + 8192); glds16(vb_ + vof, vd_); } while (0)
  int kq[2];
  { const int x = (r32 >> 2) & 3; const int kb = (int)lds0 + LDS_K3 + r32 * KROWB; kq[0] = kb + 16 * ((2 * hi) ^ x); kq[1] = kb + 16 * ((2 * hi + 1) ^ x); }
  int vq[2];
  { const int x = (r32 >> 2) & 3; const int vbb = (int)lds0 + LDS_V3 + r32 * 64; vq[0] = vbb + 16 * ((2 * hi) ^ x); vq[1] = vbb + 16 * ((2 * hi + 1) ^ x); }
#define RESC(a) do { if (__any((a) < 1.f)) { if (hi == 0) al_l[r32] = (a); asm volatile("s_waitcnt lgkmcnt(0)" ::: "memory"); \
    for (int d = 0; d < 4; ++d) for (int r = 0; r < 16; ++r) o[d][r] *= al_l[crow(r, hi)]; } } while (0)
  f32x16 p0 = {}, p1 = {}; float al; v8i pa = {}; const int NT = seq / KVBLK;
  int s0 = 0;
#define SL(d) ((s0 + (d)) & 3)
#define CLAMP(t) ((t) < NT ? (t) : NT - 1)
#define BAR() asm volatile("s_barrier" ::: "memory")
#define LGKM(n) do { asm volatile("s_waitcnt lgkmcnt(" #n ")" ::: "memory"); SBAR(); } while (0)
  DMA_KV(0, 0, 0, 0); DMA_KV(1, 1, 1, 1); DMA_KV(2, 2, 1, 1);
  asm volatile("s_waitcnt vmcnt(0)\n\ts_barrier" ::: "memory");
#ifndef ATT_PRIO
#define ATT_PRIO 0
#endif
#ifndef ATT_HALF
#define ATT_HALF(w) ((w) >= 4)
#endif
#define KRD(F0, F1, OFF) asm volatile("ds_read_b128 %0, %4 offset:%6\n\tds_read_b128 %1, %5 offset:%6\n\tds_read_b128 %2, %4 offset:%7\n\tds_read_b128 %3, %5 offset:%7" \
    : "=&v"(F0##l), "=&v"(F0##h), "=&v"(F1##l), "=&v"(F1##h) : "v"(a0_), "v"(a1_), "i"(OFF), "i"((OFF) + 32 * KROWB) : "memory")
#define VRD8(FL, FH, CB) asm volatile("ds_read_b128 %0, %2 offset:%4\n\tds_read_b128 %1, %3 offset:%4" : "=&v"(FL), "=&v"(FH) : "v"(v0_), "v"(v1_), "i"((CB) * 2048) : "memory")
#define PV8(OD, FL, FH) do { if (AEXP == 2 || AEXP == 5) { asm volatile("" :: "v"(FL), "v"(FH)); break; } OD = __builtin_amdgcn_mfma_scale_f32_32x32x64_f8f6f4(pa, F8(FL, FH), OD, 0, 0, 0, 0, 0, 0); } while (0)
#define F8(L, H) (v8i){L[0], L[1], L[2], L[3], H[0], H[1], H[2], H[3]}
#define QK8(F0, F1, S, C0, C1) do { if (AEXP == 2 || AEXP == 5) { asm volatile("" :: "v"(F0##l), "v"(F1##h)); break; } p0 = __builtin_amdgcn_mfma_scale_f32_32x32x64_f8f6f4(F8(F0##l, F0##h), qf[S], C0, 0, 0, 0, 0, 0, 0); p1 = __builtin_amdgcn_mfma_scale_f32_32x32x64_f8f6f4(F8(F1##l, F1##h), qf[S], C1, 0, 0, 0, 0, 0, 0); } while (0)
#define MPH(PREV) do { const int ko_ = s0 * SHM_K3; const int a0_ = kq[0] + ko_, a1_ = kq[1] + ko_; const int vo_ = SL(3) * SHM_V3; const int v0_ = vq[0] + vo_, v1_ = vq[1] + vo_; \
    v4i ka0l, ka0h, ka1l, ka1h, kb0l, kb0h, kb1l, kb1h, v0l, v0h, v1l, v1h, v2l, v2h, v3l, v3h; \
    SBAR(); \
    KRD(ka0, ka1, 0); KRD(kb0, kb1, 64);                       \
    LGKM(4);  QK8(ka0, ka1, 0, negm, negm); \
    KRD(ka0, ka1, 128); VRD8(v0l, v0h, 0); VRD8(v1l, v1h, 1);   \
    LGKM(8);  QK8(kb0, kb1, 1, p0, p1); \
    VRD8(v2l, v2h, 2); VRD8(v3l, v3h, 3);                       \
    LGKM(8);  QK8(ka0, ka1, 2, p0, p1); \
    if (PREV) { LGKM(4); PV8(o[0], v0l, v0h); PV8(o[1], v1l, v1h); LGKM(0); PV8(o[2], v2l, v2h); PV8(o[3], v3l, v3h); } else { LGKM(0); } \
    } while (0)
#define WB() do { if (wid < 4) asm volatile("s_waitcnt vmcnt(3)\n\ts_barrier" ::: "memory"); else asm volatile("s_waitcnt vmcnt(2)\n\ts_barrier" ::: "memory"); } while (0)
#define VPH(j) do { if (AEXP != 3 && AEXP != 5) DMA_KV(CLAMP((j) + 3), SL(3), CLAMP((j) + 2), SL(2)); if (AEXP != 1 && AEXP != 5) { al = softmaxPP(p0, p1, m_reg, negm, l_reg, (j) == 0, pa); RESC(al); } else { asm volatile("" : "+v"(p0), "+v"(p1), "+v"(pa)); } s0 = SL(1); } while (0)
#define DRAIN() do { const int vo_ = SL(3) * SHM_V3; const int v0_ = vq[0] + vo_, v1_ = vq[1] + vo_; v4i v0l, v0h, v1l, v1h, v2l, v2h, v3l, v3h; \
    VRD8(v0l, v0h, 0); VRD8(v1l, v1h, 1); VRD8(v2l, v2h, 2); VRD8(v3l, v3h, 3); LGKM(0); PV8(o[0], v0l, v0h); PV8(o[1], v1l, v1h); PV8(o[2], v2l, v2h); PV8(o[3], v3l, v3h); } while (0)
  { const bool trail = ATT_HALF(wid);
    if (AEXP == 6 && trail) {
      BAR();
#pragma unroll 1
      for (int j = 0; j + 1 < NT; ++j) { DMA_KV(CLAMP((j) + 3), SL(3), CLAMP((j) + 2), SL(2)); s0 = SL(1); WB(); }
    } else {
    if (trail) BAR();
    if (ATT_PRIO == 1) __builtin_amdgcn_s_setprio(1);
    MPH(false); if (ATT_PRIO == 1) __builtin_amdgcn_s_setprio(0); if (!trail) WB();
#pragma unroll 1
    for (int j = 0; j + 1 < NT; ++j) { if (ATT_PRIO == 2) __builtin_amdgcn_s_setprio(1); VPH(j); if (ATT_PRIO == 2) __builtin_amdgcn_s_setprio(0); if (trail) WB(); if (ATT_PRIO == 1) __builtin_amdgcn_s_setprio(1); MPH(true); if (ATT_PRIO == 1) __builtin_amdgcn_s_setprio(0); if (!trail) WB(); }
    VPH(NT - 1); DRAIN(); } }
  if (hi == 0) li_l[r32] = l_reg; asm volatile("s_waitcnt lgkmcnt(0)" ::: "memory");
  float rli[16];
#pragma unroll
  for (int r = 0; r < 16; ++r) rli[r] = __builtin_amdgcn_rcpf(li_l[crow(r, hi)]);
  bf16r* Ow = Ob + (long)(wid * QBLK) * LDO;
#pragma unroll
  for (int r = 0; r < 16; ++r) { const int orow = crow(r, hi);
#pragma unroll
    for (int d0 = 0; d0 < 4; ++d0) { const unsigned w = cvtpk(o[d0][r] * rli[r], 0.f); Ow[(long)orow * LDO + d0 * 32 + r32] = (bf16r)(w & 0xffffu); } }
  asm volatile("s_waitcnt vmcnt(0) lgkmcnt(0)\n\ts_barrier" ::: "memory");
#undef DMA_KV
#undef RESC
#undef SL
#undef CLAMP
#undef BAR
#undef LGKM
#undef KRD
#undef VRD8
#undef PV8
#undef F8
#undef QK8
#undef MPH
#undef WB
#undef DRAIN
#undef VPH
}
#undef SBAR
}

namespace fftc {
#define FGAS __attribute__((address_space(1)))
typedef float f2 __attribute__((ext_vector_type(2)));
typedef __attribute__((address_space(3))) f2 lf2;
constexpr int L = 16384;
constexpr int FFT_LDS_BYTES = 17920 * 8;
__device__ static const float TW64C[32] = { 1.000000000e+00f, 9.951847267e-01f, 9.807852804e-01f, 9.569403357e-01f, 9.238795325e-01f, 8.819212643e-01f, 8.314696123e-01f, 7.730104534e-01f, 7.071067812e-01f, 6.343932842e-01f, 5.555702330e-01f, 4.713967368e-01f, 3.826834324e-01f, 2.902846773e-01f, 1.950903220e-01f, 9.801714033e-02f, 0.0f, -9.801714033e-02f, -1.950903220e-01f, -2.902846773e-01f, -3.826834324e-01f, -4.713967368e-01f, -5.555702330e-01f, -6.343932842e-01f, -7.071067812e-01f, -7.730104534e-01f, -8.314696123e-01f, -8.819212643e-01f, -9.238795325e-01f, -9.569403357e-01f, -9.807852804e-01f, -9.951847267e-01f };
__device__ static const float TW64S[32] = { 0.000000000e+00f, 9.801714033e-02f, 1.950903220e-01f, 2.902846773e-01f, 3.826834324e-01f, 4.713967368e-01f, 5.555702330e-01f, 6.343932842e-01f, 7.071067812e-01f, 7.730104534e-01f, 8.314696123e-01f, 8.819212643e-01f, 9.238795325e-01f, 9.569403357e-01f, 9.807852804e-01f, 9.951847267e-01f, 1.000000000e+00f, 9.951847267e-01f, 9.807852804e-01f, 9.569403357e-01f, 9.238795325e-01f, 8.819212643e-01f, 8.314696123e-01f, 7.730104534e-01f, 7.071067812e-01f, 6.343932842e-01f, 5.555702330e-01f, 4.713967368e-01f, 3.826834324e-01f, 2.902846773e-01f, 1.950903220e-01f, 9.801714033e-02f };
__device__ __forceinline__ f2 cmul(f2 a, f2 w) { return (f2){a.x * w.x - a.y * w.y, a.x * w.y + a.y * w.x}; }
template <bool INV> __device__ __forceinline__ f2 twmul(f2 d, int tw) {
    if (tw == 0) return d;
    if (tw == 16) return INV ? (f2){-d.y, d.x} : (f2){d.y, -d.x};
    const float c = TW64C[tw], s = TW64S[tw];
    return INV ? (f2){d.x * c - d.y * s, d.y * c + d.x * s} : (f2){d.x * c + d.y * s, d.y * c - d.x * s};
}
template <int N, int S, bool INV> __device__ __forceinline__ void dif_stage(f2 (&v)[N]) {
#pragma unroll
    for (int blk = 0; blk < N; blk += 2 * S)
#pragma unroll
        for (int i = 0; i < S; ++i) { const f2 a = v[blk + i], b = v[blk + i + S]; v[blk + i] = a + b; v[blk + i + S] = twmul<INV>(a - b, i * (32 / S)); }
    if constexpr (S > 1) dif_stage<N, S / 2, INV>(v);
}
constexpr int bitrev(int k, int bits) { int r = 0; for (int b = 0; b < bits; ++b) r |= ((k >> b) & 1) << (bits - 1 - b); return r; }
template <int N, bool INV> __device__ __forceinline__ void dft(f2 (&v)[N]) {
    dif_stage<N, N / 2, INV>(v);
    constexpr int bits = (N == 32) ? 5 : 4;
    f2 t[N];
#pragma unroll
    for (int k = 0; k < N; ++k) t[k] = v[bitrev(k, bits)];
#pragma unroll
    for (int k = 0; k < N; ++k) v[k] = t[k];
}
template <bool CONJ> __device__ __forceinline__ void apply_pow32(f2 (&v)[32], f2 w) {
    if (CONJ) w.y = -w.y;
    f2 lo[8]; lo[0] = (f2){1.f, 0.f}; lo[1] = w; lo[2] = cmul(w, w); lo[3] = cmul(lo[2], w); lo[4] = cmul(lo[2], lo[2]); lo[5] = cmul(lo[4], w); lo[6] = cmul(lo[4], lo[2]); lo[7] = cmul(lo[4], lo[3]);
#pragma unroll
    for (int k = 1; k < 32; ++k) if (k & 7) v[k] = cmul(v[k], lo[k & 7]);
    const f2 p8 = cmul(lo[4], lo[4]), p16 = cmul(p8, p8), p24 = cmul(p16, p8);
#pragma unroll
    for (int k = 8; k < 16; ++k) v[k] = cmul(v[k], p8);
#pragma unroll
    for (int k = 16; k < 24; ++k) v[k] = cmul(v[k], p16);
#pragma unroll
    for (int k = 24; k < 32; ++k) v[k] = cmul(v[k], p24);
}
__device__ __forceinline__ int opaque(int x) { asm volatile("" : "+v"(x)); return x; }
__device__ __forceinline__ f2 cis_pi(float x) { float s, c; sincospif(x, &s, &c); return (f2){c, s}; }
#define FPHYS(d1, d2, d3) ((d1) * 560 + (d2) * 17 + (d3))
#define FSYNC() __syncthreads()
template <int EV> __device__ __forceinline__ void pass1_fwd(lf2* X, f2 (&v)[32], int tid) {
    tid = opaque(tid);
    if (EV != 1) { dft<32, false>(v);
    apply_pow32<false>(v, cis_pi(-(float)tid * (2.0f / L))); }
    const int base = (tid >> 4) * 17 + (tid & 15);
#pragma unroll
    for (int k = 0; k < 32; ++k) { if (EV != 2) X[base + k * 560] = v[k]; else asm volatile("" :: "v"(v[k])); }
}
template <int EV> __device__ __forceinline__ void pass1_inv(const lf2* X, f2 (&v)[32], int tid) {
    tid = opaque(tid);
    const int base = (tid >> 4) * 17 + (tid & 15);
#pragma unroll
    for (int k = 0; k < 32; ++k) { if (EV != 2) v[k] = X[base + k * 560]; else v[k] = (f2){(float)(tid + k), 2.f}; }
    if (EV != 1) { apply_pow32<true>(v, cis_pi(-(float)tid * (2.0f / L)));
    dft<32, true>(v); }
}
template <bool INV, int EV> __device__ __forceinline__ void pass2(lf2* X, int tid) {
    tid = opaque(tid);
    const int base = (tid >> 4) * 560 + (tid & 15); f2 v[32];
    if (EV == 2) { for (int k = 0; k < 32; ++k) v[k] = (f2){(float)(tid + k), 1.f}; asm volatile("" : "+v"(v[0]), "+v"(v[7]), "+v"(v[19])); }
#pragma unroll
    for (int k = 0; k < 32; ++k) if (EV != 2) v[k] = X[base + k * 17];
    const f2 w = cis_pi(-(float)(tid & 15) * (2.0f / 512.0f));
    if (EV != 1) { if (INV) { apply_pow32<true>(v, w); dft<32, true>(v); } else { dft<32, false>(v); apply_pow32<false>(v, w); } }
#pragma unroll
    for (int k = 0; k < 32; ++k) { if (EV != 2) X[base + k * 17] = v[k]; else asm volatile("" :: "v"(v[k])); }
}
template <bool KMODE, int EV> __device__ __forceinline__ void pass3(lf2* X, f2 (&KR)[2][16], int tid) {
    tid = opaque(tid);
#pragma unroll
    for (int i = 0; i < 2; ++i) { const int base = ((tid >> 5) + 16 * i) * 560 + (tid & 31) * 17; f2 u[16];
#pragma unroll
        for (int k = 0; k < 16; ++k) u[k] = X[base + k];
        if (EV != 1) dft<16, false>(u);
        if (KMODE) {
#pragma unroll
            for (int k = 0; k < 16; ++k) KR[i][k] = u[k];
        } else {
#pragma unroll
            for (int k = 0; k < 16; ++k) u[k] = cmul(u[k], KR[i][k]);
            if (EV != 1) dft<16, true>(u);
#pragma unroll
            for (int k = 0; k < 16; ++k) X[base + k] = u[k];
        } }
}
template <int EV> __device__ __forceinline__ void kernel_spectrum(lf2* X, f2 (&v)[32], f2 (&KS)[2][16], int tid) {
    pass1_fwd<EV>(X, v, tid); FSYNC(); pass2<false, EV>(X, tid); FSYNC(); pass3<true, EV>(X, KS, tid); FSYNC();
}
template <int EV> __device__ __forceinline__ void conv_roundtrip(lf2* X, f2 (&v)[32], f2 (&KS)[2][16], int tid) {
    pass1_fwd<EV>(X, v, tid); FSYNC(); pass2<false, EV>(X, tid); FSYNC(); pass3<false, EV>(X, KS, tid); FSYNC(); pass2<true, EV>(X, tid); FSYNC(); pass1_inv<EV>(X, v, tid); FSYNC();
}
__device__ __forceinline__ void modulate(f2 (&v)[32], int tid) {
    const f2 wj = cis_pi(-(float)opaque(tid) * (1.0f / L));
#pragma unroll
    for (int k = 0; k < 32; ++k) v[k] = twmul<false>(cmul(v[k], wj), k);
}
__device__ __forceinline__ void demodulate(f2 (&v)[32], int tid) {
    f2 wj = cis_pi(-(float)opaque(tid) * (1.0f / L)); wj.y = -wj.y;
#pragma unroll
    for (int k = 0; k < 32; ++k) v[k] = twmul<true>(cmul(v[k], wj), k);
}
__device__ __forceinline__ float bf2f(unsigned short u) { return __uint_as_float((unsigned)u << 16); }
__device__ __forceinline__ unsigned short f2bf_rne(float f) { unsigned u = __float_as_uint(f); return (unsigned short)((u + 0x7fffu + ((u >> 16) & 1u)) >> 16); }
template <typename T> __device__ __forceinline__ FGAS T* pstep(FGAS T* p, int n) { p += n; asm volatile("" : "+v"(p)); return p; }
template <int MODE, int EV = 0> __device__ __forceinline__ void hyena_channel(lf2* X, const float* z0, const float* z1, const float* hf, const float* hb,
                                                                        const unsigned short* g0, const unsigned short* g1, float dbias, float* zo0, float* zo1,
                                                                        unsigned short* o0, unsigned short* o1, f2* stash, f2* KSg, int tid) {
    f2 v[32]; f2 KS[2][16];
    { FGAS const float* pf = (FGAS const float*)hf + opaque(tid); FGAS const float* pb = (FGAS const float*)hb + ((L - opaque(tid)) & (L - 1));
#pragma unroll
      for (int k = 0; k < 32; ++k) { v[k] = (EV == 3) ? (f2){1.f, 0.f} : (f2){*pf + *pb, 0.f}; pf = pstep(pf, 512); pb = (k == 0) ? pstep((FGAS const float*)hb + (L - 512 - tid), 0) : pstep(pb, -512); } }
    kernel_spectrum<EV>(X, v, KS, tid);
    { FGAS const float* p0 = (FGAS const float*)z0 + opaque(tid); FGAS const float* p1 = (FGAS const float*)z1 + opaque(tid);
#pragma unroll
      for (int k = 0; k < 32; ++k) { v[k] = (EV == 3) ? (f2){1.f, 2.f} : (f2){*p0, *p1}; p0 = pstep(p0, 512); p1 = pstep(p1, 512); } }
    conv_roundtrip<EV>(X, v, KS, tid);
    { FGAS f2* ps = (FGAS f2*)stash + opaque(tid);
#pragma unroll
      for (int k = 0; k < 32; ++k) { *ps = v[k]; ps = pstep(ps, 512); } }
    { FGAS const float* pf = (FGAS const float*)hf + opaque(tid); FGAS const float* pb = (FGAS const float*)hb + ((L - opaque(tid)) & (L - 1));
#pragma unroll
      for (int k = 0; k < 32; ++k) { const float hbv = (EV == 3) ? 1.f : *pb; v[k] = (f2){*pf + ((k == 0 && tid == 0) ? hbv : -hbv), 0.f}; pf = pstep(pf, 512); pb = (k == 0) ? pstep((FGAS const float*)hb + (L - 512 - tid), 0) : pstep(pb, -512); } }
    modulate(v, tid);
    kernel_spectrum<EV>(X, v, KS, tid);
    { FGAS const float* p0 = (FGAS const float*)z0 + opaque(tid); FGAS const float* p1 = (FGAS const float*)z1 + opaque(tid);
#pragma unroll
      for (int k = 0; k < 32; ++k) { v[k] = (EV == 3) ? (f2){1.f, 2.f} : (f2){*p0, *p1}; p0 = pstep(p0, 512); p1 = pstep(p1, 512); } }
    modulate(v, tid);
    conv_roundtrip<EV>(X, v, KS, tid);
    demodulate(v, tid);
    const float sc = 1.0f / (2.0f * L);
    { FGAS const f2* ps = (FGAS const f2*)stash + opaque(tid); FGAS const float* p0 = (FGAS const float*)z0 + opaque(tid); FGAS const float* p1 = (FGAS const float*)z1 + opaque(tid); FGAS const unsigned short* q0 = (FGAS const unsigned short*)g0 + opaque(tid); FGAS const unsigned short* q1 = (FGAS const unsigned short*)g1 + opaque(tid);
      FGAS float* w0 = (FGAS float*)zo0 + opaque(tid); FGAS float* w1 = (FGAS float*)zo1 + opaque(tid); FGAS unsigned short* b0 = (FGAS unsigned short*)o0 + opaque(tid); FGAS unsigned short* b1 = (FGAS unsigned short*)o1 + opaque(tid);
#pragma unroll
      for (int k = 0; k < 32; ++k) { const f2 y = (*ps + v[k]) * sc;
          const float r0 = bf2f(*q0) * (y.x + dbias * *p0), r1 = bf2f(*q1) * (y.y + dbias * *p1);
          if (MODE == 1) { *b0 = f2bf_rne(r0); *b1 = f2bf_rne(r1); b0 = pstep(b0, 512); b1 = pstep(b1, 512); } else if (MODE == 0) { *w0 = r0; *w1 = r1; w0 = pstep(w0, 512); w1 = pstep(w1, 512); } else { asm volatile("" :: "v"(r0), "v"(r1)); }
          ps = pstep(ps, 512); p0 = pstep(p0, 512); p1 = pstep(p1, 512); q0 = pstep(q0, 512); q1 = pstep(q1, 512); } }
}
#undef FPHYS
#undef FGAS
}

constexpr int BATCH = 2, SEQ = 16384, DM = 1024, T = BATCH * SEQ;
constexpr int NH = 8, DNOPE = 128, DROPE = 64, DQK = 192, DVH = 128, QLORA = 384, KVLORA = 256, MLA_IN = 704, MLA_INP = 768;
constexpr int DFF = 2816, NUP = 2 * DFF;
constexpr int HF = 64, HEMB = 33, HKP = 256;
constexpr float LN_EPS = 1e-5f, RMS_EPS = 1e-6f;
constexpr float DN_ALPHA = 1.4142135623730951f;
constexpr float QSCALE = 0.07216878364870322f * 1.4426950408889634f;
constexpr int NWAVES = 8;

constexpr size_t MiB = 1u << 20;
constexpr size_t WS_CTL = 0, CTL_ZERO_BYTES = 64 * 1024;
constexpr size_t WS_TW1 = 256 * 1024, WS_MOD = 384 * 1024, WS_TW2 = 512 * 1024;
constexpr size_t WS_WIN = 2 * MiB, WS_WUQ = 4 * MiB, WS_WUKV = 6 * MiB, WS_WO = 7 * MiB, WS_WHIN = 9 * MiB, WS_WHO = 15 * MiB, WS_WUP = 17 * MiB, WS_WDN = 39 * MiB, WS_WFO = 50 * MiB, WS_H3 = 52 * MiB;
constexpr size_t WS_XB = 60 * MiB;
constexpr size_t WS_XF = 124 * MiB;
constexpr size_t WS_S = 252 * MiB;
constexpr size_t WS_END = 512 * MiB;
constexpr size_t WS_CQN = WS_XF, WS_CKVN = WS_XF + 24 * MiB, WS_ROPE = WS_XF + 40 * MiB;
constexpr size_t WS_Q = WS_S, WS_K = WS_S + 96 * MiB, WS_VT = WS_S + 144 * MiB, WS_V = WS_S + 192 * MiB;
constexpr size_t WS_UH = WS_S;
constexpr size_t WS_U = WS_S;
constexpr size_t WS_VC0 = WS_XB, WS_VC1 = WS_S + 192 * MiB;
constexpr size_t WS_KT = WS_S, WS_STASH = WS_S + 128 * MiB, WS_KSPEC = WS_S + 160 * MiB;
constexpr int CW_TMO = 0, CW_CODE = 1, CW_BAR = 4096, CW_CHK = 8192;

constexpr int RING_BYTES = 131072;
constexpr int LDS_BYTES = 147456;
constexpr int MISC_OFF = LDS_BYTES - 512;
static_assert(fftc::FFT_LDS_BYTES <= MISC_OFF && attn::SHM_ATTN3 <= RING_BYTES, "LDS map");

typedef pg8::bf16_t bf16;
typedef unsigned u32x4t __attribute__((ext_vector_type(4)));
typedef unsigned u32x2t __attribute__((ext_vector_type(2)));
typedef float f32x2 __attribute__((ext_vector_type(2)));
__device__ __forceinline__ float wave_sum(float v) {
#pragma unroll
    for (int o = 1; o < 64; o <<= 1) v += __shfl_xor(v, o);
    return v;
}
__device__ __forceinline__ float bf_lo(unsigned w) { return __uint_as_float(w << 16); }
__device__ __forceinline__ float bf_hi(unsigned w) { return __uint_as_float(w & 0xffff0000u); }
__device__ __forceinline__ unsigned pkbf(float lo, float hi) { return pg8::cvt_pk_bf16(lo, hi); }

template <class ColMap> __device__ __forceinline__ void transpose_item(const float* W, int K, int N, bf16* WT, int ldk, LAS float* scr, int item, int nblk, int lane, const ColMap& cm) {
    const int kb = item / nblk, nb = item % nblk, k0 = 64 * kb, n0 = 32 * nb;
    const int q4 = 4 * (lane & 7), s0 = cm(n0 + q4), s1 = cm(n0 + q4 + 1), s2 = cm(n0 + q4 + 2), s3 = cm(n0 + q4 + 3);
    const bool vec = (s0 >= 0) && (s1 == s0 + 1) && (s2 == s0 + 2) && (s3 == s0 + 3) && ((s0 & 3) == 0) && ((N & 3) == 0);
#pragma unroll
    for (int i = 0; i < 8; ++i) { const int kk = (lane >> 3) + 8 * i; const float* wr = W + (size_t)(k0 + kk) * N; f32x4 v;
        if (vec) v = *(const f32x4*)(wr + s0);
        else { v.x = s0 >= 0 ? wr[s0] : 0.f; v.y = s1 >= 0 ? wr[s1] : 0.f; v.z = s2 >= 0 ? wr[s2] : 0.f; v.w = s3 >= 0 ? wr[s3] : 0.f; }
        LAS float* d = scr + kk * 33 + q4; d[0] = v.x; d[1] = v.y; d[2] = v.z; d[3] = v.w; }
    asm volatile("s_waitcnt lgkmcnt(0)" ::: "memory");
    const int c = lane & 7;
#pragma unroll
    for (int j = 0; j < 4; ++j) { const int n = (lane >> 3) + 8 * j; const LAS float* s = scr + (8 * c) * 33 + n;
        u32x4t o; o.x = pkbf(s[0 * 33], s[1 * 33]); o.y = pkbf(s[2 * 33], s[3 * 33]); o.z = pkbf(s[4 * 33], s[5 * 33]); o.w = pkbf(s[6 * 33], s[7 * 33]);
        *(u32x4t*)(WT + (size_t)(n0 + n) * ldk + k0 + 8 * c) = o; }
    asm volatile("s_waitcnt lgkmcnt(0)" ::: "memory");
}
struct CmIdent { __device__ __forceinline__ int operator()(int n) const { return n; } };
struct CmWin { __device__ __forceinline__ int operator()(int n) const { if (n < 640) return n; if (n >= 704) return -1; const int i = n - 640; return 640 + (i & 1) * 32 + (i >> 1); } };
struct CmWuq { __device__ __forceinline__ int operator()(int n) const { const int h = n / 192, d = n - h * 192; if (d < 128) return n; const int i = d - 128; return h * 192 + 128 + (i & 1) * 32 + (i >> 1); } };
struct CmWukv { __device__ __forceinline__ int operator()(int n) const { const int v = n >> 10, r = n & 1023, h = r >> 7, d = r & 127; return h * 256 + v * 128 + d; } };
struct CmWup { __device__ __forceinline__ int operator()(int n) const { const int pn = n >> 8, r = n & 255; return (r < 128) ? (pn * 128 + r) : (DFF + pn * 128 + (r - 128)); } };

struct Args {
    const float* in[27]; float* out; unsigned char* ws; int ph_lo, ph_hi;
};
enum { I_X = 0, I_POS, I_MLA_WIN, I_MLA_GQ, I_MLA_WUQ, I_MLA_GKV, I_MLA_WUKV, I_MLA_WO, I_HY_WIN, I_HY_WSHORT, I_HY_FW1, I_HY_FB1, I_HY_FW2, I_HY_FB2, I_HY_FW3, I_HY_FB3, I_HY_FREQ,
       I_HY_FWOUT, I_HY_DBIAS, I_HY_WO, I_FFN_WUP, I_FFN_WCONV, I_FFN_WDOWN, I_LN1G, I_LN1B, I_LN2G, I_LN2B };

__device__ __forceinline__ void ln_rows(const bf16* Y, float* OF, bf16* OB, const float* g, const float* b, int gw, int ngw, int lane, float omul = 1.0f) {
    f32x4 gv[4], bv[4];
#pragma unroll
    for (int j = 0; j < 4; ++j) { gv[j] = *(const f32x4*)(g + 4 * lane + 256 * j); bv[j] = *(const f32x4*)(b + 4 * lane + 256 * j); }
    for (int m0 = gw; m0 < T; m0 += 4 * ngw) {
        u32x2t w[4][4];
#pragma unroll
        for (int q = 0; q < 4; ++q) { const int m = m0 + q * ngw; if (m < T) { const u32x2t* xr = (const u32x2t*)(Y + (size_t)m * DM) + lane;
#pragma unroll
                for (int j = 0; j < 4; ++j) w[q][j] = xr[64 * j]; } }
#pragma unroll
        for (int q = 0; q < 4; ++q) { const int m = m0 + q * ngw; if (m < T) {
            f32x4 v[4]; float s = 0.f;
#pragma unroll
            for (int j = 0; j < 4; ++j) { v[j] = (f32x4){bf_lo(w[q][j].x), bf_hi(w[q][j].x), bf_lo(w[q][j].y), bf_hi(w[q][j].y)}; s += (v[j].x + v[j].y) + (v[j].z + v[j].w); }
            const float mean = wave_sum(s) * (1.f / DM); float s2 = 0.f;
#pragma unroll
            for (int j = 0; j < 4; ++j) { v[j] = v[j] - mean; s2 += (v[j].x * v[j].x + v[j].y * v[j].y) + (v[j].z * v[j].z + v[j].w * v[j].w); }
            const float rstd = 1.f / sqrtf(wave_sum(s2) * (1.f / DM) + LN_EPS);
            f32x4* of = (f32x4*)(OF + (size_t)m * DM) + lane;
#pragma unroll
            for (int j = 0; j < 4; ++j) { v[j] = (v[j] * rstd * gv[j] + bv[j]) * omul;
                if (OF) of[64 * j] = v[j]; }
            if (OB) { u32x2t* ob = (u32x2t*)(OB + (size_t)m * DM) + lane;
#pragma unroll
                for (int j = 0; j < 4; ++j) { u32x2t ww; ww.x = pkbf(v[j].x, v[j].y); ww.y = pkbf(v[j].z, v[j].w); ob[64 * j] = ww; } } } }
    }
}

__device__ __forceinline__ void mla_norm_rope(const float* H1, const float* gq, const float* gkv, const f32x2* tab, bf16* CQN, bf16* CKVN, unsigned char* Kb, int gw, int ngw, int lane) {
    float gqv[6], gkvv[4];
#pragma unroll
    for (int k = 0; k < 6; ++k) gqv[k] = gq[lane + 64 * k];
#pragma unroll
    for (int k = 0; k < 4; ++k) gkvv[k] = gkv[lane + 64 * k];
    for (int t0 = gw; t0 < T; t0 += 2 * ngw) {
        float q[2][6], kv[2][4]; f32x2 xr[2], cs[2];
#pragma unroll
        for (int u = 0; u < 2; ++u) { const int t = t0 + u * ngw; if (t < T) { const float* h = H1 + (size_t)t * MLA_INP;
#pragma unroll
            for (int k = 0; k < 6; ++k) q[u][k] = h[lane + 64 * k];
#pragma unroll
            for (int k = 0; k < 4; ++k) kv[u][k] = h[QLORA + lane + 64 * k];
            xr[u] = *(const f32x2*)(h + 640 + 2 * (lane & 31)); cs[u] = tab[(size_t)t * 32 + (lane & 31)]; } }
#pragma unroll
        for (int u = 0; u < 2; ++u) { const int t = t0 + u * ngw; if (t < T) {
            float sq = 0.f, sk = 0.f;
#pragma unroll
            for (int k = 0; k < 6; ++k) sq += q[u][k] * q[u][k];
#pragma unroll
            for (int k = 0; k < 4; ++k) sk += kv[u][k] * kv[u][k];
            const float rq = 1.f / sqrtf(wave_sum(sq) * (1.f / QLORA) + RMS_EPS), rk = 1.f / sqrtf(wave_sum(sk) * (1.f / KVLORA) + RMS_EPS);
#pragma unroll
            for (int k = 0; k < 6; ++k) CQN[(size_t)t * QLORA + lane + 64 * k] = (bf16)(pkbf(q[u][k] * rq * gqv[k], 0.f) & 0xffffu);
#pragma unroll
            for (int k = 0; k < 4; ++k) CKVN[(size_t)t * KVLORA + lane + 64 * k] = (bf16)(pkbf(kv[u][k] * rk * gkvv[k], 0.f) & 0xffffu);
            const unsigned short w = (unsigned short)__builtin_amdgcn_cvt_pk_fp8_f32(xr[u].x * cs[u].x - xr[u].y * cs[u].y, xr[u].x * cs[u].y + xr[u].y * cs[u].x, 0, false);
            unsigned short* kr = (unsigned short*)(Kb + (size_t)t * 1536 + 128) + (lane & 31);
            if (lane < 32) {
#pragma unroll
                for (int hh = 0; hh < NH; ++hh) kr[hh * 96] = w; } } }
    }
}

__device__ __forceinline__ void ffn_conv_silu(const bf16* UH, const float* wconv  , bf16* HACT  , int gw, int ngw, int lane) {
    constexpr int RB = 32, NRB = SEQ / RB, NCC = 6;
    for (int it = gw; it < NRB * NCC; it += ngw) {
        const int rb = it / NCC, cc = it - rb * NCC, c = cc * 512 + lane * 8;
        if (c >= DFF) continue;
        const int pn = c >> 7, ucol = pn * 256 + (c & 127);
        float wa[3][8], wg[3][8];
#pragma unroll
        for (int k = 0; k < 3; ++k)
#pragma unroll
            for (int e = 0; e < 8; ++e) { wa[k][e] = wconv[k * NUP + c + e]; wg[k][e] = wconv[k * NUP + DFF + c + e]; }
        const int r0 = rb * RB;
        const bf16* up = UH + ucol;
        const u32x4t zero = {0u, 0u, 0u, 0u};
        u32x4t ra[6], rg[6];
        ra[0] = zero; rg[0] = zero;
        if (r0 > 0) { ra[0] = *(const u32x4t*)(up + (size_t)(r0 - 1) * NUP); rg[0] = *(const u32x4t*)(up + (size_t)(r0 - 1) * NUP + 128); }
        ra[1] = *(const u32x4t*)(up + (size_t)r0 * NUP); rg[1] = *(const u32x4t*)(up + (size_t)r0 * NUP + 128);
#pragma unroll 1
        for (int r = r0; r < r0 + RB; r += 4) {
#pragma unroll
            for (int j = 1; j <= 4; ++j) { const int rr = r + j; if (rr < SEQ) { ra[1 + j] = *(const u32x4t*)(up + (size_t)rr * NUP); rg[1 + j] = *(const u32x4t*)(up + (size_t)rr * NUP + 128); } else { ra[1 + j] = zero; rg[1 + j] = zero; } }
#pragma unroll
            for (int j = 0; j < 4; ++j) {
                float o[8];
#pragma unroll
                for (int e2 = 0; e2 < 4; ++e2) {
                    const float a0 = wa[0][2 * e2] * bf_lo(ra[j][e2]) + wa[1][2 * e2] * bf_lo(ra[j + 1][e2]) + wa[2][2 * e2] * bf_lo(ra[j + 2][e2]);
                    const float a1 = wa[0][2 * e2 + 1] * bf_hi(ra[j][e2]) + wa[1][2 * e2 + 1] * bf_hi(ra[j + 1][e2]) + wa[2][2 * e2 + 1] * bf_hi(ra[j + 2][e2]);
                    const float g0 = wg[0][2 * e2] * bf_lo(rg[j][e2]) + wg[1][2 * e2] * bf_lo(rg[j + 1][e2]) + wg[2][2 * e2] * bf_lo(rg[j + 2][e2]);
                    const float g1 = wg[0][2 * e2 + 1] * bf_hi(rg[j][e2]) + wg[1][2 * e2 + 1] * bf_hi(rg[j + 1][e2]) + wg[2][2 * e2 + 1] * bf_hi(rg[j + 2][e2]);
                    o[2 * e2] = a0 * g0 * __builtin_amdgcn_rcpf(1.f + __expf(-g0)); o[2 * e2 + 1] = a1 * g1 * __builtin_amdgcn_rcpf(1.f + __expf(-g1)); }
                u32x4t w; w.x = pkbf(o[0], o[1]); w.y = pkbf(o[2], o[3]); w.z = pkbf(o[4], o[5]); w.w = pkbf(o[6], o[7]);
                *(u32x4t*)(HACT + (size_t)(r + j) * DFF + c) = w;
            }
            ra[0] = ra[4]; rg[0] = rg[4]; ra[1] = ra[5]; rg[1] = rg[5];
        }
    }
}

__device__ __forceinline__ void v_transpose_fp8(const bf16* V, unsigned char* VT, LAS unsigned char* scr, int gw, int ngw, int lane) {
    constexpr int NKT = T / 64, NCT = 1024 / 64;
    for (int it = gw; it < NKT * NCT; it += ngw) {
        const int ct = it % NCT, kt = it / NCT, b = kt / (SEQ / 64), k0 = (kt % (SEQ / 64)) * 64, c0 = ct * 64;
        const int r8 = lane >> 3, c8 = lane & 7;
#pragma unroll
        for (int i = 0; i < 8; ++i) { const int row = r8 + 8 * i; const u32x4t v = *(const u32x4t*)(V + ((size_t)b * SEQ + k0 + row) * 1024 + c0 + c8 * 8);
            u32x2t w; w.x = (unsigned)__builtin_amdgcn_cvt_pk_fp8_f32(bf_lo(v.y), bf_hi(v.y), __builtin_amdgcn_cvt_pk_fp8_f32(bf_lo(v.x), bf_hi(v.x), 0, false), true);
            w.y = (unsigned)__builtin_amdgcn_cvt_pk_fp8_f32(bf_lo(v.w), bf_hi(v.w), __builtin_amdgcn_cvt_pk_fp8_f32(bf_lo(v.z), bf_hi(v.z), 0, false), true);
            *(LAS u32x2t*)(scr + row * 72 + c8 * 8) = w; }
        asm volatile("s_waitcnt lgkmcnt(0)" ::: "memory");
        unsigned o[16];
#pragma unroll
        for (int wd = 0; wd < 16; ++wd) { unsigned acc = 0;
#pragma unroll
            for (int bb = 0; bb < 4; ++bb) { const int pi = wd * 4 + bb, h = pi >> 5, j = pi & 31, jj = j & 15, key = (j >> 4) * 32 + (jj & 3) + 8 * (jj >> 2) + 4 * h;
                acc |= (unsigned)scr[key * 72 + lane] << (8 * bb); }
            o[wd] = acc; }
        const int hh = (c0 + lane) >> 7, cc = (c0 + lane) & 127;
        unsigned char* dst = VT + (((size_t)b * 8 + hh) * 128 + cc) * SEQ + k0;
#pragma unroll
        for (int q = 0; q < 4; ++q) *(u32x4t*)(dst + 16 * q) = (u32x4t){o[4 * q], o[4 * q + 1], o[4 * q + 2], o[4 * q + 3]};
        asm volatile("s_waitcnt lgkmcnt(0)" ::: "memory");
    }
}

__device__ __forceinline__ void ffn_fixup_rows(const float* halo, const float* wconv  , bf16* HACT  , int gw, int ngw, int lane) {
    constexpr int NP = T / 256, NCC = 6;
    for (int it = gw; it < NP * 2 * NCC; it += ngw) {
        const int cc = it % NCC, pe = it / NCC, e = pe & 1, pm = pe >> 1, c = cc * 512 + lane * 8;
        if (c >= DFF) continue;
        const int row = pm * 256 + (e ? 255 : 0), ucol = (c >> 7) * 256 + (c & 127);
        const float* hp = halo + (size_t)pm * 4 * NUP + ucol;
        const float* up_ = nullptr; const float* cu_; const float* dn_ = nullptr;
        if (e == 0) { cu_ = hp; dn_ = hp + NUP; if (row % SEQ != 0) up_ = hp - 4 * NUP + 3 * NUP; }
        else { up_ = hp + 2 * NUP; cu_ = hp + 3 * NUP; if (row % SEQ != SEQ - 1) dn_ = hp + 4 * NUP; }
        float o[8];
#pragma unroll
        for (int i = 0; i < 8; ++i) {
            float ha = wconv[NUP + c + i] * cu_[i], hg = wconv[NUP + DFF + c + i] * cu_[128 + i];
            if (up_) { ha += wconv[c + i] * up_[i]; hg += wconv[DFF + c + i] * up_[128 + i]; }
            if (dn_) { ha += wconv[2 * NUP + c + i] * dn_[i]; hg += wconv[2 * NUP + DFF + c + i] * dn_[128 + i]; }
            o[i] = ha * hg * __builtin_amdgcn_rcpf(1.f + __expf(-hg)); }
        u32x4t w; w.x = pkbf(o[0], o[1]); w.y = pkbf(o[2], o[3]); w.z = pkbf(o[4], o[5]); w.w = pkbf(o[6], o[7]);
        *(u32x4t*)(HACT + (size_t)row * DFF + c) = w;
    }
}

__device__ __forceinline__ void hy_conv_transpose(const bf16* U  , const float* wshort  , float* VC0, float* VC1, bf16* G1C, bf16* G2C, LAS unsigned* scr, int gw, int ngw, int lane) {
    constexpr int NTT = T / 64, NCT = 3072 / 64;
    const int r8 = lane >> 3, c8 = lane & 7;
    u32x4t buf[9];
#define HCT_LOAD(IT) do { const int ct_ = (IT) % NCT, tt_ = (IT) / NCT, b_ = tt_ / (SEQ / 64), t0_ = (tt_ % (SEQ / 64)) * 64, c0_ = ct_ * 64; \
        _Pragma("unroll") for (int i = 0; i < 9; ++i) { const int row = r8 + 8 * i, tok = t0_ - 1 + row; buf[i] = (u32x4t){0u, 0u, 0u, 0u}; \
            if (row < 66 && tok >= 0 && tok < SEQ) buf[i] = *(const u32x4t*)(U + ((size_t)b_ * SEQ + tok) * 3072 + c0_ + c8 * 8); } } while (0)
    if (gw < NTT * NCT) HCT_LOAD(gw);
    for (int it = gw; it < NTT * NCT; it += ngw) {
        const int ct = it % NCT, tt = it / NCT, b = tt / (SEQ / 64), t0 = (tt % (SEQ / 64)) * 64, c0 = ct * 64;
#pragma unroll
        for (int i = 0; i < 9; ++i) { const int row = r8 + 8 * i; if (row < 66) { LAS unsigned* d = scr + row * 33 + c8 * 4; d[0] = buf[i].x; d[1] = buf[i].y; d[2] = buf[i].z; d[3] = buf[i].w; } }
        if (it + ngw < NTT * NCT) HCT_LOAD(it + ngw);
        asm volatile("s_waitcnt lgkmcnt(0)" ::: "memory");
        const int part = c0 >> 10, chb = c0 & 1023;
        const float wl0 = wshort[c0 + lane], wl1 = wshort[3072 + c0 + lane], wl2 = wshort[6144 + c0 + lane];
#pragma unroll
        for (int cp = 0; cp < 32; ++cp) {
            const unsigned a0 = scr[lane * 33 + cp], a1 = scr[(lane + 1) * 33 + cp], a2 = scr[(lane + 2) * 33 + cp];
            #define RL(x, i) __int_as_float(__builtin_amdgcn_readlane(__float_as_int(x), (i)))
            const float w00 = RL(wl0, 2 * cp), w10 = RL(wl1, 2 * cp), w20 = RL(wl2, 2 * cp), w01 = RL(wl0, 2 * cp + 1), w11 = RL(wl1, 2 * cp + 1), w21 = RL(wl2, 2 * cp + 1);
#undef RL
            const float v0 = w00 * bf_lo(a0) + w10 * bf_lo(a1) + w20 * bf_lo(a2), v1 = w01 * bf_hi(a0) + w11 * bf_hi(a1) + w21 * bf_hi(a2);
            const size_t o = (size_t)(chb + 2 * cp) * SEQ + t0 + lane;
            if (part == 0) { float* d = b ? VC1 : VC0; d[o] = v0; d[o + SEQ] = v1; }
            else { bf16* d = (part == 1 ? G1C : G2C) + (size_t)b * 1024 * SEQ; d[o] = (bf16)(pkbf(v0, 0.f) & 0xffffu); d[o + SEQ] = (bf16)(pkbf(v1, 0.f) & 0xffffu); }
        }
        asm volatile("s_waitcnt lgkmcnt(0)" ::: "memory");
    }
#undef HCT_LOAD
}
__device__ __forceinline__ void hy_transpose_back(const bf16* Z3C, bf16* XB, LAS unsigned* scr, int gw, int ngw, int lane) {
    constexpr int NTT = T / 64, NCT = 1024 / 64;
    for (int it = gw; it < NTT * NCT; it += ngw) {
        const int ct = it % NCT, tt = it / NCT, b = tt / (SEQ / 64), t0 = (tt % (SEQ / 64)) * 64, c0 = ct * 64;
        const bf16* src = Z3C + ((size_t)b * 1024 + c0) * SEQ + t0 + lane;
#pragma unroll 8
        for (int cp = 0; cp < 32; ++cp) { const unsigned lo = src[(size_t)(2 * cp) * SEQ], hi = src[(size_t)(2 * cp + 1) * SEQ]; scr[lane * 33 + cp] = lo | (hi << 16); }
        asm volatile("s_waitcnt lgkmcnt(0)" ::: "memory");
        const int r8 = lane >> 3, c8 = lane & 7;
#pragma unroll
        for (int i = 0; i < 8; ++i) { const int row = r8 + 8 * i; const LAS unsigned* s = scr + row * 33 + c8 * 4; u32x4t v; v.x = s[0]; v.y = s[1]; v.z = s[2]; v.w = s[3];
            *(u32x4t*)(XB + ((size_t)b * SEQ + t0 + row) * DM + c0 + c8 * 8) = v; }
        asm volatile("s_waitcnt lgkmcnt(0)" ::: "memory");
    }
}

#ifdef SELFCHECK
__device__ __forceinline__ float blk_sum(float v, LAS float* red, int tid_) {
    v = wave_sum(v); __syncthreads(); if ((tid_ & 63) == 0) red[tid_ >> 6] = v; __syncthreads();
    float t = 0.f; for (int i = 0; i < NWAVES; ++i) t += red[i]; __syncthreads(); return t;
}
__device__ __forceinline__ void chk_flag(unsigned* flag, float err2, float ref2, unsigned bit, int tid_, float tol = SELFCHECK_TOL) {
    if (tid_ == 0 && !(err2 <= tol * tol * ref2)) atomicOr(flag, bit);
}
__device__ __forceinline__ float fp8_dec(unsigned b) { const unsigned e = (b >> 3) & 15u, m = b & 7u; const float v = e ? ldexpf((float)(8u + m), (int)e - 10) : ldexpf((float)m, -9); return (b & 0x80u) ? -v : v; }
__device__ __forceinline__ float fp8_rnd(float x) { return fp8_dec((unsigned)__builtin_amdgcn_cvt_pk_fp8_f32(x, 0.f, 0, false) & 0xffu); }
__device__ __forceinline__ void selfcheck_mla(const Args& args, LAS unsigned char* ldsl, int bxx, int tid_) {
    unsigned* flag = (unsigned*)(args.ws + WS_CTL) + CW_CHK;
    const bf16* Qb_ = (const bf16*)(args.ws + WS_Q); const unsigned char* Kb_ = (const unsigned char*)(args.ws + WS_K); const bf16* Vb_ = (const bf16*)(args.ws + WS_V); const bf16* O_ = (const bf16*)(args.ws + WS_XB);
    const int* pos = (const int*)args.in[I_POS];
    LAS float* red = (LAS float*)(ldsl + 140000);
    if (bxx < 64) {
        const int t = bxx * (T / 64) + (bxx * 37) % 512;
        LAS float* h = (LAS float*)ldsl; LAS float* cq = h + 704; LAS float* ckv = cq + 384;
        const float* x = args.in[I_X] + (size_t)t * DM; const float* w_in = args.in[I_MLA_WIN];
        for (int j = tid_; j < MLA_IN; j += 512) { float a = 0.f; for (int k = 0; k < DM; ++k) a += x[k] * w_in[(size_t)k * MLA_IN + j]; h[j] = a; }
        __syncthreads();
        float sq = 0.f, sk = 0.f; for (int k = 0; k < QLORA; ++k) sq += h[k] * h[k]; for (int k = 0; k < KVLORA; ++k) sk += h[QLORA + k] * h[QLORA + k];
        const float rq = 1.f / sqrtf(sq / QLORA + RMS_EPS), rk = 1.f / sqrtf(sk / KVLORA + RMS_EPS);
        for (int k = tid_; k < QLORA; k += 512) cq[k] = h[k] * rq * args.in[I_MLA_GQ][k];
        for (int k = tid_; k < KVLORA; k += 512) ckv[k] = h[QLORA + k] * rk * args.in[I_MLA_GKV][k];
        __syncthreads();
        {
            float e2 = 0.f, r2 = 0.f; const float* w = args.in[I_MLA_WUQ];
            for (int n = tid_; n < NH * DQK; n += 512) { const int o = CmWuq()(n); float a = 0.f; for (int k = 0; k < QLORA; ++k) a += cq[k] * w[(size_t)k * (NH * DQK) + o];
                a *= QSCALE; const float g = __uint_as_float((unsigned)Qb_[(size_t)t * 1536 + n] << 16); e2 += (a - g) * (a - g); r2 += a * a; }
            e2 = blk_sum(e2, red, tid_); r2 = blk_sum(r2, red, tid_); chk_flag(flag, e2, r2, 1u, tid_);
        }
        {
            float e2 = 0.f, r2 = 0.f, e3 = 0.f, r3 = 0.f; const float* w = args.in[I_MLA_WUKV];
            for (int n = tid_; n < NH * 256; n += 512) { const int o = CmWukv()(n); float a = 0.f; for (int k = 0; k < KVLORA; ++k) a += ckv[k] * w[(size_t)k * (NH * 256) + o];
                if (n < 1024) { const float g = fp8_dec(Kb_[(size_t)t * 1536 + (n >> 7) * 192 + (n & 127)]); e2 += (a - g) * (a - g); r2 += a * a; }
                else { const float g = __uint_as_float((unsigned)Vb_[(size_t)t * 1024 + n - 1024] << 16); e3 += (a - g) * (a - g); r3 += a * a; } }
            e2 = blk_sum(e2, red, tid_); r2 = blk_sum(r2, red, tid_); chk_flag(flag, e2, r2, 2u, tid_, SELFCHECK_TOL8);
            e3 = blk_sum(e3, red, tid_); r3 = blk_sum(r3, red, tid_); chk_flag(flag, e3, r3, 8u, tid_);
        }
        {
            float e2 = 0.f, r2 = 0.f;
            if (tid_ < 256) { const int hh = tid_ >> 5, i = tid_ & 31; const float inv = powf(10000.0f, -(float)i / 32.0f); float s, c; sincosf((float)pos[t] * inv, &s, &c);
                const float x1 = h[640 + i], x2 = h[672 + i], a1 = x1 * c - x2 * s, a2 = x1 * s + x2 * c;
                const float g1 = fp8_dec(Kb_[(size_t)t * 1536 + hh * 192 + 128 + 2 * i]), g2 = fp8_dec(Kb_[(size_t)t * 1536 + hh * 192 + 129 + 2 * i]);
                e2 = (a1 - g1) * (a1 - g1) + (a2 - g2) * (a2 - g2); r2 = a1 * a1 + a2 * a2; }
            e2 = blk_sum(e2, red, tid_); r2 = blk_sum(r2, red, tid_); chk_flag(flag, e2, r2, 4u, tid_, SELFCHECK_TOL8);
        }
    } else if (bxx < 192) {
        const int sidx = bxx - 64, b = sidx & 1, hh = (sidx >> 1) & 7, row = (sidx * 509 + 13) % SEQ; const size_t t = (size_t)b * SEQ + row;
        LAS float* sc = (LAS float*)ldsl;
        LAS float* q = sc + SEQ;
        if (tid_ < DQK) { float v = __uint_as_float((unsigned)Qb_[t * 1536 + hh * DQK + tid_] << 16);
            if (tid_ >= 128) { const int i = (tid_ - 128) >> 1; const float inv = powf(10000.0f, -(float)i / 32.0f); float s, c; sincosf((float)pos[t] * inv, &s, &c);
                const float o = __uint_as_float((unsigned)Qb_[t * 1536 + hh * DQK + (tid_ ^ 1)] << 16);
                v = (tid_ & 1) ? (o * s + v * c) : (v * c - o * s); }
            q[tid_] = fp8_rnd(v); }
        __syncthreads();
        float mx = -1e30f;
        for (int k = tid_; k < SEQ; k += 512) { const unsigned char* kr = Kb_ + ((size_t)b * SEQ + k) * 1536 + hh * DQK; float a = 0.f; for (int d = 0; d < DQK; ++d) a += q[d] * fp8_dec(kr[d]); sc[k] = a; mx = fmaxf(mx, a); }
        for (int o = 1; o < 64; o <<= 1) mx = fmaxf(mx, __shfl_xor(mx, o));
        __syncthreads(); if ((tid_ & 63) == 0) red[tid_ >> 6] = mx; __syncthreads(); for (int i = 0; i < NWAVES; ++i) mx = fmaxf(mx, red[i]); __syncthreads();
        float ls = 0.f; for (int k = tid_; k < SEQ; k += 512) { const float p = exp2f(sc[k] - mx); sc[k] = p; ls += p; }
        ls = blk_sum(ls, red, tid_);
        const int d = tid_ & 127, part = tid_ >> 7; float a = 0.f;
        for (int k = part * 4096; k < (part + 1) * 4096; ++k) a += sc[k] * fp8_rnd(__uint_as_float((unsigned)Vb_[((size_t)b * SEQ + k) * 1024 + hh * DVH + d] << 16));
        LAS float* op = q + 256; op[tid_] = a; __syncthreads();
        float e2 = 0.f, r2 = 0.f;
        if (tid_ < 128) { const float o = (op[tid_] + op[tid_ + 128] + op[tid_ + 256] + op[tid_ + 384]) / ls; const float g = __uint_as_float((unsigned)O_[t * 1024 + hh * DVH + tid_] << 16); e2 = (o - g) * (o - g); r2 = o * o; }
        e2 = blk_sum(e2, red, tid_); r2 = blk_sum(r2, red, tid_); chk_flag(flag, e2, r2, 16u, tid_, SELFCHECK_TOL8);
    }
}
#endif
#ifndef MK_PER_PHASE
#define MK_PER_PHASE 0
#endif
constexpr int N_PHASES = 30;
constexpr int GEMM_SP2 = true, GEMM_ALIGN = true;

__global__ void __launch_bounds__(NWAVES * 64, 2) mega_fwd(Args args) {
    extern __shared__ __attribute__((aligned(16))) unsigned char lds[];
    LAS unsigned char* ldsl = (LAS unsigned char*)lds;
    volatile LAS unsigned* MISC = (volatile LAS unsigned*)(ldsl + MISC_OFF);
    const int wave = __builtin_amdgcn_readfirstlane((int)threadIdx.x >> 6);
#define lane hw_lane()
#define tid (wave * 64 + hw_lane())
#define G ((int)gridDim.x)
#define bx ((int)blockIdx.x)
#define gw (bx * NWAVES + wave)
#define ngw (G * NWAVES)
    { const int t_ = tid; if (t_ < 128) MISC[t_] = 0u; }
    __syncthreads();
    if (!MK_PER_PHASE) (void)xcd_barrier_post((unsigned*)(args.ws + WS_CTL) + CW_BAR, MISC + 8, (unsigned)wave);
    const int lo = args.ph_lo, hi = args.ph_hi;
#ifdef ONLY_PHASE
#define IN(k) ((k) == ONLY_PHASE && lo <= (k) && (k) < hi)
#else
#define IN(k) (lo <= (k) && (k) < hi)
#endif
#define GRIDBAR() do { XcdBarrier bar_; bar_.bar = (unsigned*)(args.ws + WS_CTL) + CW_BAR; bar_.x = xb_xcc_id(); bar_.st = MISC + 8; bar_.wv = (unsigned)wave; xcd_barrier(bar_); } while (0)
#define SEAM(k) do { if (IN(k) && IN((k) + 1)) GRIDBAR(); } while (0)
#ifndef PROBE_DUP
#define PROBE_DUP (-1)
#define PROBE_REP 1
#endif
#define RUN(k, REAL, DUMMY) do { if (IN(k)) { if (PROBE_DUP == (k)) { for (int rep_ = 0; rep_ < PROBE_REP; ++rep_) { DUMMY; GRIDBAR(); } } REAL; } } while (0)

#define P_(T_, off) ((T_*)(args.ws + (off)))
#define Win_t P_(bf16, WS_WIN)
#define Wuq_t P_(bf16, WS_WUQ)
#define Wukv_t P_(bf16, WS_WUKV)
#define Wo_t P_(bf16, WS_WO)
#define Whin_t P_(bf16, WS_WHIN)
#define Who_t P_(bf16, WS_WHO)
#define Wup_t P_(bf16, WS_WUP)
#define Wdn_t P_(bf16, WS_WDN)
#define Wfo_t P_(bf16, WS_WFO)
#define H3 P_(bf16, WS_H3)
#define XB P_(bf16, WS_XB)
#define XF P_(float, WS_XF)
#define CQN P_(bf16, WS_CQN)
#define CKVN P_(bf16, WS_CKVN)
#define ROPE P_(f32x2, WS_ROPE)
#define Qb P_(bf16, WS_Q)
#define Kb P_(unsigned char, WS_K)
#define Vb P_(bf16, WS_V)
#define VTb P_(unsigned char, WS_VT)
#define UH P_(bf16, WS_UH)
#define U P_(bf16, WS_U)
#define VC0 P_(float, WS_VC0)
#define VC1 P_(float, WS_VC1)
#define KT P_(float, WS_KT)
#define STASH P_(fftc::f2, WS_STASH)
#define KSPEC P_(fftc::f2, WS_KSPEC)
#define FTW (fftc::Tw{P_(const fftc::f2, WS_TW1), P_(const fftc::f2, WS_TW2), P_(const fftc::f2, WS_MOD)})
#define OUT (args.out)
#define H1 (args.out)
#define G1C ((bf16*)args.out)
#define G2C ((bf16*)args.out + (size_t)2 * 1024 * SEQ)
#define Z3C ((bf16*)args.out)
#define GEMM(EPI, A_, B_, M_, N_, K_, ...) do { pg8::Gemm g{(A_), (B_), (M_), (N_), (K_)}; pg8::StaticOrder S; S.init((M_), (N_), G, bx); typedef pg8::EPI Epi_; Epi_ E{__VA_ARGS__}; \
        pg8::gemm_phase<Epi_, pg8::StaticOrder, GEMM_ALIGN, GEMM_SP2>(ldsl, g, S, E, wave); } while (0)
#define YB_A P_(bf16, WS_XF)
#define YB_B P_(bf16, WS_S + 192 * MiB)
#define YB_C P_(bf16, WS_S)

    if (IN(0)) for (int prep_ = 0; prep_ < ((PROBE_DUP == 0) ? 1 + PROBE_REP : 1); ++prep_) {
        if (prep_) GRIDBAR();
        LAS float* scr = (LAS float*)(ldsl + wave * 16384);
        {
            int base = 0;
#define TR(W_, K_, N_, WT_, NP_, LDK_, CM_) do { const int nblk_ = (NP_) / 32, nit_ = ((K_) / 64) * nblk_; \
                for (int it_ = (gw + ngw - base % ngw) % ngw; it_ < nit_; it_ += ngw) transpose_item((W_), (K_), (N_), (WT_), (LDK_), scr, it_, nblk_, lane, CM_); base += nit_; } while (0)
            TR(args.in[I_MLA_WIN], DM, MLA_IN, Win_t, MLA_INP, DM, CmWin());
            TR(args.in[I_MLA_WUQ], QLORA, NH * DQK, Wuq_t, NH * DQK, QLORA, CmWuq());
            TR(args.in[I_MLA_WUKV], KVLORA, NH * 256, Wukv_t, NH * 256, KVLORA, CmWukv());
            TR(args.in[I_MLA_WO], DM, DM, Wo_t, DM, DM, CmIdent());
            TR(args.in[I_HY_WIN], DM, 3 * DM, Whin_t, 3 * DM, DM, CmIdent());
            TR(args.in[I_HY_WO], DM, DM, Who_t, DM, DM, CmIdent());
            TR(args.in[I_FFN_WUP], DM, NUP, Wup_t, NUP, DM, CmWup());
            TR(args.in[I_FFN_WUP] + (size_t)DM * NUP, DM, NUP, Wup_t + (size_t)NUP * DM, NUP, DM, CmWup());
            TR(args.in[I_FFN_WDOWN], DFF, DM, Wdn_t, DM, DFF, CmIdent());
            TR(args.in[I_FFN_WDOWN] + (size_t)DFF * DM, DFF, DM, Wdn_t + (size_t)DM * DFF, DM, DFF, CmIdent());
            TR(args.in[I_HY_FWOUT], HF, 4 * DM, Wfo_t, 4 * DM, HKP, CmIdent());
#undef TR
        }
        for (size_t i = (size_t)gw * 64 + lane; i < (size_t)4096 * 24; i += (size_t)ngw * 64) { const size_t r = i / 24, c = i % 24; *(u32x4t*)(Wfo_t + r * HKP + 64 + c * 8) = (u32x4t){0u, 0u, 0u, 0u}; }
        for (size_t i = (size_t)gw * 64 + lane; i < (size_t)SEQ * 24; i += (size_t)ngw * 64) { const size_t r = i / 24, c = i % 24; *(u32x4t*)(H3 + r * HKP + 64 + c * 8) = (u32x4t){0u, 0u, 0u, 0u}; }
        { const float* x_in = args.in[I_X];
          const size_t n8 = (size_t)T * DM / 8, st = (size_t)ngw * 64;
          for (size_t i = (size_t)gw * 64 + lane; i < n8; i += 4 * st) { f32x4 a[4], b[4];
#pragma unroll
            for (int q = 0; q < 4; ++q) { const size_t ii = i + q * st; if (ii < n8) { a[q] = *(const f32x4*)(x_in + ii * 8); b[q] = *(const f32x4*)(x_in + ii * 8 + 4); } }
#pragma unroll
            for (int q = 0; q < 4; ++q) { const size_t ii = i + q * st; if (ii < n8) { u32x4t w; w.x = pkbf(a[q].x, a[q].y); w.y = pkbf(a[q].z, a[q].w); w.z = pkbf(b[q].x, b[q].y); w.w = pkbf(b[q].z, b[q].w); *(u32x4t*)(XB + ii * 8) = w; } } } }
        { const int* pos = (const int*)args.in[I_POS]; const double inv = exp(-(double)(lane & 31) * (9.210340371976184 / 32.0));
          for (size_t i = (size_t)gw * 64 + lane; i < (size_t)T * 32; i += (size_t)ngw * 64) { const int t = (int)(i >> 5);
              const double ang = (double)pos[t] * inv; double s, c; sincos(ang, &s, &c); ROPE[i] = (f32x2){(float)c, (float)s}; } }
        { const float* fw1 = args.in[I_HY_FW1]; const float* fb1 = args.in[I_HY_FB1]; const float* fw2 = args.in[I_HY_FW2]; const float* fb2 = args.in[I_HY_FB2];
          const float* fw3 = args.in[I_HY_FW3]; const float* fb3 = args.in[I_HY_FB3]; const float fr = args.in[I_HY_FREQ][lane];
          for (int l0 = gw; l0 < SEQ; l0 += 4 * ngw) {
              float z[4], a[4], h[4];
#pragma unroll
              for (int u = 0; u < 4; ++u) { const int l = l0 + u * ngw < SEQ ? l0 + u * ngw : SEQ - 1;
                  const float tt = (float)l / (float)(SEQ - 1); const float w = 6.283185307179586f * (float)l / (float)SEQ;
                  z[u] = 0.f;
                  if (lane == 0) z[u] = tt;
                  else if (lane <= 16) { const float f = 1e-4f + (float)(lane - 1) * ((15.0f - 1e-4f) / 15.0f); z[u] = cosf(f * w); }
                  else if (lane <= 32) { const float f = 1e-4f + (float)(lane - 17) * ((15.0f - 1e-4f) / 15.0f); z[u] = -sinf(f * w); }
                  a[u] = fb1[lane]; }
#pragma unroll
              for (int i = 0; i < HEMB; ++i) { const float wv = fw1[i * HF + lane];
#pragma unroll
                  for (int u = 0; u < 4; ++u) a[u] += __shfl(z[u], i) * wv; }
#pragma unroll
              for (int u = 0; u < 4; ++u) { h[u] = sinf(fr * a[u]); a[u] = fb2[lane]; }
#pragma unroll 8
              for (int i = 0; i < HF; ++i) { const float wv = fw2[i * HF + lane];
#pragma unroll
                  for (int u = 0; u < 4; ++u) a[u] += __shfl(h[u], i) * wv; }
#pragma unroll
              for (int u = 0; u < 4; ++u) { h[u] = sinf(fr * a[u]); a[u] = fb3[lane]; }
#pragma unroll 8
              for (int i = 0; i < HF; ++i) { const float wv = fw3[i * HF + lane];
#pragma unroll
                  for (int u = 0; u < 4; ++u) a[u] += __shfl(h[u], i) * wv; }
#pragma unroll
              for (int u = 0; u < 4; ++u) { const int l = l0 + u * ngw; if (l < SEQ) H3[(size_t)l * HKP + lane] = (bf16)(pkbf(sinf(fr * a[u]), 0.f) & 0xffffu); }
          } }
    }
    SEAM(0);
#define B1 GEMM(EpiF32, XB, Win_t, T, MLA_INP, DM, H1, MLA_INP)
    RUN(1, B1, B1);
    SEAM(1);
#define B2 mla_norm_rope(H1, args.in[I_MLA_GQ], args.in[I_MLA_GKV], ROPE, CQN, CKVN, Kb, gw, ngw, lane)
    RUN(2, B2, B2);
    SEAM(2);
#define B3 do { GEMM(EpiBf16, CQN, Wuq_t, T, NH * DQK, QLORA, Qb, NH * DQK, QSCALE); GEMM(EpiKV, CKVN, Wukv_t, T, NH * 256, KVLORA, Kb, Vb); GRIDBAR(); v_transpose_fp8(Vb, VTb, (LAS unsigned char*)(ldsl + wave * 8192), gw, ngw, lane); } while (0)
    RUN(3, B3, B3);
    SEAM(3);
#ifndef ATT_EXP
#define ATT_EXP 0
#endif
#define B4X(EXPV) do { for (int u = bx; u < BATCH * NH * (SEQ / 256); u += G) { const int qb = u & 63, h = (u >> 6) & 7, b = u >> 9; const size_t r0 = (size_t)b * SEQ + (size_t)qb * 256; \
            attn::attn_unit<EXPV>(Qb + r0 * 1536 + h * DQK, Kb + (size_t)b * SEQ * 1536 + h * DQK, VTb + ((size_t)b * 8 + h) * 128 * SEQ, XB + r0 * 1024 + h * DVH, (const float*)(ROPE + r0 * 32), SEQ, (char*)lds, wave); } } while (0)
    RUN(4, B4X(0), B4X(ATT_EXP));
#ifdef SELFCHECK
    if (IN(4) && IN(5)) { GRIDBAR(); selfcheck_mla(args, ldsl, bx, tid); }
#endif
    SEAM(4);
#define B5 GEMM(EpiRes<false>, XB, Wo_t, T, DM, DM, args.in[I_X], YB_A, DN_ALPHA)
    RUN(5, B5, B5);
    SEAM(5);
#define B6 ln_rows(YB_A, nullptr, XB, args.in[I_LN1G], args.in[I_LN1B], gw, ngw, lane)
    RUN(6, B6, B6);
    SEAM(6);
#define HACT P_(bf16, WS_S)
#define HALO P_(float, WS_S + 180 * MiB)
#define FFN_UP(layer) GEMM(EpiConvSilu, XB, Wup_t + (size_t)(layer) * NUP * DM, T, NUP, DM, HACT, args.in[I_FFN_WCONV] + (size_t)(layer) * 3 * NUP, HALO, (PG8_LAS float*)(ldsl + RING_BYTES))
#define FFN_FIX(layer) ffn_fixup_rows(HALO, args.in[I_FFN_WCONV] + (size_t)(layer) * 3 * NUP, HACT, gw, ngw, lane)
#define FFN_DN(layer, OUT_) GEMM(EpiRes<true>, HACT, Wdn_t + (size_t)(layer) * DM * DFF, T, DM, DFF, XB, (OUT_), DN_ALPHA)
#define FFN_LAYER(p, layer) \
    RUN(p, FFN_UP(layer), FFN_UP(layer)); SEAM(p); \
    RUN((p) + 1, FFN_FIX(layer), FFN_FIX(layer)); SEAM((p) + 1); \
    RUN((p) + 2, FFN_DN(layer, (layer) ? YB_A : YB_B), FFN_DN(layer, (layer) ? YB_A : YB_B)); if (IN((p) + 2) && IN((p) + 6)) GRIDBAR();
    FFN_LAYER(7, 0)
#define X2B P_(bf16, WS_XF)
#define B13 ln_rows(YB_B, nullptr, X2B, args.in[I_LN2G], args.in[I_LN2B], gw, ngw, lane)
    RUN(13, B13, B13);
    SEAM(13);
#define B14 GEMM(EpiBf16, X2B, Whin_t, T, 3 * DM, DM, U, 3 * DM, 1.0f)
    RUN(14, B14, B14);
    SEAM(14);
#define B15 hy_conv_transpose(U, args.in[I_HY_WSHORT], VC0, VC1, G1C, G2C, (LAS unsigned*)(ldsl + wave * 16384), gw, ngw, lane)
    RUN(15, B15, B15);
    SEAM(15);
#define HY_FILT(od) GEMM(EpiFilt, H3, Wfo_t + (size_t)(od) * 2048 * HKP, SEQ, 2 * DM, HKP, KT, SEQ, -120.39728043259360f, (40.54651081081644f + 120.39728043259360f) / 1023.0f, 1.0f / (float)(SEQ - 1))
#ifndef FFT_EV
#define FFT_EV 0
#endif
#define HY_FFT(MODE_, GC_, DB_) do { for (int c = bx; c < DM; c += G) { const size_t co = (size_t)c * SEQ; \
            fftc::hyena_channel<MODE_, ((MODE_) == 2 ? FFT_EV : 0)>((fftc::lf2*)ldsl, VC0 + co, VC1 + co, KT + co, KT + (size_t)DM * SEQ + co, (GC_) + co, (GC_) + (size_t)DM * SEQ + co, args.in[I_HY_DBIAS][(DB_) + c], \
                                       VC0 + co, VC1 + co, Z3C + co, Z3C + (size_t)DM * SEQ + co, STASH + (size_t)bx * SEQ, KSPEC + (size_t)bx * SEQ, tid); } } while (0)
    RUN(16, HY_FILT(0), HY_FILT(0)); SEAM(16);
    RUN(17, HY_FFT(0, G1C, 0), HY_FFT(2, G1C, 0)); SEAM(17);
    RUN(18, HY_FILT(1), HY_FILT(1)); SEAM(18);
    RUN(19, HY_FFT(1, G2C, DM), HY_FFT(1, G2C, DM)); SEAM(19);
#define B20 hy_transpose_back(Z3C, XB, (LAS unsigned*)(ldsl + wave * 16384), gw, ngw, lane)
    RUN(20, B20, B20);
    SEAM(20);
#define B21 GEMM(EpiRes<true>, XB, Who_t, T, DM, DM, X2B, YB_C, DN_ALPHA)
    RUN(21, B21, B21);
    SEAM(21);
#define B22 ln_rows(YB_C, nullptr, XB, args.in[I_LN1G] + DM, args.in[I_LN1B] + DM, gw, ngw, lane)
    RUN(22, B22, B22);
    SEAM(22);
    FFN_LAYER(23, 1)
#ifdef SELFCHECK
    if (IN(29)) { const unsigned mask = __hip_atomic_load((unsigned*)(args.ws + WS_CTL) + CW_CHK, __ATOMIC_RELAXED, __HIP_MEMORY_SCOPE_AGENT);
        ln_rows(YB_A, OUT, nullptr, args.in[I_LN2G] + DM, args.in[I_LN2B] + DM, gw, ngw, lane, 1.0f + 0.1f * (float)mask); }
#else
    RUN(29, ln_rows(YB_A, OUT, nullptr, args.in[I_LN2G] + DM, args.in[I_LN2B] + DM, gw, ngw, lane), ln_rows(YB_A, OUT, nullptr, args.in[I_LN2G] + DM, args.in[I_LN2B] + DM, gw, ngw, lane));
#endif
#undef IN
#undef SEAM
#undef lane
#undef tid
#undef G
#undef bx
#undef gw
#undef ngw
}

extern "C" void kernel_launch(void* const* d_in, const int* in_sizes, int n_in, void* d_out, int out_size, void* d_ws, size_t ws_size, hipStream_t stream) {
    static int grid = 0;
    if (grid == 0) {
        if (n_in != 27 || in_sizes[0] != T * DM || out_size != T * DM || ws_size < WS_END) { fprintf(stderr, "kernel_launch: shape/workspace mismatch (n_in %d, in0 %d, out %d, ws %zu)\n", n_in, n_in > 0 ? in_sizes[0] : -1, out_size, ws_size); grid = -1; return; }
        int dev = 0, cus = 0, per_cu = 0;
        if (hipGetDevice(&dev) != hipSuccess || hipDeviceGetAttribute(&cus, hipDeviceAttributeMultiprocessorCount, dev) != hipSuccess) { grid = -1; return; }
        if (hipFuncSetAttribute((const void*)mega_fwd, hipFuncAttributeMaxDynamicSharedMemorySize, LDS_BYTES) != hipSuccess) { fprintf(stderr, "kernel_launch: hipFuncSetAttribute failed\n"); grid = -1; return; }
        if (hipOccupancyMaxActiveBlocksPerMultiprocessor(&per_cu, (const void*)mega_fwd, NWAVES * 64, LDS_BYTES) != hipSuccess || per_cu < 1) { fprintf(stderr, "kernel_launch: occupancy query says %d\n", per_cu); }
        (void)hipGetLastError();
        grid = cus;
    }
    if (grid < 0) return;
    if (hipMemsetAsync((char*)d_ws + WS_CTL, 0, CTL_ZERO_BYTES, stream) != hipSuccess) return;
    Args a{};
    for (int i = 0; i < 27; ++i) a.in[i] = (const float*)d_in[i];
    a.out = (float*)d_out; a.ws = (unsigned char*)d_ws;
#if MK_PER_PHASE
    for (int p = 0; p < N_PHASES; ++p) { a.ph_lo = p; a.ph_hi = p + 1; hipLaunchKernelGGL(mega_fwd, dim3(grid), dim3(NWAVES * 64), LDS_BYTES, stream, a); }
#else
    a.ph_lo = 0; a.ph_hi = N_PHASES; hipLaunchKernelGGL(mega_fwd, dim3(grid), dim3(NWAVES * 64), LDS_BYTES, stream, a);
#endif
}
```

```cpp
#include <hip/hip_runtime.h>
#include <cstdio>
#include <cstdint>
__device__ __forceinline__ int hw_lane() { int l; asm volatile("v_mbcnt_lo_u32_b32 %0, -1, 0\n\tv_mbcnt_hi_u32_b32 %0, -1, %0" : "=v"(l)); return l; }
namespace pg8 {
#define PG8_LAS __attribute__((address_space(3)))
typedef unsigned short bf16_t;
typedef short bf16x8 __attribute__((ext_vector_type(8)));
typedef float f32x4 __attribute__((ext_vector_type(4)));
typedef unsigned u32x4 __attribute__((ext_vector_type(4)));
constexpr int BM = 256, BK = 64, HALF = 128, HTB = HALF * BK * 2  , STAGE_BYTES = 8 * HTB, NXCD = 8, WGM = 8;

__host__ __device__ __forceinline__ int lds_byte(int r, int c) { const int st = (r >> 4) * 2 + (c >> 5), rr = r & 15, cc = c & 31, ob = rr * 64 + cc * 2; return st * 1024 + (ob ^ (((ob >> 9) & 1) << 5)); }
__host__ __device__ __forceinline__ void stage_rc(int b, int& R, int& C) { const int st = b / 1024, sb = b % 1024, swz = sb ^ (((sb >> 9) & 1) << 5); R = (st >> 1) * 16 + swz / 64; C = (st & 1) * 32 + (swz % 64) / 2; }
__host__ __device__ __forceinline__ int perm32(int rho) { const int n = rho >> 4, i = rho & 15; return 8 * (i >> 2) + 4 * n + (i & 3); }

struct Unit { int pm, pn; };
struct Gemm { const bf16_t* A; const bf16_t* Bt; int M, N, K; };

struct StaticOrder {
    int nM, nN, nwg, G, c;
    __host__ __device__ void init(int M, int N, int G_, int c_) { nM = M / BM; nN = N / BM; nwg = nM * nN; G = G_; c = c_; }
    __host__ __device__ bool next(int i, Unit& u) const {
        const long L = (long)i * G + c; if (L >= nwg) return false;
        int wgid = (int)L; { const int q = nwg / NXCD, r = nwg % NXCD, xcd = wgid % NXCD, off = wgid / NXCD; wgid = (xcd < r ? xcd * (q + 1) : r * (q + 1) + (xcd - r) * q) + off; }
        const int nig = WGM * nN, gid = wgid / nig, fm = gid * WGM, gsz = (nM - fm) < WGM ? (nM - fm) : WGM;
        u.pm = fm + ((wgid % nig) % gsz); u.pn = (wgid % nig) / gsz; return true;
    }
    __device__ __forceinline__ void a_ready(const Unit&) const {}
    __device__ __forceinline__ void done(const Unit&) const {}
};

__device__ __forceinline__ unsigned cvt_pk_bf16(float lo, float hi) { unsigned r; asm volatile("v_cvt_pk_bf16_f32 %0, %1, %2" : "=v"(r) : "v"(lo), "v"(hi)); return r; }
typedef float f32x2 __attribute__((ext_vector_type(2)));

struct EpiF32 {
    static constexpr bool PERM = false, AFTER_DRAIN = false;
    float* C; int ldc;
    __device__ __forceinline__ void operator()(const f32x4 (&acc)[2][2][4][2], const Unit& u_, int wr, int wc, int fr, int fq) const {
        Unit u = u_; asm volatile("" : "+s"(u.pm), "+s"(u.pn)); { const int l_ = hw_lane(); fr = l_ & 15; fq = l_ >> 4; }
        const int row0 = u.pm * BM + wr * 64 + fr, col0 = u.pn * BM + wc * 32 + 4 * fq;
#pragma unroll
        for (int ai = 0; ai < 2; ++ai)
#pragma unroll
            for (int m = 0; m < 4; ++m) { float* rowp = C + (size_t)(row0 + ai * HALF + m * 16) * ldc + col0;
#pragma unroll
                for (int bj = 0; bj < 2; ++bj)
#pragma unroll
                    for (int n = 0; n < 2; ++n) *(f32x4*)(rowp + bj * HALF + n * 16) = acc[ai][bj][m][n]; }
    }
};
struct EpiBf16 {
    static constexpr bool PERM = true, AFTER_DRAIN = false;
    bf16_t* O; int ldc; float scale;
    __device__ __forceinline__ void operator()(const f32x4 (&acc)[2][2][4][2], const Unit& u_, int wr, int wc, int fr, int fq) const {
        Unit u = u_; asm volatile("" : "+s"(u.pm), "+s"(u.pn)); { const int l_ = hw_lane(); fr = l_ & 15; fq = l_ >> 4; }
        const int row0 = u.pm * BM + wr * 64 + fr, col0 = u.pn * BM + wc * 32 + 8 * fq;
#pragma unroll
        for (int ai = 0; ai < 2; ++ai)
#pragma unroll
            for (int m = 0; m < 4; ++m) { bf16_t* rowp = O + (size_t)(row0 + ai * HALF + m * 16) * ldc + col0;
#pragma unroll
                for (int bj = 0; bj < 2; ++bj) { const f32x4 v0 = acc[ai][bj][m][0] * scale, v1 = acc[ai][bj][m][1] * scale;
                    u32x4 w; w.x = cvt_pk_bf16(v0[0], v0[1]); w.y = cvt_pk_bf16(v0[2], v0[3]); w.z = cvt_pk_bf16(v1[0], v1[1]); w.w = cvt_pk_bf16(v1[2], v1[3]);
                    *(u32x4*)(rowp + bj * HALF) = w; } }
    }
};
template <bool BASE_BF16> struct EpiRes {
    static constexpr bool PERM = true, AFTER_DRAIN = false;
    const void* base; bf16_t* out; float alpha;
    __device__ __forceinline__ void operator()(const f32x4 (&acc)[2][2][4][2], const Unit& u_, int wr, int wc, int fr, int fq) const {
        Unit u = u_; asm volatile("" : "+s"(u.pm), "+s"(u.pn)); { const int l_ = hw_lane(); fr = l_ & 15; fq = l_ >> 4; }
        const int row0 = u.pm * BM + wr * 64 + fr, col0 = u.pn * BM + wc * 32 + 8 * fq;
        if (BASE_BF16) {
            u32x4 bb[2][4][2];
#pragma unroll
            for (int ai = 0; ai < 2; ++ai)
#pragma unroll
                for (int m = 0; m < 4; ++m)
#pragma unroll
                    for (int bj = 0; bj < 2; ++bj) bb[ai][m][bj] = *(const u32x4*)((const bf16_t*)base + (size_t)(row0 + ai * HALF + m * 16) * 1024 + col0 + bj * HALF);
#pragma unroll
            for (int ai = 0; ai < 2; ++ai)
#pragma unroll
                for (int m = 0; m < 4; ++m) { const size_t off = (size_t)(row0 + ai * HALF + m * 16) * 1024 + col0;
#pragma unroll
                    for (int bj = 0; bj < 2; ++bj) { const u32x4 b = bb[ai][m][bj];
                        const f32x4 b0 = (f32x4){__uint_as_float(b.x << 16), __uint_as_float(b.x & 0xffff0000u), __uint_as_float(b.y << 16), __uint_as_float(b.y & 0xffff0000u)};
                        const f32x4 b1 = (f32x4){__uint_as_float(b.z << 16), __uint_as_float(b.z & 0xffff0000u), __uint_as_float(b.w << 16), __uint_as_float(b.w & 0xffff0000u)};
                        const f32x4 v0 = b0 * alpha + acc[ai][bj][m][0], v1 = b1 * alpha + acc[ai][bj][m][1];
                        u32x4 w; w.x = cvt_pk_bf16(v0[0], v0[1]); w.y = cvt_pk_bf16(v0[2], v0[3]); w.z = cvt_pk_bf16(v1[0], v1[1]); w.w = cvt_pk_bf16(v1[2], v1[3]);
                        *(u32x4*)(out + off + bj * HALF) = w; } }
        } else {
#pragma unroll
            for (int ai = 0; ai < 2; ++ai) { f32x4 bf[4][2][2];
#pragma unroll
                for (int m = 0; m < 4; ++m)
#pragma unroll
                    for (int bj = 0; bj < 2; ++bj) { const float* bp = (const float*)base + (size_t)(row0 + ai * HALF + m * 16) * 1024 + col0 + bj * HALF; bf[m][bj][0] = *(const f32x4*)bp; bf[m][bj][1] = *(const f32x4*)(bp + 4); }
#pragma unroll
                for (int m = 0; m < 4; ++m) { const size_t off = (size_t)(row0 + ai * HALF + m * 16) * 1024 + col0;
#pragma unroll
                    for (int bj = 0; bj < 2; ++bj) { const f32x4 v0 = bf[m][bj][0] * alpha + acc[ai][bj][m][0], v1 = bf[m][bj][1] * alpha + acc[ai][bj][m][1];
                        u32x4 w; w.x = cvt_pk_bf16(v0[0], v0[1]); w.y = cvt_pk_bf16(v0[2], v0[3]); w.z = cvt_pk_bf16(v1[0], v1[1]); w.w = cvt_pk_bf16(v1[2], v1[3]);
                        *(u32x4*)(out + off + bj * HALF) = w; } }
                asm volatile("" ::: "memory"); }
        }
    }
};
struct EpiKV {
    static constexpr bool PERM = true, AFTER_DRAIN = false;
    unsigned char* Kb; bf16_t* Vb;
    __device__ __forceinline__ void operator()(const f32x4 (&acc)[2][2][4][2], const Unit& u_, int wr, int wc, int fr, int fq) const {
        Unit u = u_; asm volatile("" : "+s"(u.pm), "+s"(u.pn)); { const int l_ = hw_lane(); fr = l_ & 15; fq = l_ >> 4; }
        const int row0 = u.pm * BM + wr * 64 + fr, col0 = u.pn * BM + wc * 32 + 8 * fq;
        typedef unsigned u32x2 __attribute__((ext_vector_type(2)));
#pragma unroll
        for (int bj = 0; bj < 2; ++bj) { const int c = col0 + bj * HALF; const bool isk = c < 1024;
#pragma unroll
            for (int ai = 0; ai < 2; ++ai)
#pragma unroll
                for (int m = 0; m < 4; ++m) { const int row = row0 + ai * HALF + m * 16; const f32x4 v0 = acc[ai][bj][m][0], v1 = acc[ai][bj][m][1];
                    if (isk) { u32x2 w; int t = __builtin_amdgcn_cvt_pk_fp8_f32(v0[0], v0[1], 0, false); t = __builtin_amdgcn_cvt_pk_fp8_f32(v0[2], v0[3], t, true); w.x = (unsigned)t;
                        t = __builtin_amdgcn_cvt_pk_fp8_f32(v1[0], v1[1], 0, false); t = __builtin_amdgcn_cvt_pk_fp8_f32(v1[2], v1[3], t, true); w.y = (unsigned)t;
                        *(u32x2*)(Kb + (size_t)row * 1536 + (c >> 7) * 192 + (c & 127)) = w; }
                    else { u32x4 w; w.x = cvt_pk_bf16(v0[0], v0[1]); w.y = cvt_pk_bf16(v0[2], v0[3]); w.z = cvt_pk_bf16(v1[0], v1[1]); w.w = cvt_pk_bf16(v1[2], v1[3]);
                        *(u32x4*)(Vb + (size_t)row * 1024 + (c - 1024)) = w; } } }
    }
};
#define DPP_SHR1 0x111
#define DPP_SHL1 0x101
#define DPP_SHL15 0x10F
#define DPP_SHR15 0x11F
template <int CTRL> __device__ __forceinline__ float dpp_mov(float old, float src) { return __int_as_float(__builtin_amdgcn_update_dpp(__float_as_int(old), __float_as_int(src), CTRL, 0xF, 0xF, false)); }
struct EpiConvSilu {
    static constexpr bool PERM = true, AFTER_DRAIN = false;
    bf16_t* H; const float* wcv; float* halo; PG8_LAS float* ex;
    __device__ __forceinline__ void operator()(const f32x4 (&acc)[2][2][4][2], const Unit& u_, int wr, int wc, int fr, int fq) const {
        Unit u = u_; asm volatile("" : "+s"(u.pm), "+s"(u.pn)); { const int l_ = hw_lane(); fr = l_ & 15; fq = l_ >> 4; }
        const int hc0 = wc * 32 + 8 * fq;
#pragma unroll
        for (int ai = 0; ai < 2; ++ai)
#pragma unroll
            for (int bj = 0; bj < 2; ++bj)
#pragma unroll
                for (int n = 0; n < 2; ++n) {
                    if (fr == 0)  *(PG8_LAS f32x4*)(ex + ((ai * 2 + wr) * 2 + 0) * 256 + bj * 128 + hc0 + 4 * n) = acc[ai][bj][0][n];
                    if (fr == 15) *(PG8_LAS f32x4*)(ex + ((ai * 2 + wr) * 2 + 1) * 256 + bj * 128 + hc0 + 4 * n) = acc[ai][bj][3][n]; }
        if (wr == 0 && fr < 2) {
#pragma unroll
            for (int bj = 0; bj < 2; ++bj)
#pragma unroll
                for (int n = 0; n < 2; ++n) *(f32x4*)(halo + ((size_t)u.pm * 4 + fr) * 5632 + u.pn * 256 + bj * 128 + hc0 + 4 * n) = acc[0][bj][0][n]; }
        if (wr == 1 && fr >= 14) {
#pragma unroll
            for (int bj = 0; bj < 2; ++bj)
#pragma unroll
                for (int n = 0; n < 2; ++n) *(f32x4*)(halo + ((size_t)u.pm * 4 + 2 + (fr - 14)) * 5632 + u.pn * 256 + bj * 128 + hc0 + 4 * n) = acc[1][bj][3][n]; }
        asm volatile("s_waitcnt lgkmcnt(0)" ::: "memory"); __builtin_amdgcn_s_barrier(); asm volatile("" ::: "memory");
        float wv[2][3][8];
        { const int cg = u.pn * 128 + hc0;
#pragma unroll
          for (int bj = 0; bj < 2; ++bj)
#pragma unroll
            for (int k = 0; k < 3; ++k) { const f32x4 t0 = *(const f32x4*)(wcv + k * 5632 + bj * 2816 + cg), t1 = *(const f32x4*)(wcv + k * 5632 + bj * 2816 + cg + 4);
                wv[bj][k][0] = t0[0]; wv[bj][k][1] = t0[1]; wv[bj][k][2] = t0[2]; wv[bj][k][3] = t0[3]; wv[bj][k][4] = t1[0]; wv[bj][k][5] = t1[1]; wv[bj][k][6] = t1[2]; wv[bj][k][7] = t1[3]; } }
#pragma unroll
        for (int ai = 0; ai < 2; ++ai) {
            const int ch = ai * 2 + wr, cp = ch > 0 ? ch - 1 : 0, cn = ch < 3 ? ch + 1 : 3;
            f32x4 pe[2][2], ne[2][2];
#pragma unroll
            for (int bj = 0; bj < 2; ++bj)
#pragma unroll
                for (int n = 0; n < 2; ++n) { pe[bj][n] = *(const PG8_LAS f32x4*)(ex + (cp * 2 + 1) * 256 + bj * 128 + hc0 + 4 * n); ne[bj][n] = *(const PG8_LAS f32x4*)(ex + (cn * 2 + 0) * 256 + bj * 128 + hc0 + 4 * n); }
#pragma unroll
            for (int m = 0; m < 4; ++m) {
                float hv[2][8];
#pragma unroll
                for (int bj = 0; bj < 2; ++bj)
#pragma unroll
                    for (int n = 0; n < 2; ++n)
#pragma unroll
                        for (int j = 0; j < 4; ++j) {
                            const float cur = acc[ai][bj][m][n][j];
                            const float pin = (m > 0) ? dpp_mov<DPP_SHL15>(0.f, acc[ai][bj][m > 0 ? m - 1 : 0][n][j]) : pe[bj][n][j];
                            const float nin = (m < 3) ? dpp_mov<DPP_SHR15>(0.f, acc[ai][bj][m < 3 ? m + 1 : 3][n][j]) : ne[bj][n][j];
                            const float prv = dpp_mov<DPP_SHR1>(pin, cur), nxt = dpp_mov<DPP_SHL1>(nin, cur);
                            hv[bj][4 * n + j] = wv[bj][0][4 * n + j] * prv + wv[bj][1][4 * n + j] * cur + wv[bj][2][4 * n + j] * nxt; }
                float o[8];
#pragma unroll
                for (int i = 0; i < 8; ++i) o[i] = hv[0][i] * hv[1][i] * __builtin_amdgcn_rcpf(1.f + __expf(-hv[1][i]));
                u32x4 w; w.x = cvt_pk_bf16(o[0], o[1]); w.y = cvt_pk_bf16(o[2], o[3]); w.z = cvt_pk_bf16(o[4], o[5]); w.w = cvt_pk_bf16(o[6], o[7]);
                *(u32x4*)(H + (size_t)(u.pm * BM + ai * HALF + wr * 64 + m * 16 + fr) * 2816 + u.pn * 128 + hc0) = w;
            }
        }
        asm volatile("s_waitcnt lgkmcnt(0)" ::: "memory"); __builtin_amdgcn_s_barrier(); asm volatile("" ::: "memory");
    }
};

struct EpiFilt {
    static constexpr bool PERM = false, AFTER_DRAIN = false;
    float* KT; int L; float d0, dstep, tinv;
    __device__ __forceinline__ void operator()(const f32x4 (&acc)[2][2][4][2], const Unit& u_, int wr, int wc, int fr, int fq) const {
        Unit u = u_; asm volatile("" : "+s"(u.pm), "+s"(u.pn)); { const int l_ = hw_lane(); fr = l_ & 15; fq = l_ >> 4; }
        const int row0 = u.pm * BM + wr * 64 + fr, col0 = u.pn * BM + wc * 32 + 4 * fq;
#pragma unroll
        for (int bj = 0; bj < 2; ++bj)
#pragma unroll
            for (int n = 0; n < 2; ++n) { const int c = col0 + bj * HALF + n * 16;
#pragma unroll
                for (int j = 0; j < 4; ++j) { const int cc = c + j, ch = cc & 1023; const float nd = -__builtin_fabsf(d0 + (float)ch * dstep) * tinv; float* dst = KT + (size_t)cc * L;
#pragma unroll
                    for (int ai = 0; ai < 2; ++ai)
#pragma unroll
                        for (int m = 0; m < 4; ++m) { const int l = row0 + ai * HALF + m * 16; dst[l] = acc[ai][bj][m][n][j] * __expf(nd * (float)l); } } }
    }
};

template <class Epi, class Sched, bool ALIGN_EPI = false, bool SP2 = false>
__device__ __forceinline__ void gemm_phase(PG8_LAS unsigned char* lds, const Gemm g, const Sched& S, const Epi& E, int wid_in) {
    const int wid = wid_in, lane = hw_lane(), tid = wid * 64 + lane, wr = wid >> 2, wc = wid & 3, fr = lane & 15, fq = lane >> 4;
    const int K = g.K, nt = K / BK;
    unsigned voffA[2], voffB[2];
#pragma unroll
    for (int i = 0; i < 2; ++i) { int R, C; stage_rc(tid * 16 + i * 8192, R, C); const int Rb = Epi::PERM ? ((R & ~31) + perm32(R & 31)) : R;
        voffA[i] = (unsigned)(R * K + C) * 2u; voffB[i] = (unsigned)(Rb * K + C) * 2u; }
    const size_t kstep = (size_t)(BK * 2);
    const size_t hstep = (size_t)HALF * K * 2;
    const size_t tstep = 2 * hstep;
    const unsigned ldsw = (unsigned)wid * 1024u;
    const int aoff = lds_byte(wr * 64 + fr, fq * 8), boff = lds_byte(wc * 32 + fr, fq * 8);
#define PG8_SA(b, h) (((b) * 2 + (h)) * HTB)
#define PG8_SB(b, h) ((4 + (b) * 2 + (h)) * HTB)
#define PG8_STAGE(bufoff, gbase, voff) do { _Pragma("unroll") for (int _i = 0; _i < 2; ++_i) \
        __builtin_amdgcn_global_load_lds((const unsigned*)((const char*)(gbase) + (voff)[_i]), (PG8_LAS unsigned*)(lds + (bufoff) + ldsw + _i * 8192), 16, 0, 0); } while (0)
#define PG8_LDA(dst, b, h) do { _Pragma("unroll") for (int m = 0; m < 4; ++m) _Pragma("unroll") for (int k = 0; k < 2; ++k) dst[m][k] = *(const PG8_LAS bf16x8*)(lds + PG8_SA(b, h) + aoff + m * 2048 + k * 1024); } while (0)
#define PG8_LDB(dst, b, h) do { _Pragma("unroll") for (int n = 0; n < 2; ++n) _Pragma("unroll") for (int k = 0; k < 2; ++k) dst[n][k] = *(const PG8_LAS bf16x8*)(lds + PG8_SB(b, h) + boff + n * 2048 + k * 1024); } while (0)
#define PG8_MMA(ai, bj, At, Bt) do { __builtin_amdgcn_s_setprio(1); _Pragma("unroll") for (int m = 0; m < 4; ++m) _Pragma("unroll") for (int n = 0; n < 2; ++n) _Pragma("unroll") for (int k = 0; k < 2; ++k) \
        acc[ai][bj][m][n] = __builtin_amdgcn_mfma_f32_16x16x32_bf16(Bt[n][k], At[m][k], acc[ai][bj][m][n], 0, 0, 0); __builtin_amdgcn_s_setprio(0); } while (0)
#define PG8_WAIT_V(n) asm volatile("s_waitcnt vmcnt(" #n ")" ::: "memory")
#define PG8_WAIT_L(n) asm volatile("s_waitcnt lgkmcnt(" #n ")" ::: "memory")
#define PG8_BAR __builtin_amdgcn_s_barrier()
#define PG8_SCHED __builtin_amdgcn_sched_barrier(0)
    Unit cur, nxt; int ui = 0;
    if (!S.next(0, cur)) return;
    f32x4 acc[2][2][4][2];
#pragma unroll
    for (int a = 0; a < 2; ++a)
#pragma unroll
        for (int b = 0; b < 2; ++b)
#pragma unroll
            for (int m = 0; m < 4; ++m)
#pragma unroll
                for (int n = 0; n < 2; ++n) acc[a][b][m][n] = (f32x4){0.f, 0.f, 0.f, 0.f};
    bf16x8 At[4][2], B0[2][2], B1[2][2];
    const char* cA = (const char*)g.A + (size_t)cur.pm * tstep; const char* cB = (const char*)g.Bt + (size_t)cur.pn * tstep;
    S.a_ready(cur);
    if constexpr (SP2) {
        PG8_STAGE(PG8_SB(0, 0), cB, voffB); PG8_STAGE(PG8_SB(0, 1), cB + hstep, voffB); PG8_STAGE(PG8_SA(0, 0), cA, voffA); PG8_STAGE(PG8_SA(0, 1), cA + hstep, voffA);
        if (wr == 1) PG8_BAR;
        PG8_WAIT_V(2); PG8_BAR;
        PG8_STAGE(PG8_SB(1, 0), cB + kstep, voffB); PG8_STAGE(PG8_SA(1, 0), cA + kstep, voffA); PG8_STAGE(PG8_SB(1, 1), cB + hstep + kstep, voffB);
        PG8_WAIT_V(6); PG8_BAR;
    } else {
        PG8_STAGE(PG8_SB(0, 0), cB, voffB); PG8_STAGE(PG8_SA(0, 0), cA, voffA); PG8_STAGE(PG8_SB(0, 1), cB + hstep, voffB); PG8_STAGE(PG8_SA(0, 1), cA + hstep, voffA);
        if (wr == 1) PG8_BAR;
        PG8_WAIT_V(4); PG8_BAR;
        PG8_STAGE(PG8_SB(1, 0), cB + kstep, voffB); PG8_STAGE(PG8_SA(1, 0), cA + kstep, voffA); PG8_STAGE(PG8_SB(1, 1), cB + hstep + kstep, voffB);
        PG8_WAIT_V(6); PG8_BAR;
    }
    for (;;) {
        const bool has_next = S.next(ui + 1, nxt);
        const char* nA = has_next ? (const char*)g.A + (size_t)nxt.pm * tstep : cA; const char* nB = has_next ? (const char*)g.Bt + (size_t)nxt.pn * tstep : cB;
        for (int t = 0; t < nt; t += 2) {
            const bool last = (t == nt - 2);
            const char* a1 = cA + (size_t)(t + 1) * kstep;
            const char* a2 = last ? nA : cA + (size_t)(t + 2) * kstep; const char* b2 = last ? nB : cB + (size_t)(t + 2) * kstep;
            const char* a3 = a2 + kstep; const char* b3 = b2 + kstep;
            if (last && has_next) S.a_ready(nxt);
            if constexpr (SP2) {
            PG8_LDB(B0, 0, 0); PG8_LDB(B1, 0, 1); PG8_SCHED; PG8_LDA(At, 0, 0); PG8_STAGE(PG8_SA(1, 1), a1 + hstep, voffA);
            PG8_WAIT_V(8); PG8_WAIT_L(0); PG8_BAR; PG8_MMA(0, 0, At, B0); PG8_MMA(0, 1, At, B1); PG8_BAR; PG8_SCHED;
            PG8_LDA(At, 0, 1); PG8_STAGE(PG8_SB(0, 0), b2, voffB); PG8_STAGE(PG8_SB(0, 1), b2 + hstep, voffB); PG8_STAGE(PG8_SA(0, 0), a2, voffA);
            PG8_WAIT_V(8); PG8_WAIT_L(0); PG8_BAR; PG8_MMA(1, 0, At, B0); PG8_MMA(1, 1, At, B1); PG8_BAR; PG8_SCHED;
            PG8_LDB(B0, 1, 0); PG8_LDB(B1, 1, 1); PG8_SCHED; PG8_LDA(At, 1, 0); PG8_STAGE(PG8_SA(0, 1), a2 + hstep, voffA);
            PG8_WAIT_V(8); PG8_WAIT_L(0); PG8_BAR; PG8_MMA(0, 0, At, B0); PG8_MMA(0, 1, At, B1); PG8_BAR; PG8_SCHED;
            PG8_LDA(At, 1, 1); PG8_STAGE(PG8_SB(1, 0), b3, voffB); PG8_STAGE(PG8_SB(1, 1), b3 + hstep, voffB); PG8_STAGE(PG8_SA(1, 0), a3, voffA);
            PG8_WAIT_V(8); PG8_WAIT_L(0); PG8_BAR; PG8_MMA(1, 0, At, B0); PG8_MMA(1, 1, At, B1); PG8_BAR; PG8_SCHED;
            } else {
            PG8_LDB(B0, 0, 0); PG8_SCHED; PG8_LDA(At, 0, 0); PG8_STAGE(PG8_SA(1, 1), a1 + hstep, voffA);
            PG8_WAIT_L(8); PG8_BAR; PG8_WAIT_L(0); PG8_MMA(0, 0, At, B0); PG8_BAR; PG8_SCHED;
            PG8_LDB(B1, 0, 1); PG8_STAGE(PG8_SB(0, 0), b2, voffB);
            PG8_BAR; PG8_WAIT_L(0); PG8_MMA(0, 1, At, B1); PG8_BAR;
            PG8_LDA(At, 0, 1); PG8_STAGE(PG8_SA(0, 0), a2, voffA);
            PG8_BAR; PG8_WAIT_L(0); PG8_MMA(1, 0, At, B0); PG8_BAR; PG8_SCHED;
            PG8_STAGE(PG8_SB(0, 1), b2 + hstep, voffB);
            PG8_WAIT_V(6); PG8_BAR; PG8_MMA(1, 1, At, B1); PG8_BAR;
            PG8_LDB(B0, 1, 0); PG8_SCHED; PG8_LDA(At, 1, 0); PG8_STAGE(PG8_SA(0, 1), a2 + hstep, voffA);
            PG8_WAIT_L(8); PG8_BAR; PG8_WAIT_L(0); PG8_MMA(0, 0, At, B0); PG8_BAR; PG8_SCHED;
            PG8_LDB(B1, 1, 1); PG8_STAGE(PG8_SB(1, 0), b3, voffB);
            PG8_BAR; PG8_WAIT_L(0); PG8_MMA(0, 1, At, B1); PG8_BAR;
            PG8_LDA(At, 1, 1); PG8_STAGE(PG8_SA(1, 0), a3, voffA);
            PG8_BAR; PG8_WAIT_L(0); PG8_MMA(1, 0, At, B0); PG8_BAR; PG8_SCHED;
            PG8_STAGE(PG8_SB(1, 1), b3 + hstep, voffB);
            PG8_WAIT_V(6); PG8_BAR; PG8_MMA(1, 1, At, B1); PG8_BAR;
            }
        }
        if constexpr (ALIGN_EPI) { if (wr == 0) PG8_BAR; }
        if constexpr (!Epi::AFTER_DRAIN) { E(acc, cur, wr, wc, fr, fq); S.done(cur); }
        if (!has_next) break;
#pragma unroll
        for (int a = 0; a < 2; ++a)
#pragma unroll
            for (int b = 0; b < 2; ++b)
#pragma unroll
                for (int m = 0; m < 4; ++m)
#pragma unroll
                    for (int n = 0; n < 2; ++n) acc[a][b][m][n] = (f32x4){0.f, 0.f, 0.f, 0.f};
        cur = nxt; cA = nA; cB = nB; ++ui;
        if constexpr (ALIGN_EPI) { if (wr == 1) PG8_BAR; }
    }
    PG8_WAIT_V(0);
    if constexpr (!ALIGN_EPI) { if (wr == 0) PG8_BAR; }
    PG8_BAR;
    if constexpr (Epi::AFTER_DRAIN) { E.fused(acc, cur, wr, wc, fr, fq, lds, wid, lane); S.done(cur); }
#undef PG8_SA
#undef PG8_SB
#undef PG8_STAGE
#undef PG8_LDA
#undef PG8_LDB
#undef PG8_MMA
#undef PG8_WAIT_V
#undef PG8_WAIT_L
#undef PG8_BAR
#undef PG8_SCHED
}
}
#define GAS __attribute__((address_space(1)))
#define LAS __attribute__((address_space(3)))
typedef unsigned short bf16;
typedef unsigned v4u __attribute__((ext_vector_type(4)));
typedef float f32x4 __attribute__((ext_vector_type(4)));
typedef short bf16x8 __attribute__((ext_vector_type(8)));
typedef GAS unsigned gu32;
typedef GAS unsigned long long gu64;
#define RLX_AGENT __ATOMIC_RELAXED, __HIP_MEMORY_SCOPE_AGENT
#define LDS_WAIT() asm volatile("s_waitcnt lgkmcnt(0)" ::: "memory")
#define VM_WAIT() asm volatile("s_waitcnt vmcnt(0)" ::: "memory")
__device__ __forceinline__ unsigned long long rt() { return __builtin_amdgcn_s_memrealtime(); }
__device__ __forceinline__ unsigned f2bf(float f) { unsigned u = __builtin_bit_cast(unsigned, f); return (u + 0x7fffu + ((u >> 16) & 1u)) >> 16; }
__device__ __forceinline__ unsigned pk2(float lo, float hi) { return f2bf(lo) | (f2bf(hi) << 16); }

#define XB_TMO      128
#define XB_XCNT(j)  (256  + 64 * (j))
#define XB_XSUB(j)  (1280 + 64 * (j))
#define XB_XGEN(j)  (2304 + 64 * (j))
#define XB_TOP      3328
#define XB_TOPGEN   3392
#define XCD_BAR_WORDS 3456
#define XB_SPIN_CAP (1u << 18)

__device__ __forceinline__ unsigned xb_ld(unsigned* p)              { return __hip_atomic_load(p, __ATOMIC_RELAXED, __HIP_MEMORY_SCOPE_AGENT); }
__device__ __forceinline__ unsigned xb_add(unsigned* p, unsigned v) { return __hip_atomic_fetch_add(p, v, __ATOMIC_RELAXED, __HIP_MEMORY_SCOPE_AGENT); }
__device__ __forceinline__ unsigned xb_xcc_id() { return (unsigned)__builtin_amdgcn_s_getreg((3 << 11) | 20) & 0xFu; }
#define XB_SPIN(cond, bar) do { unsigned _sp = 0; while (cond) { __builtin_amdgcn_s_sleep(1); \
    if ((++_sp & 255u) == 0u) { if (xb_ld(&(bar)[XB_TMO])) break; if (_sp > XB_SPIN_CAP) { atomicAdd(&(bar)[XB_TMO], 1u); break; } } } } while (0)

struct XcdBarrier {
    unsigned* bar; unsigned x; unsigned wv;
    volatile LAS unsigned* st;
};

__device__ __forceinline__ XcdBarrier xcd_barrier_post(unsigned* bar, volatile LAS unsigned* st, unsigned wv) {
    XcdBarrier b; b.bar = bar; b.x = xb_xcc_id(); b.st = st; b.wv = wv;
    if (wv == 0u && hw_lane() == 0) (void)xb_add(&bar[XB_XCNT(b.x)], 1u);
    return b;
}
__device__ __forceinline__ void xcd_barrier_complete(unsigned* bar, unsigned x, unsigned& nloc, unsigned& nx) {
    const unsigned G = gridDim.x * gridDim.y * gridDim.z;
    unsigned sum, cnt, mine, sp = 0u;
    for (;;) {
        sum = 0u; cnt = 0u; mine = 0u;
#pragma unroll
        for (unsigned j = 0; j < 16; ++j) { const unsigned c = xb_ld(&bar[XB_XCNT(j)]); sum += c; cnt += (c > 0u) ? 1u : 0u; mine = (j == x) ? c : mine; }
        if (sum == G) break;
        __builtin_amdgcn_s_sleep(1);
        if ((++sp & 255u) == 0u) { if (xb_ld(&bar[XB_TMO])) break; if (sp > XB_SPIN_CAP) { atomicAdd(&bar[XB_TMO], 1u); break; } }
    }
    nloc = mine > 0u ? mine : 1u; nx = cnt > 0u ? cnt : 1u;
}

__device__ __forceinline__ void xcd_barrier(const XcdBarrier& b) {
    asm volatile("s_waitcnt vmcnt(0)" ::: "memory");
    __syncthreads();
    if (b.wv == 0u && hw_lane() == 0) {
        unsigned* bar = b.bar;
        __builtin_amdgcn_s_waitcnt(0);
        unsigned nloc = b.st[0], nx = b.st[1];
        if (nloc == 0u) { xcd_barrier_complete(bar, b.x, nloc, nx); b.st[0] = nloc; b.st[1] = nx; }
        const unsigned old = xb_add(&bar[XB_XSUB(b.x)], 1u);
        const unsigned gen = old / nloc;
        if (old + 1u == (gen + 1u) * nloc) {
            __builtin_amdgcn_fence(__ATOMIC_RELEASE, "agent");
            asm volatile("s_waitcnt vmcnt(0)" ::: "memory");
            const unsigned og = xb_add(&bar[XB_TOP], 1u);
            const unsigned tg = og / nx;
            if (og + 1u == (tg + 1u) * nx) xb_add(&bar[XB_TOPGEN], 1u);
            else XB_SPIN(xb_ld(&bar[XB_TOPGEN]) == tg, bar);
            __builtin_amdgcn_fence(__ATOMIC_ACQUIRE, "agent");
            xb_add(&bar[XB_XGEN(b.x)], 1u);
            asm volatile("s_waitcnt vmcnt(0)" ::: "memory");
        } else {
            XB_SPIN(xb_ld(&bar[XB_XGEN(b.x)]) == gen, bar);
            __builtin_amdgcn_fence(__ATOMIC_ACQUIRE, "agent");
            asm volatile("s_waitcnt vmcnt(0)" ::: "memory");
        }
    }
    __syncthreads();
}
namespace attn {
using f32x16 = __attribute__((ext_vector_type(16))) float;
using u32x4  = __attribute__((ext_vector_type(4))) unsigned;
constexpr int NW = 8, QBLK = 32, KVBLK = 64, DQ = 192, DVV = 128;
constexpr int LDQ = 1536, LDO = 1024;
constexpr float THRL = 7.0f;
#define SBAR() __builtin_amdgcn_sched_barrier(0)
__device__ __forceinline__ int crow(int r, int hi) { return (r & 3) + 8 * (r >> 2) + 4 * hi; }
typedef int v8i __attribute__((ext_vector_type(8)));
typedef int v4i __attribute__((ext_vector_type(4)));
__device__ __forceinline__ int pk8(float a, float b, float c, float d) { int t = __builtin_amdgcn_cvt_pk_fp8_f32(a, b, 0, false); return __builtin_amdgcn_cvt_pk_fp8_f32(c, d, t, true); }
__device__ __forceinline__ unsigned cvtpk(float lo, float hi) { unsigned r; asm volatile("v_cvt_pk_bf16_f32 %0, %1, %2" : "=v"(r) : "v"(lo), "v"(hi)); return r; }

__device__ __forceinline__ float vmax3(float a, float b, float c) { float r; asm("v_max3_f32 %0, %1, %2, %3" : "=v"(r) : "v"(a), "v"(b), "v"(c)); return r; }
__device__ __forceinline__ float vmax2(float a, float b) { float r; asm("v_max_f32 %0, %1, %2" : "=v"(r) : "v"(a), "v"(b)); return r; }
__device__ __forceinline__ float softmaxPP(f32x16& p0, f32x16& p1, float& m_reg, f32x16& negm, float& l_reg, bool first, v8i& pa) {
  const float a0 = vmax3(p0[0], p0[1], p0[2]), a1 = vmax3(p0[3], p0[4], p0[5]), a2 = vmax3(p0[6], p0[7], p0[8]), a3 = vmax3(p0[9], p0[10], p0[11]), a4 = vmax3(p0[12], p0[13], p0[14]);
  const float a5 = vmax3(p1[0], p1[1], p1[2]), a6 = vmax3(p1[3], p1[4], p1[5]), a7 = vmax3(p1[6], p1[7], p1[8]), a8 = vmax3(p1[9], p1[10], p1[11]), a9 = vmax3(p1[12], p1[13], p1[14]);
  const float b0 = vmax3(a0, a1, a2), b1 = vmax3(a3, a4, a5), b2 = vmax3(a6, a7, a8), b3 = vmax3(a9, p0[15], p1[15]);
  float pmax = vmax2(vmax3(b0, b1, b2), b3);
  { auto rr = __builtin_amdgcn_permlane32_swap(__float_as_uint(pmax), __float_as_uint(pmax), false, false); pmax = vmax2(__uint_as_float(rr[0]), __uint_as_float(rr[1])); }
  float alpha = 1.f;
  if (__builtin_expect(first || __any(pmax > THRL), 0)) { const float dl = first ? pmax : vmax2(pmax, 0.f); alpha = first ? 1.f : __builtin_amdgcn_exp2f(-dl); m_reg += dl;
    for (int r = 0; r < 16; ++r) { p0[r] -= dl; p1[r] -= dl; }
    for (int r = 0; r < 16; ++r) negm[r] = -m_reg; }
  for (int r = 0; r < 16; ++r) p0[r] = __builtin_amdgcn_exp2f(p0[r]);
  for (int r = 0; r < 16; ++r) p1[r] = __builtin_amdgcn_exp2f(p1[r]);
  float s0 = (p0[0] + p0[1]) + (p0[2] + p0[3]), s1 = (p0[4] + p0[5]) + (p0[6] + p0[7]), s2 = (p0[8] + p0[9]) + (p0[10] + p0[11]), s3 = (p0[12] + p0[13]) + (p0[14] + p0[15]);
  s0 += (p1[0] + p1[1]) + (p1[2] + p1[3]); s1 += (p1[4] + p1[5]) + (p1[6] + p1[7]); s2 += (p1[8] + p1[9]) + (p1[10] + p1[11]); s3 += (p1[12] + p1[13]) + (p1[14] + p1[15]);
  float ps = (s0 + s1) + (s2 + s3);
  { auto rr = __builtin_amdgcn_permlane32_swap(__float_as_uint(ps), __float_as_uint(ps), false, false); ps = __uint_as_float(rr[0]) + __uint_as_float(rr[1]); }
  l_reg = l_reg * alpha + ps;
#pragma unroll
  for (int w = 0; w < 4; ++w) {
    pa[w] = __builtin_amdgcn_cvt_pk_fp8_f32(p0[4 * w], p0[4 * w + 1], pa[w], false); pa[w] = __builtin_amdgcn_cvt_pk_fp8_f32(p0[4 * w + 2], p0[4 * w + 3], pa[w], true);
    pa[4 + w] = __builtin_amdgcn_cvt_pk_fp8_f32(p1[4 * w], p1[4 * w + 1], pa[4 + w], false); pa[4 + w] = __builtin_amdgcn_cvt_pk_fp8_f32(p1[4 * w + 2], p1[4 * w + 3], pa[4 + w], true); }
  return alpha;
}
typedef unsigned short bf16r;
constexpr int KROWB = 192, LDKB = 1536, SHM_K3 = KVBLK * KROWB, SHM_V3 = KVBLK * DVV, NSLOT = 4;
constexpr int LDS_K3 = 0, LDS_V3 = NSLOT * SHM_K3, LDS_WS3 = LDS_V3 + NSLOT * SHM_V3, SHM_ATTN3 = LDS_WS3 + NW * 64 * 4;
__device__ __forceinline__ void glds16(const void* gsrc, unsigned lds_dst) { unsigned keep;
  asm volatile("s_mov_b32 %0, m0\n\ts_mov_b32 m0, %2\n\ts_nop 0\n\tglobal_load_lds_dwordx4 %1, off\n\ts_mov_b32 m0, %0" : "=&s"(keep) : "v"(gsrc), "s"(lds_dst) : "memory"); }
__device__ __forceinline__ float bfl(unsigned w) { return __uint_as_float(w << 16); }
__device__ __forceinline__ float bfh(unsigned w) { return __uint_as_float(w & 0xffff0000u); }
template <int AEXP> __device__ __forceinline__ void attn_unit(const bf16r* __restrict__ Qb, const unsigned char* __restrict__ Kh, const unsigned char* __restrict__ Vh, bf16r* __restrict__ Ob, const float* __restrict__ tab, int seq, char* lds, int wid) {
  const int lane = hw_lane(), r32 = lane & 31, hi = lane >> 5;
  const unsigned lds0 = (unsigned)(uintptr_t)lds;
  float* wsf = (float*)(lds + LDS_WS3) + wid * 64; float* li_l = wsf; float* al_l = wsf + 32;
  float m_reg = 0.f, l_reg = 0; f32x16 o[4] = {}; v8i qf[3]; f32x16 negm = {}; asm volatile("" : "+v"(negm));
  { const bf16r* Qw = Qb + (long)(wid * QBLK + r32) * LDQ + hi * 32;
#pragma unroll
    for (int s = 0; s < 2; ++s) { u32x4 q4[4];
#pragma unroll
      for (int i = 0; i < 4; ++i) q4[i] = *reinterpret_cast<const u32x4*>(Qw + s * 64 + i * 8);
#pragma unroll
      for (int i = 0; i < 4; ++i) { qf[s][2 * i] = pk8(bfl(q4[i][0]), bfh(q4[i][0]), bfl(q4[i][1]), bfh(q4[i][1])); qf[s][2 * i + 1] = pk8(bfl(q4[i][2]), bfh(q4[i][2]), bfl(q4[i][3]), bfh(q4[i][3])); } }
    { const float* tr = tab + (long)(wid * QBLK + r32) * 64 + hi * 32;
#pragma unroll
      for (int i = 0; i < 4; ++i) { const u32x4 qv = *reinterpret_cast<const u32x4*>(Qw + 128 + i * 8);
        const float4 t0 = *reinterpret_cast<const float4*>(tr + i * 8), t1 = *reinterpret_cast<const float4*>(tr + i * 8 + 4);
        float r_[8];
#define ROT(K_, Q_, C_, S_) do { r_[K_] = bfl(Q_) * (C_) - bfh(Q_) * (S_); r_[K_ + 1] = bfl(Q_) * (S_) + bfh(Q_) * (C_); } while (0)
        ROT(0, qv[0], t0.x, t0.y); ROT(2, qv[1], t0.z, t0.w); ROT(4, qv[2], t1.x, t1.y); ROT(6, qv[3], t1.z, t1.w);
#undef ROT
        qf[2][2 * i] = pk8(r_[0], r_[1], r_[2], r_[3]); qf[2][2 * i + 1] = pk8(r_[4], r_[5], r_[6], r_[7]); } } }
  int kof[2], vof;
#pragma unroll
  for (int i = 0; i < 2; ++i) { const int ob = (wid + 8 * i) * 1024 + 16 * lane, row = ob / KROWB, pp = (ob - row * KROWB) >> 4, sl = pp ^ ((row >> 2) & 3); kof[i] = row * LDKB + sl * 16; }
  { const int c = 16 * wid + (lane >> 2), sl = (lane & 3) ^ ((c >> 2) & 3); vof = c * seq + sl * 16; }
  const unsigned kdst = lds0 + LDS_K3 + wid * 1024, vdst = lds0 + LDS_V3 + wid * 1024;
#define DMA_KV(kt, ks, vt, vs) do { const unsigned char* kb_ = Kh + (long)(kt) * KVBLK * LDKB; const unsigned char* vb_ = Vh + (long)(vt) * KVBLK; const unsigned kd_ = (unsigned)__builtin_amdgcn_readfirstlane(kdst + (ks) * SHM_K3), vd_ = (unsigned)__builtin_amdgcn_readfirstlane(vdst + (vs) * SHM_V3); \
    glds16(kb_ + kof[0], kd_); if (wid < 4) glds16(kb_ + kof[1], kd_ + 8192); glds16(vb_ + vof, vd_); } while (0)
  int kq[2];
  { const int x = (r32 >> 2) & 3; const int kb = (int)lds0 + LDS_K3 + r32 * KROWB; kq[0] = kb + 16 * ((2 * hi) ^ x); kq[1] = kb + 16 * ((2 * hi + 1) ^ x); }
  int vq[2];
  { const int x = (r32 >> 2) & 3; const int vbb = (int)lds0 + LDS_V3 + r32 * 64; vq[0] = vbb + 16 * ((2 * hi) ^ x); vq[1] = vbb + 16 * ((2 * hi + 1) ^ x); }
#define RESC(a) do { if (__any((a) < 1.f)) { if (hi == 0) al_l[r32] = (a); asm volatile("s_waitcnt lgkmcnt(0)" ::: "memory"); \
    for (int d = 0; d < 4; ++d) for (int r = 0; r < 16; ++r) o[d][r] *= al_l[crow(r, hi)]; } } while (0)
  f32x16 p0 = {}, p1 = {}; float al; v8i pa = {}; const int NT = seq / KVBLK;
  int s0 = 0;
#define SL(d) ((s0 + (d)) & 3)
#define CLAMP(t) ((t) < NT ? (t) : NT - 1)
#define BAR() asm volatile("s_barrier" ::: "memory")
#define LGKM(n) do { asm volatile("s_waitcnt lgkmcnt(" #n ")" ::: "memory"); SBAR(); } while (0)
  DMA_KV(0, 0, 0, 0); DMA_KV(1, 1, 1, 1); DMA_KV(2, 2, 1, 1);
  asm volatile("s_waitcnt vmcnt(0)\n\ts_barrier" ::: "memory");
#ifndef ATT_PRIO
#define ATT_PRIO 0
#endif
#ifndef ATT_HALF
#define ATT_HALF(w) ((w) >= 4)
#endif
#define KRD(F0, F1, OFF) asm volatile("ds_read_b128 %0, %4 offset:%6\n\tds_read_b128 %1, %5 offset:%6\n\tds_read_b128 %2, %4 offset:%7\n\tds_read_b128 %3, %5 offset:%7" \
    : "=&v"(F0##l), "=&v"(F0##h), "=&v"(F1##l), "=&v"(F1##h) : "v"(a0_), "v"(a1_), "i"(OFF), "i"((OFF) + 32 * KROWB) : "memory")
#define VRD8(FL, FH, CB) asm volatile("ds_read_b128 %0, %2 offset:%4\n\tds_read_b128 %1, %3 offset:%4" : "=&v"(FL), "=&v"(FH) : "v"(v0_), "v"(v1_), "i"((CB) * 2048) : "memory")
#define PV8(OD, FL, FH) do { if (AEXP == 2 || AEXP == 5) { asm volatile("" :: "v"(FL), "v"(FH)); break; } OD = __builtin_amdgcn_mfma_scale_f32_32x32x64_f8f6f4(pa, F8(FL, FH), OD, 0, 0, 0, 0, 0, 0); } while (0)
#define F8(L, H) (v8i){L[0], L[1], L[2], L[3], H[0], H[1], H[2], H[3]}
#define QK8(F0, F1, S, C0, C1) do { if (AEXP == 2 || AEXP == 5) { asm volatile("" :: "v"(F0##l), "v"(F1##h)); break; } p0 = __builtin_amdgcn_mfma_scale_f32_32x32x64_f8f6f4(F8(F0##l, F0##h), qf[S], C0, 0, 0, 0, 0, 0, 0); p1 = __builtin_amdgcn_mfma_scale_f32_32x32x64_f8f6f4(F8(F1##l, F1##h), qf[S], C1, 0, 0, 0, 0, 0, 0); } while (0)
#define MPH(PREV) do { const int ko_ = s0 * SHM_K3; const int a0_ = kq[0] + ko_, a1_ = kq[1] + ko_; const int vo_ = SL(3) * SHM_V3; const int v0_ = vq[0] + vo_, v1_ = vq[1] + vo_; \
    v4i ka0l, ka0h, ka1l, ka1h, kb0l, kb0h, kb1l, kb1h, v0l, v0h, v1l, v1h, v2l, v2h, v3l, v3h; \
    SBAR(); \
    KRD(ka0, ka1, 0); KRD(kb0, kb1, 64);                       \
    LGKM(4);  QK8(ka0, ka1, 0, negm, negm); \
    KRD(ka0, ka1, 128); VRD8(v0l, v0h, 0); VRD8(v1l, v1h, 1);   \
    LGKM(8);  QK8(kb0, kb1, 1, p0, p1); \
    VRD8(v2l, v2h, 2); VRD8(v3l, v3h, 3);                       \
    LGKM(8);  QK8(ka0, ka1, 2, p0, p1); \
    if (PREV) { LGKM(4); PV8(o[0], v0l, v0h); PV8(o[1], v1l, v1h); LGKM(0); PV8(o[2], v2l, v2h); PV8(o[3], v3l, v3h); } else { LGKM(0); } \
    } while (0)
#define WB() do { if (wid < 4) asm volatile("s_waitcnt vmcnt(3)\n\ts_barrier" ::: "memory"); else asm volatile("s_waitcnt vmcnt(2)\n\ts_barrier" ::: "memory"); } while (0)
#define VPH(j) do { if (AEXP != 3 && AEXP != 5) DMA_KV(CLAMP((j) + 3), SL(3), CLAMP((j) + 2), SL(2)); if (AEXP != 1 && AEXP != 5) { al = softmaxPP(p0, p1, m_reg, negm, l_reg, (j) == 0, pa); RESC(al); } else { asm volatile("" : "+v"(p0), "+v"(p1), "+v"(pa)); } s0 = SL(1); } while (0)
#define DRAIN() do { const int vo_ = SL(3) * SHM_V3; const int v0_ = vq[0] + vo_, v1_ = vq[1] + vo_; v4i v0l, v0h, v1l, v1h, v2l, v2h, v3l, v3h; \
    VRD8(v0l, v0h, 0); VRD8(v1l, v1h, 1); VRD8(v2l, v2h, 2); VRD8(v3l, v3h, 3); LGKM(0); PV8(o[0], v0l, v0h); PV8(o[1], v1l, v1h); PV8(o[2], v2l, v2h); PV8(o[3], v3l, v3h); } while (0)
  { const bool trail = ATT_HALF(wid);
    if (AEXP == 6 && trail) {
      BAR();
#pragma unroll 1
      for (int j = 0; j + 1 < NT; ++j) { DMA_KV(CLAMP((j) + 3), SL(3), CLAMP((j) + 2), SL(2)); s0 = SL(1); WB(); }
    } else {
    if (trail) BAR();
    if (ATT_PRIO == 1) __builtin_amdgcn_s_setprio(1);
    MPH(false); if (ATT_PRIO == 1) __builtin_amdgcn_s_setprio(0); if (!trail) WB();
#pragma unroll 1
    for (int j = 0; j + 1 < NT; ++j) { if (ATT_PRIO == 2) __builtin_amdgcn_s_setprio(1); VPH(j); if (ATT_PRIO == 2) __builtin_amdgcn_s_setprio(0); if (trail) WB(); if (ATT_PRIO == 1) __builtin_amdgcn_s_setprio(1); MPH(true); if (ATT_PRIO == 1) __builtin_amdgcn_s_setprio(0); if (!trail) WB(); }
    VPH(NT - 1); DRAIN(); } }
  if (hi == 0) li_l[r32] = l_reg; asm volatile("s_waitcnt lgkmcnt(0)" ::: "memory");
  float rli[16];
#pragma unroll
  for (int r = 0; r < 16; ++r) rli[r] = __builtin_amdgcn_rcpf(li_l[crow(r, hi)]);
  bf16r* Ow = Ob + (long)(wid * QBLK) * LDO;
#pragma unroll
  for (int r = 0; r < 16; ++r) { const int orow = crow(r, hi);
#pragma unroll
    for (int d0 = 0; d0 < 4; ++d0) { const unsigned w = cvtpk(o[d0][r] * rli[r], 0.f); Ow[(long)orow * LDO + d0 * 32 + r32] = (bf16r)(w & 0xffffu); } }
  asm volatile("s_waitcnt vmcnt(0) lgkmcnt(0)\n\ts_barrier" ::: "memory");
#undef DMA_KV
#undef RESC
#undef SL
#undef CLAMP
#undef BAR
#undef LGKM
#undef KRD
#undef VRD8
#undef PV8
#undef F8
#undef QK8
#undef MPH
#undef WB
#undef DRAIN
#undef VPH
}
#undef SBAR
}

namespace fftc {
#define FGAS __attribute__((address_space(1)))
typedef float f2 __attribute__((ext_vector_type(2)));
typedef __attribute__((address_space(3))) f2 lf2;
constexpr int L = 16384;
constexpr int FFT_LDS_BYTES = 17920 * 8;
__device__ static const float TW64C[32] = { 1.000000000e+00f, 9.951847267e-01f, 9.807852804e-01f, 9.569403357e-01f, 9.238795325e-01f, 8.819212643e-01f, 8.314696123e-01f, 7.730104534e-01f, 7.071067812e-01f, 6.343932842e-01f, 5.555702330e-01f, 4.713967368e-01f, 3.826834324e-01f, 2.902846773e-01f, 1.950903220e-01f, 9.801714033e-02f, 0.0f, -9.801714033e-02f, -1.950903220e-01f, -2.902846773e-01f, -3.826834324e-01f, -4.713967368e-01f, -5.555702330e-01f, -6.343932842e-01f, -7.071067812e-01f, -7.730104534e-01f, -8.314696123e-01f, -8.819212643e-01f, -9.238795325e-01f, -9.569403357e-01f, -9.807852804e-01f, -9.951847267e-01f };
__device__ static const float TW64S[32] = { 0.000000000e+00f, 9.801714033e-02f, 1.950903220e-01f, 2.902846773e-01f, 3.826834324e-01f, 4.713967368e-01f, 5.555702330e-01f, 6.343932842e-01f, 7.071067812e-01f, 7.730104534e-01f, 8.314696123e-01f, 8.819212643e-01f, 9.238795325e-01f, 9.569403357e-01f, 9.807852804e-01f, 9.951847267e-01f, 1.000000000e+00f, 9.951847267e-01f, 9.807852804e-01f, 9.569403357e-01f, 9.238795325e-01f, 8.819212643e-01f, 8.314696123e-01f, 7.730104534e-01f, 7.071067812e-01f, 6.343932842e-01f, 5.555702330e-01f, 4.713967368e-01f, 3.826834324e-01f, 2.902846773e-01f, 1.950903220e-01f, 9.801714033e-02f };
__device__ __forceinline__ f2 cmul(f2 a, f2 w) { return (f2){a.x * w.x - a.y * w.y, a.x * w.y + a.y * w.x}; }
template <bool INV> __device__ __forceinline__ f2 twmul(f2 d, int tw) {
    if (tw == 0) return d;
    if (tw == 16) return INV ? (f2){-d.y, d.x} : (f2){d.y, -d.x};
    const float c = TW64C[tw], s = TW64S[tw];
    return INV ? (f2){d.x * c - d.y * s, d.y * c + d.x * s} : (f2){d.x * c + d.y * s, d.y * c - d.x * s};
}
template <int N, int S, bool INV> __device__ __forceinline__ void dif_stage(f2 (&v)[N]) {
#pragma unroll
    for (int blk = 0; blk < N; blk += 2 * S)
#pragma unroll
        for (int i = 0; i < S; ++i) { const f2 a = v[blk + i], b = v[blk + i + S]; v[blk + i] = a + b; v[blk + i + S] = twmul<INV>(a - b, i * (32 / S)); }
    if constexpr (S > 1) dif_stage<N, S / 2, INV>(v);
}
constexpr int bitrev(int k, int bits) { int r = 0; for (int b = 0; b < bits; ++b) r |= ((k >> b) & 1) << (bits - 1 - b); return r; }
template <int N, bool INV> __device__ __forceinline__ void dft(f2 (&v)[N]) {
    dif_stage<N, N / 2, INV>(v);
    constexpr int bits = (N == 32) ? 5 : 4;
    f2 t[N];
#pragma unroll
    for (int k = 0; k < N; ++k) t[k] = v[bitrev(k, bits)];
#pragma unroll
    for (int k = 0; k < N; ++k) v[k] = t[k];
}
template <bool CONJ> __device__ __forceinline__ void apply_pow32(f2 (&v)[32], f2 w) {
    if (CONJ) w.y = -w.y;
    f2 lo[8]; lo[0] = (f2){1.f, 0.f}; lo[1] = w; lo[2] = cmul(w, w); lo[3] = cmul(lo[2], w); lo[4] = cmul(lo[2], lo[2]); lo[5] = cmul(lo[4], w); lo[6] = cmul(lo[4], lo[2]); lo[7] = cmul(lo[4], lo[3]);
#pragma unroll
    for (int k = 1; k < 32; ++k) if (k & 7) v[k] = cmul(v[k], lo[k & 7]);
    const f2 p8 = cmul(lo[4], lo[4]), p16 = cmul(p8, p8), p24 = cmul(p16, p8);
#pragma unroll
    for (int k = 8; k < 16; ++k) v[k] = cmul(v[k], p8);
#pragma unroll
    for (int k = 16; k < 24; ++k) v[k] = cmul(v[k], p16);
#pragma unroll
    for (int k = 24; k < 32; ++k) v[k] = cmul(v[k], p24);
}
__device__ __forceinline__ int opaque(int x) { asm volatile("" : "+v"(x)); return x; }
__device__ __forceinline__ f2 cis_pi(float x) { float s, c; sincospif(x, &s, &c); return (f2){c, s}; }
#define FPHYS(d1, d2, d3) ((d1) * 560 + (d2) * 17 + (d3))
#define FSYNC() __syncthreads()
template <int EV> __device__ __forceinline__ void pass1_fwd(lf2* X, f2 (&v)[32], int tid) {
    tid = opaque(tid);
    if (EV != 1) { dft<32, false>(v);
    apply_pow32<false>(v, cis_pi(-(float)tid * (2.0f / L))); }
    const int base = (tid >> 4) * 17 + (tid & 15);
#pragma unroll
    for (int k = 0; k < 32; ++k) { if (EV != 2) X[base + k * 560] = v[k]; else asm volatile("" :: "v"(v[k])); }
}
template <int EV> __device__ __forceinline__ void pass1_inv(const lf2* X, f2 (&v)[32], int tid) {
    tid = opaque(tid);
    const int base = (tid >> 4) * 17 + (tid & 15);
#pragma unroll
    for (int k = 0; k < 32; ++k) { if (EV != 2) v[k] = X[base + k * 560]; else v[k] = (f2){(float)(tid + k), 2.f}; }
    if (EV != 1) { apply_pow32<true>(v, cis_pi(-(float)tid * (2.0f / L)));
    dft<32, true>(v); }
}
template <bool INV, int EV> __device__ __forceinline__ void pass2(lf2* X, int tid) {
    tid = opaque(tid);
    const int base = (tid >> 4) * 560 + (tid & 15); f2 v[32];
    if (EV == 2) { for (int k = 0; k < 32; ++k) v[k] = (f2){(float)(tid + k), 1.f}; asm volatile("" : "+v"(v[0]), "+v"(v[7]), "+v"(v[19])); }
#pragma unroll
    for (int k = 0; k < 32; ++k) if (EV != 2) v[k] = X[base + k * 17];
    const f2 w = cis_pi(-(float)(tid & 15) * (2.0f / 512.0f));
    if (EV != 1) { if (INV) { apply_pow32<true>(v, w); dft<32, true>(v); } else { dft<32, false>(v); apply_pow32<false>(v, w); } }
#pragma unroll
    for (int k = 0; k < 32; ++k) { if (EV != 2) X[base + k * 17] = v[k]; else asm volatile("" :: "v"(v[k])); }
}
template <bool KMODE, int EV> __device__ __forceinline__ void pass3(lf2* X, f2 (&KR)[2][16], int tid) {
    tid = opaque(tid);
#pragma unroll
    for (int i = 0; i < 2; ++i) { const int base = ((tid >> 5) + 16 * i) * 560 + (tid & 31) * 17; f2 u[16];
#pragma unroll
        for (int k = 0; k < 16; ++k) u[k] = X[base + k];
        if (EV != 1) dft<16, false>(u);
        if (KMODE) {
#pragma unroll
            for (int k = 0; k < 16; ++k) KR[i][k] = u[k];
        } else {
#pragma unroll
            for (int k = 0; k < 16; ++k) u[k] = cmul(u[k], KR[i][k]);
            if (EV != 1) dft<16, true>(u);
#pragma unroll
            for (int k = 0; k < 16; ++k) X[base + k] = u[k];
        } }
}
template <int EV> __device__ __forceinline__ void kernel_spectrum(lf2* X, f2 (&v)[32], f2 (&KS)[2][16], int tid) {
    pass1_fwd<EV>(X, v, tid); FSYNC(); pass2<false, EV>(X, tid); FSYNC(); pass3<true, EV>(X, KS, tid); FSYNC();
}
template <int EV> __device__ __forceinline__ void conv_roundtrip(lf2* X, f2 (&v)[32], f2 (&KS)[2][16], int tid) {
    pass1_fwd<EV>(X, v, tid); FSYNC(); pass2<false, EV>(X, tid); FSYNC(); pass3<false, EV>(X, KS, tid); FSYNC(); pass2<true, EV>(X, tid); FSYNC(); pass1_inv<EV>(X, v, tid); FSYNC();
}
__device__ __forceinline__ void modulate(f2 (&v)[32], int tid) {
    const f2 wj = cis_pi(-(float)opaque(tid) * (1.0f / L));
#pragma unroll
    for (int k = 0; k < 32; ++k) v[k] = twmul<false>(cmul(v[k], wj), k);
}
__device__ __forceinline__ void demodulate(f2 (&v)[32], int tid) {
    f2 wj = cis_pi(-(float)opaque(tid) * (1.0f / L)); wj.y = -wj.y;
#pragma unroll
    for (int k = 0; k < 32; ++k) v[k] = twmul<true>(cmul(v[k], wj), k);
}
__device__ __forceinline__ float bf2f(unsigned short u) { return __uint_as_float((unsigned)u << 16); }
__device__ __forceinline__ unsigned short f2bf_rne(float f) { unsigned u = __float_as_uint(f); return (unsigned short)((u + 0x7fffu + ((u >> 16) & 1u)) >> 16); }
template <typename T> __device__ __forceinline__ FGAS T* pstep(FGAS T* p, int n) { p += n; asm volatile("" : "+v"(p)); return p; }
template <int MODE, int EV = 0> __device__ __forceinline__ void hyena_channel(lf2* X, const float* z0, const float* z1, const float* hf, const float* hb,
                                                                        const unsigned short* g0, const unsigned short* g1, float dbias, float* zo0, float* zo1,
                                                                        unsigned short* o0, unsigned short* o1, f2* stash, f2* KSg, int tid) {
    f2 v[32]; f2 KS[2][16];
    { FGAS const float* pf = (FGAS const float*)hf + opaque(tid); FGAS const float* pb = (FGAS const float*)hb + ((L - opaque(tid)) & (L - 1));
#pragma unroll
      for (int k = 0; k < 32; ++k) { v[k] = (EV == 3) ? (f2){1.f, 0.f} : (f2){*pf + *pb, 0.f}; pf = pstep(pf, 512); pb = (k == 0) ? pstep((FGAS const float*)hb + (L - 512 - tid), 0) : pstep(pb, -512); } }
    kernel_spectrum<EV>(X, v, KS, tid);
    { FGAS const float* p0 = (FGAS const float*)z0 + opaque(tid); FGAS const float* p1 = (FGAS const float*)z1 + opaque(tid);
#pragma unroll
      for (int k = 0; k < 32; ++k) { v[k] = (EV == 3) ? (f2){1.f, 2.f} : (f2){*p0, *p1}; p0 = pstep(p0, 512); p1 = pstep(p1, 512); } }
    conv_roundtrip<EV>(X, v, KS, tid);
    { FGAS f2* ps = (FGAS f2*)stash + opaque(tid);
#pragma unroll
      for (int k = 0; k < 32; ++k) { *ps = v[k]; ps = pstep(ps, 512); } }
    { FGAS const float* pf = (FGAS const float*)hf + opaque(tid); FGAS const float* pb = (FGAS const float*)hb + ((L - opaque(tid)) & (L - 1));
#pragma unroll
      for (int k = 0; k < 32; ++k) { const float hbv = (EV == 3) ? 1.f : *pb; v[k] = (f2){*pf + ((k == 0 && tid == 0) ? hbv : -hbv), 0.f}; pf = pstep(pf, 512); pb = (k == 0) ? pstep((FGAS const float*)hb + (L - 512 - tid), 0) : pstep(pb, -512); } }
    modulate(v, tid);
    kernel_spectrum<EV>(X, v, KS, tid);
    { FGAS const float* p0 = (FGAS const float*)z0 + opaque(tid); FGAS const float* p1 = (FGAS const float*)z1 + opaque(tid);
#pragma unroll
      for (int k = 0; k < 32; ++k) { v[k] = (EV == 3) ? (f2){1.f, 2.f} : (f2){*p0, *p1}; p0 = pstep(p0, 512); p1 = pstep(p1, 512); } }
    modulate(v, tid);
    conv_roundtrip<EV>(X, v, KS, tid);
    demodulate(v, tid);
    const float sc = 1.0f / (2.0f * L);
    { FGAS const f2* ps = (FGAS const f2*)stash + opaque(tid); FGAS const float* p0 = (FGAS const float*)z0 + opaque(tid); FGAS const float* p1 = (FGAS const float*)z1 + opaque(tid); FGAS const unsigned short* q0 = (FGAS const unsigned short*)g0 + opaque(tid); FGAS const unsigned short* q1 = (FGAS const unsigned short*)g1 + opaque(tid);
      FGAS float* w0 = (FGAS float*)zo0 + opaque(tid); FGAS float* w1 = (FGAS float*)zo1 + opaque(tid); FGAS unsigned short* b0 = (FGAS unsigned short*)o0 + opaque(tid); FGAS unsigned short* b1 = (FGAS unsigned short*)o1 + opaque(tid);
#pragma unroll
      for (int k = 0; k < 32; ++k) { const f2 y = (*ps + v[k]) * sc;
          const float r0 = bf2f(*q0) * (y.x + dbias * *p0), r1 = bf2f(*q1) * (y.y + dbias * *p1);
          if (MODE == 1) { *b0 = f2bf_rne(r0); *b1 = f2bf_rne(r1); b0 = pstep(b0, 512); b1 = pstep(b1, 512); } else if (MODE == 0) { *w0 = r0; *w1 = r1; w0 = pstep(w0, 512); w1 = pstep(w1, 512); } else { asm volatile("" :: "v"(r0), "v"(r1)); }
          ps = pstep(ps, 512); p0 = pstep(p0, 512); p1 = pstep(p1, 512); q0 = pstep(q0, 512); q1 = pstep(q1, 512); } }
}
#undef FPHYS
#undef FGAS
}

constexpr int BATCH = 2, SEQ = 16384, DM = 1024, T = BATCH * SEQ;
constexpr int NH = 8, DNOPE = 128, DROPE = 64, DQK = 192, DVH = 128, QLORA = 384, KVLORA = 256, MLA_IN = 704, MLA_INP = 768;
constexpr int DFF = 2816, NUP = 2 * DFF;
constexpr int HF = 64, HEMB = 33, HKP = 256;
constexpr float LN_EPS = 1e-5f, RMS_EPS = 1e-6f;
constexpr float DN_ALPHA = 1.4142135623730951f;
constexpr float QSCALE = 0.07216878364870322f * 1.4426950408889634f;
constexpr int NWAVES = 8;

constexpr size_t MiB = 1u << 20;
constexpr size_t WS_CTL = 0, CTL_ZERO_BYTES = 64 * 1024;
constexpr size_t WS_TW1 = 256 * 1024, WS_MOD = 384 * 1024, WS_TW2 = 512 * 1024;
constexpr size_t WS_WIN = 2 * MiB, WS_WUQ = 4 * MiB, WS_WUKV = 6 * MiB, WS_WO = 7 * MiB, WS_WHIN = 9 * MiB, WS_WHO = 15 * MiB, WS_WUP = 17 * MiB, WS_WDN = 39 * MiB, WS_WFO = 50 * MiB, WS_H3 = 52 * MiB;
constexpr size_t WS_XB = 60 * MiB;
constexpr size_t WS_XF = 124 * MiB;
constexpr size_t WS_S = 252 * MiB;
constexpr size_t WS_END = 512 * MiB;
constexpr size_t WS_CQN = WS_XF, WS_CKVN = WS_XF + 24 * MiB, WS_ROPE = WS_XF + 40 * MiB;
constexpr size_t WS_Q = WS_S, WS_K = WS_S + 96 * MiB, WS_VT = WS_S + 144 * MiB, WS_V = WS_S + 192 * MiB;
constexpr size_t WS_UH = WS_S;
constexpr size_t WS_U = WS_S;
constexpr size_t WS_VC0 = WS_XB, WS_VC1 = WS_S + 192 * MiB;
constexpr size_t WS_KT = WS_S, WS_STASH = WS_S + 128 * MiB, WS_KSPEC = WS_S + 160 * MiB;
constexpr int CW_TMO = 0, CW_CODE = 1, CW_BAR = 4096, CW_CHK = 8192;

constexpr int RING_BYTES = 131072;
constexpr int LDS_BYTES = 147456;
constexpr int MISC_OFF = LDS_BYTES - 512;
static_assert(fftc::FFT_LDS_BYTES <= MISC_OFF && attn::SHM_ATTN3 <= RING_BYTES, "LDS map");

typedef pg8::bf16_t bf16;
typedef unsigned u32x4t __attribute__((ext_vector_type(4)));
typedef unsigned u32x2t __attribute__((ext_vector_type(2)));
typedef float f32x2 __attribute__((ext_vector_type(2)));
__device__ __forceinline__ float wave_sum(float v) {
#pragma unroll
    for (int o = 1; o < 64; o <<= 1) v += __shfl_xor(v, o);
    return v;
}
__device__ __forceinline__ float bf_lo(unsigned w) { return __uint_as_float(w << 16); }
__device__ __forceinline__ float bf_hi(unsigned w) { return __uint_as_float(w & 0xffff0000u); }
__device__ __forceinline__ unsigned pkbf(float lo, float hi) { return pg8::cvt_pk_bf16(lo, hi); }

template <class ColMap> __device__ __forceinline__ void transpose_item(const float* W, int K, int N, bf16* WT, int ldk, LAS float* scr, int item, int nblk, int lane, const ColMap& cm) {
    const int kb = item / nblk, nb = item % nblk, k0 = 64 * kb, n0 = 32 * nb;
    const int q4 = 4 * (lane & 7), s0 = cm(n0 + q4), s1 = cm(n0 + q4 + 1), s2 = cm(n0 + q4 + 2), s3 = cm(n0 + q4 + 3);
    const bool vec = (s0 >= 0) && (s1 == s0 + 1) && (s2 == s0 + 2) && (s3 == s0 + 3) && ((s0 & 3) == 0) && ((N & 3) == 0);
#pragma unroll
    for (int i = 0; i < 8; ++i) { const int kk = (lane >> 3) + 8 * i; const float* wr = W + (size_t)(k0 + kk) * N; f32x4 v;
        if (vec) v = *(const f32x4*)(wr + s0);
        else { v.x = s0 >= 0 ? wr[s0] : 0.f; v.y = s1 >= 0 ? wr[s1] : 0.f; v.z = s2 >= 0 ? wr[s2] : 0.f; v.w = s3 >= 0 ? wr[s3] : 0.f; }
        LAS float* d = scr + kk * 33 + q4; d[0] = v.x; d[1] = v.y; d[2] = v.z; d[3] = v.w; }
    asm volatile("s_waitcnt lgkmcnt(0)" ::: "memory");
    const int c = lane & 7;
#pragma unroll
    for (int j = 0; j < 4; ++j) { const int n = (lane >> 3) + 8 * j; const LAS float* s = scr + (8 * c) * 33 + n;
        u32x4t o; o.x = pkbf(s[0 * 33], s[1 * 33]); o.y = pkbf(s[2 * 33], s[3 * 33]); o.z = pkbf(s[4 * 33], s[5 * 33]); o.w = pkbf(s[6 * 33], s[7 * 33]);
        *(u32x4t*)(WT + (size_t)(n0 + n) * ldk + k0 + 8 * c) = o; }
    asm volatile("s_waitcnt lgkmcnt(0)" ::: "memory");
}
struct CmIdent { __device__ __forceinline__ int operator()(int n) const { return n; } };
struct CmWin { __device__ __forceinline__ int operator()(int n) const { if (n < 640) return n; if (n >= 704) return -1; const int i = n - 640; return 640 + (i & 1) * 32 + (i >> 1); } };
struct CmWuq { __device__ __forceinline__ int operator()(int n) const { const int h = n / 192, d = n - h * 192; if (d < 128) return n; const int i = d - 128; return h * 192 + 128 + (i & 1) * 32 + (i >> 1); } };
struct CmWukv { __device__ __forceinline__ int operator()(int n) const { const int v = n >> 10, r = n & 1023, h = r >> 7, d = r & 127; return h * 256 + v * 128 + d; } };
struct CmWup { __device__ __forceinline__ int operator()(int n) const { const int pn = n >> 8, r = n & 255; return (r < 128) ? (pn * 128 + r) : (DFF + pn * 128 + (r - 128)); } };

struct Args {
    const float* in[27]; float* out; unsigned char* ws; int ph_lo, ph_hi;
};
enum { I_X = 0, I_POS, I_MLA_WIN, I_MLA_GQ, I_MLA_WUQ, I_MLA_GKV, I_MLA_WUKV, I_MLA_WO, I_HY_WIN, I_HY_WSHORT, I_HY_FW1, I_HY_FB1, I_HY_FW2, I_HY_FB2, I_HY_FW3, I_HY_FB3, I_HY_FREQ,
       I_HY_FWOUT, I_HY_DBIAS, I_HY_WO, I_FFN_WUP, I_FFN_WCONV, I_FFN_WDOWN, I_LN1G, I_LN1B, I_LN2G, I_LN2B };

__device__ __forceinline__ void ln_rows(const bf16* Y, float* OF, bf16* OB, const float* g, const float* b, int gw, int ngw, int lane, float omul = 1.0f) {
    f32x4 gv[4], bv[4];
#pragma unroll
    for (int j = 0; j < 4; ++j) { gv[j] = *(const f32x4*)(g + 4 * lane + 256 * j); bv[j] = *(const f32x4*)(b + 4 * lane + 256 * j); }
    for (int m0 = gw; m0 < T; m0 += 4 * ngw) {
        u32x2t w[4][4];
#pragma unroll
        for (int q = 0; q < 4; ++q) { const int m = m0 + q * ngw; if (m < T) { const u32x2t* xr = (const u32x2t*)(Y + (size_t)m * DM) + lane;
#pragma unroll
                for (int j = 0; j < 4; ++j) w[q][j] = xr[64 * j]; } }
#pragma unroll
        for (int q = 0; q < 4; ++q) { const int m = m0 + q * ngw; if (m < T) {
            f32x4 v[4]; float s = 0.f;
#pragma unroll
            for (int j = 0; j < 4; ++j) { v[j] = (f32x4){bf_lo(w[q][j].x), bf_hi(w[q][j].x), bf_lo(w[q][j].y), bf_hi(w[q][j].y)}; s += (v[j].x + v[j].y) + (v[j].z + v[j].w); }
            const float mean = wave_sum(s) * (1.f / DM); float s2 = 0.f;
#pragma unroll
            for (int j = 0; j < 4; ++j) { v[j] = v[j] - mean; s2 += (v[j].x * v[j].x + v[j].y * v[j].y) + (v[j].z * v[j].z + v[j].w * v[j].w); }
            const float rstd = 1.f / sqrtf(wave_sum(s2) * (1.f / DM) + LN_EPS);
            f32x4* of = (f32x4*)(OF + (size_t)m * DM) + lane;
#pragma unroll
            for (int j = 0; j < 4; ++j) { v[j] = (v[j] * rstd * gv[j] + bv[j]) * omul;
                if (OF) of[64 * j] = v[j]; }
            if (OB) { u32x2t* ob = (u32x2t*)(OB + (size_t)m * DM) + lane;
#pragma unroll
                for (int j = 0; j < 4; ++j) { u32x2t ww; ww.x = pkbf(v[j].x, v[j].y); ww.y = pkbf(v[j].z, v[j].w); ob[64 * j] = ww; } } } }
    }
}

__device__ __forceinline__ void mla_norm_rope(const float* H1, const float* gq, const float* gkv, const f32x2* tab, bf16* CQN, bf16* CKVN, unsigned char* Kb, int gw, int ngw, int lane) {
    float gqv[6], gkvv[4];
#pragma unroll
    for (int k = 0; k < 6; ++k) gqv[k] = gq[lane + 64 * k];
#pragma unroll
    for (int k = 0; k < 4; ++k) gkvv[k] = gkv[lane + 64 * k];
    for (int t0 = gw; t0 < T; t0 += 2 * ngw) {
        float q[2][6], kv[2][4]; f32x2 xr[2], cs[2];
#pragma unroll
        for (int u = 0; u < 2; ++u) { const int t = t0 + u * ngw; if (t < T) { const float* h = H1 + (size_t)t * MLA_INP;
#pragma unroll
            for (int k = 0; k < 6; ++k) q[u][k] = h[lane + 64 * k];
#pragma unroll
            for (int k = 0; k < 4; ++k) kv[u][k] = h[QLORA + lane + 64 * k];
            xr[u] = *(const f32x2*)(h + 640 + 2 * (lane & 31)); cs[u] = tab[(size_t)t * 32 + (lane & 31)]; } }
#pragma unroll
        for (int u = 0; u < 2; ++u) { const int t = t0 + u * ngw; if (t < T) {
            float sq = 0.f, sk = 0.f;
#pragma unroll
            for (int k = 0; k < 6; ++k) sq += q[u][k] * q[u][k];
#pragma unroll
            for (int k = 0; k < 4; ++k) sk += kv[u][k] * kv[u][k];
            const float rq = 1.f / sqrtf(wave_sum(sq) * (1.f / QLORA) + RMS_EPS), rk = 1.f / sqrtf(wave_sum(sk) * (1.f / KVLORA) + RMS_EPS);
#pragma unroll
            for (int k = 0; k < 6; ++k) CQN[(size_t)t * QLORA + lane + 64 * k] = (bf16)(pkbf(q[u][k] * rq * gqv[k], 0.f) & 0xffffu);
#pragma unroll
            for (int k = 0; k < 4; ++k) CKVN[(size_t)t * KVLORA + lane + 64 * k] = (bf16)(pkbf(kv[u][k] * rk * gkvv[k], 0.f) & 0xffffu);
            const unsigned short w = (unsigned short)__builtin_amdgcn_cvt_pk_fp8_f32(xr[u].x * cs[u].x - xr[u].y * cs[u].y, xr[u].x * cs[u].y + xr[u].y * cs[u].x, 0, false);
            unsigned short* kr = (unsigned short*)(Kb + (size_t)t * 1536 + 128) + (lane & 31);
            if (lane < 32) {
#pragma unroll
                for (int hh = 0; hh < NH; ++hh) kr[hh * 96] = w; } } }
    }
}

__device__ __forceinline__ void ffn_conv_silu(const bf16* UH, const float* wconv  , bf16* HACT  , int gw, int ngw, int lane) {
    constexpr int RB = 32, NRB = SEQ / RB, NCC = 6;
    for (int it = gw; it < NRB * NCC; it += ngw) {
        const int rb = it / NCC, cc = it - rb * NCC, c = cc * 512 + lane * 8;
        if (c >= DFF) continue;
        const int pn = c >> 7, ucol = pn * 256 + (c & 127);
        float wa[3][8], wg[3][8];
#pragma unroll
        for (int k = 0; k < 3; ++k)
#pragma unroll
            for (int e = 0; e < 8; ++e) { wa[k][e] = wconv[k * NUP + c + e]; wg[k][e] = wconv[k * NUP + DFF + c + e]; }
        const int r0 = rb * RB;
        const bf16* up = UH + ucol;
        const u32x4t zero = {0u, 0u, 0u, 0u};
        u32x4t ra[6], rg[6];
        ra[0] = zero; rg[0] = zero;
        if (r0 > 0) { ra[0] = *(const u32x4t*)(up + (size_t)(r0 - 1) * NUP); rg[0] = *(const u32x4t*)(up + (size_t)(r0 - 1) * NUP + 128); }
        ra[1] = *(const u32x4t*)(up + (size_t)r0 * NUP); rg[1] = *(const u32x4t*)(up + (size_t)r0 * NUP + 128);
#pragma unroll 1
        for (int r = r0; r < r0 + RB; r += 4) {
#pragma unroll
            for (int j = 1; j <= 4; ++j) { const int rr = r + j; if (rr < SEQ) { ra[1 + j] = *(const u32x4t*)(up + (size_t)rr * NUP); rg[1 + j] = *(const u32x4t*)(up + (size_t)rr * NUP + 128); } else { ra[1 + j] = zero; rg[1 + j] = zero; } }
#pragma unroll
            for (int j = 0; j < 4; ++j) {
                float o[8];
#pragma unroll
                for (int e2 = 0; e2 < 4; ++e2) {
                    const float a0 = wa[0][2 * e2] * bf_lo(ra[j][e2]) + wa[1][2 * e2] * bf_lo(ra[j + 1][e2]) + wa[2][2 * e2] * bf_lo(ra[j + 2][e2]);
                    const float a1 = wa[0][2 * e2 + 1] * bf_hi(ra[j][e2]) + wa[1][2 * e2 + 1] * bf_hi(ra[j + 1][e2]) + wa[2][2 * e2 + 1] * bf_hi(ra[j + 2][e2]);
                    const float g0 = wg[0][2 * e2] * bf_lo(rg[j][e2]) + wg[1][2 * e2] * bf_lo(rg[j + 1][e2]) + wg[2][2 * e2] * bf_lo(rg[j + 2][e2]);
                    const float g1 = wg[0][2 * e2 + 1] * bf_hi(rg[j][e2]) + wg[1][2 * e2 + 1] * bf_hi(rg[j + 1][e2]) + wg[2][2 * e2 + 1] * bf_hi(rg[j + 2][e2]);
                    o[2 * e2] = a0 * g0 * __builtin_amdgcn_rcpf(1.f + __expf(-g0)); o[2 * e2 + 1] = a1 * g1 * __builtin_amdgcn_rcpf(1.f + __expf(-g1)); }
                u32x4t w; w.x = pkbf(o[0], o[1]); w.y = pkbf(o[2], o[3]); w.z = pkbf(o[4], o[5]); w.w = pkbf(o[6], o[7]);
                *(u32x4t*)(HACT + (size_t)(r + j) * DFF + c) = w;
            }
            ra[0] = ra[4]; rg[0] = rg[4]; ra[1] = ra[5]; rg[1] = rg[5];
        }
    }
}

__device__ __forceinline__ void v_transpose_fp8(const bf16* V, unsigned char* VT, LAS unsigned char* scr, int gw, int ngw, int lane) {
    constexpr int NKT = T / 64, NCT = 1024 / 64;
    for (int it = gw; it < NKT * NCT; it += ngw) {
        const int ct = it % NCT, kt = it / NCT, b = kt / (SEQ / 64), k0 = (kt % (SEQ / 64)) * 64, c0 = ct * 64;
        const int r8 = lane >> 3, c8 = lane & 7;
#pragma unroll
        for (int i = 0; i < 8; ++i) { const int row = r8 + 8 * i; const u32x4t v = *(const u32x4t*)(V + ((size_t)b * SEQ + k0 + row) * 1024 + c0 + c8 * 8);
            u32x2t w; w.x = (unsigned)__builtin_amdgcn_cvt_pk_fp8_f32(bf_lo(v.y), bf_hi(v.y), __builtin_amdgcn_cvt_pk_fp8_f32(bf_lo(v.x), bf_hi(v.x), 0, false), true);
            w.y = (unsigned)__builtin_amdgcn_cvt_pk_fp8_f32(bf_lo(v.w), bf_hi(v.w), __builtin_amdgcn_cvt_pk_fp8_f32(bf_lo(v.z), bf_hi(v.z), 0, false), true);
            *(LAS u32x2t*)(scr + row * 72 + c8 * 8) = w; }
        asm volatile("s_waitcnt lgkmcnt(0)" ::: "memory");
        unsigned o[16];
#pragma unroll
        for (int wd = 0; wd < 16; ++wd) { unsigned acc = 0;
#pragma unroll
            for (int bb = 0; bb < 4; ++bb) { const int pi = wd * 4 + bb, h = pi >> 5, j = pi & 31, jj = j & 15, key = (j >> 4) * 32 + (jj & 3) + 8 * (jj >> 2) + 4 * h;
                acc |= (unsigned)scr[key * 72 + lane] << (8 * bb); }
            o[wd] = acc; }
        const int hh = (c0 + lane) >> 7, cc = (c0 + lane) & 127;
        unsigned char* dst = VT + (((size_t)b * 8 + hh) * 128 + cc) * SEQ + k0;
#pragma unroll
        for (int q = 0; q < 4; ++q) *(u32x4t*)(dst + 16 * q) = (u32x4t){o[4 * q], o[4 * q + 1], o[4 * q + 2], o[4 * q + 3]};
        asm volatile("s_waitcnt lgkmcnt(0)" ::: "memory");
    }
}

__device__ __forceinline__ void ffn_fixup_rows(const float* halo, const float* wconv  , bf16* HACT  , int gw, int ngw, int lane) {
    constexpr int NP = T / 256, NCC = 6;
    for (int it = gw; it < NP * 2 * NCC; it += ngw) {
        const int cc = it % NCC, pe = it / NCC, e = pe & 1, pm = pe >> 1, c = cc * 512 + lane * 8;
        if (c >= DFF) continue;
        const int row = pm * 256 + (e ? 255 : 0), ucol = (c >> 7) * 256 + (c & 127);
        const float* hp = halo + (size_t)pm * 4 * NUP + ucol;
        const float* up_ = nullptr; const float* cu_; const float* dn_ = nullptr;
        if (e == 0) { cu_ = hp; dn_ = hp + NUP; if (row % SEQ != 0) up_ = hp - 4 * NUP + 3 * NUP; }
        else { up_ = hp + 2 * NUP; cu_ = hp + 3 * NUP; if (row % SEQ != SEQ - 1) dn_ = hp + 4 * NUP; }
        float o[8];
#pragma unroll
        for (int i = 0; i < 8; ++i) {
            float ha = wconv[NUP + c + i] * cu_[i], hg = wconv[NUP + DFF + c + i] * cu_[128 + i];
            if (up_) { ha += wconv[c + i] * up_[i]; hg += wconv[DFF + c + i] * up_[128 + i]; }
            if (dn_) { ha += wconv[2 * NUP + c + i] * dn_[i]; hg += wconv[2 * NUP + DFF + c + i] * dn_[128 + i]; }
            o[i] = ha * hg * __builtin_amdgcn_rcpf(1.f + __expf(-hg)); }
        u32x4t w; w.x = pkbf(o[0], o[1]); w.y = pkbf(o[2], o[3]); w.z = pkbf(o[4], o[5]); w.w = pkbf(o[6], o[7]);
        *(u32x4t*)(HACT + (size_t)row * DFF + c) = w;
    }
}

__device__ __forceinline__ void hy_conv_transpose(const bf16* U  , const float* wshort  , float* VC0, float* VC1, bf16* G1C, bf16* G2C, LAS unsigned* scr, int gw, int ngw, int lane) {
    constexpr int NTT = T / 64, NCT = 3072 / 64;
    const int r8 = lane >> 3, c8 = lane & 7;
    u32x4t buf[9];
#define HCT_LOAD(IT) do { const int ct_ = (IT) % NCT, tt_ = (IT) / NCT, b_ = tt_ / (SEQ / 64), t0_ = (tt_ % (SEQ / 64)) * 64, c0_ = ct_ * 64; \
        _Pragma("unroll") for (int i = 0; i < 9; ++i) { const int row = r8 + 8 * i, tok = t0_ - 1 + row; buf[i] = (u32x4t){0u, 0u, 0u, 0u}; \
            if (row < 66 && tok >= 0 && tok < SEQ) buf[i] = *(const u32x4t*)(U + ((size_t)b_ * SEQ + tok) * 3072 + c0_ + c8 * 8); } } while (0)
    if (gw < NTT * NCT) HCT_LOAD(gw);
    for (int it = gw; it < NTT * NCT; it += ngw) {
        const int ct = it % NCT, tt = it / NCT, b = tt / (SEQ / 64), t0 = (tt % (SEQ / 64)) * 64, c0 = ct * 64;
#pragma unroll
        for (int i = 0; i < 9; ++i) { const int row = r8 + 8 * i; if (row < 66) { LAS unsigned* d = scr + row * 33 + c8 * 4; d[0] = buf[i].x; d[1] = buf[i].y; d[2] = buf[i].z; d[3] = buf[i].w; } }
        if (it + ngw < NTT * NCT) HCT_LOAD(it + ngw);
        asm volatile("s_waitcnt lgkmcnt(0)" ::: "memory");
        const int part = c0 >> 10, chb = c0 & 1023;
        const float wl0 = wshort[c0 + lane], wl1 = wshort[3072 + c0 + lane], wl2 = wshort[6144 + c0 + lane];
#pragma unroll
        for (int cp = 0; cp < 32; ++cp) {
            const unsigned a0 = scr[lane * 33 + cp], a1 = scr[(lane + 1) * 33 + cp], a2 = scr[(lane + 2) * 33 + cp];
            #define RL(x, i) __int_as_float(__builtin_amdgcn_readlane(__float_as_int(x), (i)))
            const float w00 = RL(wl0, 2 * cp), w10 = RL(wl1, 2 * cp), w20 = RL(wl2, 2 * cp), w01 = RL(wl0, 2 * cp + 1), w11 = RL(wl1, 2 * cp + 1), w21 = RL(wl2, 2 * cp + 1);
#undef RL
            const float v0 = w00 * bf_lo(a0) + w10 * bf_lo(a1) + w20 * bf_lo(a2), v1 = w01 * bf_hi(a0) + w11 * bf_hi(a1) + w21 * bf_hi(a2);
            const size_t o = (size_t)(chb + 2 * cp) * SEQ + t0 + lane;
            if (part == 0) { float* d = b ? VC1 : VC0; d[o] = v0; d[o + SEQ] = v1; }
            else { bf16* d = (part == 1 ? G1C : G2C) + (size_t)b * 1024 * SEQ; d[o] = (bf16)(pkbf(v0, 0.f) & 0xffffu); d[o + SEQ] = (bf16)(pkbf(v1, 0.f) & 0xffffu); }
        }
        asm volatile("s_waitcnt lgkmcnt(0)" ::: "memory");
    }
#undef HCT_LOAD
}
__device__ __forceinline__ void hy_transpose_back(const bf16* Z3C, bf16* XB, LAS unsigned* scr, int gw, int ngw, int lane) {
    constexpr int NTT = T / 64, NCT = 1024 / 64;
    for (int it = gw; it < NTT * NCT; it += ngw) {
        const int ct = it % NCT, tt = it / NCT, b = tt / (SEQ / 64), t0 = (tt % (SEQ / 64)) * 64, c0 = ct * 64;
        const bf16* src = Z3C + ((size_t)b * 1024 + c0) * SEQ + t0 + lane;
#pragma unroll 8
        for (int cp = 0; cp < 32; ++cp) { const unsigned lo = src[(size_t)(2 * cp) * SEQ], hi = src[(size_t)(2 * cp + 1) * SEQ]; scr[lane * 33 + cp] = lo | (hi << 16); }
        asm volatile("s_waitcnt lgkmcnt(0)" ::: "memory");
        const int r8 = lane >> 3, c8 = lane & 7;
#pragma unroll
        for (int i = 0; i < 8; ++i) { const int row = r8 + 8 * i; const LAS unsigned* s = scr + row * 33 + c8 * 4; u32x4t v; v.x = s[0]; v.y = s[1]; v.z = s[2]; v.w = s[3];
            *(u32x4t*)(XB + ((size_t)b * SEQ + t0 + row) * DM + c0 + c8 * 8) = v; }
        asm volatile("s_waitcnt lgkmcnt(0)" ::: "memory");
    }
}

#ifdef SELFCHECK
__device__ __forceinline__ float blk_sum(float v, LAS float* red, int tid_) {
    v = wave_sum(v); __syncthreads(); if ((tid_ & 63) == 0) red[tid_ >> 6] = v; __syncthreads();
    float t = 0.f; for (int i = 0; i < NWAVES; ++i) t += red[i]; __syncthreads(); return t;
}
__device__ __forceinline__ void chk_flag(unsigned* flag, float err2, float ref2, unsigned bit, int tid_, float tol = SELFCHECK_TOL) {
    if (tid_ == 0 && !(err2 <= tol * tol * ref2)) atomicOr(flag, bit);
}
__device__ __forceinline__ float fp8_dec(unsigned b) { const unsigned e = (b >> 3) & 15u, m = b & 7u; const float v = e ? ldexpf((float)(8u + m), (int)e - 10) : ldexpf((float)m, -9); return (b & 0x80u) ? -v : v; }
__device__ __forceinline__ float fp8_rnd(float x) { return fp8_dec((unsigned)__builtin_amdgcn_cvt_pk_fp8_f32(x, 0.f, 0, false) & 0xffu); }
__device__ __forceinline__ void selfcheck_mla(const Args& args, LAS unsigned char* ldsl, int bxx, int tid_) {
    unsigned* flag = (unsigned*)(args.ws + WS_CTL) + CW_CHK;
    const bf16* Qb_ = (const bf16*)(args.ws + WS_Q); const unsigned char* Kb_ = (const unsigned char*)(args.ws + WS_K); const bf16* Vb_ = (const bf16*)(args.ws + WS_V); const bf16* O_ = (const bf16*)(args.ws + WS_XB);
    const int* pos = (const int*)args.in[I_POS];
    LAS float* red = (LAS float*)(ldsl + 140000);
    if (bxx < 64) {
        const int t = bxx * (T / 64) + (bxx * 37) % 512;
        LAS float* h = (LAS float*)ldsl; LAS float* cq = h + 704; LAS float* ckv = cq + 384;
        const float* x = args.in[I_X] + (size_t)t * DM; const float* w_in = args.in[I_MLA_WIN];
        for (int j = tid_; j < MLA_IN; j += 512) { float a = 0.f; for (int k = 0; k < DM; ++k) a += x[k] * w_in[(size_t)k * MLA_IN + j]; h[j] = a; }
        __syncthreads();
        float sq = 0.f, sk = 0.f; for (int k = 0; k < QLORA; ++k) sq += h[k] * h[k]; for (int k = 0; k < KVLORA; ++k) sk += h[QLORA + k] * h[QLORA + k];
        const float rq = 1.f / sqrtf(sq / QLORA + RMS_EPS), rk = 1.f / sqrtf(sk / KVLORA + RMS_EPS);
        for (int k = tid_; k < QLORA; k += 512) cq[k] = h[k] * rq * args.in[I_MLA_GQ][k];
        for (int k = tid_; k < KVLORA; k += 512) ckv[k] = h[QLORA + k] * rk * args.in[I_MLA_GKV][k];
        __syncthreads();
        {
            float e2 = 0.f, r2 = 0.f; const float* w = args.in[I_MLA_WUQ];
            for (int n = tid_; n < NH * DQK; n += 512) { const int o = CmWuq()(n); float a = 0.f; for (int k = 0; k < QLORA; ++k) a += cq[k] * w[(size_t)k * (NH * DQK) + o];
                a *= QSCALE; const float g = __uint_as_float((unsigned)Qb_[(size_t)t * 1536 + n] << 16); e2 += (a - g) * (a - g); r2 += a * a; }
            e2 = blk_sum(e2, red, tid_); r2 = blk_sum(r2, red, tid_); chk_flag(flag, e2, r2, 1u, tid_);
        }
        {
            float e2 = 0.f, r2 = 0.f, e3 = 0.f, r3 = 0.f; const float* w = args.in[I_MLA_WUKV];
            for (int n = tid_; n < NH * 256; n += 512) { const int o = CmWukv()(n); float a = 0.f; for (int k = 0; k < KVLORA; ++k) a += ckv[k] * w[(size_t)k * (NH * 256) + o];
                if (n < 1024) { const float g = fp8_dec(Kb_[(size_t)t * 1536 + (n >> 7) * 192 + (n & 127)]); e2 += (a - g) * (a - g); r2 += a * a; }
                else { const float g = __uint_as_float((unsigned)Vb_[(size_t)t * 1024 + n - 1024] << 16); e3 += (a - g) * (a - g); r3 += a * a; } }
            e2 = blk_sum(e2, red, tid_); r2 = blk_sum(r2, red, tid_); chk_flag(flag, e2, r2, 2u, tid_, SELFCHECK_TOL8);
            e3 = blk_sum(e3, red, tid_); r3 = blk_sum(r3, red, tid_); chk_flag(flag, e3, r3, 8u, tid_);
        }
        {
            float e2 = 0.f, r2 = 0.f;
            if (tid_ < 256) { const int hh = tid_ >> 5, i = tid_ & 31; const float inv = powf(10000.0f, -(float)i / 32.0f); float s, c; sincosf((float)pos[t] * inv, &s, &c);
                const float x1 = h[640 + i], x2 = h[672 + i], a1 = x1 * c - x2 * s, a2 = x1 * s + x2 * c;
                const float g1 = fp8_dec(Kb_[(size_t)t * 1536 + hh * 192 + 128 + 2 * i]), g2 = fp8_dec(Kb_[(size_t)t * 1536 + hh * 192 + 129 + 2 * i]);
                e2 = (a1 - g1) * (a1 - g1) + (a2 - g2) * (a2 - g2); r2 = a1 * a1 + a2 * a2; }
            e2 = blk_sum(e2, red, tid_); r2 = blk_sum(r2, red, tid_); chk_flag(flag, e2, r2, 4u, tid_, SELFCHECK_TOL8);
        }
    } else if (bxx < 192) {
        const int sidx = bxx - 64, b = sidx & 1, hh = (sidx >> 1) & 7, row = (sidx * 509 + 13) % SEQ; const size_t t = (size_t)b * SEQ + row;
        LAS float* sc = (LAS float*)ldsl;
        LAS float* q = sc + SEQ;
        if (tid_ < DQK) { float v = __uint_as_float((unsigned)Qb_[t * 1536 + hh * DQK + tid_] << 16);
            if (tid_ >= 128) { const int i = (tid_ - 128) >> 1; const float inv = powf(10000.0f, -(float)i / 32.0f); float s, c; sincosf((float)pos[t] * inv, &s, &c);
                const float o = __uint_as_float((unsigned)Qb_[t * 1536 + hh * DQK + (tid_ ^ 1)] << 16);
                v = (tid_ & 1) ? (o * s + v * c) : (v * c - o * s); }
            q[tid_] = fp8_rnd(v); }
        __syncthreads();
        float mx = -1e30f;
        for (int k = tid_; k < SEQ; k += 512) { const unsigned char* kr = Kb_ + ((size_t)b * SEQ + k) * 1536 + hh * DQK; float a = 0.f; for (int d = 0; d < DQK; ++d) a += q[d] * fp8_dec(kr[d]); sc[k] = a; mx = fmaxf(mx, a); }
        for (int o = 1; o < 64; o <<= 1) mx = fmaxf(mx, __shfl_xor(mx, o));
        __syncthreads(); if ((tid_ & 63) == 0) red[tid_ >> 6] = mx; __syncthreads(); for (int i = 0; i < NWAVES; ++i) mx = fmaxf(mx, red[i]); __syncthreads();
        float ls = 0.f; for (int k = tid_; k < SEQ; k += 512) { const float p = exp2f(sc[k] - mx); sc[k] = p; ls += p; }
        ls = blk_sum(ls, red, tid_);
        const int d = tid_ & 127, part = tid_ >> 7; float a = 0.f;
        for (int k = part * 4096; k < (part + 1) * 4096; ++k) a += sc[k] * fp8_rnd(__uint_as_float((unsigned)Vb_[((size_t)b * SEQ + k) * 1024 + hh * DVH + d] << 16));
        LAS float* op = q + 256; op[tid_] = a; __syncthreads();
        float e2 = 0.f, r2 = 0.f;
        if (tid_ < 128) { const float o = (op[tid_] + op[tid_ + 128] + op[tid_ + 256] + op[tid_ + 384]) / ls; const float g = __uint_as_float((unsigned)O_[t * 1024 + hh * DVH + tid_] << 16); e2 = (o - g) * (o - g); r2 = o * o; }
        e2 = blk_sum(e2, red, tid_); r2 = blk_sum(r2, red, tid_); chk_flag(flag, e2, r2, 16u, tid_, SELFCHECK_TOL8);
    }
}
#endif
#ifndef MK_PER_PHASE
#define MK_PER_PHASE 0
#endif
constexpr int N_PHASES = 30;
constexpr int GEMM_SP2 = true, GEMM_ALIGN = true;

__global__ void __launch_bounds__(NWAVES * 64, 2) mega_fwd(Args args) {
    extern __shared__ __attribute__((aligned(16))) unsigned char lds[];
    LAS unsigned char* ldsl = (LAS unsigned char*)lds;
    volatile LAS unsigned* MISC = (volatile LAS unsigned*)(ldsl + MISC_OFF);
    const int wave = __builtin_amdgcn_readfirstlane((int)threadIdx.x >> 6);
#define lane hw_lane()
#define tid (wave * 64 + hw_lane())
#define G ((int)gridDim.x)
#define bx ((int)blockIdx.x)
#define gw (bx * NWAVES + wave)
#define ngw (G * NWAVES)
    { const int t_ = tid; if (t_ < 128) MISC[t_] = 0u; }
    __syncthreads();
    if (!MK_PER_PHASE) (void)xcd_barrier_post((unsigned*)(args.ws + WS_CTL) + CW_BAR, MISC + 8, (unsigned)wave);
    const int lo = args.ph_lo, hi = args.ph_hi;
#ifdef ONLY_PHASE
#define IN(k) ((k) == ONLY_PHASE && lo <= (k) && (k) < hi)
#else
#define IN(k) (lo <= (k) && (k) < hi)
#endif
#define GRIDBAR() do { XcdBarrier bar_; bar_.bar = (unsigned*)(args.ws + WS_CTL) + CW_BAR; bar_.x = xb_xcc_id(); bar_.st = MISC + 8; bar_.wv = (unsigned)wave; xcd_barrier(bar_); } while (0)
#define SEAM(k) do { if (IN(k) && IN((k) + 1)) GRIDBAR(); } while (0)
#ifndef PROBE_DUP
#define PROBE_DUP (-1)
#define PROBE_REP 1
#endif
#define RUN(k, REAL, DUMMY) do { if (IN(k)) { if (PROBE_DUP == (k)) { for (int rep_ = 0; rep_ < PROBE_REP; ++rep_) { DUMMY; GRIDBAR(); } } REAL; } } while (0)

#define P_(T_, off) ((T_*)(args.ws + (off)))
#define Win_t P_(bf16, WS_WIN)
#define Wuq_t P_(bf16, WS_WUQ)
#define Wukv_t P_(bf16, WS_WUKV)
#define Wo_t P_(bf16, WS_WO)
#define Whin_t P_(bf16, WS_WHIN)
#define Who_t P_(bf16, WS_WHO)
#define Wup_t P_(bf16, WS_WUP)
#define Wdn_t P_(bf16, WS_WDN)
#define Wfo_t P_(bf16, WS_WFO)
#define H3 P_(bf16, WS_H3)
#define XB P_(bf16, WS_XB)
#define XF P_(float, WS_XF)
#define CQN P_(bf16, WS_CQN)
#define CKVN P_(bf16, WS_CKVN)
#define ROPE P_(f32x2, WS_ROPE)
#define Qb P_(bf16, WS_Q)
#define Kb P_(unsigned char, WS_K)
#define Vb P_(bf16, WS_V)
#define VTb P_(unsigned char, WS_VT)
#define UH P_(bf16, WS_UH)
#define U P_(bf16, WS_U)
#define VC0 P_(float, WS_VC0)
#define VC1 P_(float, WS_VC1)
#define KT P_(float, WS_KT)
#define STASH P_(fftc::f2, WS_STASH)
#define KSPEC P_(fftc::f2, WS_KSPEC)
#define FTW (fftc::Tw{P_(const fftc::f2, WS_TW1), P_(const fftc::f2, WS_TW2), P_(const fftc::f2, WS_MOD)})
#define OUT (args.out)
#define H1 (args.out)
#define G1C ((bf16*)args.out)
#define G2C ((bf16*)args.out + (size_t)2 * 1024 * SEQ)
#define Z3C ((bf16*)args.out)
#define GEMM(EPI, A_, B_, M_, N_, K_, ...) do { pg8::Gemm g{(A_), (B_), (M_), (N_), (K_)}; pg8::StaticOrder S; S.init((M_), (N_), G, bx); typedef pg8::EPI Epi_; Epi_ E{__VA_ARGS__}; \
        pg8::gemm_phase<Epi_, pg8::StaticOrder, GEMM_ALIGN, GEMM_SP2>(ldsl, g, S, E, wave); } while (0)
#define YB_A P_(bf16, WS_XF)
#define YB_B P_(bf16, WS_S + 192 * MiB)
#define YB_C P_(bf16, WS_S)

    if (IN(0)) for (int prep_ = 0; prep_ < ((PROBE_DUP == 0) ? 1 + PROBE_REP : 1); ++prep_) {
        if (prep_) GRIDBAR();
        LAS float* scr = (LAS float*)(ldsl + wave * 16384);
        {
            int base = 0;
#define TR(W_, K_, N_, WT_, NP_, LDK_, CM_) do { const int nblk_ = (NP_) / 32, nit_ = ((K_) / 64) * nblk_; \
                for (int it_ = (gw + ngw - base % ngw) % ngw; it_ < nit_; it_ += ngw) transpose_item((W_), (K_), (N_), (WT_), (LDK_), scr, it_, nblk_, lane, CM_); base += nit_; } while (0)
            TR(args.in[I_MLA_WIN], DM, MLA_IN, Win_t, MLA_INP, DM, CmWin());
            TR(args.in[I_MLA_WUQ], QLORA, NH * DQK, Wuq_t, NH * DQK, QLORA, CmWuq());
            TR(args.in[I_MLA_WUKV], KVLORA, NH * 256, Wukv_t, NH * 256, KVLORA, CmWukv());
            TR(args.in[I_MLA_WO], DM, DM, Wo_t, DM, DM, CmIdent());
            TR(args.in[I_HY_WIN], DM, 3 * DM, Whin_t, 3 * DM, DM, CmIdent());
            TR(args.in[I_HY_WO], DM, DM, Who_t, DM, DM, CmIdent());
            TR(args.in[I_FFN_WUP], DM, NUP, Wup_t, NUP, DM, CmWup());
            TR(args.in[I_FFN_WUP] + (size_t)DM * NUP, DM, NUP, Wup_t + (size_t)NUP * DM, NUP, DM, CmWup());
            TR(args.in[I_FFN_WDOWN], DFF, DM, Wdn_t, DM, DFF, CmIdent());
            TR(args.in[I_FFN_WDOWN] + (size_t)DFF * DM, DFF, DM, Wdn_t + (size_t)DM * DFF, DM, DFF, CmIdent());
            TR(args.in[I_HY_FWOUT], HF, 4 * DM, Wfo_t, 4 * DM, HKP, CmIdent());
#undef TR
        }
        for (size_t i = (size_t)gw * 64 + lane; i < (size_t)4096 * 24; i += (size_t)ngw * 64) { const size_t r = i / 24, c = i % 24; *(u32x4t*)(Wfo_t + r * HKP + 64 + c * 8) = (u32x4t){0u, 0u, 0u, 0u}; }
        for (size_t i = (size_t)gw * 64 + lane; i < (size_t)SEQ * 24; i += (size_t)ngw * 64) { const size_t r = i / 24, c = i % 24; *(u32x4t*)(H3 + r * HKP + 64 + c * 8) = (u32x4t){0u, 0u, 0u, 0u}; }
        { const float* x_in = args.in[I_X];
          const size_t n8 = (size_t)T * DM / 8, st = (size_t)ngw * 64;
          for (size_t i = (size_t)gw * 64 + lane; i < n8; i += 4 * st) { f32x4 a[4], b[4];
#pragma unroll
            for (int q = 0; q < 4; ++q) { const size_t ii = i + q * st; if (ii < n8) { a[q] = *(const f32x4*)(x_in + ii * 8); b[q] = *(const f32x4*)(x_in + ii * 8 + 4); } }
#pragma unroll
            for (int q = 0; q < 4; ++q) { const size_t ii = i + q * st; if (ii < n8) { u32x4t w; w.x = pkbf(a[q].x, a[q].y); w.y = pkbf(a[q].z, a[q].w); w.z = pkbf(b[q].x, b[q].y); w.w = pkbf(b[q].z, b[q].w); *(u32x4t*)(XB + ii * 8) = w; } } } }
        { const int* pos = (const int*)args.in[I_POS]; const double inv = exp(-(double)(lane & 31) * (9.210340371976184 / 32.0));
          for (size_t i = (size_t)gw * 64 + lane; i < (size_t)T * 32; i += (size_t)ngw * 64) { const int t = (int)(i >> 5);
              const double ang = (double)pos[t] * inv; double s, c; sincos(ang, &s, &c); ROPE[i] = (f32x2){(float)c, (float)s}; } }
        { const float* fw1 = args.in[I_HY_FW1]; const float* fb1 = args.in[I_HY_FB1]; const float* fw2 = args.in[I_HY_FW2]; const float* fb2 = args.in[I_HY_FB2];
          const float* fw3 = args.in[I_HY_FW3]; const float* fb3 = args.in[I_HY_FB3]; const float fr = args.in[I_HY_FREQ][lane];
          for (int l0 = gw; l0 < SEQ; l0 += 4 * ngw) {
              float z[4], a[4], h[4];
#pragma unroll
              for (int u = 0; u < 4; ++u) { const int l = l0 + u * ngw < SEQ ? l0 + u * ngw : SEQ - 1;
                  const float tt = (float)l / (float)(SEQ - 1); const float w = 6.283185307179586f * (float)l / (float)SEQ;
                  z[u] = 0.f;
                  if (lane == 0) z[u] = tt;
                  else if (lane <= 16) { const float f = 1e-4f + (float)(lane - 1) * ((15.0f - 1e-4f) / 15.0f); z[u] = cosf(f * w); }
                  else if (lane <= 32) { const float f = 1e-4f + (float)(lane - 17) * ((15.0f - 1e-4f) / 15.0f); z[u] = -sinf(f * w); }
                  a[u] = fb1[lane]; }
#pragma unroll
              for (int i = 0; i < HEMB; ++i) { const float wv = fw1[i * HF + lane];
#pragma unroll
                  for (int u = 0; u < 4; ++u) a[u] += __shfl(z[u], i) * wv; }
#pragma unroll
              for (int u = 0; u < 4; ++u) { h[u] = sinf(fr * a[u]); a[u] = fb2[lane]; }
#pragma unroll 8
              for (int i = 0; i < HF; ++i) { const float wv = fw2[i * HF + lane];
#pragma unroll
                  for (int u = 0; u < 4; ++u) a[u] += __shfl(h[u], i) * wv; }
#pragma unroll
              for (int u = 0; u < 4; ++u) { h[u] = sinf(fr * a[u]); a[u] = fb3[lane]; }
#pragma unroll 8
              for (int i = 0; i < HF; ++i) { const float wv = fw3[i * HF + lane];
#pragma unroll
                  for (int u = 0; u < 4; ++u) a[u] += __shfl(h[u], i) * wv; }
#pragma unroll
              for (int u = 0; u < 4; ++u) { const int l = l0 + u * ngw; if (l < SEQ) H3[(size_t)l * HKP + lane] = (bf16)(pkbf(sinf(fr * a[u]), 0.f) & 0xffffu); }
          } }
    }
    SEAM(0);
#define B1 GEMM(EpiF32, XB, Win_t, T, MLA_INP, DM, H1, MLA_INP)
    RUN(1, B1, B1);
    SEAM(1);
#define B2 mla_norm_rope(H1, args.in[I_MLA_GQ], args.in[I_MLA_GKV], ROPE, CQN, CKVN, Kb, gw, ngw, lane)
    RUN(2, B2, B2);
    SEAM(2);
#define B3 do { GEMM(EpiBf16, CQN, Wuq_t, T, NH * DQK, QLORA, Qb, NH * DQK, QSCALE); GEMM(EpiKV, CKVN, Wukv_t, T, NH * 256, KVLORA, Kb, Vb); GRIDBAR(); v_transpose_fp8(Vb, VTb, (LAS unsigned char*)(ldsl + wave * 8192), gw, ngw, lane); } while (0)
    RUN(3, B3, B3);
    SEAM(3);
#ifndef ATT_EXP
#define ATT_EXP 0
#endif
#define B4X(EXPV) do { for (int u = bx; u < BATCH * NH * (SEQ / 256); u += G) { const int qb = u & 63, h = (u >> 6) & 7, b = u >> 9; const size_t r0 = (size_t)b * SEQ + (size_t)qb * 256; \
            attn::attn_unit<EXPV>(Qb + r0 * 1536 + h * DQK, Kb + (size_t)b * SEQ * 1536 + h * DQK, VTb + ((size_t)b * 8 + h) * 128 * SEQ, XB + r0 * 1024 + h * DVH, (const float*)(ROPE + r0 * 32), SEQ, (char*)lds, wave); } } while (0)
    RUN(4, B4X(0), B4X(ATT_EXP));
#ifdef SELFCHECK
    if (IN(4) && IN(5)) { GRIDBAR(); selfcheck_mla(args, ldsl, bx, tid); }
#endif
    SEAM(4);
#define B5 GEMM(EpiRes<false>, XB, Wo_t, T, DM, DM, args.in[I_X], YB_A, DN_ALPHA)
    RUN(5, B5, B5);
    SEAM(5);
#define B6 ln_rows(YB_A, nullptr, XB, args.in[I_LN1G], args.in[I_LN1B], gw, ngw, lane)
    RUN(6, B6, B6);
    SEAM(6);
#define HACT P_(bf16, WS_S)
#define HALO P_(float, WS_S + 180 * MiB)
#define FFN_UP(layer) GEMM(EpiConvSilu, XB, Wup_t + (size_t)(layer) * NUP * DM, T, NUP, DM, HACT, args.in[I_FFN_WCONV] + (size_t)(layer) * 3 * NUP, HALO, (PG8_LAS float*)(ldsl + RING_BYTES))
#define FFN_FIX(layer) ffn_fixup_rows(HALO, args.in[I_FFN_WCONV] + (size_t)(layer) * 3 * NUP, HACT, gw, ngw, lane)
#define FFN_DN(layer, OUT_) GEMM(EpiRes<true>, HACT, Wdn_t + (size_t)(layer) * DM * DFF, T, DM, DFF, XB, (OUT_), DN_ALPHA)
#define FFN_LAYER(p, layer) \
    RUN(p, FFN_UP(layer), FFN_UP(layer)); SEAM(p); \
    RUN((p) + 1, FFN_FIX(layer), FFN_FIX(layer)); SEAM((p) + 1); \
    RUN((p) + 2, FFN_DN(layer, (layer) ? YB_A : YB_B), FFN_DN(layer, (layer) ? YB_A : YB_B)); if (IN((p) + 2) && IN((p) + 6)) GRIDBAR();
    FFN_LAYER(7, 0)
#define X2B P_(bf16, WS_XF)
#define B13 ln_rows(YB_B, nullptr, X2B, args.in[I_LN2G], args.in[I_LN2B], gw, ngw, lane)
    RUN(13, B13, B13);
    SEAM(13);
#define B14 GEMM(EpiBf16, X2B, Whin_t, T, 3 * DM, DM, U, 3 * DM, 1.0f)
    RUN(14, B14, B14);
    SEAM(14);
#define B15 hy_conv_transpose(U, args.in[I_HY_WSHORT], VC0, VC1, G1C, G2C, (LAS unsigned*)(ldsl + wave * 16384), gw, ngw, lane)
    RUN(15, B15, B15);
    SEAM(15);
#define HY_FILT(od) GEMM(EpiFilt, H3, Wfo_t + (size_t)(od) * 2048 * HKP, SEQ, 2 * DM, HKP, KT, SEQ, -120.39728043259360f, (40.54651081081644f + 120.39728043259360f) / 1023.0f, 1.0f / (float)(SEQ - 1))
#ifndef FFT_EV
#define FFT_EV 0
#endif
#define HY_FFT(MODE_, GC_, DB_) do { for (int c = bx; c < DM; c += G) { const size_t co = (size_t)c * SEQ; \
            fftc::hyena_channel<MODE_, ((MODE_) == 2 ? FFT_EV : 0)>((fftc::lf2*)ldsl, VC0 + co, VC1 + co, KT + co, KT + (size_t)DM * SEQ + co, (GC_) + co, (GC_) + (size_t)DM * SEQ + co, args.in[I_HY_DBIAS][(DB_) + c], \
                                       VC0 + co, VC1 + co, Z3C + co, Z3C + (size_t)DM * SEQ + co, STASH + (size_t)bx * SEQ, KSPEC + (size_t)bx * SEQ, tid); } } while (0)
    RUN(16, HY_FILT(0), HY_FILT(0)); SEAM(16);
    RUN(17, HY_FFT(0, G1C, 0), HY_FFT(2, G1C, 0)); SEAM(17);
    RUN(18, HY_FILT(1), HY_FILT(1)); SEAM(18);
    RUN(19, HY_FFT(1, G2C, DM), HY_FFT(1, G2C, DM)); SEAM(19);
#define B20 hy_transpose_back(Z3C, XB, (LAS unsigned*)(ldsl + wave * 16384), gw, ngw, lane)
    RUN(20, B20, B20);
    SEAM(20);
#define B21 GEMM(EpiRes<true>, XB, Who_t, T, DM, DM, X2B, YB_C, DN_ALPHA)
    RUN(21, B21, B21);
    SEAM(21);
#define B22 ln_rows(YB_C, nullptr, XB, args.in[I_LN1G] + DM, args.in[I_LN1B] + DM, gw, ngw, lane)
    RUN(22, B22, B22);
    SEAM(22);
    FFN_LAYER(23, 1)
#ifdef SELFCHECK
    if (IN(29)) { const unsigned mask = __hip_atomic_load((unsigned*)(args.ws + WS_CTL) + CW_CHK, __ATOMIC_RELAXED, __HIP_MEMORY_SCOPE_AGENT);
        ln_rows(YB_A, OUT, nullptr, args.in[I_LN2G] + DM, args.in[I_LN2B] + DM, gw, ngw, lane, 1.0f + 0.1f * (float)mask); }
#else
    RUN(29, ln_rows(YB_A, OUT, nullptr, args.in[I_LN2G] + DM, args.in[I_LN2B] + DM, gw, ngw, lane), ln_rows(YB_A, OUT, nullptr, args.in[I_LN2G] + DM, args.in[I_LN2B] + DM, gw, ngw, lane));
#endif
#undef IN
#undef SEAM
#undef lane
#undef tid
#undef G
#undef bx
#undef gw
#undef ngw
}

extern "C" void kernel_launch(void* const* d_in, const int* in_sizes, int n_in, void* d_out, int out_size, void* d_ws, size_t ws_size, hipStream_t stream) {
    static int grid = 0;
    if (grid == 0) {
        if (n_in != 27 || in_sizes[0] != T * DM || out_size != T * DM || ws_size < WS_END) { fprintf(stderr, "kernel_launch: shape/workspace mismatch (n_in %d, in0 %d, out %d, ws %zu)\n", n_in, n_in > 0 ? in_sizes[0] : -1, out_size, ws_size); grid = -1; return; }
        int dev = 0, cus = 0, per_cu = 0;
        if (hipGetDevice(&dev) != hipSuccess || hipDeviceGetAttribute(&cus, hipDeviceAttributeMultiprocessorCount, dev) != hipSuccess) { grid = -1; return; }
        if (hipFuncSetAttribute((const void*)mega_fwd, hipFuncAttributeMaxDynamicSharedMemorySize, LDS_BYTES) != hipSuccess) { fprintf(stderr, "kernel_launch: hipFuncSetAttribute failed\n"); grid = -1; return; }
        if (hipOccupancyMaxActiveBlocksPerMultiprocessor(&per_cu, (const void*)mega_fwd, NWAVES * 64, LDS_BYTES) != hipSuccess || per_cu < 1) { fprintf(stderr, "kernel_launch: occupancy query says %d\n", per_cu); }
        (void)hipGetLastError();
        grid = cus;
    }
    if (grid < 0) return;
    if (hipMemsetAsync((char*)d_ws + WS_CTL, 0, CTL_ZERO_BYTES, stream) != hipSuccess) return;
    Args a{};
    for (int i = 0; i < 27; ++i) a.in[i] = (const float*)d_in[i];
    a.out = (float*)d_out; a.ws = (unsigned char*)d_ws;
#if MK_PER_PHASE
    for (int p = 0; p < N_PHASES; ++p) { a.ph_lo = p; a.ph_hi = p + 1; hipLaunchKernelGGL(mega_fwd, dim3(grid), dim3(NWAVES * 64), LDS_BYTES, stream, a); }
#else
    a.ph_lo = 0; a.ph_hi = N_PHASES; hipLaunchKernelGGL(mega_fwd, dim3(grid), dim3(NWAVES * 64), LDS_BYTES, stream, a);
#endif
}
```

```cpp
#include <hip/hip_runtime.h>
#include <cstdio>
#include <cstdint>
__device__ __forceinline__ int hw_lane() { int l; asm volatile("v_mbcnt_lo_u32_b32 %0, -1, 0\n\tv_mbcnt_hi_u32_b32 %0, -1, %0" : "=v"(l)); return l; }
namespace pg8 {
#define PG8_LAS __attribute__((address_space(3)))
typedef unsigned short bf16_t;
typedef short bf16x8 __attribute__((ext_vector_type(8)));
typedef float f32x4 __attribute__((ext_vector_type(4)));
typedef unsigned u32x4 __attribute__((ext_vector_type(4)));
constexpr int BM = 256, BK = 64, HALF = 128, HTB = HALF * BK * 2  , STAGE_BYTES = 8 * HTB, NXCD = 8, WGM = 8;

__host__ __device__ __forceinline__ int lds_byte(int r, int c) { const int st = (r >> 4) * 2 + (c >> 5), rr = r & 15, cc = c & 31, ob = rr * 64 + cc * 2; return st * 1024 + (ob ^ (((ob >> 9) & 1) << 5)); }
__host__ __device__ __forceinline__ void stage_rc(int b, int& R, int& C) { const int st = b / 1024, sb = b % 1024, swz = sb ^ (((sb >> 9) & 1) << 5); R = (st >> 1) * 16 + swz / 64; C = (st & 1) * 32 + (swz % 64) / 2; }
__host__ __device__ __forceinline__ int perm32(int rho) { const int n = rho >> 4, i = rho & 15; return 8 * (i >> 2) + 4 * n + (i & 3); }

struct Unit { int pm, pn; };
struct Gemm { const bf16_t* A; const bf16_t* Bt; int M, N, K; };

struct StaticOrder {
    int nM, nN, nwg, G, c;
    __host__ __device__ void init(int M, int N, int G_, int c_) { nM = M / BM; nN = N / BM; nwg = nM * nN; G = G_; c = c_; }
    __host__ __device__ bool next(int i, Unit& u) const {
        const long L = (long)i * G + c; if (L >= nwg) return false;
        int wgid = (int)L; { const int q = nwg / NXCD, r = nwg % NXCD, xcd = wgid % NXCD, off = wgid / NXCD; wgid = (xcd < r ? xcd * (q + 1) : r * (q + 1) + (xcd - r) * q) + off; }
        const int nig = WGM * nN, gid = wgid / nig, fm = gid * WGM, gsz = (nM - fm) < WGM ? (nM - fm) : WGM;
        u.pm = fm + ((wgid % nig) % gsz); u.pn = (wgid % nig) / gsz; return true;
    }
    __device__ __forceinline__ void a_ready(const Unit&) const {}
    __device__ __forceinline__ void done(const Unit&) const {}
};

__device__ __forceinline__ unsigned cvt_pk_bf16(float lo, float hi) { unsigned r; asm volatile("v_cvt_pk_bf16_f32 %0, %1, %2" : "=v"(r) : "v"(lo), "v"(hi)); return r; }
typedef float f32x2 __attribute__((ext_vector_type(2)));

struct EpiF32 {
    static constexpr bool PERM = false, AFTER_DRAIN = false;
    float* C; int ldc;
    __device__ __forceinline__ void operator()(const f32x4 (&acc)[2][2][4][2], const Unit& u_, int wr, int wc, int fr, int fq) const {
        Unit u = u_; asm volatile("" : "+s"(u.pm), "+s"(u.pn)); { const int l_ = hw_lane(); fr = l_ & 15; fq = l_ >> 4; }
        const int row0 = u.pm * BM + wr * 64 + fr, col0 = u.pn * BM + wc * 32 + 4 * fq;
#pragma unroll
        for (int ai = 0; ai < 2; ++ai)
#pragma unroll
            for (int m = 0; m < 4; ++m) { float* rowp = C + (size_t)(row0 + ai * HALF + m * 16) * ldc + col0;
#pragma unroll
                for (int bj = 0; bj < 2; ++bj)
#pragma unroll
                    for (int n = 0; n < 2; ++n) *(f32x4*)(rowp + bj * HALF + n * 16) = acc[ai][bj][m][n]; }
    }
};
struct EpiBf16 {
    static constexpr bool PERM = true, AFTER_DRAIN = false;
    bf16_t* O; int ldc; float scale;
    __device__ __forceinline__ void operator()(const f32x4 (&acc)[2][2][4][2], const Unit& u_, int wr, int wc, int fr, int fq) const {
        Unit u = u_; asm volatile("" : "+s"(u.pm), "+s"(u.pn)); { const int l_ = hw_lane(); fr = l_ & 15; fq = l_ >> 4; }
        const int row0 = u.pm * BM + wr * 64 + fr, col0 = u.pn * BM + wc * 32 + 8 * fq;
#pragma unroll
        for (int ai = 0; ai < 2; ++ai)
#pragma unroll
            for (int m = 0; m < 4; ++m) { bf16_t* rowp = O + (size_t)(row0 + ai * HALF + m * 16) * ldc + col0;
#pragma unroll
                for (int bj = 0; bj < 2; ++bj) { const f32x4 v0 = acc[ai][bj][m][0] * scale, v1 = acc[ai][bj][m][1] * scale;
                    u32x4 w; w.x = cvt_pk_bf16(v0[0], v0[1]); w.y = cvt_pk_bf16(v0[2], v0[3]); w.z = cvt_pk_bf16(v1[0], v1[1]); w.w = cvt_pk_bf16(v1[2], v1[3]);
                    *(u32x4*)(rowp + bj * HALF) = w; } }
    }
};
template <bool BASE_BF16> struct EpiRes {
    static constexpr bool PERM = true, AFTER_DRAIN = false;
    const void* base; bf16_t* out; float alpha;
    __device__ __forceinline__ void operator()(const f32x4 (&acc)[2][2][4][2], const Unit& u_, int wr, int wc, int fr, int fq) const {
        Unit u = u_; asm volatile("" : "+s"(u.pm), "+s"(u.pn)); { const int l_ = hw_lane(); fr = l_ & 15; fq = l_ >> 4; }
        const int row0 = u.pm * BM + wr * 64 + fr, col0 = u.pn * BM + wc * 32 + 8 * fq;
        if (BASE_BF16) {
            u32x4 bb[2][4][2];
#pragma unroll
            for (int ai = 0; ai < 2; ++ai)
#pragma unroll
                for (int m = 0; m < 4; ++m)
#pragma unroll
                    for (int bj = 0; bj < 2; ++bj) bb[ai][m][bj] = *(const u32x4*)((const bf16_t*)base + (size_t)(row0 + ai * HALF + m * 16) * 1024 + col0 + bj * HALF);
#pragma unroll
            for (int ai = 0; ai < 2; ++ai)
#pragma unroll
                for (int m = 0; m < 4; ++m) { const size_t off = (size_t)(row0 + ai * HALF + m * 16) * 1024 + col0;
#pragma unroll
                    for (int bj = 0; bj < 2; ++bj) { const u32x4 b = bb[ai][m][bj];
                        const f32x4 b0 = (f32x4){__uint_as_float(b.x << 16), __uint_as_float(b.x & 0xffff0000u), __uint_as_float(b.y << 16), __uint_as_float(b.y & 0xffff0000u)};
                        const f32x4 b1 = (f32x4){__uint_as_float(b.z << 16), __uint_as_float(b.z & 0xffff0000u), __uint_as_float(b.w << 16), __uint_as_float(b.w & 0xffff0000u)};
                        const f32x4 v0 = b0 * alpha + acc[ai][bj][m][0], v1 = b1 * alpha + acc[ai][bj][m][1];
                        u32x4 w; w.x = cvt_pk_bf16(v0[0], v0[1]); w.y = cvt_pk_bf16(v0[2], v0[3]); w.z = cvt_pk_bf16(v1[0], v1[1]); w.w = cvt_pk_bf16(v1[2], v1[3]);
                        *(u32x4*)(out + off + bj * HALF) = w; } }
        } else {
#pragma unroll
            for (int ai = 0; ai < 2; ++ai) { f32x4 bf[4][2][2];
#pragma unroll
                for (int m = 0; m < 4; ++m)
#pragma unroll
                    for (int bj = 0; bj < 2; ++bj) { const float* bp = (const float*)base + (size_t)(row0 + ai * HALF + m * 16) * 1024 + col0 + bj * HALF; bf[m][bj][0] = *(const f32x4*)bp; bf[m][bj][1] = *(const f32x4*)(bp + 4); }
#pragma unroll
                for (int m = 0; m < 4; ++m) { const size_t off = (size_t)(row0 + ai * HALF + m * 16) * 1024 + col0;
#pragma unroll
                    for (int bj = 0; bj < 2; ++bj) { const f32x4 v0 = bf[m][bj][0] * alpha + acc[ai][bj][m][0], v1 = bf[m][bj][1] * alpha + acc[ai][bj][m][1];
                        u32x4 w; w.x = cvt_pk_bf16(v0[0], v0[1]); w.y = cvt_pk_bf16(v0[2], v0[3]); w.z = cvt_pk_bf16(v1[0], v1[1]); w.w = cvt_pk_bf16(v1[2], v1[3]);
                        *(u32x4*)(out + off + bj * HALF) = w; } }
                asm volatile("" ::: "memory"); }
        }
    }
};
struct EpiKV {
    static constexpr bool PERM = true, AFTER_DRAIN = false;
    unsigned char* Kb; bf16_t* Vb;
    __device__ __forceinline__ void operator()(const f32x4 (&acc)[2][2][4][2], const Unit& u_, int wr, int wc, int fr, int fq) const {
        Unit u = u_; asm volatile("" : "+s"(u.pm), "+s"(u.pn)); { const int l_ = hw_lane(); fr = l_ & 15; fq = l_ >> 4; }
        const int row0 = u.pm * BM + wr * 64 + fr, col0 = u.pn * BM + wc * 32 + 8 * fq;
        typedef unsigned u32x2 __attribute__((ext_vector_type(2)));
#pragma unroll
        for (int bj = 0; bj < 2; ++bj) { const int c = col0 + bj * HALF; const bool isk = c < 1024;
#pragma unroll
            for (int ai = 0; ai < 2; ++ai)
#pragma unroll
                for (int m = 0; m < 4; ++m) { const int row = row0 + ai * HALF + m * 16; const f32x4 v0 = acc[ai][bj][m][0], v1 = acc[ai][bj][m][1];
                    if (isk) { u32x2 w; int t = __builtin_amdgcn_cvt_pk_fp8_f32(v0[0], v0[1], 0, false); t = __builtin_amdgcn_cvt_pk_fp8_f32(v0[2], v0[3], t, true); w.x = (unsigned)t;
                        t = __builtin_amdgcn_cvt_pk_fp8_f32(v1[0], v1[1], 0, false); t = __builtin_amdgcn_cvt_pk_fp8_f32(v1[2], v1[3], t, true); w.y = (unsigned)t;
                        *(u32x2*)(Kb + (size_t)row * 1536 + (c >> 7) * 192 + (c & 127)) = w; }
                    else { u32x4 w; w.x = cvt_pk_bf16(v0[0], v0[1]); w.y = cvt_pk_bf16(v0[2], v0[3]); w.z = cvt_pk_bf16(v1[0], v1[1]); w.w = cvt_pk_bf16(v1[2], v1[3]);
                        *(u32x4*)(Vb + (size_t)row * 1024 + (c - 1024)) = w; } } }
    }
};
#define DPP_SHR1 0x111
#define DPP_SHL1 0x101
#define DPP_SHL15 0x10F
#define DPP_SHR15 0x11F
template <int CTRL> __device__ __forceinline__ float dpp_mov(float old, float src) { return __int_as_float(__builtin_amdgcn_update_dpp(__float_as_int(old), __float_as_int(src), CTRL, 0xF, 0xF, false)); }
struct EpiConvSilu {
    static constexpr bool PERM = true, AFTER_DRAIN = false;
    bf16_t* H; const float* wcv; float* halo; PG8_LAS float* ex;
    __device__ __forceinline__ void operator()(const f32x4 (&acc)[2][2][4][2], const Unit& u_, int wr, int wc, int fr, int fq) const {
        Unit u = u_; asm volatile("" : "+s"(u.pm), "+s"(u.pn)); { const int l_ = hw_lane(); fr = l_ & 15; fq = l_ >> 4; }
        const int hc0 = wc * 32 + 8 * fq;
#pragma unroll
        for (int ai = 0; ai < 2; ++ai)
#pragma unroll
            for (int bj = 0; bj < 2; ++bj)
#pragma unroll
                for (int n = 0; n < 2; ++n) {
                    if (fr == 0)  *(PG8_LAS f32x4*)(ex + ((ai * 2 + wr) * 2 + 0) * 256 + bj * 128 + hc0 + 4 * n) = acc[ai][bj][0][n];
                    if (fr == 15) *(PG8_LAS f32x4*)(ex + ((ai * 2 + wr) * 2 + 1) * 256 + bj * 128 + hc0 + 4 * n) = acc[ai][bj][3][n]; }
        if (wr == 0 && fr < 2) {
#pragma unroll
            for (int bj = 0; bj < 2; ++bj)
#pragma unroll
                for (int n = 0; n < 2; ++n) *(f32x4*)(halo + ((size_t)u.pm * 4 + fr) * 5632 + u.pn * 256 + bj * 128 + hc0 + 4 * n) = acc[0][bj][0][n]; }
        if (wr == 1 && fr >= 14) {
#pragma unroll
            for (int bj = 0; bj < 2; ++bj)
#pragma unroll
                for (int n = 0; n < 2; ++n) *(f32x4*)(halo + ((size_t)u.pm * 4 + 2 + (fr - 14)) * 5632 + u.pn * 256 + bj * 128 + hc0 + 4 * n) = acc[1][bj][3][n]; }
        asm volatile("s_waitcnt lgkmcnt(0)" ::: "memory"); __builtin_amdgcn_s_barrier(); asm volatile("" ::: "memory");
        float wv[2][3][8];
        { const int cg = u.pn * 128 + hc0;
#pragma unroll
          for (int bj = 0; bj < 2; ++bj)
#pragma unroll
            for (int k = 0; k < 3; ++k) { const f32x4 t0 = *(const f32x4*)(wcv + k * 5632 + bj * 2816 + cg), t1 = *(const f32x4*)(wcv + k * 5632 + bj * 2816 + cg + 4);
                wv[bj][k][0] = t0[0]; wv[bj][k][1] = t0[1]; wv[bj][k][2] = t0[2]; wv[bj][k][3] = t0[3]; wv[bj][k][4] = t1[0]; wv[bj][k][5] = t1[1]; wv[bj][k][6] = t1[2]; wv[bj][k][7] = t1[3]; } }
#pragma unroll
        for (int ai = 0; ai < 2; ++ai) {
            const int ch = ai * 2 + wr, cp = ch > 0 ? ch - 1 : 0, cn = ch < 3 ? ch + 1 : 3;
            f32x4 pe[2][2], ne[2][2];
#pragma unroll
            for (int bj = 0; bj < 2; ++bj)
#pragma unroll
                for (int n = 0; n < 2; ++n) { pe[bj][n] = *(const PG8_LAS f32x4*)(ex + (cp * 2 + 1) * 256 + bj * 128 + hc0 + 4 * n); ne[bj][n] = *(const PG8_LAS f32x4*)(ex + (cn * 2 + 0) * 256 + bj * 128 + hc0 + 4 * n); }
#pragma unroll
            for (int m = 0; m < 4; ++m) {
                float hv[2][8];
#pragma unroll
                for (int bj = 0; bj < 2; ++bj)
#pragma unroll
                    for (int n = 0; n < 2; ++n)
#pragma unroll
                        for (int j = 0; j < 4; ++j) {
                            const float cur = acc[ai][bj][m][n][j];
                            const float pin = (m > 0) ? dpp_mov<DPP_SHL15>(0.f, acc[ai][bj][m > 0 ? m - 1 : 0][n][j]) : pe[bj][n][j];
                            const float nin = (m < 3) ? dpp_mov<DPP_SHR15>(0.f, acc[ai][bj][m < 3 ? m + 1 : 3][n][j]) : ne[bj][n][j];
                            const float prv = dpp_mov<DPP_SHR1>(pin, cur), nxt = dpp_mov<DPP_SHL1>(nin, cur);
                            hv[bj][4 * n + j] = wv[bj][0][4 * n + j] * prv + wv[bj][1][4 * n + j] * cur + wv[bj][2][4 * n + j] * nxt; }
                float o[8];
#pragma unroll
                for (int i = 0; i < 8; ++i) o[i] = hv[0][i] * hv[1][i] * __builtin_amdgcn_rcpf(1.f + __expf(-hv[1][i]));
                u32x4 w; w.x = cvt_pk_bf16(o[0], o[1]); w.y = cvt_pk_bf16(o[2], o[3]); w.z = cvt_pk_bf16(o[4], o[5]); w.w = cvt_pk_bf16(o[6], o[7]);
                *(u32x4*)(H + (size_t)(u.pm * BM + ai * HALF + wr * 64 + m * 16 + fr) * 2816 + u.pn * 128 + hc0) = w;
            }
        }
        asm volatile("s_waitcnt lgkmcnt(0)" ::: "memory"); __builtin_amdgcn_s_barrier(); asm volatile("" ::: "memory");
    }
};

struct EpiFilt {
    static constexpr bool PERM = false, AFTER_DRAIN = false;
    float* KT; int L; float d0, dstep, tinv;
    __device__ __forceinline__ void operator()(const f32x4 (&acc)[2][2][4][2], const Unit& u_, int wr, int wc, int fr, int fq) const {
        Unit u = u_; asm volatile("" : "+s"(u.pm), "+s"(u.pn)); { const int l_ = hw_lane(); fr = l_ & 15; fq = l_ >> 4; }
        const int row0 = u.pm * BM + wr * 64 + fr, col0 = u.pn * BM + wc * 32 + 4 * fq;
#pragma unroll
        for (int bj = 0; bj < 2; ++bj)
#pragma unroll
            for (int n = 0; n < 2; ++n) { const int c = col0 + bj * HALF + n * 16;
#pragma unroll
                for (int j = 0; j < 4; ++j) { const int cc = c + j, ch = cc & 1023; const float nd = -__builtin_fabsf(d0 + (float)ch * dstep) * tinv; float* dst = KT + (size_t)cc * L;
#pragma unroll
                    for (int ai = 0; ai < 2; ++ai)
#pragma unroll
                        for (int m = 0; m < 4; ++m) { const int l = row0 + ai * HALF + m * 16; dst[l] = acc[ai][bj][m][n][j] * __expf(nd * (float)l); } } }
    }
};

template <class Epi, class Sched, bool ALIGN_EPI = false, bool SP2 = false>
__device__ __forceinline__ void gemm_phase(PG8_LAS unsigned char* lds, const Gemm g, const Sched& S, const Epi& E, int wid_in) {
    const int wid = wid_in, lane = hw_lane(), tid = wid * 64 + lane, wr = wid >> 2, wc = wid & 3, fr = lane & 15, fq = lane >> 4;
    const int K = g.K, nt = K / BK;
    unsigned voffA[2], voffB[2];
#pragma unroll
    for (int i = 0; i < 2; ++i) { int R, C; stage_rc(tid * 16 + i * 8192, R, C); const int Rb = Epi::PERM ? ((R & ~31) + perm32(R & 31)) : R;
        voffA[i] = (unsigned)(R * K + C) * 2u; voffB[i] = (unsigned)(Rb * K + C) * 2u; }
    const size_t kstep = (size_t)(BK * 2);
    const size_t hstep = (size_t)HALF * K * 2;
    const size_t tstep = 2 * hstep;
    const unsigned ldsw = (unsigned)wid * 1024u;
    const int aoff = lds_byte(wr * 64 + fr, fq * 8), boff = lds_byte(wc * 32 + fr, fq * 8);
#define PG8_SA(b, h) (((b) * 2 + (h)) * HTB)
#define PG8_SB(b, h) ((4 + (b) * 2 + (h)) * HTB)
#define PG8_STAGE(bufoff, gbase, voff) do { _Pragma("unroll") for (int _i = 0; _i < 2; ++_i) \
        __builtin_amdgcn_global_load_lds((const unsigned*)((const char*)(gbase) + (voff)[_i]), (PG8_LAS unsigned*)(lds + (bufoff) + ldsw + _i * 8192), 16, 0, 0); } while (0)
#define PG8_LDA(dst, b, h) do { _Pragma("unroll") for (int m = 0; m < 4; ++m) _Pragma("unroll") for (int k = 0; k < 2; ++k) dst[m][k] = *(const PG8_LAS bf16x8*)(lds + PG8_SA(b, h) + aoff + m * 2048 + k * 1024); } while (0)
#define PG8_LDB(dst, b, h) do { _Pragma("unroll") for (int n = 0; n < 2; ++n) _Pragma("unroll") for (int k = 0; k < 2; ++k) dst[n][k] = *(const PG8_LAS bf16x8*)(lds + PG8_SB(b, h) + boff + n * 2048 + k * 1024); } while (0)
#define PG8_MMA(ai, bj, At, Bt) do { __builtin_amdgcn_s_setprio(1); _Pragma("unroll") for (int m = 0; m < 4; ++m) _Pragma("unroll") for (int n = 0; n < 2; ++n) _Pragma("unroll") for (int k = 0; k < 2; ++k) \
        acc[ai][bj][m][n] = __builtin_amdgcn_mfma_f32_16x16x32_bf16(Bt[n][k], At[m][k], acc[ai][bj][m][n], 0, 0, 0); __builtin_amdgcn_s_setprio(0); } while (0)
#define PG8_WAIT_V(n) asm volatile("s_waitcnt vmcnt(" #n ")" ::: "memory")
#define PG8_WAIT_L(n) asm volatile("s_waitcnt lgkmcnt(" #n ")" ::: "memory")
#define PG8_BAR __builtin_amdgcn_s_barrier()
#define PG8_SCHED __builtin_amdgcn_sched_barrier(0)
    Unit cur, nxt; int ui = 0;
    if (!S.next(0, cur)) return;
    f32x4 acc[2][2][4][2];
#pragma unroll
    for (int a = 0; a < 2; ++a)
#pragma unroll
        for (int b = 0; b < 2; ++b)
#pragma unroll
            for (int m = 0; m < 4; ++m)
#pragma unroll
                for (int n = 0; n < 2; ++n) acc[a][b][m][n] = (f32x4){0.f, 0.f, 0.f, 0.f};
    bf16x8 At[4][2], B0[2][2], B1[2][2];
    const char* cA = (const char*)g.A + (size_t)cur.pm * tstep; const char* cB = (const char*)g.Bt + (size_t)cur.pn * tstep;
    S.a_ready(cur);
    if constexpr (SP2) {
        PG8_STAGE(PG8_SB(0, 0), cB, voffB); PG8_STAGE(PG8_SB(0, 1), cB + hstep, voffB); PG8_STAGE(PG8_SA(0, 0), cA, voffA); PG8_STAGE(PG8_SA(0, 1), cA + hstep, voffA);
        if (wr == 1) PG8_BAR;
        PG8_WAIT_V(2); PG8_BAR;
        PG8_STAGE(PG8_SB(1, 0), cB + kstep, voffB); PG8_STAGE(PG8_SA(1, 0), cA + kstep, voffA); PG8_STAGE(PG8_SB(1, 1), cB + hstep + kstep, voffB);
        PG8_WAIT_V(6); PG8_BAR;
    } else {
        PG8_STAGE(PG8_SB(0, 0), cB, voffB); PG8_STAGE(PG8_SA(0, 0), cA, voffA); PG8_STAGE(PG8_SB(0, 1), cB + hstep, voffB); PG8_STAGE(PG8_SA(0, 1), cA + hstep, voffA);
        if (wr == 1) PG8_BAR;
        PG8_WAIT_V(4); PG8_BAR;
        PG8_STAGE(PG8_SB(1, 0), cB + kstep, voffB); PG8_STAGE(PG8_SA(1, 0), cA + kstep, voffA); PG8_STAGE(PG8_SB(1, 1), cB + hstep + kstep, voffB);
        PG8_WAIT_V(6); PG8_BAR;
    }
    for (;;) {
        const bool has_next = S.next(ui + 1, nxt);
        const char* nA = has_next ? (const char*)g.A + (size_t)nxt.pm * tstep : cA; const char* nB = has_next ? (const char*)g.Bt + (size_t)nxt.pn * tstep : cB;
        for (int t = 0; t < nt; t += 2) {
            const bool last = (t == nt - 2);
            const char* a1 = cA + (size_t)(t + 1) * kstep;
            const char* a2 = last ? nA : cA + (size_t)(t + 2) * kstep; const char* b2 = last ? nB : cB + (size_t)(t + 2) * kstep;
            const char* a3 = a2 + kstep; const char* b3 = b2 + kstep;
            if (last && has_next) S.a_ready(nxt);
            if constexpr (SP2) {
            PG8_LDB(B0, 0, 0); PG8_LDB(B1, 0, 1); PG8_SCHED; PG8_LDA(At, 0, 0); PG8_STAGE(PG8_SA(1, 1), a1 + hstep, voffA);
            PG8_WAIT_V(8); PG8_WAIT_L(0); PG8_BAR; PG8_MMA(0, 0, At, B0); PG8_MMA(0, 1, At, B1); PG8_BAR; PG8_SCHED;
            PG8_LDA(At, 0, 1); PG8_STAGE(PG8_SB(0, 0), b2, voffB); PG8_STAGE(PG8_SB(0, 1), b2 + hstep, voffB); PG8_STAGE(PG8_SA(0, 0), a2, voffA);
            PG8_WAIT_V(8); PG8_WAIT_L(0); PG8_BAR; PG8_MMA(1, 0, At, B0); PG8_MMA(1, 1, At, B1); PG8_BAR; PG8_SCHED;
            PG8_LDB(B0, 1, 0); PG8_LDB(B1, 1, 1); PG8_SCHED; PG8_LDA(At, 1, 0); PG8_STAGE(PG8_SA(0, 1), a2 + hstep, voffA);
            PG8_WAIT_V(8); PG8_WAIT_L(0); PG8_BAR; PG8_MMA(0, 0, At, B0); PG8_MMA(0, 1, At, B1); PG8_BAR; PG8_SCHED;
            PG8_LDA(At, 1, 1); PG8_STAGE(PG8_SB(1, 0), b3, voffB); PG8_STAGE(PG8_SB(1, 1), b3 + hstep, voffB); PG8_STAGE(PG8_SA(1, 0), a3, voffA);
            PG8_WAIT_V(8); PG8_WAIT_L(0); PG8_BAR; PG8_MMA(1, 0, At, B0); PG8_MMA(1, 1, At, B1); PG8_BAR; PG8_SCHED;
            } else {
            PG8_LDB(B0, 0, 0); PG8_SCHED; PG8_LDA(At, 0, 0); PG8_STAGE(PG8_SA(1, 1), a1 + hstep, voffA);
            PG8_WAIT_L(8); PG8_BAR; PG8_WAIT_L(0); PG8_MMA(0, 0, At, B0); PG8_BAR; PG8_SCHED;
            PG8_LDB(B1, 0, 1); PG8_STAGE(PG8_SB(0, 0), b2, voffB);
            PG8_BAR; PG8_WAIT_L(0); PG8_MMA(0, 1, At, B1); PG8_BAR;
            PG8_LDA(At, 0, 1); PG8_STAGE(PG8_SA(0, 0), a2, voffA);
            PG8_BAR; PG8_WAIT_L(0); PG8_MMA(1, 0, At, B0); PG8_BAR; PG8_SCHED;
            PG8_STAGE(PG8_SB(0, 1), b2 + hstep, voffB);
            PG8_WAIT_V(6); PG8_BAR; PG8_MMA(1, 1, At, B1); PG8_BAR;
            PG8_LDB(B0, 1, 0); PG8_SCHED; PG8_LDA(At, 1, 0); PG8_STAGE(PG8_SA(0, 1), a2 + hstep, voffA);
            PG8_WAIT_L(8); PG8_BAR; PG8_WAIT_L(0); PG8_MMA(0, 0, At, B0); PG8_BAR; PG8_SCHED;
            PG8_LDB(B1, 1, 1); PG8_STAGE(PG8_SB(1, 0), b3, voffB);
            PG8_BAR; PG8_WAIT_L(0); PG8_MMA(0, 1, At, B1); PG8_BAR;
            PG8_LDA(At, 1, 1); PG8_STAGE(PG8_SA(1, 0), a3, voffA);
            PG8_BAR; PG8_WAIT_L(0); PG8_MMA(1, 0, At, B0); PG8_BAR; PG8_SCHED;
            PG8_STAGE(PG8_SB(1, 1), b3 + hstep, voffB);
            PG8_WAIT_V(6); PG8_BAR; PG8_MMA(1, 1, At, B1); PG8_BAR;
            }
        }
        if constexpr (ALIGN_EPI) { if (wr == 0) PG8_BAR; }
        if constexpr (!Epi::AFTER_DRAIN) { E(acc, cur, wr, wc, fr, fq); S.done(cur); }
        if (!has_next) break;
#pragma unroll
        for (int a = 0; a < 2; ++a)
#pragma unroll
            for (int b = 0; b < 2; ++b)
#pragma unroll
                for (int m = 0; m < 4; ++m)
#pragma unroll
                    for (int n = 0; n < 2; ++n) acc[a][b][m][n] = (f32x4){0.f, 0.f, 0.f, 0.f};
        cur = nxt; cA = nA; cB = nB; ++ui;
        if constexpr (ALIGN_EPI) { if (wr == 1) PG8_BAR; }
    }
    PG8_WAIT_V(0);
    if constexpr (!ALIGN_EPI) { if (wr == 0) PG8_BAR; }
    PG8_BAR;
    if constexpr (Epi::AFTER_DRAIN) { E.fused(acc, cur, wr, wc, fr, fq, lds, wid, lane); S.done(cur); }
#undef PG8_SA
#undef PG8_SB
#undef PG8_STAGE
#undef PG8_LDA
#undef PG8_LDB
#undef PG8_MMA
#undef PG8_WAIT_V
#undef PG8_WAIT_L
#undef PG8_BAR
#undef PG8_SCHED
}
}
#define GAS __attribute__((address_space(1)))
#define LAS __attribute__((address_space(3)))
typedef unsigned short bf16;
typedef unsigned v4u __attribute__((ext_vector_type(4)));
typedef float f32x4 __attribute__((ext_vector_type(4)));
typedef short bf16x8 __attribute__((ext_vector_type(8)));
typedef GAS unsigned gu32;
typedef GAS unsigned long long gu64;
#define RLX_AGENT __ATOMIC_RELAXED, __HIP_MEMORY_SCOPE_AGENT
#define LDS_WAIT() asm volatile("s_waitcnt lgkmcnt(0)" ::: "memory")
#define VM_WAIT() asm volatile("s_waitcnt vmcnt(0)" ::: "memory")
__device__ __forceinline__ unsigned long long rt() { return __builtin_amdgcn_s_memrealtime(); }
__device__ __forceinline__ unsigned f2bf(float f) { unsigned u = __builtin_bit_cast(unsigned, f); return (u + 0x7fffu + ((u >> 16) & 1u)) >> 16; }
__device__ __forceinline__ unsigned pk2(float lo, float hi) { return f2bf(lo) | (f2bf(hi) << 16); }

#define XB_TMO      128
#define XB_XCNT(j)  (256  + 64 * (j))
#define XB_XSUB(j)  (1280 + 64 * (j))
#define XB_XGEN(j)  (2304 + 64 * (j))
#define XB_TOP      3328
#define XB_TOPGEN   3392
#define XCD_BAR_WORDS 3456
#define XB_SPIN_CAP (1u << 18)

__device__ __forceinline__ unsigned xb_ld(unsigned* p)              { return __hip_atomic_load(p, __ATOMIC_RELAXED, __HIP_MEMORY_SCOPE_AGENT); }
__device__ __forceinline__ unsigned xb_add(unsigned* p, unsigned v) { return __hip_atomic_fetch_add(p, v, __ATOMIC_RELAXED, __HIP_MEMORY_SCOPE_AGENT); }
__device__ __forceinline__ unsigned xb_xcc_id() { return (unsigned)__builtin_amdgcn_s_getreg((3 << 11) | 20) & 0xFu; }
#define XB_SPIN(cond, bar) do { unsigned _sp = 0; while (cond) { __builtin_amdgcn_s_sleep(1); \
    if ((++_sp & 255u) == 0u) { if (xb_ld(&(bar)[XB_TMO])) break; if (_sp > XB_SPIN_CAP) { atomicAdd(&(bar)[XB_TMO], 1u); break; } } } } while (0)

struct XcdBarrier {
    unsigned* bar; unsigned x; unsigned wv;
    volatile LAS unsigned* st;
};

__device__ __forceinline__ XcdBarrier xcd_barrier_post(unsigned* bar, volatile LAS unsigned* st, unsigned wv) {
    XcdBarrier b; b.bar = bar; b.x = xb_xcc_id(); b.st = st; b.wv = wv;
    if (wv == 0u && hw_lane() == 0) (void)xb_add(&bar[XB_XCNT(b.x)], 1u);
    return b;
}
__device__ __forceinline__ void xcd_barrier_complete(unsigned* bar, unsigned x, unsigned& nloc, unsigned& nx) {
    const unsigned G = gridDim.x * gridDim.y * gridDim.z;
    unsigned sum, cnt, mine, sp = 0u;
    for (;;) {
        sum = 0u; cnt = 0u; mine = 0u;
#pragma unroll
        for (unsigned j = 0; j < 16; ++j) { const unsigned c = xb_ld(&bar[XB_XCNT(j)]); sum += c; cnt += (c > 0u) ? 1u : 0u; mine = (j == x) ? c : mine; }
        if (sum == G) break;
        __builtin_amdgcn_s_sleep(1);
        if ((++sp & 255u) == 0u) { if (xb_ld(&bar[XB_TMO])) break; if (sp > XB_SPIN_CAP) { atomicAdd(&bar[XB_TMO], 1u); break; } }
    }
    nloc = mine > 0u ? mine : 1u; nx = cnt > 0u ? cnt : 1u;
}

__device__ __forceinline__ void xcd_barrier(const XcdBarrier& b) {
    asm volatile("s_waitcnt vmcnt(0)" ::: "memory");
    __syncthreads();
    if (b.wv == 0u && hw_lane() == 0) {
        unsigned* bar = b.bar;
        __builtin_amdgcn_s_waitcnt(0);
        unsigned nloc = b.st[0], nx = b.st[1];
        if (nloc == 0u) { xcd_barrier_complete(bar, b.x, nloc, nx); b.st[0] = nloc; b.st[1] = nx; }
        const unsigned old = xb_add(&bar[XB_XSUB(b.x)], 1u);
        const unsigned gen = old / nloc;
        if (old + 1u == (gen + 1u) * nloc) {
            __builtin_amdgcn_fence(__ATOMIC_RELEASE, "agent");
            asm volatile("s_waitcnt vmcnt(0)" ::: "memory");
            const unsigned og = xb_add(&bar[XB_TOP], 1u);
            const unsigned tg = og / nx;
            if (og + 1u == (tg + 1u) * nx) xb_add(&bar[XB_TOPGEN], 1u);
            else XB_SPIN(xb_ld(&bar[XB_TOPGEN]) == tg, bar);
            __builtin_amdgcn_fence(__ATOMIC_ACQUIRE, "agent");
            xb_add(&bar[XB_XGEN(b.x)], 1u);
            asm volatile("s_waitcnt vmcnt(0)" ::: "memory");
        } else {
            XB_SPIN(xb_ld(&bar[XB_XGEN(b.x)]) == gen, bar);
            __builtin_amdgcn_fence(__ATOMIC_ACQUIRE, "agent");
            asm volatile("s_waitcnt vmcnt(0)" ::: "memory");
        }
    }
    __syncthreads();
}
namespace attn {
using f32x16 = __attribute__((ext_vector_type(16))) float;
using u32x4  = __attribute__((ext_vector_type(4))) unsigned;
constexpr int NW = 8, QBLK = 32, KVBLK = 64, DQ = 192, DVV = 128;
constexpr int LDQ = 1536, LDO = 1024;
constexpr float THRL = 7.0f;
#define SBAR() __builtin_amdgcn_sched_barrier(0)
__device__ __forceinline__ int crow(int r, int hi) { return (r & 3) + 8 * (r >> 2) + 4 * hi; }
typedef int v8i __attribute__((ext_vector_type(8)));
typedef int v4i __attribute__((ext_vector_type(4)));
__device__ __forceinline__ int pk8(float a, float b, float c, float d) { int t = __builtin_amdgcn_cvt_pk_fp8_f32(a, b, 0, false); return __builtin_amdgcn_cvt_pk_fp8_f32(c, d, t, true); }
__device__ __forceinline__ unsigned cvtpk(float lo, float hi) { unsigned r; asm volatile("v_cvt_pk_bf16_f32 %0, %1, %2" : "=v"(r) : "v"(lo), "v"(hi)); return r; }

__device__ __forceinline__ float vmax3(float a, float b, float c) { float r; asm("v_max3_f32 %0, %1, %2, %3" : "=v"(r) : "v"(a), "v"(b), "v"(c)); return r; }
__device__ __forceinline__ float vmax2(float a, float b) { float r; asm("v_max_f32 %0, %1, %2" : "=v"(r) : "v"(a), "v"(b)); return r; }
__device__ __forceinline__ float softmaxPP(f32x16& p0, f32x16& p1, float& m_reg, f32x16& negm, float& l_reg, bool first, v8i& pa) {
  const float a0 = vmax3(p0[0], p0[1], p0[2]), a1 = vmax3(p0[3], p0[4], p0[5]), a2 = vmax3(p0[6], p0[7], p0[8]), a3 = vmax3(p0[9], p0[10], p0[11]), a4 = vmax3(p0[12], p0[13], p0[14]);
  const float a5 = vmax3(p1[0], p1[1], p1[2]), a6 = vmax3(p1[3], p1[4], p1[5]), a7 = vmax3(p1[6], p1[7], p1[8]), a8 = vmax3(p1[9], p1[10], p1[11]), a9 = vmax3(p1[12], p1[13], p1[14]);
  const float b0 = vmax3(a0, a1, a2), b1 = vmax3(a3, a4, a5), b2 = vmax3(a6, a7, a8), b3 = vmax3(a9, p0[15], p1[15]);
  float pmax = vmax2(vmax3(b0, b1, b2), b3);
  { auto rr = __builtin_amdgcn_permlane32_swap(__float_as_uint(pmax), __float_as_uint(pmax), false, false); pmax = vmax2(__uint_as_float(rr[0]), __uint_as_float(rr[1])); }
  float alpha = 1.f;
  if (__builtin_expect(first || __any(pmax > THRL), 0)) { const float dl = first ? pmax : vmax2(pmax, 0.f); alpha = first ? 1.f : __builtin_amdgcn_exp2f(-dl); m_reg += dl;
    for (int r = 0; r < 16; ++r) { p0[r] -= dl; p1[r] -= dl; }
    for (int r = 0; r < 16; ++r) negm[r] = -m_reg; }
  for (int r = 0; r < 16; ++r) p0[r] = __builtin_amdgcn_exp2f(p0[r]);
  for (int r = 0; r < 16; ++r) p1[r] = __builtin_amdgcn_exp2f(p1[r]);
  float s0 = (p0[0] + p0[1]) + (p0[2] + p0[3]), s1 = (p0[4] + p0[5]) + (p0[6] + p0[7]), s2 = (p0[8] + p0[9]) + (p0[10] + p0[11]), s3 = (p0[12] + p0[13]) + (p0[14] + p0[15]);
  s0 += (p1[0] + p1[1]) + (p1[2] + p1[3]); s1 += (p1[4] + p1[5]) + (p1[6] + p1[7]); s2 += (p1[8] + p1[9]) + (p1[10] + p1[11]); s3 += (p1[12] + p1[13]) + (p1[14] + p1[15]);
  float ps = (s0 + s1) + (s2 + s3);
  { auto rr = __builtin_amdgcn_permlane32_swap(__float_as_uint(ps), __float_as_uint(ps), false, false); ps = __uint_as_float(rr[0]) + __uint_as_float(rr[1]); }
  l_reg = l_reg * alpha + ps;
#pragma unroll
  for (int w = 0; w < 4; ++w) {
    pa[w] = __builtin_amdgcn_cvt_pk_fp8_f32(p0[4 * w], p0[4 * w + 1], pa[w], false); pa[w] = __builtin_amdgcn_cvt_pk_fp8_f32(p0[4 * w + 2], p0[4 * w + 3], pa[w], true);
    pa[4 + w] = __builtin_amdgcn_cvt_pk_fp8_f32(p1[4 * w], p1[4 * w + 1], pa[4 + w], false); pa[4 + w] = __builtin_amdgcn_cvt_pk_fp8_f32(p1[4 * w + 2], p1[4 * w + 3], pa[4 + w], true); }
  return alpha;
}
typedef unsigned short bf16r;
constexpr int KROWB = 192, LDKB = 1536, SHM_K3 = KVBLK * KROWB, SHM_V3 = KVBLK * DVV, NSLOT = 4;
constexpr int LDS_K3 = 0, LDS_V3 = NSLOT * SHM_K3, LDS_WS3 = LDS_V3 + NSLOT * SHM_V3, SHM_ATTN3 = LDS_WS3 + NW * 64 * 4;
__device__ __forceinline__ void glds16(const void* gsrc, unsigned lds_dst) { unsigned keep;
  asm volatile("s_mov_b32 %0, m0\n\ts_mov_b32 m0, %2\n\ts_nop 0\n\tglobal_load_lds_dwordx4 %1, off\n\ts_mov_b32 m0, %0" : "=&s"(keep) : "v"(gsrc), "s"(lds_dst) : "memory"); }
__device__ __forceinline__ float bfl(unsigned w) { return __uint_as_float(w << 16); }
__device__ __forceinline__ float bfh(unsigned w) { return __uint_as_float(w & 0xffff0000u); }
template <int AEXP> __device__ __forceinline__ void attn_unit(const bf16r* __restrict__ Qb, const unsigned char* __restrict__ Kh, const unsigned char* __restrict__ Vh, bf16r* __restrict__ Ob, const float* __restrict__ tab, int seq, char* lds, int wid) {
  const int lane = hw_lane(), r32 = lane & 31, hi = lane >> 5;
  const unsigned lds0 = (unsigned)(uintptr_t)lds;
  float* wsf = (float*)(lds + LDS_WS3) + wid * 64; float* li_l = wsf; float* al_l = wsf + 32;
  float m_reg = 0.f, l_reg = 0; f32x16 o[4] = {}; v8i qf[3]; f32x16 negm = {}; asm volatile("" : "+v"(negm));
  int kof[2], vof;
#pragma unroll
  for (int i = 0; i < 2; ++i) { const int ob = (wid + 8 * i) * 1024 + 16 * lane, row = ob / KROWB, pp = (ob - row * KROWB) >> 4, sl = pp ^ ((row >> 2) & 3); kof[i] = row * LDKB + sl * 16; }
  { const int c = 16 * wid + (lane >> 2), sl = (lane & 3) ^ ((c >> 2) & 3); vof = c * seq + sl * 16; }
  const unsigned kdst = lds0 + LDS_K3 + wid * 1024, vdst = lds0 + LDS_V3 + wid * 1024;
#define DMA_KV(kt, ks, vt, vs) do { const unsigned char* kb_ = Kh + (long)(kt) * KVBLK * LDKB; const unsigned char* vb_ = Vh + (long)(vt) * KVBLK; const unsigned kd_ = (unsigned)__builtin_amdgcn_readfirstlane(kdst + (ks) * SHM_K3), vd_ = (unsigned)__builtin_amdgcn_readfirstlane(vdst + (vs) * SHM_V3); \
    glds16(kb_ + kof[0], kd_); if (wid < 4) glds16(kb_ + kof[1], kd_ + 8192); glds16(vb_ + vof, vd_); } while (0)
  int kq[2];
  { const int x = (r32 >> 2) & 3; const int kb = (int)lds0 + LDS_K3 + r32 * KROWB; kq[0] = kb + 16 * ((2 * hi) ^ x); kq[1] = kb + 16 * ((2 * hi + 1) ^ x); }
  int vq[2];
  { const int x = (r32 >> 2) & 3; const int vbb = (int)lds0 + LDS_V3 + r32 * 64; vq[0] = vbb + 16 * ((2 * hi) ^ x); vq[1] = vbb + 16 * ((2 * hi + 1) ^ x); }
#define RESC(a) do { if (__any((a) < 1.f)) { if (hi == 0) al_l[r32] = (a); asm volatile("s_waitcnt lgkmcnt(0)" ::: "memory"); \
    for (int d = 0; d < 4; ++d) for (int r = 0; r < 16; ++r) o[d][r] *= al_l[crow(r, hi)]; } } while (0)
  f32x16 p0 = {}, p1 = {}; float al; v8i pa = {}; const int NT = seq / KVBLK;
  int s0 = 0;
#define SL(d) ((s0 + (d)) & 3)
#define CLAMP(t) ((t) < NT ? (t) : NT - 1)
#define BAR() asm volatile("s_barrier" ::: "memory")
#define LGKM(n) do { asm volatile("s_waitcnt lgkmcnt(" #n ")" ::: "memory"); SBAR(); } while (0)
  DMA_KV(0, 0, 0, 0); DMA_KV(1, 1, 1, 1); DMA_KV(2, 2, 1, 1);
  { const bf16r* Qw = Qb + (long)(wid * QBLK + r32) * LDQ + hi * 32;
#pragma unroll
    for (int s = 0; s < 2; ++s) { u32x4 q4[4];
#pragma unroll
      for (int i = 0; i < 4; ++i) q4[i] = *reinterpret_cast<const u32x4*>(Qw + s * 64 + i * 8);
#pragma unroll
      for (int i = 0; i < 4; ++i) { qf[s][2 * i] = pk8(bfl(q4[i][0]), bfh(q4[i][0]), bfl(q4[i][1]), bfh(q4[i][1])); qf[s][2 * i + 1] = pk8(bfl(q4[i][2]), bfh(q4[i][2]), bfl(q4[i][3]), bfh(q4[i][3])); } }
    { const float* tr = tab + (long)(wid * QBLK + r32) * 64 + hi * 32;
#pragma unroll
      for (int i = 0; i < 4; ++i) { const u32x4 qv = *reinterpret_cast<const u32x4*>(Qw + 128 + i * 8);
        const float4 t0 = *reinterpret_cast<const float4*>(tr + i * 8), t1 = *reinterpret_cast<const float4*>(tr + i * 8 + 4);
        float r_[8];
#define ROT(K_, Q_, C_, S_) do { r_[K_] = bfl(Q_) * (C_) - bfh(Q_) * (S_); r_[K_ + 1] = bfl(Q_) * (S_) + bfh(Q_) * (C_); } while (0)
        ROT(0, qv[0], t0.x, t0.y); ROT(2, qv[1], t0.z, t0.w); ROT(4, qv[2], t1.x, t1.y); ROT(6, qv[3], t1.z, t1.w);
#undef ROT
        qf[2][2 * i] = pk8(r_[0], r_[1], r_[2], r_[3]); qf[2][2 * i + 1] = pk8(r_[4], r_[5], r_[6], r_[7]); } } }
  asm volatile("s_waitcnt vmcnt(0)\n\ts_barrier" ::: "memory");
#ifndef ATT_PRIO
#define ATT_PRIO 0
#endif
#ifndef ATT_HALF
#define ATT_HALF(w) ((w) >= 4)
#endif
#define KRD(F0, F1, OFF) asm volatile("ds_read_b128 %0, %4 offset:%6\n\tds_read_b128 %1, %5 offset:%6\n\tds_read_b128 %2, %4 offset:%7\n\tds_read_b128 %3, %5 offset:%7" \
    : "=&v"(F0##l), "=&v"(F0##h), "=&v"(F1##l), "=&v"(F1##h) : "v"(a0_), "v"(a1_), "i"(OFF), "i"((OFF) + 32 * KROWB) : "memory")
#define VRD8(FL, FH, CB) asm volatile("ds_read_b128 %0, %2 offset:%4\n\tds_read_b128 %1, %3 offset:%4" : "=&v"(FL), "=&v"(FH) : "v"(v0_), "v"(v1_), "i"((CB) * 2048) : "memory")
#define PV8(OD, FL, FH) do { if (AEXP == 2 || AEXP == 5) { asm volatile("" :: "v"(FL), "v"(FH)); break; } OD = __builtin_amdgcn_mfma_scale_f32_32x32x64_f8f6f4(pa, F8(FL, FH), OD, 0, 0, 0, 0, 0, 0); } while (0)
#define F8(L, H) (v8i){L[0], L[1], L[2], L[3], H[0], H[1], H[2], H[3]}
#define QK8(F0, F1, S, C0, C1) do { if (AEXP == 2 || AEXP == 5) { asm volatile("" :: "v"(F0##l), "v"(F1##h)); break; } p0 = __builtin_amdgcn_mfma_scale_f32_32x32x64_f8f6f4(F8(F0##l, F0##h), qf[S], C0, 0, 0, 0, 0, 0, 0); p1 = __builtin_amdgcn_mfma_scale_f32_32x32x64_f8f6f4(F8(F1##l, F1##h), qf[S], C1, 0, 0, 0, 0, 0, 0); } while (0)
#define MPH(PREV) do { const int ko_ = s0 * SHM_K3; const int a0_ = kq[0] + ko_, a1_ = kq[1] + ko_; const int vo_ = SL(3) * SHM_V3; const int v0_ = vq[0] + vo_, v1_ = vq[1] + vo_; \
    v4i ka0l, ka0h, ka1l, ka1h, kb0l, kb0h, kb1l, kb1h, v0l, v0h, v1l, v1h, v2l, v2h, v3l, v3h; \
    SBAR(); \
    KRD(ka0, ka1, 0); KRD(kb0, kb1, 64);                       \
    LGKM(4);  QK8(ka0, ka1, 0, negm, negm); \
    KRD(ka0, ka1, 128); VRD8(v0l, v0h, 0); VRD8(v1l, v1h, 1);   \
    LGKM(8);  QK8(kb0, kb1, 1, p0, p1); \
    VRD8(v2l, v2h, 2); VRD8(v3l, v3h, 3);                       \
    LGKM(8);  QK8(ka0, ka1, 2, p0, p1); \
    if (PREV) { LGKM(4); PV8(o[0], v0l, v0h); PV8(o[1], v1l, v1h); LGKM(0); PV8(o[2], v2l, v2h); PV8(o[3], v3l, v3h); } else { LGKM(0); } \
    } while (0)
#define WB() do { if (wid < 4) asm volatile("s_waitcnt vmcnt(3)\n\ts_barrier" ::: "memory"); else asm volatile("s_waitcnt vmcnt(2)\n\ts_barrier" ::: "memory"); } while (0)
#define VPH(j) do { if (AEXP != 3 && AEXP != 5) DMA_KV(CLAMP((j) + 3), SL(3), CLAMP((j) + 2), SL(2)); if (AEXP != 1 && AEXP != 5) { al = softmaxPP(p0, p1, m_reg, negm, l_reg, (j) == 0, pa); RESC(al); } else { asm volatile("" : "+v"(p0), "+v"(p1), "+v"(pa)); } s0 = SL(1); } while (0)
#define DRAIN() do { const int vo_ = SL(3) * SHM_V3; const int v0_ = vq[0] + vo_, v1_ = vq[1] + vo_; v4i v0l, v0h, v1l, v1h, v2l, v2h, v3l, v3h; \
    VRD8(v0l, v0h, 0); VRD8(v1l, v1h, 1); VRD8(v2l, v2h, 2); VRD8(v3l, v3h, 3); LGKM(0); PV8(o[0], v0l, v0h); PV8(o[1], v1l, v1h); PV8(o[2], v2l, v2h); PV8(o[3], v3l, v3h); } while (0)
  { const bool trail = ATT_HALF(wid);
    if (AEXP == 6 && trail) {
      BAR();
#pragma unroll 1
      for (int j = 0; j + 1 < NT; ++j) { DMA_KV(CLAMP((j) + 3), SL(3), CLAMP((j) + 2), SL(2)); s0 = SL(1); WB(); }
    } else {
    if (trail) BAR();
    if (ATT_PRIO == 1) __builtin_amdgcn_s_setprio(1);
    MPH(false); if (ATT_PRIO == 1) __builtin_amdgcn_s_setprio(0); if (!trail) WB();
#pragma unroll 1
    for (int j = 0; j + 1 < NT; ++j) { if (ATT_PRIO == 2) __builtin_amdgcn_s_setprio(1); VPH(j); if (ATT_PRIO == 2) __builtin_amdgcn_s_setprio(0); if (trail) WB(); if (ATT_PRIO == 1) __builtin_amdgcn_s_setprio(1); MPH(true); if (ATT_PRIO == 1) __builtin_amdgcn_s_setprio(0); if (!trail) WB(); }
    VPH(NT - 1); DRAIN(); } }
  if (hi == 0) li_l[r32] = l_reg; asm volatile("s_waitcnt lgkmcnt(0)" ::: "memory");
  float rli[16];
#pragma unroll
  for (int r = 0; r < 16; ++r) rli[r] = __builtin_amdgcn_rcpf(li_l[crow(r, hi)]);
  bf16r* Ow = Ob + (long)(wid * QBLK) * LDO;
#pragma unroll
  for (int r = 0; r < 16; ++r) { const int orow = crow(r, hi);
#pragma unroll
    for (int d0 = 0; d0 < 4; ++d0) { const unsigned w = cvtpk(o[d0][r] * rli[r], 0.f); Ow[(long)orow * LDO + d0 * 32 + r32] = (bf16r)(w & 0xffffu); } }
  asm volatile("s_waitcnt vmcnt(0) lgkmcnt(0)\n\ts_barrier" ::: "memory");
#undef DMA_KV
#undef RESC
#undef SL
#undef CLAMP
#undef BAR
#undef LGKM
#undef KRD
#undef VRD8
#undef PV8
#undef F8
#undef QK8
#undef MPH
#undef WB
#undef DRAIN
#undef VPH
}
#undef SBAR
}

namespace fftc {
#define FGAS __attribute__((address_space(1)))
typedef float f2 __attribute__((ext_vector_type(2)));
typedef __attribute__((address_space(3))) f2 lf2;
constexpr int L = 16384;
constexpr int FFT_LDS_BYTES = 17920 * 8;
__device__ static const float TW64C[32] = { 1.000000000e+00f, 9.951847267e-01f, 9.807852804e-01f, 9.569403357e-01f, 9.238795325e-01f, 8.819212643e-01f, 8.314696123e-01f, 7.730104534e-01f, 7.071067812e-01f, 6.343932842e-01f, 5.555702330e-01f, 4.713967368e-01f, 3.826834324e-01f, 2.902846773e-01f, 1.950903220e-01f, 9.801714033e-02f, 0.0f, -9.801714033e-02f, -1.950903220e-01f, -2.902846773e-01f, -3.826834324e-01f, -4.713967368e-01f, -5.555702330e-01f, -6.343932842e-01f, -7.071067812e-01f, -7.730104534e-01f, -8.314696123e-01f, -8.819212643e-01f, -9.238795325e-01f, -9.569403357e-01f, -9.807852804e-01f, -9.951847267e-01f };
__device__ static const float TW64S[32] = { 0.000000000e+00f, 9.801714033e-02f, 1.950903220e-01f, 2.902846773e-01f, 3.826834324e-01f, 4.713967368e-01f, 5.555702330e-01f, 6.343932842e-01f, 7.071067812e-01f, 7.730104534e-01f, 8.314696123e-01f, 8.819212643e-01f, 9.238795325e-01f, 9.569403357e-01f, 9.807852804e-01f, 9.951847267e-01f, 1.000000000e+00f, 9.951847267e-01f, 9.807852804e-01f, 9.569403357e-01f, 9.238795325e-01f, 8.819212643e-01f, 8.314696123e-01f, 7.730104534e-01f, 7.071067812e-01f, 6.343932842e-01f, 5.555702330e-01f, 4.713967368e-01f, 3.826834324e-01f, 2.902846773e-01f, 1.950903220e-01f, 9.801714033e-02f };
__device__ __forceinline__ f2 cmul(f2 a, f2 w) { return (f2){a.x * w.x - a.y * w.y, a.x * w.y + a.y * w.x}; }
template <bool INV> __device__ __forceinline__ f2 twmul(f2 d, int tw) {
    if (tw == 0) return d;
    if (tw == 16) return INV ? (f2){-d.y, d.x} : (f2){d.y, -d.x};
    const float c = TW64C[tw], s = TW64S[tw];
    return INV ? (f2){d.x * c - d.y * s, d.y * c + d.x * s} : (f2){d.x * c + d.y * s, d.y * c - d.x * s};
}
template <int N, int S, bool INV> __device__ __forceinline__ void dif_stage(f2 (&v)[N]) {
#pragma unroll
    for (int blk = 0; blk < N; blk += 2 * S)
#pragma unroll
        for (int i = 0; i < S; ++i) { const f2 a = v[blk + i], b = v[blk + i + S]; v[blk + i] = a + b; v[blk + i + S] = twmul<INV>(a - b, i * (32 / S)); }
    if constexpr (S > 1) dif_stage<N, S / 2, INV>(v);
}
constexpr int bitrev(int k, int bits) { int r = 0; for (int b = 0; b < bits; ++b) r |= ((k >> b) & 1) << (bits - 1 - b); return r; }
template <int N, bool INV> __device__ __forceinline__ void dft(f2 (&v)[N]) {
    dif_stage<N, N / 2, INV>(v);
    constexpr int bits = (N == 32) ? 5 : 4;
    f2 t[N];
#pragma unroll
    for (int k = 0; k < N; ++k) t[k] = v[bitrev(k, bits)];
#pragma unroll
    for (int k = 0; k < N; ++k) v[k] = t[k];
}
template <bool CONJ> __device__ __forceinline__ void apply_pow32(f2 (&v)[32], f2 w) {
    if (CONJ) w.y = -w.y;
    f2 lo[8]; lo[0] = (f2){1.f, 0.f}; lo[1] = w; lo[2] = cmul(w, w); lo[3] = cmul(lo[2], w); lo[4] = cmul(lo[2], lo[2]); lo[5] = cmul(lo[4], w); lo[6] = cmul(lo[4], lo[2]); lo[7] = cmul(lo[4], lo[3]);
#pragma unroll
    for (int k = 1; k < 32; ++k) if (k & 7) v[k] = cmul(v[k], lo[k & 7]);
    const f2 p8 = cmul(lo[4], lo[4]), p16 = cmul(p8, p8), p24 = cmul(p16, p8);
#pragma unroll
    for (int k = 8; k < 16; ++k) v[k] = cmul(v[k], p8);
#pragma unroll
    for (int k = 16; k < 24; ++k) v[k] = cmul(v[k], p16);
#pragma unroll
    for (int k = 24; k < 32; ++k) v[k] = cmul(v[k], p24);
}
__device__ __forceinline__ int opaque(int x) { asm volatile("" : "+v"(x)); return x; }
__device__ __forceinline__ f2 cis_pi(float x) { float s, c; sincospif(x, &s, &c); return (f2){c, s}; }
#define FPHYS(d1, d2, d3) ((d1) * 560 + (d2) * 17 + (d3))
#define FSYNC() __syncthreads()
template <int EV> __device__ __forceinline__ void pass1_fwd(lf2* X, f2 (&v)[32], int tid) {
    tid = opaque(tid);
    if (EV != 1) { dft<32, false>(v);
    apply_pow32<false>(v, cis_pi(-(float)tid * (2.0f / L))); }
    const int base = (tid >> 4) * 17 + (tid & 15);
#pragma unroll
    for (int k = 0; k < 32; ++k) { if (EV != 2) X[base + k * 560] = v[k]; else asm volatile("" :: "v"(v[k])); }
}
template <int EV> __device__ __forceinline__ void pass1_inv(const lf2* X, f2 (&v)[32], int tid) {
    tid = opaque(tid);
    const int base = (tid >> 4) * 17 + (tid & 15);
#pragma unroll
    for (int k = 0; k < 32; ++k) { if (EV != 2) v[k] = X[base + k * 560]; else v[k] = (f2){(float)(tid + k), 2.f}; }
    if (EV != 1) { apply_pow32<true>(v, cis_pi(-(float)tid * (2.0f / L)));
    dft<32, true>(v); }
}
template <bool INV, int EV> __device__ __forceinline__ void pass2(lf2* X, int tid) {
    tid = opaque(tid);
    const int base = (tid >> 4) * 560 + (tid & 15); f2 v[32];
    if (EV == 2) { for (int k = 0; k < 32; ++k) v[k] = (f2){(float)(tid + k), 1.f}; asm volatile("" : "+v"(v[0]), "+v"(v[7]), "+v"(v[19])); }
#pragma unroll
    for (int k = 0; k < 32; ++k) if (EV != 2) v[k] = X[base + k * 17];
    const f2 w = cis_pi(-(float)(tid & 15) * (2.0f / 512.0f));
    if (EV != 1) { if (INV) { apply_pow32<true>(v, w); dft<32, true>(v); } else { dft<32, false>(v); apply_pow32<false>(v, w); } }
#pragma unroll
    for (int k = 0; k < 32; ++k) { if (EV != 2) X[base + k * 17] = v[k]; else asm volatile("" :: "v"(v[k])); }
}
template <bool KMODE, int EV> __device__ __forceinline__ void pass3(lf2* X, f2 (&KR)[2][16], int tid) {
    tid = opaque(tid);
#pragma unroll
    for (int i = 0; i < 2; ++i) { const int base = ((tid >> 5) + 16 * i) * 560 + (tid & 31) * 17; f2 u[16];
#pragma unroll
        for (int k = 0; k < 16; ++k) u[k] = X[base + k];
        if (EV != 1) dft<16, false>(u);
        if (KMODE) {
#pragma unroll
            for (int k = 0; k < 16; ++k) KR[i][k] = u[k];
        } else {
#pragma unroll
            for (int k = 0; k < 16; ++k) u[k] = cmul(u[k], KR[i][k]);
            if (EV != 1) dft<16, true>(u);
#pragma unroll
            for (int k = 0; k < 16; ++k) X[base + k] = u[k];
        } }
}
template <int EV> __device__ __forceinline__ void kernel_spectrum(lf2* X, f2 (&v)[32], f2 (&KS)[2][16], int tid) {
    pass1_fwd<EV>(X, v, tid); FSYNC(); pass2<false, EV>(X, tid); FSYNC(); pass3<true, EV>(X, KS, tid); FSYNC();
}
template <int EV> __device__ __forceinline__ void conv_roundtrip(lf2* X, f2 (&v)[32], f2 (&KS)[2][16], int tid) {
    pass1_fwd<EV>(X, v, tid); FSYNC(); pass2<false, EV>(X, tid); FSYNC(); pass3<false, EV>(X, KS, tid); FSYNC(); pass2<true, EV>(X, tid); FSYNC(); pass1_inv<EV>(X, v, tid); FSYNC();
}
__device__ __forceinline__ void modulate(f2 (&v)[32], int tid) {
    const f2 wj = cis_pi(-(float)opaque(tid) * (1.0f / L));
#pragma unroll
    for (int k = 0; k < 32; ++k) v[k] = twmul<false>(cmul(v[k], wj), k);
}
__device__ __forceinline__ void demodulate(f2 (&v)[32], int tid) {
    f2 wj = cis_pi(-(float)opaque(tid) * (1.0f / L)); wj.y = -wj.y;
#pragma unroll
    for (int k = 0; k < 32; ++k) v[k] = twmul<true>(cmul(v[k], wj), k);
}
__device__ __forceinline__ float bf2f(unsigned short u) { return __uint_as_float((unsigned)u << 16); }
__device__ __forceinline__ unsigned short f2bf_rne(float f) { unsigned u = __float_as_uint(f); return (unsigned short)((u + 0x7fffu + ((u >> 16) & 1u)) >> 16); }
template <typename T> __device__ __forceinline__ FGAS T* pstep(FGAS T* p, int n) { p += n; asm volatile("" : "+v"(p)); return p; }
template <int MODE, int EV = 0> __device__ __forceinline__ void hyena_channel(lf2* X, const float* z0, const float* z1, const float* hf, const float* hb,
                                                                        const unsigned short* g0, const unsigned short* g1, float dbias, float* zo0, float* zo1,
                                                                        unsigned short* o0, unsigned short* o1, f2* stash, f2* KSg, int tid) {
    f2 v[32]; f2 KS[2][16];
    { FGAS const float* pf = (FGAS const float*)hf + opaque(tid); FGAS const float* pb = (FGAS const float*)hb + ((L - opaque(tid)) & (L - 1));
#pragma unroll
      for (int k = 0; k < 32; ++k) { v[k] = (EV == 3) ? (f2){1.f, 0.f} : (f2){*pf + *pb, 0.f}; pf = pstep(pf, 512); pb = (k == 0) ? pstep((FGAS const float*)hb + (L - 512 - tid), 0) : pstep(pb, -512); } }
    kernel_spectrum<EV>(X, v, KS, tid);
    { FGAS const float* p0 = (FGAS const float*)z0 + opaque(tid); FGAS const float* p1 = (FGAS const float*)z1 + opaque(tid);
#pragma unroll
      for (int k = 0; k < 32; ++k) { v[k] = (EV == 3) ? (f2){1.f, 2.f} : (f2){*p0, *p1}; p0 = pstep(p0, 512); p1 = pstep(p1, 512); } }
    conv_roundtrip<EV>(X, v, KS, tid);
    { FGAS f2* ps = (FGAS f2*)stash + opaque(tid);
#pragma unroll
      for (int k = 0; k < 32; ++k) { *ps = v[k]; ps = pstep(ps, 512); } }
    { FGAS const float* pf = (FGAS const float*)hf + opaque(tid); FGAS const float* pb = (FGAS const float*)hb + ((L - opaque(tid)) & (L - 1));
#pragma unroll
      for (int k = 0; k < 32; ++k) { const float hbv = (EV == 3) ? 1.f : *pb; v[k] = (f2){*pf + ((k == 0 && tid == 0) ? hbv : -hbv), 0.f}; pf = pstep(pf, 512); pb = (k == 0) ? pstep((FGAS const float*)hb + (L - 512 - tid), 0) : pstep(pb, -512); } }
    modulate(v, tid);
    kernel_spectrum<EV>(X, v, KS, tid);
    { FGAS const float* p0 = (FGAS const float*)z0 + opaque(tid); FGAS const float* p1 = (FGAS const float*)z1 + opaque(tid);
#pragma unroll
      for (int k = 0; k < 32; ++k) { v[k] = (EV == 3) ? (f2){1.f, 2.f} : (f2){*p0, *p1}; p0 = pstep(p0, 512); p1 = pstep(p1, 512); } }
    modulate(v, tid);
    conv_roundtrip<EV>(X, v, KS, tid);
    demodulate(v, tid);
    const float sc = 1.0f / (2.0f * L);
    { FGAS const f2* ps = (FGAS const f2*)stash + opaque(tid); FGAS const float* p0 = (FGAS const float*)z0 + opaque(tid); FGAS const float* p1 = (FGAS const float*)z1 + opaque(tid); FGAS const unsigned short* q0 = (FGAS const unsigned short*)g0 + opaque(tid); FGAS const unsigned short* q1 = (FGAS const unsigned short*)g1 + opaque(tid);
      FGAS float* w0 = (FGAS float*)zo0 + opaque(tid); FGAS float* w1 = (FGAS float*)zo1 + opaque(tid); FGAS unsigned short* b0 = (FGAS unsigned short*)o0 + opaque(tid); FGAS unsigned short* b1 = (FGAS unsigned short*)o1 + opaque(tid);
#pragma unroll
      for (int g8 = 0; g8 < 4; ++g8) { f2 sv[8]; float za[8], zb[8]; unsigned short ga[8], gb[8];
#pragma unroll
          for (int j = 0; j < 8; ++j) { sv[j] = *ps; za[j] = *p0; zb[j] = *p1; ga[j] = *q0; gb[j] = *q1;
              ps = pstep(ps, 512); p0 = pstep(p0, 512); p1 = pstep(p1, 512); q0 = pstep(q0, 512); q1 = pstep(q1, 512); }
#pragma unroll
          for (int j = 0; j < 8; ++j) { const f2 y = (sv[j] + v[8 * g8 + j]) * sc;
              const float r0 = bf2f(ga[j]) * (y.x + dbias * za[j]), r1 = bf2f(gb[j]) * (y.y + dbias * zb[j]);
              if (MODE == 1) { *b0 = f2bf_rne(r0); *b1 = f2bf_rne(r1); b0 = pstep(b0, 512); b1 = pstep(b1, 512); } else if (MODE == 0) { *w0 = r0; *w1 = r1; w0 = pstep(w0, 512); w1 = pstep(w1, 512); } else { asm volatile("" :: "v"(r0), "v"(r1)); } } } }
}
#undef FPHYS
#undef FGAS
}

constexpr int BATCH = 2, SEQ = 16384, DM = 1024, T = BATCH * SEQ;
constexpr int NH = 8, DNOPE = 128, DROPE = 64, DQK = 192, DVH = 128, QLORA = 384, KVLORA = 256, MLA_IN = 704, MLA_INP = 768;
constexpr int DFF = 2816, NUP = 2 * DFF;
constexpr int HF = 64, HEMB = 33, HKP = 256;
constexpr float LN_EPS = 1e-5f, RMS_EPS = 1e-6f;
constexpr float DN_ALPHA = 1.4142135623730951f;
constexpr float QSCALE = 0.07216878364870322f * 1.4426950408889634f;
constexpr int NWAVES = 8;

constexpr size_t MiB = 1u << 20;
constexpr size_t WS_CTL = 0, CTL_ZERO_BYTES = 64 * 1024;
constexpr size_t WS_TW1 = 256 * 1024, WS_MOD = 384 * 1024, WS_TW2 = 512 * 1024;
constexpr size_t WS_WIN = 2 * MiB, WS_WUQ = 4 * MiB, WS_WUKV = 6 * MiB, WS_WO = 7 * MiB, WS_WHIN = 9 * MiB, WS_WHO = 15 * MiB, WS_WUP = 17 * MiB, WS_WDN = 39 * MiB, WS_WFO = 50 * MiB, WS_H3 = 52 * MiB;
constexpr size_t WS_XB = 60 * MiB;
constexpr size_t WS_XF = 124 * MiB;
constexpr size_t WS_S = 252 * MiB;
constexpr size_t WS_END = 512 * MiB;
constexpr size_t WS_CQN = WS_XF, WS_CKVN = WS_XF + 24 * MiB, WS_ROPE = WS_XF + 40 * MiB;
constexpr size_t WS_Q = WS_S, WS_K = WS_S + 96 * MiB, WS_VT = WS_S + 144 * MiB, WS_V = WS_S + 192 * MiB;
constexpr size_t WS_UH = WS_S;
constexpr size_t WS_U = WS_S;
constexpr size_t WS_VC0 = WS_XB, WS_VC1 = WS_S + 192 * MiB;
constexpr size_t WS_KT = WS_S, WS_STASH = WS_S + 128 * MiB, WS_KSPEC = WS_S + 160 * MiB;
constexpr int CW_TMO = 0, CW_CODE = 1, CW_BAR = 4096, CW_CHK = 8192;

constexpr int RING_BYTES = 131072;
constexpr int LDS_BYTES = 147456;
constexpr int MISC_OFF = LDS_BYTES - 512;
static_assert(fftc::FFT_LDS_BYTES <= MISC_OFF && attn::SHM_ATTN3 <= RING_BYTES, "LDS map");

typedef pg8::bf16_t bf16;
typedef unsigned u32x4t __attribute__((ext_vector_type(4)));
typedef float f32x4t __attribute__((ext_vector_type(4)));
typedef unsigned u32x2t __attribute__((ext_vector_type(2)));
typedef float f32x2 __attribute__((ext_vector_type(2)));
__device__ __forceinline__ float wave_sum(float v) {
#pragma unroll
    for (int o = 1; o < 64; o <<= 1) v += __shfl_xor(v, o);
    return v;
}
__device__ __forceinline__ float bf_lo(unsigned w) { return __uint_as_float(w << 16); }
__device__ __forceinline__ float bf_hi(unsigned w) { return __uint_as_float(w & 0xffff0000u); }
__device__ __forceinline__ unsigned pkbf(float lo, float hi) { return pg8::cvt_pk_bf16(lo, hi); }

template <class ColMap> __device__ __forceinline__ void transpose_item(const float* W, int K, int N, bf16* WT, int ldk, LAS float* scr, int item, int nblk, int lane, const ColMap& cm) {
    const int kb = item / nblk, nb = item % nblk, k0 = 64 * kb, n0 = 32 * nb;
    const int q4 = 4 * (lane & 7), s0 = cm(n0 + q4), s1 = cm(n0 + q4 + 1), s2 = cm(n0 + q4 + 2), s3 = cm(n0 + q4 + 3);
    const bool vec = (s0 >= 0) && (s1 == s0 + 1) && (s2 == s0 + 2) && (s3 == s0 + 3) && ((s0 & 3) == 0) && ((N & 3) == 0);
    f32x4 v[8];
    if (vec) {
#pragma unroll
        for (int i = 0; i < 8; ++i) v[i] = *(const f32x4*)(W + (size_t)(k0 + (lane >> 3) + 8 * i) * N + s0);
    } else { const int c0_ = s0 >= 0 ? s0 : 0, c1_ = s1 >= 0 ? s1 : 0, c2_ = s2 >= 0 ? s2 : 0, c3_ = s3 >= 0 ? s3 : 0;
#pragma unroll
        for (int i = 0; i < 8; ++i) { const float* wr = W + (size_t)(k0 + (lane >> 3) + 8 * i) * N; v[i].x = wr[c0_]; v[i].y = wr[c1_]; v[i].z = wr[c2_]; v[i].w = wr[c3_]; }
#pragma unroll
        for (int i = 0; i < 8; ++i) { if (s0 < 0) v[i].x = 0.f; if (s1 < 0) v[i].y = 0.f; if (s2 < 0) v[i].z = 0.f; if (s3 < 0) v[i].w = 0.f; } }
#pragma unroll
    for (int i = 0; i < 8; ++i) { const int kk = (lane >> 3) + 8 * i; LAS float* d = scr + kk * 33 + q4; d[0] = v[i].x; d[1] = v[i].y; d[2] = v[i].z; d[3] = v[i].w; }
    asm volatile("s_waitcnt lgkmcnt(0)" ::: "memory");
    const int c = lane & 7;
#pragma unroll
    for (int j = 0; j < 4; ++j) { const int n = (lane >> 3) + 8 * j; const LAS float* s = scr + (8 * c) * 33 + n;
        u32x4t o; o.x = pkbf(s[0 * 33], s[1 * 33]); o.y = pkbf(s[2 * 33], s[3 * 33]); o.z = pkbf(s[4 * 33], s[5 * 33]); o.w = pkbf(s[6 * 33], s[7 * 33]);
        *(u32x4t*)(WT + (size_t)(n0 + n) * ldk + k0 + 8 * c) = o; }
    asm volatile("s_waitcnt lgkmcnt(0)" ::: "memory");
}
struct CmIdent { __device__ __forceinline__ int operator()(int n) const { return n; } };
struct CmWin { __device__ __forceinline__ int operator()(int n) const { if (n < 640) return n; if (n >= 704) return -1; const int i = n - 640; return 640 + (i & 1) * 32 + (i >> 1); } };
struct CmWuq { __device__ __forceinline__ int operator()(int n) const { const int h = n / 192, d = n - h * 192; if (d < 128) return n; const int i = d - 128; return h * 192 + 128 + (i & 1) * 32 + (i >> 1); } };
struct CmWukv { __device__ __forceinline__ int operator()(int n) const { const int v = n >> 10, r = n & 1023, h = r >> 7, d = r & 127; return h * 256 + v * 128 + d; } };
struct CmWup { __device__ __forceinline__ int operator()(int n) const { const int pn = n >> 8, r = n & 255; return (r < 128) ? (pn * 128 + r) : (DFF + pn * 128 + (r - 128)); } };

struct Args {
    const float* in[27]; float* out; unsigned char* ws; int ph_lo, ph_hi;
};
enum { I_X = 0, I_POS, I_MLA_WIN, I_MLA_GQ, I_MLA_WUQ, I_MLA_GKV, I_MLA_WUKV, I_MLA_WO, I_HY_WIN, I_HY_WSHORT, I_HY_FW1, I_HY_FB1, I_HY_FW2, I_HY_FB2, I_HY_FW3, I_HY_FB3, I_HY_FREQ,
       I_HY_FWOUT, I_HY_DBIAS, I_HY_WO, I_FFN_WUP, I_FFN_WCONV, I_FFN_WDOWN, I_LN1G, I_LN1B, I_LN2G, I_LN2B };

__device__ __forceinline__ void ln_rows(const bf16* Y, float* OF, bf16* OB, const float* g, const float* b, int gw, int ngw, int lane, float omul = 1.0f) {
    f32x4 gv[4], bv[4];
#pragma unroll
    for (int j = 0; j < 4; ++j) { gv[j] = *(const f32x4*)(g + 4 * lane + 256 * j); bv[j] = *(const f32x4*)(b + 4 * lane + 256 * j); }
    for (int m0 = gw; m0 < T; m0 += 4 * ngw) {
        u32x2t w[4][4];
#pragma unroll
        for (int q = 0; q < 4; ++q) { const int m = m0 + q * ngw; if (m < T) { const u32x2t* xr = (const u32x2t*)(Y + (size_t)m * DM) + lane;
#pragma unroll
                for (int j = 0; j < 4; ++j) w[q][j] = xr[64 * j]; } }
#pragma unroll
        for (int q = 0; q < 4; ++q) { const int m = m0 + q * ngw; if (m < T) {
            f32x4 v[4]; float s = 0.f;
#pragma unroll
            for (int j = 0; j < 4; ++j) { v[j] = (f32x4){bf_lo(w[q][j].x), bf_hi(w[q][j].x), bf_lo(w[q][j].y), bf_hi(w[q][j].y)}; s += (v[j].x + v[j].y) + (v[j].z + v[j].w); }
            const float mean = wave_sum(s) * (1.f / DM); float s2 = 0.f;
#pragma unroll
            for (int j = 0; j < 4; ++j) { v[j] = v[j] - mean; s2 += (v[j].x * v[j].x + v[j].y * v[j].y) + (v[j].z * v[j].z + v[j].w * v[j].w); }
            const float rstd = 1.f / sqrtf(wave_sum(s2) * (1.f / DM) + LN_EPS);
            f32x4* of = (f32x4*)(OF + (size_t)m * DM) + lane;
#pragma unroll
            for (int j = 0; j < 4; ++j) { v[j] = (v[j] * rstd * gv[j] + bv[j]) * omul;
                if (OF) of[64 * j] = v[j]; }
            if (OB) { u32x2t* ob = (u32x2t*)(OB + (size_t)m * DM) + lane;
#pragma unroll
                for (int j = 0; j < 4; ++j) { u32x2t ww; ww.x = pkbf(v[j].x, v[j].y); ww.y = pkbf(v[j].z, v[j].w); ob[64 * j] = ww; } } } }
    }
}

__device__ __forceinline__ void mla_norm_rope(const float* H1, const float* gq, const float* gkv, const f32x2* tab, bf16* CQN, bf16* CKVN, unsigned char* Kb, int gw, int ngw, int lane) {
    float gqv[6], gkvv[4];
#pragma unroll
    for (int k = 0; k < 6; ++k) gqv[k] = gq[lane + 64 * k];
#pragma unroll
    for (int k = 0; k < 4; ++k) gkvv[k] = gkv[lane + 64 * k];
    for (int t0 = gw; t0 < T; t0 += 2 * ngw) {
        float q[2][6], kv[2][4]; f32x2 xr[2], cs[2];
#pragma unroll
        for (int u = 0; u < 2; ++u) { const int t = t0 + u * ngw; if (t < T) { const float* h = H1 + (size_t)t * MLA_INP;
#pragma unroll
            for (int k = 0; k < 6; ++k) q[u][k] = h[lane + 64 * k];
#pragma unroll
            for (int k = 0; k < 4; ++k) kv[u][k] = h[QLORA + lane + 64 * k];
            xr[u] = *(const f32x2*)(h + 640 + 2 * (lane & 31)); cs[u] = tab[(size_t)t * 32 + (lane & 31)]; } }
#pragma unroll
        for (int u = 0; u < 2; ++u) { const int t = t0 + u * ngw; if (t < T) {
            float sq = 0.f, sk = 0.f;
#pragma unroll
            for (int k = 0; k < 6; ++k) sq += q[u][k] * q[u][k];
#pragma unroll
            for (int k = 0; k < 4; ++k) sk += kv[u][k] * kv[u][k];
            const float rq = 1.f / sqrtf(wave_sum(sq) * (1.f / QLORA) + RMS_EPS), rk = 1.f / sqrtf(wave_sum(sk) * (1.f / KVLORA) + RMS_EPS);
#pragma unroll
            for (int k = 0; k < 6; ++k) CQN[(size_t)t * QLORA + lane + 64 * k] = (bf16)(pkbf(q[u][k] * rq * gqv[k], 0.f) & 0xffffu);
#pragma unroll
            for (int k = 0; k < 4; ++k) CKVN[(size_t)t * KVLORA + lane + 64 * k] = (bf16)(pkbf(kv[u][k] * rk * gkvv[k], 0.f) & 0xffffu);
            const unsigned short w = (unsigned short)__builtin_amdgcn_cvt_pk_fp8_f32(xr[u].x * cs[u].x - xr[u].y * cs[u].y, xr[u].x * cs[u].y + xr[u].y * cs[u].x, 0, false);
            unsigned short* kr = (unsigned short*)(Kb + (size_t)t * 1536 + 128) + (lane & 31);
            if (lane < 32) {
#pragma unroll
                for (int hh = 0; hh < NH; ++hh) kr[hh * 96] = w; } } }
    }
}

__device__ __forceinline__ void ffn_conv_silu(const bf16* UH, const float* wconv  , bf16* HACT  , int gw, int ngw, int lane) {
    constexpr int RB = 32, NRB = SEQ / RB, NCC = 6;
    for (int it = gw; it < NRB * NCC; it += ngw) {
        const int rb = it / NCC, cc = it - rb * NCC, c = cc * 512 + lane * 8;
        if (c >= DFF) continue;
        const int pn = c >> 7, ucol = pn * 256 + (c & 127);
        float wa[3][8], wg[3][8];
#pragma unroll
        for (int k = 0; k < 3; ++k)
#pragma unroll
            for (int e = 0; e < 8; ++e) { wa[k][e] = wconv[k * NUP + c + e]; wg[k][e] = wconv[k * NUP + DFF + c + e]; }
        const int r0 = rb * RB;
        const bf16* up = UH + ucol;
        const u32x4t zero = {0u, 0u, 0u, 0u};
        u32x4t ra[6], rg[6];
        ra[0] = zero; rg[0] = zero;
        if (r0 > 0) { ra[0] = *(const u32x4t*)(up + (size_t)(r0 - 1) * NUP); rg[0] = *(const u32x4t*)(up + (size_t)(r0 - 1) * NUP + 128); }
        ra[1] = *(const u32x4t*)(up + (size_t)r0 * NUP); rg[1] = *(const u32x4t*)(up + (size_t)r0 * NUP + 128);
#pragma unroll 1
        for (int r = r0; r < r0 + RB; r += 4) {
#pragma unroll
            for (int j = 1; j <= 4; ++j) { const int rr = r + j; if (rr < SEQ) { ra[1 + j] = *(const u32x4t*)(up + (size_t)rr * NUP); rg[1 + j] = *(const u32x4t*)(up + (size_t)rr * NUP + 128); } else { ra[1 + j] = zero; rg[1 + j] = zero; } }
#pragma unroll
            for (int j = 0; j < 4; ++j) {
                float o[8];
#pragma unroll
                for (int e2 = 0; e2 < 4; ++e2) {
                    const float a0 = wa[0][2 * e2] * bf_lo(ra[j][e2]) + wa[1][2 * e2] * bf_lo(ra[j + 1][e2]) + wa[2][2 * e2] * bf_lo(ra[j + 2][e2]);
                    const float a1 = wa[0][2 * e2 + 1] * bf_hi(ra[j][e2]) + wa[1][2 * e2 + 1] * bf_hi(ra[j + 1][e2]) + wa[2][2 * e2 + 1] * bf_hi(ra[j + 2][e2]);
                    const float g0 = wg[0][2 * e2] * bf_lo(rg[j][e2]) + wg[1][2 * e2] * bf_lo(rg[j + 1][e2]) + wg[2][2 * e2] * bf_lo(rg[j + 2][e2]);
                    const float g1 = wg[0][2 * e2 + 1] * bf_hi(rg[j][e2]) + wg[1][2 * e2 + 1] * bf_hi(rg[j + 1][e2]) + wg[2][2 * e2 + 1] * bf_hi(rg[j + 2][e2]);
                    o[2 * e2] = a0 * g0 * __builtin_amdgcn_rcpf(1.f + __expf(-g0)); o[2 * e2 + 1] = a1 * g1 * __builtin_amdgcn_rcpf(1.f + __expf(-g1)); }
                u32x4t w; w.x = pkbf(o[0], o[1]); w.y = pkbf(o[2], o[3]); w.z = pkbf(o[4], o[5]); w.w = pkbf(o[6], o[7]);
                *(u32x4t*)(HACT + (size_t)(r + j) * DFF + c) = w;
            }
            ra[0] = ra[4]; rg[0] = rg[4]; ra[1] = ra[5]; rg[1] = rg[5];
        }
    }
}

__device__ __forceinline__ void v_transpose_fp8(const bf16* V, unsigned char* VT, LAS unsigned char* scr, int gw, int ngw, int lane) {
    constexpr int NKT = T / 64, NCT = 1024 / 64;
    for (int it = gw; it < NKT * NCT; it += ngw) {
        const int ct = it % NCT, kt = it / NCT, b = kt / (SEQ / 64), k0 = (kt % (SEQ / 64)) * 64, c0 = ct * 64;
        const int r8 = lane >> 3, c8 = lane & 7;
#pragma unroll
        for (int i = 0; i < 8; ++i) { const int row = r8 + 8 * i; const u32x4t v = *(const u32x4t*)(V + ((size_t)b * SEQ + k0 + row) * 1024 + c0 + c8 * 8);
            u32x2t w; w.x = (unsigned)__builtin_amdgcn_cvt_pk_fp8_f32(bf_lo(v.y), bf_hi(v.y), __builtin_amdgcn_cvt_pk_fp8_f32(bf_lo(v.x), bf_hi(v.x), 0, false), true);
            w.y = (unsigned)__builtin_amdgcn_cvt_pk_fp8_f32(bf_lo(v.w), bf_hi(v.w), __builtin_amdgcn_cvt_pk_fp8_f32(bf_lo(v.z), bf_hi(v.z), 0, false), true);
            *(LAS u32x2t*)(scr + row * 72 + c8 * 8) = w; }
        asm volatile("s_waitcnt lgkmcnt(0)" ::: "memory");
        unsigned o[16];
#pragma unroll
        for (int wd = 0; wd < 16; ++wd) { unsigned acc = 0;
#pragma unroll
            for (int bb = 0; bb < 4; ++bb) { const int pi = wd * 4 + bb, h = pi >> 5, j = pi & 31, jj = j & 15, key = (j >> 4) * 32 + (jj & 3) + 8 * (jj >> 2) + 4 * h;
                acc |= (unsigned)scr[key * 72 + lane] << (8 * bb); }
            o[wd] = acc; }
        const int hh = (c0 + lane) >> 7, cc = (c0 + lane) & 127;
        unsigned char* dst = VT + (((size_t)b * 8 + hh) * 128 + cc) * SEQ + k0;
#pragma unroll
        for (int q = 0; q < 4; ++q) *(u32x4t*)(dst + 16 * q) = (u32x4t){o[4 * q], o[4 * q + 1], o[4 * q + 2], o[4 * q + 3]};
        asm volatile("s_waitcnt lgkmcnt(0)" ::: "memory");
    }
}

__device__ __forceinline__ void ffn_fixup_rows(const float* halo, const float* wconv  , bf16* HACT  , int gw, int ngw, int lane) {
    constexpr int NP = T / 256, NCC = 6;
    for (int it = gw; it < NP * 2 * NCC; it += ngw) {
        const int cc = it % NCC, pe = it / NCC, e = pe & 1, pm = pe >> 1, c = cc * 512 + lane * 8;
        if (c >= DFF) continue;
        const int row = pm * 256 + (e ? 255 : 0), ucol = (c >> 7) * 256 + (c & 127);
        const float* hp = halo + (size_t)pm * 4 * NUP + ucol;
        const float* up_ = nullptr; const float* cu_; const float* dn_ = nullptr;
        if (e == 0) { cu_ = hp; dn_ = hp + NUP; if (row % SEQ != 0) up_ = hp - 4 * NUP + 3 * NUP; }
        else { up_ = hp + 2 * NUP; cu_ = hp + 3 * NUP; if (row % SEQ != SEQ - 1) dn_ = hp + 4 * NUP; }
        const float zu = up_ ? 1.f : 0.f, zd = dn_ ? 1.f : 0.f; const float* rp[3] = {up_ ? up_ : cu_, cu_, dn_ ? dn_ : cu_};
        f32x4t wa[3][2], wg[3][2], ua[3][2], ug[3][2];
#pragma unroll
        for (int tp = 0; tp < 3; ++tp)
#pragma unroll
            for (int h = 0; h < 2; ++h) { wa[tp][h] = *(const f32x4t*)(wconv + tp * NUP + c + 4 * h); wg[tp][h] = *(const f32x4t*)(wconv + tp * NUP + DFF + c + 4 * h);
                ua[tp][h] = *(const f32x4t*)(rp[tp] + 4 * h); ug[tp][h] = *(const f32x4t*)(rp[tp] + 128 + 4 * h); }
        float o[8];
#pragma unroll
        for (int i = 0; i < 8; ++i) { const int h = i >> 2, j = i & 3;
            const float ha = wa[1][h][j] * ua[1][h][j] + zu * (wa[0][h][j] * ua[0][h][j]) + zd * (wa[2][h][j] * ua[2][h][j]);
            const float hg = wg[1][h][j] * ug[1][h][j] + zu * (wg[0][h][j] * ug[0][h][j]) + zd * (wg[2][h][j] * ug[2][h][j]);
            o[i] = ha * hg * __builtin_amdgcn_rcpf(1.f + __expf(-hg)); }
        u32x4t w; w.x = pkbf(o[0], o[1]); w.y = pkbf(o[2], o[3]); w.z = pkbf(o[4], o[5]); w.w = pkbf(o[6], o[7]);
        *(u32x4t*)(HACT + (size_t)row * DFF + c) = w;
    }
}

__device__ __forceinline__ void hy_conv_transpose(const bf16* U  , const float* wshort  , float* VC0, float* VC1, bf16* G1C, bf16* G2C, LAS unsigned* scr, int gw, int ngw, int lane) {
    constexpr int NTT = T / 64, NCT = 3072 / 64;
    const int r8 = lane >> 3, c8 = lane & 7;
    u32x4t buf[9];
#define HCT_LOAD(IT) do { const int ct_ = (IT) % NCT, tt_ = (IT) / NCT, b_ = tt_ / (SEQ / 64), t0_ = (tt_ % (SEQ / 64)) * 64, c0_ = ct_ * 64; \
        _Pragma("unroll") for (int i = 0; i < 9; ++i) { const int row = r8 + 8 * i, tok = t0_ - 1 + row; buf[i] = (u32x4t){0u, 0u, 0u, 0u}; \
            if (row < 66 && tok >= 0 && tok < SEQ) buf[i] = *(const u32x4t*)(U + ((size_t)b_ * SEQ + tok) * 3072 + c0_ + c8 * 8); } } while (0)
    if (gw < NTT * NCT) HCT_LOAD(gw);
    for (int it = gw; it < NTT * NCT; it += ngw) {
        const int ct = it % NCT, tt = it / NCT, b = tt / (SEQ / 64), t0 = (tt % (SEQ / 64)) * 64, c0 = ct * 64;
#pragma unroll
        for (int i = 0; i < 9; ++i) { const int row = r8 + 8 * i; if (row < 66) { LAS unsigned* d = scr + row * 33 + c8 * 4; d[0] = buf[i].x; d[1] = buf[i].y; d[2] = buf[i].z; d[3] = buf[i].w; } }
        if (it + ngw < NTT * NCT) HCT_LOAD(it + ngw);
        asm volatile("s_waitcnt lgkmcnt(0)" ::: "memory");
        const int part = c0 >> 10, chb = c0 & 1023;
        const float wl0 = wshort[c0 + lane], wl1 = wshort[3072 + c0 + lane], wl2 = wshort[6144 + c0 + lane];
#pragma unroll
        for (int cp = 0; cp < 32; ++cp) {
            const unsigned a0 = scr[lane * 33 + cp], a1 = scr[(lane + 1) * 33 + cp], a2 = scr[(lane + 2) * 33 + cp];
            #define RL(x, i) __int_as_float(__builtin_amdgcn_readlane(__float_as_int(x), (i)))
            const float w00 = RL(wl0, 2 * cp), w10 = RL(wl1, 2 * cp), w20 = RL(wl2, 2 * cp), w01 = RL(wl0, 2 * cp + 1), w11 = RL(wl1, 2 * cp + 1), w21 = RL(wl2, 2 * cp + 1);
#undef RL
            const float v0 = w00 * bf_lo(a0) + w10 * bf_lo(a1) + w20 * bf_lo(a2), v1 = w01 * bf_hi(a0) + w11 * bf_hi(a1) + w21 * bf_hi(a2);
            const size_t o = (size_t)(chb + 2 * cp) * SEQ + t0 + lane;
            if (part == 0) { float* d = b ? VC1 : VC0; d[o] = v0; d[o + SEQ] = v1; }
            else { bf16* d = (part == 1 ? G1C : G2C) + (size_t)b * 1024 * SEQ; d[o] = (bf16)(pkbf(v0, 0.f) & 0xffffu); d[o + SEQ] = (bf16)(pkbf(v1, 0.f) & 0xffffu); }
        }
        asm volatile("s_waitcnt lgkmcnt(0)" ::: "memory");
    }
#undef HCT_LOAD
}
__device__ __forceinline__ void hy_transpose_back(const bf16* Z3C, bf16* XB, LAS unsigned* scr, int gw, int ngw, int lane) {
    constexpr int NTT = T / 64, NCT = 1024 / 64;
    for (int it = gw; it < NTT * NCT; it += ngw) {
        const int ct = it % NCT, tt = it / NCT, b = tt / (SEQ / 64), t0 = (tt % (SEQ / 64)) * 64, c0 = ct * 64;
        const bf16* src = Z3C + ((size_t)b * 1024 + c0) * SEQ + t0 + lane;
#pragma unroll 8
        for (int cp = 0; cp < 32; ++cp) { const unsigned lo = src[(size_t)(2 * cp) * SEQ], hi = src[(size_t)(2 * cp + 1) * SEQ]; scr[lane * 33 + cp] = lo | (hi << 16); }
        asm volatile("s_waitcnt lgkmcnt(0)" ::: "memory");
        const int r8 = lane >> 3, c8 = lane & 7;
#pragma unroll
        for (int i = 0; i < 8; ++i) { const int row = r8 + 8 * i; const LAS unsigned* s = scr + row * 33 + c8 * 4; u32x4t v; v.x = s[0]; v.y = s[1]; v.z = s[2]; v.w = s[3];
            *(u32x4t*)(XB + ((size_t)b * SEQ + t0 + row) * DM + c0 + c8 * 8) = v; }
        asm volatile("s_waitcnt lgkmcnt(0)" ::: "memory");
    }
}

#ifdef SELFCHECK
__device__ __forceinline__ float blk_sum(float v, LAS float* red, int tid_) {
    v = wave_sum(v); __syncthreads(); if ((tid_ & 63) == 0) red[tid_ >> 6] = v; __syncthreads();
    float t = 0.f; for (int i = 0; i < NWAVES; ++i) t += red[i]; __syncthreads(); return t;
}
__device__ __forceinline__ void chk_flag(unsigned* flag, float err2, float ref2, unsigned bit, int tid_, float tol = SELFCHECK_TOL) {
    if (tid_ == 0 && !(err2 <= tol * tol * ref2)) atomicOr(flag, bit);
}
__device__ __forceinline__ float fp8_dec(unsigned b) { const unsigned e = (b >> 3) & 15u, m = b & 7u; const float v = e ? ldexpf((float)(8u + m), (int)e - 10) : ldexpf((float)m, -9); return (b & 0x80u) ? -v : v; }
__device__ __forceinline__ float fp8_rnd(float x) { return fp8_dec((unsigned)__builtin_amdgcn_cvt_pk_fp8_f32(x, 0.f, 0, false) & 0xffu); }
__device__ __forceinline__ void selfcheck_mla(const Args& args, LAS unsigned char* ldsl, int bxx, int tid_) {
    unsigned* flag = (unsigned*)(args.ws + WS_CTL) + CW_CHK;
    const bf16* Qb_ = (const bf16*)(args.ws + WS_Q); const unsigned char* Kb_ = (const unsigned char*)(args.ws + WS_K); const bf16* Vb_ = (const bf16*)(args.ws + WS_V); const bf16* O_ = (const bf16*)(args.ws + WS_XB);
    const int* pos = (const int*)args.in[I_POS];
    LAS float* red = (LAS float*)(ldsl + 140000);
    if (bxx < 64) {
        const int t = bxx * (T / 64) + (bxx * 37) % 512;
        LAS float* h = (LAS float*)ldsl; LAS float* cq = h + 704; LAS float* ckv = cq + 384;
        const float* x = args.in[I_X] + (size_t)t * DM; const float* w_in = args.in[I_MLA_WIN];
        for (int j = tid_; j < MLA_IN; j += 512) { float a = 0.f; for (int k = 0; k < DM; ++k) a += x[k] * w_in[(size_t)k * MLA_IN + j]; h[j] = a; }
        __syncthreads();
        float sq = 0.f, sk = 0.f; for (int k = 0; k < QLORA; ++k) sq += h[k] * h[k]; for (int k = 0; k < KVLORA; ++k) sk += h[QLORA + k] * h[QLORA + k];
        const float rq = 1.f / sqrtf(sq / QLORA + RMS_EPS), rk = 1.f / sqrtf(sk / KVLORA + RMS_EPS);
        for (int k = tid_; k < QLORA; k += 512) cq[k] = h[k] * rq * args.in[I_MLA_GQ][k];
        for (int k = tid_; k < KVLORA; k += 512) ckv[k] = h[QLORA + k] * rk * args.in[I_MLA_GKV][k];
        __syncthreads();
        {
            float e2 = 0.f, r2 = 0.f; const float* w = args.in[I_MLA_WUQ];
            for (int n = tid_; n < NH * DQK; n += 512) { const int o = CmWuq()(n); float a = 0.f; for (int k = 0; k < QLORA; ++k) a += cq[k] * w[(size_t)k * (NH * DQK) + o];
                a *= QSCALE; const float g = __uint_as_float((unsigned)Qb_[(size_t)t * 1536 + n] << 16); e2 += (a - g) * (a - g); r2 += a * a; }
            e2 = blk_sum(e2, red, tid_); r2 = blk_sum(r2, red, tid_); chk_flag(flag, e2, r2, 1u, tid_);
        }
        {
            float e2 = 0.f, r2 = 0.f, e3 = 0.f, r3 = 0.f; const float* w = args.in[I_MLA_WUKV];
            for (int n = tid_; n < NH * 256; n += 512) { const int o = CmWukv()(n); float a = 0.f; for (int k = 0; k < KVLORA; ++k) a += ckv[k] * w[(size_t)k * (NH * 256) + o];
                if (n < 1024) { const float g = fp8_dec(Kb_[(size_t)t * 1536 + (n >> 7) * 192 + (n & 127)]); e2 += (a - g) * (a - g); r2 += a * a; }
                else { const float g = __uint_as_float((unsigned)Vb_[(size_t)t * 1024 + n - 1024] << 16); e3 += (a - g) * (a - g); r3 += a * a; } }
            e2 = blk_sum(e2, red, tid_); r2 = blk_sum(r2, red, tid_); chk_flag(flag, e2, r2, 2u, tid_, SELFCHECK_TOL8);
            e3 = blk_sum(e3, red, tid_); r3 = blk_sum(r3, red, tid_); chk_flag(flag, e3, r3, 8u, tid_);
        }
        {
            float e2 = 0.f, r2 = 0.f;
            if (tid_ < 256) { const int hh = tid_ >> 5, i = tid_ & 31; const float inv = powf(10000.0f, -(float)i / 32.0f); float s, c; sincosf((float)pos[t] * inv, &s, &c);
                const float x1 = h[640 + i], x2 = h[672 + i], a1 = x1 * c - x2 * s, a2 = x1 * s + x2 * c;
                const float g1 = fp8_dec(Kb_[(size_t)t * 1536 + hh * 192 + 128 + 2 * i]), g2 = fp8_dec(Kb_[(size_t)t * 1536 + hh * 192 + 129 + 2 * i]);
                e2 = (a1 - g1) * (a1 - g1) + (a2 - g2) * (a2 - g2); r2 = a1 * a1 + a2 * a2; }
            e2 = blk_sum(e2, red, tid_); r2 = blk_sum(r2, red, tid_); chk_flag(flag, e2, r2, 4u, tid_, SELFCHECK_TOL8);
        }
    } else if (bxx < 192) {
        const int sidx = bxx - 64, b = sidx & 1, hh = (sidx >> 1) & 7, row = (sidx * 509 + 13) % SEQ; const size_t t = (size_t)b * SEQ + row;
        LAS float* sc = (LAS float*)ldsl;
        LAS float* q = sc + SEQ;
        if (tid_ < DQK) { float v = __uint_as_float((unsigned)Qb_[t * 1536 + hh * DQK + tid_] << 16);
            if (tid_ >= 128) { const int i = (tid_ - 128) >> 1; const float inv = powf(10000.0f, -(float)i / 32.0f); float s, c; sincosf((float)pos[t] * inv, &s, &c);
                const float o = __uint_as_float((unsigned)Qb_[t * 1536 + hh * DQK + (tid_ ^ 1)] << 16);
                v = (tid_ & 1) ? (o * s + v * c) : (v * c - o * s); }
            q[tid_] = fp8_rnd(v); }
        __syncthreads();
        float mx = -1e30f;
        for (int k = tid_; k < SEQ; k += 512) { const unsigned char* kr = Kb_ + ((size_t)b * SEQ + k) * 1536 + hh * DQK; float a = 0.f; for (int d = 0; d < DQK; ++d) a += q[d] * fp8_dec(kr[d]); sc[k] = a; mx = fmaxf(mx, a); }
        for (int o = 1; o < 64; o <<= 1) mx = fmaxf(mx, __shfl_xor(mx, o));
        __syncthreads(); if ((tid_ & 63) == 0) red[tid_ >> 6] = mx; __syncthreads(); for (int i = 0; i < NWAVES; ++i) mx = fmaxf(mx, red[i]); __syncthreads();
        float ls = 0.f; for (int k = tid_; k < SEQ; k += 512) { const float p = exp2f(sc[k] - mx); sc[k] = p; ls += p; }
        ls = blk_sum(ls, red, tid_);
        const int d = tid_ & 127, part = tid_ >> 7; float a = 0.f;
        for (int k = part * 4096; k < (part + 1) * 4096; ++k) a += sc[k] * fp8_rnd(__uint_as_float((unsigned)Vb_[((size_t)b * SEQ + k) * 1024 + hh * DVH + d] << 16));
        LAS float* op = q + 256; op[tid_] = a; __syncthreads();
        float e2 = 0.f, r2 = 0.f;
        if (tid_ < 128) { const float o = (op[tid_] + op[tid_ + 128] + op[tid_ + 256] + op[tid_ + 384]) / ls; const float g = __uint_as_float((unsigned)O_[t * 1024 + hh * DVH + tid_] << 16); e2 = (o - g) * (o - g); r2 = o * o; }
        e2 = blk_sum(e2, red, tid_); r2 = blk_sum(r2, red, tid_); chk_flag(flag, e2, r2, 16u, tid_, SELFCHECK_TOL8);
    }
}
#endif
#ifndef MK_PER_PHASE
#define MK_PER_PHASE 0
#endif
constexpr int N_PHASES = 30;
constexpr int GEMM_SP2 = true, GEMM_ALIGN = true;

__global__ void __launch_bounds__(NWAVES * 64, 2) mega_fwd(Args args) {
    extern __shared__ __attribute__((aligned(16))) unsigned char lds[];
    LAS unsigned char* ldsl = (LAS unsigned char*)lds;
    volatile LAS unsigned* MISC = (volatile LAS unsigned*)(ldsl + MISC_OFF);
    const int wave = __builtin_amdgcn_readfirstlane((int)threadIdx.x >> 6);
#define lane hw_lane()
#define tid (wave * 64 + hw_lane())
#define G ((int)gridDim.x)
#define bx ((int)blockIdx.x)
#define gw (bx * NWAVES + wave)
#define ngw (G * NWAVES)
    { const int t_ = tid; if (t_ < 128) MISC[t_] = 0u; }
    __syncthreads();
    if (!MK_PER_PHASE) (void)xcd_barrier_post((unsigned*)(args.ws + WS_CTL) + CW_BAR, MISC + 8, (unsigned)wave);
    const int lo = args.ph_lo, hi = args.ph_hi;
#ifdef ONLY_PHASE
#define IN(k) ((k) == ONLY_PHASE && lo <= (k) && (k) < hi)
#else
#define IN(k) (lo <= (k) && (k) < hi)
#endif
#define GRIDBAR() do { XcdBarrier bar_; bar_.bar = (unsigned*)(args.ws + WS_CTL) + CW_BAR; bar_.x = xb_xcc_id(); bar_.st = MISC + 8; bar_.wv = (unsigned)wave; xcd_barrier(bar_); } while (0)
#define SEAM(k) do { if (IN(k) && IN((k) + 1)) GRIDBAR(); } while (0)
#ifndef PROBE_DUP
#define PROBE_DUP (-1)
#define PROBE_REP 1
#endif
#define RUN(k, REAL, DUMMY) do { if (IN(k)) { if (PROBE_DUP == (k)) { for (int rep_ = 0; rep_ < PROBE_REP; ++rep_) { DUMMY; GRIDBAR(); } } REAL; } } while (0)

#define P_(T_, off) ((T_*)(args.ws + (off)))
#define Win_t P_(bf16, WS_WIN)
#define Wuq_t P_(bf16, WS_WUQ)
#define Wukv_t P_(bf16, WS_WUKV)
#define Wo_t P_(bf16, WS_WO)
#define Whin_t P_(bf16, WS_WHIN)
#define Who_t P_(bf16, WS_WHO)
#define Wup_t P_(bf16, WS_WUP)
#define Wdn_t P_(bf16, WS_WDN)
#define Wfo_t P_(bf16, WS_WFO)
#define H3 P_(bf16, WS_H3)
#define XB P_(bf16, WS_XB)
#define XF P_(float, WS_XF)
#define CQN P_(bf16, WS_CQN)
#define CKVN P_(bf16, WS_CKVN)
#define ROPE P_(f32x2, WS_ROPE)
#define Qb P_(bf16, WS_Q)
#define Kb P_(unsigned char, WS_K)
#define Vb P_(bf16, WS_V)
#define VTb P_(unsigned char, WS_VT)
#define UH P_(bf16, WS_UH)
#define U P_(bf16, WS_U)
#define VC0 P_(float, WS_VC0)
#define VC1 P_(float, WS_VC1)
#define KT P_(float, WS_KT)
#define STASH P_(fftc::f2, WS_STASH)
#define KSPEC P_(fftc::f2, WS_KSPEC)
#define FTW (fftc::Tw{P_(const fftc::f2, WS_TW1), P_(const fftc::f2, WS_TW2), P_(const fftc::f2, WS_MOD)})
#define OUT (args.out)
#define H1 (args.out)
#define G1C ((bf16*)args.out)
#define G2C ((bf16*)args.out + (size_t)2 * 1024 * SEQ)
#define Z3C ((bf16*)args.out)
#define GEMM(EPI, A_, B_, M_, N_, K_, ...) do { pg8::Gemm g{(A_), (B_), (M_), (N_), (K_)}; pg8::StaticOrder S; S.init((M_), (N_), G, bx); typedef pg8::EPI Epi_; Epi_ E{__VA_ARGS__}; \
        pg8::gemm_phase<Epi_, pg8::StaticOrder, GEMM_ALIGN, GEMM_SP2>(ldsl, g, S, E, wave); } while (0)
#define YB_A P_(bf16, WS_XF)
#define YB_B P_(bf16, WS_S + 192 * MiB)
#define YB_C P_(bf16, WS_S)

    if (IN(0)) for (int prep_ = 0; prep_ < ((PROBE_DUP == 0) ? 1 + PROBE_REP : 1); ++prep_) {
        if (prep_) GRIDBAR();
        LAS float* scr = (LAS float*)(ldsl + wave * 16384);
        {
            int base = 0;
#define TR(W_, K_, N_, WT_, NP_, LDK_, CM_) do { const int nblk_ = (NP_) / 32, nit_ = ((K_) / 64) * nblk_; \
                for (int it_ = (gw + ngw - base % ngw) % ngw; it_ < nit_; it_ += ngw) transpose_item((W_), (K_), (N_), (WT_), (LDK_), scr, it_, nblk_, lane, CM_); base += nit_; } while (0)
            TR(args.in[I_MLA_WIN], DM, MLA_IN, Win_t, MLA_INP, DM, CmWin());
            TR(args.in[I_MLA_WUQ], QLORA, NH * DQK, Wuq_t, NH * DQK, QLORA, CmWuq());
            TR(args.in[I_MLA_WUKV], KVLORA, NH * 256, Wukv_t, NH * 256, KVLORA, CmWukv());
            TR(args.in[I_MLA_WO], DM, DM, Wo_t, DM, DM, CmIdent());
            TR(args.in[I_HY_WIN], DM, 3 * DM, Whin_t, 3 * DM, DM, CmIdent());
            TR(args.in[I_HY_WO], DM, DM, Who_t, DM, DM, CmIdent());
            TR(args.in[I_FFN_WUP], DM, NUP, Wup_t, NUP, DM, CmWup());
            TR(args.in[I_FFN_WUP] + (size_t)DM * NUP, DM, NUP, Wup_t + (size_t)NUP * DM, NUP, DM, CmWup());
            TR(args.in[I_FFN_WDOWN], DFF, DM, Wdn_t, DM, DFF, CmIdent());
            TR(args.in[I_FFN_WDOWN] + (size_t)DFF * DM, DFF, DM, Wdn_t + (size_t)DM * DFF, DM, DFF, CmIdent());
            TR(args.in[I_HY_FWOUT], HF, 4 * DM, Wfo_t, 4 * DM, HKP, CmIdent());
#undef TR
        }
        for (size_t i = (size_t)gw * 64 + lane; i < (size_t)4096 * 24; i += (size_t)ngw * 64) { const size_t r = i / 24, c = i % 24; *(u32x4t*)(Wfo_t + r * HKP + 64 + c * 8) = (u32x4t){0u, 0u, 0u, 0u}; }
        for (size_t i = (size_t)gw * 64 + lane; i < (size_t)SEQ * 24; i += (size_t)ngw * 64) { const size_t r = i / 24, c = i % 24; *(u32x4t*)(H3 + r * HKP + 64 + c * 8) = (u32x4t){0u, 0u, 0u, 0u}; }
        { const float* x_in = args.in[I_X];
          const size_t n8 = (size_t)T * DM / 8, st = (size_t)ngw * 64;
          for (size_t i = (size_t)gw * 64 + lane; i < n8; i += 4 * st) { f32x4 a[4], b[4];
#pragma unroll
            for (int q = 0; q < 4; ++q) { const size_t ii = i + q * st; if (ii < n8) { a[q] = *(const f32x4*)(x_in + ii * 8); b[q] = *(const f32x4*)(x_in + ii * 8 + 4); } }
#pragma unroll
            for (int q = 0; q < 4; ++q) { const size_t ii = i + q * st; if (ii < n8) { u32x4t w; w.x = pkbf(a[q].x, a[q].y); w.y = pkbf(a[q].z, a[q].w); w.z = pkbf(b[q].x, b[q].y); w.w = pkbf(b[q].z, b[q].w); *(u32x4t*)(XB + ii * 8) = w; } } } }
        { const int* pos = (const int*)args.in[I_POS]; const double inv = exp(-(double)(lane & 31) * (9.210340371976184 / 32.0));
          for (size_t i = (size_t)gw * 64 + lane; i < (size_t)T * 32; i += (size_t)ngw * 64) { const int t = (int)(i >> 5);
              const double ang = (double)pos[t] * inv; double s, c; sincos(ang, &s, &c); ROPE[i] = (f32x2){(float)c, (float)s}; } }
        { const float* fw1 = args.in[I_HY_FW1]; const float* fb1 = args.in[I_HY_FB1]; const float* fw2 = args.in[I_HY_FW2]; const float* fb2 = args.in[I_HY_FB2];
          const float* fw3 = args.in[I_HY_FW3]; const float* fb3 = args.in[I_HY_FB3]; const float fr = args.in[I_HY_FREQ][lane];
          for (int l0 = gw; l0 < SEQ; l0 += 4 * ngw) {
              float z[4], a[4], h[4];
#pragma unroll
              for (int u = 0; u < 4; ++u) { const int l = l0 + u * ngw < SEQ ? l0 + u * ngw : SEQ - 1;
                  const float tt = (float)l / (float)(SEQ - 1); const float w = 6.283185307179586f * (float)l / (float)SEQ;
                  z[u] = 0.f;
                  if (lane == 0) z[u] = tt;
                  else if (lane <= 16) { const float f = 1e-4f + (float)(lane - 1) * ((15.0f - 1e-4f) / 15.0f); z[u] = cosf(f * w); }
                  else if (lane <= 32) { const float f = 1e-4f + (float)(lane - 17) * ((15.0f - 1e-4f) / 15.0f); z[u] = -sinf(f * w); }
                  a[u] = fb1[lane]; }
#pragma unroll
              for (int i = 0; i < HEMB; ++i) { const float wv = fw1[i * HF + lane];
#pragma unroll
                  for (int u = 0; u < 4; ++u) a[u] += __shfl(z[u], i) * wv; }
#pragma unroll
              for (int u = 0; u < 4; ++u) { h[u] = sinf(fr * a[u]); a[u] = fb2[lane]; }
#pragma unroll 8
              for (int i = 0; i < HF; ++i) { const float wv = fw2[i * HF + lane];
#pragma unroll
                  for (int u = 0; u < 4; ++u) a[u] += __shfl(h[u], i) * wv; }
#pragma unroll
              for (int u = 0; u < 4; ++u) { h[u] = sinf(fr * a[u]); a[u] = fb3[lane]; }
#pragma unroll 8
              for (int i = 0; i < HF; ++i) { const float wv = fw3[i * HF + lane];
#pragma unroll
                  for (int u = 0; u < 4; ++u) a[u] += __shfl(h[u], i) * wv; }
#pragma unroll
              for (int u = 0; u < 4; ++u) { const int l = l0 + u * ngw; if (l < SEQ) H3[(size_t)l * HKP + lane] = (bf16)(pkbf(sinf(fr * a[u]), 0.f) & 0xffffu); }
          } }
    }
    SEAM(0);
#define B1 GEMM(EpiF32, XB, Win_t, T, MLA_INP, DM, H1, MLA_INP)
    RUN(1, B1, B1);
    SEAM(1);
#define B2 mla_norm_rope(H1, args.in[I_MLA_GQ], args.in[I_MLA_GKV], ROPE, CQN, CKVN, Kb, gw, ngw, lane)
    RUN(2, B2, B2);
    SEAM(2);
#define B3 do { GEMM(EpiBf16, CQN, Wuq_t, T, NH * DQK, QLORA, Qb, NH * DQK, QSCALE); GEMM(EpiKV, CKVN, Wukv_t, T, NH * 256, KVLORA, Kb, Vb); GRIDBAR(); v_transpose_fp8(Vb, VTb, (LAS unsigned char*)(ldsl + wave * 8192), gw, ngw, lane); } while (0)
    RUN(3, B3, B3);
    SEAM(3);
#ifndef ATT_EXP
#define ATT_EXP 0
#endif
#define B4X(EXPV) do { for (int u = bx; u < BATCH * NH * (SEQ / 256); u += G) { const int qb = u & 63, h = (u >> 6) & 7, b = u >> 9; const size_t r0 = (size_t)b * SEQ + (size_t)qb * 256; \
            attn::attn_unit<EXPV>(Qb + r0 * 1536 + h * DQK, Kb + (size_t)b * SEQ * 1536 + h * DQK, VTb + ((size_t)b * 8 + h) * 128 * SEQ, XB + r0 * 1024 + h * DVH, (const float*)(ROPE + r0 * 32), SEQ, (char*)lds, wave); } } while (0)
    RUN(4, B4X(0), B4X(ATT_EXP));
#ifdef SELFCHECK
    if (IN(4) && IN(5)) { GRIDBAR(); selfcheck_mla(args, ldsl, bx, tid); }
#endif
    SEAM(4);
#define B5 GEMM(EpiRes<false>, XB, Wo_t, T, DM, DM, args.in[I_X], YB_A, DN_ALPHA)
    RUN(5, B5, B5);
    SEAM(5);
#define B6 ln_rows(YB_A, nullptr, XB, args.in[I_LN1G], args.in[I_LN1B], gw, ngw, lane)
    RUN(6, B6, B6);
    SEAM(6);
#define HACT P_(bf16, WS_S)
#define HALO P_(float, WS_S + 180 * MiB)
#define FFN_UP(layer) GEMM(EpiConvSilu, XB, Wup_t + (size_t)(layer) * NUP * DM, T, NUP, DM, HACT, args.in[I_FFN_WCONV] + (size_t)(layer) * 3 * NUP, HALO, (PG8_LAS float*)(ldsl + RING_BYTES))
#define FFN_FIX(layer) ffn_fixup_rows(HALO, args.in[I_FFN_WCONV] + (size_t)(layer) * 3 * NUP, HACT, gw, ngw, lane)
#define FFN_DN(layer, OUT_) GEMM(EpiRes<true>, HACT, Wdn_t + (size_t)(layer) * DM * DFF, T, DM, DFF, XB, (OUT_), DN_ALPHA)
#define FFN_LAYER(p, layer) \
    RUN(p, FFN_UP(layer), FFN_UP(layer)); SEAM(p); \
    RUN((p) + 1, FFN_FIX(layer), FFN_FIX(layer)); SEAM((p) + 1); \
    RUN((p) + 2, FFN_DN(layer, (layer) ? YB_A : YB_B), FFN_DN(layer, (layer) ? YB_A : YB_B)); if (IN((p) + 2) && IN((p) + 6)) GRIDBAR();
    FFN_LAYER(7, 0)
#define X2B P_(bf16, WS_XF)
#define B13 ln_rows(YB_B, nullptr, X2B, args.in[I_LN2G], args.in[I_LN2B], gw, ngw, lane)
    RUN(13, B13, B13);
    SEAM(13);
#define B14 GEMM(EpiBf16, X2B, Whin_t, T, 3 * DM, DM, U, 3 * DM, 1.0f)
    RUN(14, B14, B14);
    SEAM(14);
#define B15 hy_conv_transpose(U, args.in[I_HY_WSHORT], VC0, VC1, G1C, G2C, (LAS unsigned*)(ldsl + wave * 16384), gw, ngw, lane)
    RUN(15, B15, B15);
    SEAM(15);
#define HY_FILT(od) GEMM(EpiFilt, H3, Wfo_t + (size_t)(od) * 2048 * HKP, SEQ, 2 * DM, HKP, KT, SEQ, -120.39728043259360f, (40.54651081081644f + 120.39728043259360f) / 1023.0f, 1.0f / (float)(SEQ - 1))
#ifndef FFT_EV
#define FFT_EV 0
#endif
#define HY_FFT(MODE_, GC_, DB_) do { for (int c = bx; c < DM; c += G) { const size_t co = (size_t)c * SEQ; \
            fftc::hyena_channel<MODE_, ((MODE_) == 2 ? FFT_EV : 0)>((fftc::lf2*)ldsl, VC0 + co, VC1 + co, KT + co, KT + (size_t)DM * SEQ + co, (GC_) + co, (GC_) + (size_t)DM * SEQ + co, args.in[I_HY_DBIAS][(DB_) + c], \
                                       VC0 + co, VC1 + co, Z3C + co, Z3C + (size_t)DM * SEQ + co, STASH + (size_t)bx * SEQ, KSPEC + (size_t)bx * SEQ, tid); } } while (0)
    RUN(16, HY_FILT(0), HY_FILT(0)); SEAM(16);
    RUN(17, HY_FFT(0, G1C, 0), HY_FFT(2, G1C, 0)); SEAM(17);
    RUN(18, HY_FILT(1), HY_FILT(1)); SEAM(18);
    RUN(19, HY_FFT(1, G2C, DM), HY_FFT(1, G2C, DM)); SEAM(19);
#define B20 hy_transpose_back(Z3C, XB, (LAS unsigned*)(ldsl + wave * 16384), gw, ngw, lane)
    RUN(20, B20, B20);
    SEAM(20);
#define B21 GEMM(EpiRes<true>, XB, Who_t, T, DM, DM, X2B, YB_C, DN_ALPHA)
    RUN(21, B21, B21);
    SEAM(21);
#define B22 ln_rows(YB_C, nullptr, XB, args.in[I_LN1G] + DM, args.in[I_LN1B] + DM, gw, ngw, lane)
    RUN(22, B22, B22);
    SEAM(22);
    FFN_LAYER(23, 1)
#ifdef SELFCHECK
    if (IN(29)) { const unsigned mask = __hip_atomic_load((unsigned*)(args.ws + WS_CTL) + CW_CHK, __ATOMIC_RELAXED, __HIP_MEMORY_SCOPE_AGENT);
        ln_rows(YB_A, OUT, nullptr, args.in[I_LN2G] + DM, args.in[I_LN2B] + DM, gw, ngw, lane, 1.0f + 0.1f * (float)mask); }
#else
    RUN(29, ln_rows(YB_A, OUT, nullptr, args.in[I_LN2G] + DM, args.in[I_LN2B] + DM, gw, ngw, lane), ln_rows(YB_A, OUT, nullptr, args.in[I_LN2G] + DM, args.in[I_LN2B] + DM, gw, ngw, lane));
#endif
#undef IN
#undef SEAM
#undef lane
#undef tid
#undef G
#undef bx
#undef gw
#undef ngw
}

extern "C" void kernel_launch(void* const* d_in, const int* in_sizes, int n_in, void* d_out, int out_size, void* d_ws, size_t ws_size, hipStream_t stream) {
    static int grid = 0;
    if (grid == 0) {
        if (n_in != 27 || in_sizes[0] != T * DM || out_size != T * DM || ws_size < WS_END) { fprintf(stderr, "kernel_launch: shape/workspace mismatch (n_in %d, in0 %d, out %d, ws %zu)\n", n_in, n_in > 0 ? in_sizes[0] : -1, out_size, ws_size); grid = -1; return; }
        int dev = 0, cus = 0, per_cu = 0;
        if (hipGetDevice(&dev) != hipSuccess || hipDeviceGetAttribute(&cus, hipDeviceAttributeMultiprocessorCount, dev) != hipSuccess) { grid = -1; return; }
        if (hipFuncSetAttribute((const void*)mega_fwd, hipFuncAttributeMaxDynamicSharedMemorySize, LDS_BYTES) != hipSuccess) { fprintf(stderr, "kernel_launch: hipFuncSetAttribute failed\n"); grid = -1; return; }
        if (hipOccupancyMaxActiveBlocksPerMultiprocessor(&per_cu, (const void*)mega_fwd, NWAVES * 64, LDS_BYTES) != hipSuccess || per_cu < 1) { fprintf(stderr, "kernel_launch: occupancy query says %d\n", per_cu); }
        (void)hipGetLastError();
        grid = cus;
    }
    if (grid < 0) return;
    if (hipMemsetAsync((char*)d_ws + WS_CTL, 0, CTL_ZERO_BYTES, stream) != hipSuccess) return;
    Args a{};
    for (int i = 0; i < 27; ++i) a.in[i] = (const float*)d_in[i];
    a.out = (float*)d_out; a.ws = (unsigned char*)d_ws;
#if MK_PER_PHASE
    for (int p = 0; p < N_PHASES; ++p) { a.ph_lo = p; a.ph_hi = p + 1; hipLaunchKernelGGL(mega_fwd, dim3(grid), dim3(NWAVES * 64), LDS_BYTES, stream, a); }
#else
    a.ph_lo = 0; a.ph_hi = N_PHASES; hipLaunchKernelGGL(mega_fwd, dim3(grid), dim3(NWAVES * 64), LDS_BYTES, stream, a);
#endif
}
```
